# Optimizing an MI355X kernel written in HIP

```python
import jax, jax.numpy as jnp
from jax import lax
import numpy as np

D_MODEL = 2048
BATCH = 8
SEQ = 4096
DEPTH = 1

HEAD_DIM = 64
N_Q_HEADS = 16
N_KV_HEADS = 4
ATTN_WIDTH = N_Q_HEADS * HEAD_DIM
KV_WIDTH = N_KV_HEADS * HEAD_DIM
CONV_WIDTH = D_MODEL - ATTN_WIDTH
CONV_GROUPS = 16
CONV_GROUP_DIM = CONV_WIDTH // CONV_GROUPS
CONV_K = 3
IN_COLS = ATTN_WIDTH + 2 * KV_WIDTH + 3 * CONV_WIDTH

WINDOW = 128
ROPE_THETA = 500000.0
ROPE_DIM = HEAD_DIM // 4
ATTN_SCALE = HEAD_DIM ** -0.5
NEG_INF = -1e30

PEER_HEADS = 8
PEER_NKEYS = 128
PEER_N = PEER_NKEYS * PEER_NKEYS
PEER_DKEY = 256
PEER_HALF = PEER_DKEY // 2
PEER_TOPK = 16
PEER_CHUNK = 128

EPS = 1e-6

kernel_name = "hymba_swa_shortconv_peer_adaln"


def rmsnorm(x, gain):
    xf = x.astype(jnp.float32)
    y = xf * lax.rsqrt(jnp.mean(xf * xf, axis=-1, keepdims=True) + EPS)
    return (y * gain.astype(jnp.float32)).astype(x.dtype)


def head_rmsnorm(y, gain, n_heads):
    b, s, w = y.shape
    yf = y.reshape(b, s, n_heads, w // n_heads).astype(jnp.float32)
    yf = yf * lax.rsqrt(jnp.mean(yf * yf, axis=-1, keepdims=True) + EPS)
    return (yf.reshape(b, s, w) * gain.astype(jnp.float32)).astype(y.dtype)


def partial_rope(t, cos, sin):
    half = ROPE_DIM // 2
    t1 = t[..., :half]
    t2 = t[..., half:ROPE_DIM]
    rot = jnp.concatenate([t1 * cos - t2 * sin, t2 * cos + t1 * sin], axis=-1)
    return jnp.concatenate([rot.astype(t.dtype), t[..., ROPE_DIM:]], axis=-1)


def sliding_window_attention(q, k, v, sinks):
    b, s = q.shape[:2]
    nb = s // WINDOW
    g = N_Q_HEADS // N_KV_HEADS
    qb = q.reshape(b, nb, WINDOW, N_KV_HEADS, g, HEAD_DIM).transpose(1, 0, 2, 3, 4, 5)

    def band(t):
        tb = t.reshape(b, nb, WINDOW, N_KV_HEADS, HEAD_DIM)
        prev = jnp.concatenate([jnp.zeros_like(tb[:, :1]), tb[:, :-1]], axis=1)
        return jnp.concatenate([prev, tb], axis=2).transpose(1, 0, 2, 3, 4)

    kb, vb = band(k), band(v)
    sink = sinks.astype(jnp.float32).reshape(1, N_KV_HEADS, g, 1, 1)
    qi = jnp.arange(WINDOW)[:, None]
    kj = jnp.arange(2 * WINDOW)[None, :]
    diff = WINDOW + qi - kj
    band_mask = (diff >= 0) & (diff < WINDOW)

    def one_block(args):
        qn, kn, vn, n = args
        sc = jnp.einsum('bqhgd,bkhd->bhgqk', qn, kn,
                        preferred_element_type=jnp.float32) * ATTN_SCALE
        key_pos = (n - 1) * WINDOW + kj
        mask = band_mask & (key_pos >= 0)
        sc = jnp.where(mask, sc, NEG_INF)
        m = jnp.maximum(jnp.max(sc, axis=-1, keepdims=True), sink)
        p = jnp.exp(sc - m)
        denom = jnp.sum(p, axis=-1, keepdims=True) + jnp.exp(sink - m)
        probs = (p / denom).astype(vn.dtype)
        return jnp.einsum('bhgqk,bkhd->bqhgd', probs, vn)

    out = lax.map(one_block, (qb, kb, vb, jnp.arange(nb)))
    return out.transpose(1, 0, 2, 3, 4, 5).reshape(b, s, ATTN_WIDTH)


def short_conv(bg, cg, hc, conv_w):
    s = hc.shape[1]
    u = cg * hc
    upad = jnp.pad(u, ((0, 0), (CONV_K - 1, 0), (0, 0)))
    acc = conv_w[0] * upad[:, 0:s]
    for tap in range(1, CONV_K):
        acc = acc + conv_w[tap] * upad[:, tap:tap + s]
    return bg * acc


def peer(h, w_pq, peer_subkeys, peer_u, peer_v):
    b, s, d = h.shape
    q = jnp.einsum('bsd,de->bse', h, w_pq).reshape(b, s, PEER_HEADS, PEER_DKEY)
    q1, q2 = q[..., :PEER_HALF], q[..., PEER_HALF:]
    s1 = jnp.einsum('bshd,hkd->bshk', q1, peer_subkeys[:, 0], preferred_element_type=jnp.float32)
    s2 = jnp.einsum('bshd,hkd->bshk', q2, peer_subkeys[:, 1], preferred_element_type=jnp.float32)
    t1, i1 = lax.top_k(s1, PEER_TOPK)
    t2, i2 = lax.top_k(s2, PEER_TOPK)
    cand = (t1[..., :, None] + t2[..., None, :]).reshape(b, s, PEER_HEADS, PEER_TOPK * PEER_TOPK)
    ts, ci = lax.top_k(cand, PEER_TOPK)
    e1 = jnp.take_along_axis(i1, ci // PEER_TOPK, axis=-1)
    e2 = jnp.take_along_axis(i2, ci % PEER_TOPK, axis=-1)
    expert = e1 * PEER_NKEYS + e2
    gates = jax.nn.softmax(ts, axis=-1).astype(h.dtype)

    n_tok = b * s
    n_chunk = n_tok // PEER_CHUNK
    xt = h.reshape(n_chunk, PEER_CHUNK, d)
    idx = expert.reshape(n_chunk, PEER_CHUNK, PEER_HEADS * PEER_TOPK)
    gw = gates.reshape(n_chunk, PEER_CHUNK, PEER_HEADS * PEER_TOPK)

    def chunk_fn(args):
        xc, ic, gc = args
        u = peer_u[ic]
        a = jax.nn.gelu(jnp.einsum('cd,ced->ce', xc, u), approximate=False)
        vv = peer_v[ic]
        return jnp.einsum('ce,ced->cd', gc * a, vv)

    y = lax.map(chunk_fn, (xt, idx, gw))
    return y.reshape(b, s, d)


def setup_inputs(seed: int = 0) -> dict:
    key = jax.random.key(seed)
    ks = jax.random.split(key, 20)
    f32 = jnp.float32
    nrm = lambda k, shape, scale: jax.random.normal(k, shape, f32) * scale
    return {
        "x": nrm(ks[0], (BATCH, SEQ, D_MODEL), 1.0),
        "c": nrm(ks[1], (BATCH, D_MODEL), 1.0),
        "w_ada": nrm(ks[2], (D_MODEL, 6 * D_MODEL), 0.5 * D_MODEL ** -0.5),
        "b_ada": nrm(ks[3], (6 * D_MODEL,), 0.01),
        "g_norm1": 1.0 + nrm(ks[4], (D_MODEL,), 0.02),
        "w_in": nrm(ks[5], (D_MODEL, IN_COLS), D_MODEL ** -0.5),
        "g_q": 1.0 + nrm(ks[6], (HEAD_DIM,), 0.02),
        "g_k": 1.0 + nrm(ks[7], (HEAD_DIM,), 0.02),
        "sinks": nrm(ks[8], (N_Q_HEADS,), 0.5),
        "conv_w": nrm(ks[9], (CONV_K, CONV_WIDTH), CONV_K ** -0.5),
        "g_out_attn": 1.0 + nrm(ks[10], (ATTN_WIDTH,), 0.02),
        "g_out_conv": 1.0 + nrm(ks[11], (CONV_WIDTH,), 0.02),
        "w_out": nrm(ks[12], (D_MODEL, D_MODEL), D_MODEL ** -0.5),
        "g_norm2": 1.0 + nrm(ks[13], (D_MODEL,), 0.02),
        "w_pq": nrm(ks[14], (D_MODEL, PEER_HEADS * PEER_DKEY), D_MODEL ** -0.5),
        "peer_subkeys": nrm(ks[15], (PEER_HEADS, 2, PEER_NKEYS, PEER_HALF), PEER_HALF ** -0.5),
        "peer_u": nrm(ks[16], (PEER_N, D_MODEL), D_MODEL ** -0.5),
        "peer_v": nrm(ks[17], (PEER_N, D_MODEL), 0.5),
    }


def reference(x, c, w_ada, b_ada, g_norm1, w_in, g_q, g_k, sinks, conv_w,
              g_out_attn, g_out_conv, w_out, g_norm2, w_pq, peer_subkeys,
              peer_u, peer_v):
    b, s, d = x.shape
    pos = jnp.arange(s, dtype=jnp.float32)
    inv_freq = ROPE_THETA ** (-jnp.arange(0, ROPE_DIM, 2, dtype=jnp.float32) / ROPE_DIM)
    ang = pos[:, None] * inv_freq[None, :]
    cos = jnp.cos(ang)[None, :, None, :].astype(x.dtype)
    sin = jnp.sin(ang)[None, :, None, :].astype(x.dtype)

    for _ in range(DEPTH):
        mod = jnp.einsum('bd,de->be', jax.nn.silu(c), w_ada) + b_ada
        sh1, sc1, gt1, sh2, sc2, gt2 = jnp.split(mod[:, None, :], 6, axis=-1)

        h1 = rmsnorm(x, g_norm1) * (1.0 + sc1) + sh1
        proj = jnp.einsum('bsd,de->bse', h1, w_in)
        o = 0
        q = proj[..., o:o + ATTN_WIDTH]; o += ATTN_WIDTH
        k = proj[..., o:o + KV_WIDTH]; o += KV_WIDTH
        v = proj[..., o:o + KV_WIDTH]; o += KV_WIDTH
        bg = proj[..., o:o + CONV_WIDTH]; o += CONV_WIDTH
        cg = proj[..., o:o + CONV_WIDTH]; o += CONV_WIDTH
        hc = proj[..., o:o + CONV_WIDTH]

        q = rmsnorm(q.reshape(b, s, N_Q_HEADS, HEAD_DIM), g_q)
        k = rmsnorm(k.reshape(b, s, N_KV_HEADS, HEAD_DIM), g_k)
        v = v.reshape(b, s, N_KV_HEADS, HEAD_DIM)
        q = partial_rope(q, cos, sin)
        k = partial_rope(k, cos, sin)
        attn = sliding_window_attention(q, k, v, sinks)
        conv = short_conv(bg, cg, hc, conv_w)

        mixed = jnp.concatenate([head_rmsnorm(attn, g_out_attn, N_Q_HEADS),
                                 head_rmsnorm(conv, g_out_conv, CONV_GROUPS)], axis=-1)
        x = x + gt1 * jnp.einsum('bse,ed->bsd', mixed, w_out)

        h2 = rmsnorm(x, g_norm2) * (1.0 + sc2) + sh2
        x = x + gt2 * peer(h2, w_pq, peer_subkeys, peer_u, peer_v)
    return x
```

```cpp
#include <hip/hip_runtime.h>
#include <cstdio>
#include <cstdint>

#ifndef MK_N_LAUNCHES
#define MK_N_LAUNCHES 1
#endif

#ifndef REP0
#define REP0 1
#endif
#ifndef REP0A
#define REP0A 1
#endif
#ifndef REP0C
#define REP0C 1
#endif
#ifndef REP1
#define REP1 1
#endif
#ifndef REP2
#define REP2 1
#endif
#ifndef REP3
#define REP3 1
#endif
#ifndef REP4
#define REP4 1
#endif
#ifndef REP5
#define REP5 1
#endif
#ifndef REP6
#define REP6 1
#endif
#ifndef REP7A
#define REP7A 1
#endif
#ifndef REP7U
#define REP7U 1
#endif
#ifndef REPSEL
#define REPSEL 1
#endif
#ifndef REP7V
#define REP7V 1
#endif
#ifndef REPSC
#define REPSC 1
#endif

#define LAS __attribute__((address_space(3)))
#define GAS __attribute__((address_space(1)))
typedef unsigned short bf16_t;
typedef short bf16x8 __attribute__((ext_vector_type(8)));
typedef short s16x4 __attribute__((ext_vector_type(4)));
typedef float f32x4 __attribute__((ext_vector_type(4)));
typedef float f32x2 __attribute__((ext_vector_type(2)));
typedef unsigned u32x4 __attribute__((ext_vector_type(4)));
typedef unsigned u32x2 __attribute__((ext_vector_type(2)));
typedef int i32x4 __attribute__((ext_vector_type(4)));
typedef __bf16 bf16x2_t __attribute__((ext_vector_type(2)));

constexpr int DM = 2048, BATCH = 8, SEQ = 4096, MTOK = BATCH * SEQ;
constexpr int INC = 4608;
constexpr int COL_K = 1024, COL_V = 1280, COL_B = 1536, COL_C = 2560, COL_H = 3584;
constexpr int MODW = 6 * DM;
constexpr int PEER_N = 16384;
constexpr float EPS = 1e-6f;
constexpr float LOG2E = 1.4426950408889634f;
constexpr float MIX_SCALE = 127.0f / 6.0f;
constexpr float V_SCALE = 16.0f;

constexpr size_t MiB = 1u << 20;
constexpr size_t WS_CTL = 0, CTL_ZERO_BYTES = 1 * MiB;
constexpr size_t WS_MOD = 1 * MiB;
constexpr size_t WS_ROPE = 1 * MiB + 512 * 1024;
constexpr size_t WS_SK = 2 * MiB;
constexpr size_t WS_WIN = 4 * MiB;
constexpr size_t WS_WOUT = 22 * MiB;
constexpr size_t WS_WPQ = 30 * MiB;
constexpr size_t WS_SU = 3 * MiB;
constexpr size_t WS_SH = 3 * MiB + 256 * 1024;
constexpr size_t WS_SX1 = 3 * MiB + 512 * 1024;
constexpr size_t WS_UB = 40 * MiB;
constexpr size_t WS_VB = 104 * MiB;
constexpr size_t WS_XN = 168 * MiB;
constexpr size_t WS_PROJ = 296 * MiB;
constexpr size_t WS_QP = WS_PROJ;
constexpr size_t WS_X1B = WS_PROJ + 128 * MiB;
constexpr size_t WS_MIXED = 584 * MiB;
constexpr size_t WS_H8 = 712 * MiB;
constexpr size_t WS_END = 776 * MiB;
constexpr int CW_BAR = 4096;
constexpr int CW_CMX_IN = 32768, CW_CMX_OUT = CW_CMX_IN + 4608, CW_CMX_PQ = CW_CMX_OUT + 2048;

constexpr int RING_BYTES = 131072;
constexpr int LDSCTL_OFF = RING_BYTES, MISC_OFF = LDSCTL_OFF + 320;
constexpr int LDS_BYTES = 148480;
constexpr int NWAVES = 8;

#define LDS_WAIT() asm volatile("s_waitcnt lgkmcnt(0)" ::: "memory")
#define VM_WAIT() asm volatile("s_waitcnt vmcnt(0)" ::: "memory")

__device__ __forceinline__ unsigned cvtpk(float lo, float hi) { f32x2 v = {lo, hi}; bf16x2_t b = __builtin_convertvector(v, bf16x2_t); return __builtin_bit_cast(unsigned, b); }
__device__ __forceinline__ float bf_lo(unsigned u) { return __uint_as_float(u << 16); }
__device__ __forceinline__ float bf_hi(unsigned u) { return __uint_as_float(u & 0xffff0000u); }
__device__ __forceinline__ float dot2bf(unsigned a, unsigned b, float c) { return __builtin_amdgcn_fdot2_f32_bf16(__builtin_bit_cast(bf16x2_t, a), __builtin_bit_cast(bf16x2_t, b), c, false); }
__device__ __forceinline__ int fresh_lane() { int l = (int)__builtin_amdgcn_mbcnt_hi(~0u, __builtin_amdgcn_mbcnt_lo(~0u, 0u)); asm volatile("" : "+v"(l)); return l; }
__device__ __forceinline__ float xrow_sum(float v) {
    const u32x2 a = __builtin_amdgcn_permlane16_swap(__float_as_uint(v), __float_as_uint(v), false, false); v = __uint_as_float(a.x) + __uint_as_float(a.y);
    const u32x2 b = __builtin_amdgcn_permlane32_swap(__float_as_uint(v), __float_as_uint(v), false, false); return __uint_as_float(b.x) + __uint_as_float(b.y);
}
__device__ __forceinline__ float xrow_max(float v) {
    const u32x2 a = __builtin_amdgcn_permlane16_swap(__float_as_uint(v), __float_as_uint(v), false, false); v = fmaxf(__uint_as_float(a.x), __uint_as_float(a.y));
    const u32x2 b = __builtin_amdgcn_permlane32_swap(__float_as_uint(v), __float_as_uint(v), false, false); return fmaxf(__uint_as_float(b.x), __uint_as_float(b.y));
}
__device__ __forceinline__ float xrow16_other(float v, bool odd_row) {
    const u32x2 a = __builtin_amdgcn_permlane16_swap(__float_as_uint(v), __float_as_uint(v), false, false); return __uint_as_float(odd_row ? a.x : a.y);
}

template <int CTRL> __device__ __forceinline__ float dpp_add(float v) { return v + __int_as_float(__builtin_amdgcn_update_dpp(0, __float_as_int(v), CTRL, 0xF, 0xF, false)); }
template <int CTRL> __device__ __forceinline__ float dpp_mov(float v) { return __int_as_float(__builtin_amdgcn_update_dpp(0, __float_as_int(v), CTRL, 0xF, 0xF, true)); }
__device__ __forceinline__ float allred8(float v) { v = dpp_add<0x141>(v); v = dpp_add<0x1B>(v); v = dpp_add<0xB1>(v); return v; }

template <int CTRL> __device__ __forceinline__ float dpp_max(float v) { return fmaxf(v, __int_as_float(__builtin_amdgcn_update_dpp(0, __float_as_int(v), CTRL, 0xF, 0xF, false))); }
__device__ __forceinline__ float wave_sum(float v) { v = dpp_add<0xB1>(v); v = dpp_add<0x4E>(v); v = dpp_add<0x141>(v); v = dpp_add<0x140>(v); return xrow_sum(v); }
__device__ __forceinline__ float wave_max(float v) { v = dpp_max<0xB1>(v); v = dpp_max<0x4E>(v); v = dpp_max<0x141>(v); v = dpp_max<0x140>(v); return xrow_max(v); }
__device__ __forceinline__ unsigned pack_i8x4_sat(f32x4 x, float inv) {
    const int a = (int)rintf(fminf(fmaxf(x[0] * inv, -127.f), 127.f)), b = (int)rintf(fminf(fmaxf(x[1] * inv, -127.f), 127.f)), c = (int)rintf(fminf(fmaxf(x[2] * inv, -127.f), 127.f)), d = (int)rintf(fminf(fmaxf(x[3] * inv, -127.f), 127.f));
    return ((unsigned)a & 0xffu) | (((unsigned)b & 0xffu) << 8) | (((unsigned)c & 0xffu) << 16) | ((unsigned)d << 24);
}
__device__ __forceinline__ unsigned pack_i8x4(f32x4 x, float inv) {
    const int a = (int)rintf(x[0] * inv), b = (int)rintf(x[1] * inv), c = (int)rintf(x[2] * inv), d = (int)rintf(x[3] * inv);
    return ((unsigned)a & 0xffu) | (((unsigned)b & 0xffu) << 8) | (((unsigned)c & 0xffu) << 16) | ((unsigned)d << 24);
}
template <int CTRL> __device__ __forceinline__ int dpp_movi(int v) { return __builtin_amdgcn_update_dpp(0, v, CTRL, 0xF, 0xF, true); }

namespace pg8 {
#define PG8_LAS __attribute__((address_space(3)))
constexpr int BM = 256, BK = 64, HALF = 128, HTB = HALF * BK * 2, STAGE_BYTES = 8 * HTB, NXCD = 8, WGM = 4;
__host__ __device__ __forceinline__ int lds_byte(int r, int c) { const int st = (r >> 4) * 2 + (c >> 5), rr = r & 15, cc = c & 31, ob = rr * 64 + cc * 2; return st * 1024 + (ob ^ (((ob >> 9) & 1) << 5)); }
__host__ __device__ __forceinline__ void stage_rc(int b, int& R, int& C) { const int st = b / 1024, sb = b % 1024, swz = sb ^ (((sb >> 9) & 1) << 5); R = (st >> 1) * 16 + swz / 64; C = (st & 1) * 32 + (swz % 64) / 2; }
__host__ __device__ __forceinline__ int perm32(int rho) { const int n = rho >> 4, i = rho & 15; return 8 * (i >> 2) + 4 * n + (i & 3); }
struct Unit { int pm, pn; };
struct Gemm { const bf16_t* A; const bf16_t* Bt; int M, N, K; };
struct StaticOrder {
    int nM, nN, nwg, G, c;
    __host__ __device__ void init(int M, int N, int G_, int c_) { nM = M / BM; nN = N / BM; nwg = nM * nN; G = G_; c = c_; }
    __host__ __device__ bool next(int i, Unit& u) const {
        const long L = (long)i * G + c; if (L >= nwg) return false;
        int wgid = (int)L; { const int q = nwg / NXCD, r = nwg % NXCD, xcd = wgid % NXCD, off = wgid / NXCD; wgid = (xcd < r ? xcd * (q + 1) : r * (q + 1) + (xcd - r) * q) + off; }
        const int nig = WGM * nN, gid = wgid / nig, fm = gid * WGM, gsz = (nM - fm) < WGM ? (nM - fm) : WGM;
        u.pm = fm + ((wgid % nig) % gsz); u.pn = (wgid % nig) / gsz; return true;
    }
    __device__ __forceinline__ void a_ready(const Unit&) const {}
    __device__ __forceinline__ void done(const Unit&) const {}
};
__device__ __forceinline__ unsigned cvt_pk_bf16(float lo, float hi) { unsigned r; asm volatile("v_cvt_pk_bf16_f32 %0, %1, %2" : "=v"(r) : "v"(lo), "v"(hi)); return r; }

struct EpiBf16 {
    static constexpr bool PERM = true, AFTER_DRAIN = false;
    bf16_t* O; int ldc;
    __device__ __forceinline__ void operator()(const f32x4 (&acc)[2][2][4][2], const Unit& u, int wr, int wc, int fr, int fq) const {
        const int row0 = u.pm * BM + wr * 64 + fr, col0 = u.pn * BM + wc * 32 + 8 * fq;
#pragma unroll
        for (int ai = 0; ai < 2; ++ai)
#pragma unroll
            for (int m = 0; m < 4; ++m) { bf16_t* rowp = O + (size_t)(row0 + ai * HALF + m * 16) * ldc + col0;
#pragma unroll
                for (int bj = 0; bj < 2; ++bj) { const f32x4 v0 = acc[ai][bj][m][0], v1 = acc[ai][bj][m][1];
                    u32x4 w; w.x = cvt_pk_bf16(v0[0], v0[1]); w.y = cvt_pk_bf16(v0[2], v0[3]); w.z = cvt_pk_bf16(v1[0], v1[1]); w.w = cvt_pk_bf16(v1[2], v1[3]);
                    *(u32x4*)(rowp + bj * HALF) = w; } }
    }
};
struct EpiBf16I8 {
    static constexpr bool PERM = true, AFTER_DRAIN = false;
    bf16_t* O; int ldc; const float* srow; const unsigned* cmax;
    __device__ __forceinline__ void operator()(const f32x4 (&acc)[2][2][4][2], const Unit& u, int wr, int wc, int fr, int fq) const {
        const int row0 = u.pm * BM + wr * 64 + fr, col0 = u.pn * BM + wc * 32 + 8 * fq;
        f32x4 sc[2][2];
#pragma unroll
        for (int bj = 0; bj < 2; ++bj)
#pragma unroll
            for (int n = 0; n < 2; ++n) { const u32x4 b = *(const u32x4*)(cmax + col0 + bj * HALF + 4 * n);
#pragma unroll
                for (int i = 0; i < 4; ++i) sc[bj][n][i] = __uint_as_float(b[i]) * (1.0f / 127.0f); }
        float srv[2][4];
#pragma unroll
        for (int ai = 0; ai < 2; ++ai)
#pragma unroll
            for (int m = 0; m < 4; ++m) srv[ai][m] = srow[row0 + ai * HALF + m * 16];
#pragma unroll
        for (int ai = 0; ai < 2; ++ai)
#pragma unroll
            for (int m = 0; m < 4; ++m) { const int row = row0 + ai * HALF + m * 16; const float sr = srv[ai][m]; bf16_t* rowp = O + (size_t)row * ldc + col0;
#pragma unroll
                for (int bj = 0; bj < 2; ++bj) { const i32x4 a0 = __builtin_bit_cast(i32x4, acc[ai][bj][m][0]), a1 = __builtin_bit_cast(i32x4, acc[ai][bj][m][1]);
                    f32x4 v0, v1;
#pragma unroll
                    for (int i = 0; i < 4; ++i) { v0[i] = (float)a0[i] * sr * sc[bj][0][i]; v1[i] = (float)a1[i] * sr * sc[bj][1][i]; }
                    u32x4 w; w.x = cvt_pk_bf16(v0[0], v0[1]); w.y = cvt_pk_bf16(v0[2], v0[3]); w.z = cvt_pk_bf16(v1[0], v1[1]); w.w = cvt_pk_bf16(v1[2], v1[3]);
                    *(u32x4*)(rowp + bj * HALF) = w; } }
    }
};
struct EpiScoresI8 {
    static constexpr bool PERM = true, AFTER_DRAIN = false;
    bf16_t* O; int M; const float* srow; const unsigned* cmax;
    __device__ __forceinline__ void operator()(const f32x4 (&acc)[2][2][4][2], const Unit& u, int wr, int wc, int fr, int fq) const {
        const int row0 = u.pm * BM + wr * 64 + fr, col0 = u.pn * BM + wc * 32 + 8 * fq;
        f32x4 sc[2][2];
#pragma unroll
        for (int bj = 0; bj < 2; ++bj)
#pragma unroll
            for (int n = 0; n < 2; ++n) { const u32x4 b = *(const u32x4*)(cmax + col0 + bj * HALF + 4 * n);
#pragma unroll
                for (int i = 0; i < 4; ++i) sc[bj][n][i] = __uint_as_float(b[i]) * (1.0f / 127.0f); }
        float srv[2][4];
#pragma unroll
        for (int ai = 0; ai < 2; ++ai)
#pragma unroll
            for (int m = 0; m < 4; ++m) srv[ai][m] = srow[row0 + ai * HALF + m * 16];
#pragma unroll
        for (int ai = 0; ai < 2; ++ai)
#pragma unroll
            for (int m = 0; m < 4; ++m) { const int row = row0 + ai * HALF + m * 16; const float sr = srv[ai][m];
#pragma unroll
                for (int bj = 0; bj < 2; ++bj) { const i32x4 a0 = __builtin_bit_cast(i32x4, acc[ai][bj][m][0]), a1 = __builtin_bit_cast(i32x4, acc[ai][bj][m][1]);
                    f32x4 v0, v1;
#pragma unroll
                    for (int i = 0; i < 4; ++i) { v0[i] = (float)a0[i] * sr * sc[bj][0][i]; v1[i] = (float)a1[i] * sr * sc[bj][1][i]; }
                    u32x4 w; w.x = cvt_pk_bf16(v0[0], v0[1]); w.y = cvt_pk_bf16(v0[2], v0[3]); w.z = cvt_pk_bf16(v1[0], v1[1]); w.w = cvt_pk_bf16(v1[2], v1[3]);
                    *(u32x4*)(O + ((size_t)(u.pn * 32 + bj * 16 + wc * 4 + fq) * M + row) * 8) = w; } }
    }
};
struct EpiProjI8 {
    static constexpr bool PERM = true, AFTER_DRAIN = false;
    bf16_t* O; int ldc; const float* srow; const unsigned* cmax;
    __device__ __forceinline__ void operator()(const f32x4 (&acc)[2][2][4][2], const Unit& u, int wr, int wc, int fr, int fq) const {
        const int row0 = u.pm * BM + wr * 64 + fr;
        const bool prod = u.pn >= 10;
        const int col0 = prod ? 2560 + (u.pn - 10) * 128 + wc * 32 + 8 * fq : u.pn * BM + wc * 32 + 8 * fq;
        const int sc0 = col0, sc1 = prod ? col0 + 1024 : col0 + HALF;
        f32x4 sc[2][2];
#pragma unroll
        for (int n = 0; n < 2; ++n) { const u32x4 b0 = *(const u32x4*)(cmax + sc0 + 4 * n), b1 = *(const u32x4*)(cmax + sc1 + 4 * n);
#pragma unroll
            for (int i = 0; i < 4; ++i) { sc[0][n][i] = __uint_as_float(b0[i]) * (1.0f / 127.0f); sc[1][n][i] = __uint_as_float(b1[i]) * (1.0f / 127.0f); } }
        float srv[2][4];
#pragma unroll
        for (int ai = 0; ai < 2; ++ai)
#pragma unroll
            for (int m = 0; m < 4; ++m) srv[ai][m] = srow[row0 + ai * HALF + m * 16];
#pragma unroll
        for (int ai = 0; ai < 2; ++ai)
#pragma unroll
            for (int m = 0; m < 4; ++m) { const float sr = srv[ai][m]; bf16_t* rowp = O + (size_t)(row0 + ai * HALF + m * 16) * ldc + col0;
                f32x4 v[2][2];
#pragma unroll
                for (int bj = 0; bj < 2; ++bj) { const i32x4 a0 = __builtin_bit_cast(i32x4, acc[ai][bj][m][0]), a1 = __builtin_bit_cast(i32x4, acc[ai][bj][m][1]);
#pragma unroll
                    for (int i = 0; i < 4; ++i) { v[bj][0][i] = (float)a0[i] * sr * sc[bj][0][i]; v[bj][1][i] = (float)a1[i] * sr * sc[bj][1][i]; } }
                if (prod) { const f32x4 p0 = v[0][0] * v[1][0], p1 = v[0][1] * v[1][1];
                    u32x4 w; w.x = cvt_pk_bf16(p0[0], p0[1]); w.y = cvt_pk_bf16(p0[2], p0[3]); w.z = cvt_pk_bf16(p1[0], p1[1]); w.w = cvt_pk_bf16(p1[2], p1[3]);
                    *(u32x4*)rowp = w;
                } else {
#pragma unroll
                    for (int bj = 0; bj < 2; ++bj) { u32x4 w; w.x = cvt_pk_bf16(v[bj][0][0], v[bj][0][1]); w.y = cvt_pk_bf16(v[bj][0][2], v[bj][0][3]); w.z = cvt_pk_bf16(v[bj][1][0], v[bj][1][1]); w.w = cvt_pk_bf16(v[bj][1][2], v[bj][1][3]);
                        *(u32x4*)(rowp + bj * HALF) = w; } }
            }
    }
};
struct EpiResGateI8 {
    static constexpr bool PERM = false, AFTER_DRAIN = false;
    const float* base; float* out; int ldc; const float* gate; int gate_stride; float srow_const; const unsigned* cmax;
    __device__ __forceinline__ void operator()(const f32x4 (&acc)[2][2][4][2], const Unit& u, int wr, int wc, int fr, int fq) const {
        const int row0 = u.pm * BM + wr * 64 + fr, col0 = u.pn * BM + wc * 32 + 4 * fq;
        const float* g = gate + (size_t)((u.pm * BM) >> 12) * gate_stride + col0;
        f32x4 gv[2][2];
#pragma unroll
        for (int bj = 0; bj < 2; ++bj)
#pragma unroll
            for (int n = 0; n < 2; ++n) { const f32x4 gg = *(const f32x4*)(g + bj * HALF + n * 16); const u32x4 b = *(const u32x4*)(cmax + col0 + bj * HALF + n * 16);
#pragma unroll
                for (int i = 0; i < 4; ++i) gv[bj][n][i] = gg[i] * __uint_as_float(b[i]) * (srow_const * (1.0f / 127.0f)); }
#pragma unroll
        for (int g2 = 0; g2 < 4; ++g2) {
            const int ai = g2 >> 1, m0 = (g2 & 1) * 2;
            f32x4 bs[2][2][2];
#pragma unroll
            for (int mm = 0; mm < 2; ++mm)
#pragma unroll
                for (int bj = 0; bj < 2; ++bj)
#pragma unroll
                    for (int n = 0; n < 2; ++n) bs[mm][bj][n] = *(const f32x4*)(base + (size_t)(row0 + ai * HALF + (m0 + mm) * 16) * ldc + col0 + bj * HALF + n * 16);
            asm volatile("" ::: "memory");
#pragma unroll
            for (int mm = 0; mm < 2; ++mm) { const size_t off = (size_t)(row0 + ai * HALF + (m0 + mm) * 16) * ldc + col0;
#pragma unroll
                for (int bj = 0; bj < 2; ++bj)
#pragma unroll
                    for (int n = 0; n < 2; ++n) { const i32x4 a = __builtin_bit_cast(i32x4, acc[ai][bj][m0 + mm][n]);
                        f32x4 o;
#pragma unroll
                        for (int i = 0; i < 4; ++i) o[i] = bs[mm][bj][n][i] + gv[bj][n][i] * (float)a[i];
                        *(f32x4*)(out + off + bj * HALF + n * 16) = o; } }
            asm volatile("" ::: "memory");
        }
    }
};
struct EpiResGateBf16I8 {
    static constexpr bool PERM = true, AFTER_DRAIN = false;
    const float* base; bf16_t* O; int ldc; const float* gate; int gate_stride; float srow_const; const unsigned* cmax;
    __device__ __forceinline__ void operator()(const f32x4 (&acc)[2][2][4][2], const Unit& u, int wr, int wc, int fr, int fq) const {
        const int row0 = u.pm * BM + wr * 64 + fr, col0 = u.pn * BM + wc * 32 + 8 * fq;
        const float* g = gate + (size_t)((u.pm * BM) >> 12) * gate_stride + col0;
        f32x4 gv[2][2];
#pragma unroll
        for (int bj = 0; bj < 2; ++bj)
#pragma unroll
            for (int n = 0; n < 2; ++n) { const f32x4 gg = *(const f32x4*)(g + bj * HALF + 4 * n); const u32x4 b = *(const u32x4*)(cmax + col0 + bj * HALF + 4 * n);
#pragma unroll
                for (int i = 0; i < 4; ++i) gv[bj][n][i] = gg[i] * __uint_as_float(b[i]) * (srow_const * (1.0f / 127.0f)); }
#pragma unroll
        for (int g2 = 0; g2 < 2; ++g2) {
            const int ai = g2, m0 = 0;
            f32x4 bs[4][2][2];
#pragma unroll
            for (int mm = 0; mm < 4; ++mm)
#pragma unroll
                for (int bj = 0; bj < 2; ++bj)
#pragma unroll
                    for (int n = 0; n < 2; ++n) bs[mm][bj][n] = *(const f32x4*)(base + (size_t)(row0 + ai * HALF + (m0 + mm) * 16) * ldc + col0 + bj * HALF + 4 * n);
            asm volatile("" ::: "memory");
#pragma unroll
            for (int mm = 0; mm < 4; ++mm) { bf16_t* rowp = O + (size_t)(row0 + ai * HALF + (m0 + mm) * 16) * ldc + col0;
#pragma unroll
                for (int bj = 0; bj < 2; ++bj) { const i32x4 a0 = __builtin_bit_cast(i32x4, acc[ai][bj][m0 + mm][0]), a1 = __builtin_bit_cast(i32x4, acc[ai][bj][m0 + mm][1]);
                    f32x4 v0, v1;
#pragma unroll
                    for (int i = 0; i < 4; ++i) { v0[i] = bs[mm][bj][0][i] + gv[bj][0][i] * (float)a0[i]; v1[i] = bs[mm][bj][1][i] + gv[bj][1][i] * (float)a1[i]; }
                    u32x4 w; w.x = cvt_pk_bf16(v0[0], v0[1]); w.y = cvt_pk_bf16(v0[2], v0[3]); w.z = cvt_pk_bf16(v1[0], v1[1]); w.w = cvt_pk_bf16(v1[2], v1[3]);
                    *(u32x4*)(rowp + bj * HALF) = w; } }
            asm volatile("" ::: "memory");
        }
    }
};
struct EpiResGate {
    static constexpr bool PERM = false, AFTER_DRAIN = false;
    const float* base; float* out; int ldc; const float* gate; int gate_stride;
    __device__ __forceinline__ void operator()(const f32x4 (&acc)[2][2][4][2], const Unit& u, int wr, int wc, int fr, int fq) const {
        const int row0 = u.pm * BM + wr * 64 + fr, col0 = u.pn * BM + wc * 32 + 4 * fq;
        const float* g = gate + (size_t)((u.pm * BM) >> 12) * gate_stride + col0;
        f32x4 gv[2][2];
#pragma unroll
        for (int bj = 0; bj < 2; ++bj)
#pragma unroll
            for (int n = 0; n < 2; ++n) gv[bj][n] = *(const f32x4*)(g + bj * HALF + n * 16);
#pragma unroll
        for (int ai = 0; ai < 2; ++ai)
#pragma unroll
            for (int m = 0; m < 4; ++m) { const size_t off = (size_t)(row0 + ai * HALF + m * 16) * ldc + col0;
#pragma unroll
                for (int bj = 0; bj < 2; ++bj)
#pragma unroll
                    for (int n = 0; n < 2; ++n) { const f32x4 bs = *(const f32x4*)(base + off + bj * HALF + n * 16); *(f32x4*)(out + off + bj * HALF + n * 16) = bs + gv[bj][n] * acc[ai][bj][m][n]; }
                asm volatile("" ::: "memory"); }
    }
};

template <class Epi, class Sched, bool ALIGN_EPI = false, bool SP2 = false, bool I8 = false>
__device__ __forceinline__ void gemm_phase(PG8_LAS unsigned char* lds, const Gemm g, const Sched& S, const Epi& E, const int wid) {
    const int lane = fresh_lane(), tid = wid * 64 + lane, wr = wid >> 2, wc = wid & 3, fr = lane & 15, fq = lane >> 4;
    const int K = g.K, nt = K / BK;
    unsigned voffA[2], voffB[2];
#pragma unroll
    for (int i = 0; i < 2; ++i) { int R, C; stage_rc(tid * 16 + i * 8192, R, C); const int Rb = Epi::PERM ? ((R & ~31) + perm32(R & 31)) : R;
        voffA[i] = (unsigned)(R * K + C) * 2u; voffB[i] = (unsigned)(Rb * K + C) * 2u; }
    const size_t kstep = (size_t)(BK * 2);
    const size_t hstep = (size_t)HALF * K * 2;
    const size_t tstep = 2 * hstep;
    const unsigned ldsw = (unsigned)wid * 1024u;
    const int aoff = lds_byte(wr * 64 + fr, fq * 8), boff = lds_byte(wc * 32 + fr, fq * 8);
#define PG8_SA(b, h) (((b) * 2 + (h)) * HTB)
#define PG8_SB(b, h) ((4 + (b) * 2 + (h)) * HTB)
#define PG8_STAGE(bufoff, gbase, voff) do { _Pragma("unroll") for (int _i = 0; _i < 2; ++_i) \
        __builtin_amdgcn_global_load_lds((const unsigned*)((const char*)(gbase) + (voff)[_i]), (PG8_LAS unsigned*)(lds + (bufoff) + ldsw + _i * 8192), 16, 0, 0); } while (0)
#define PG8_LDA(dst, b, h) do { _Pragma("unroll") for (int m = 0; m < 4; ++m) _Pragma("unroll") for (int k = 0; k < 2; ++k) dst[m][k] = *(const PG8_LAS bf16x8*)(lds + PG8_SA(b, h) + aoff + m * 2048 + k * 1024); } while (0)
#define PG8_LDB(dst, b, h) do { _Pragma("unroll") for (int n = 0; n < 2; ++n) _Pragma("unroll") for (int k = 0; k < 2; ++k) dst[n][k] = *(const PG8_LAS bf16x8*)(lds + PG8_SB(b, h) + boff + n * 2048 + k * 1024); } while (0)
#define PG8_MMA(ai, bj, At, Bt) do { __builtin_amdgcn_s_setprio(1); _Pragma("unroll") for (int m = 0; m < 4; ++m) _Pragma("unroll") for (int n = 0; n < 2; ++n) _Pragma("unroll") for (int k = 0; k < 2; ++k) { \
        if constexpr (I8) acc[ai][bj][m][n] = __builtin_bit_cast(f32x4, __builtin_amdgcn_mfma_i32_16x16x64_i8(__builtin_bit_cast(i32x4, Bt[n][k]), __builtin_bit_cast(i32x4, At[m][k]), __builtin_bit_cast(i32x4, acc[ai][bj][m][n]), 0, 0, 0)); \
        else acc[ai][bj][m][n] = __builtin_amdgcn_mfma_f32_16x16x32_bf16(Bt[n][k], At[m][k], acc[ai][bj][m][n], 0, 0, 0); } __builtin_amdgcn_s_setprio(0); } while (0)
#define PG8_WAIT_V(n) asm volatile("s_waitcnt vmcnt(" #n ")" ::: "memory")
#define PG8_WAIT_L(n) asm volatile("s_waitcnt lgkmcnt(" #n ")" ::: "memory")
#define PG8_BAR __builtin_amdgcn_s_barrier()
#define PG8_SCHED __builtin_amdgcn_sched_barrier(0)
    Unit cur, nxt; int ui = 0;
    if (!S.next(0, cur)) return;
    f32x4 acc[2][2][4][2];
#pragma unroll
    for (int a = 0; a < 2; ++a)
#pragma unroll
        for (int b = 0; b < 2; ++b)
#pragma unroll
            for (int m = 0; m < 4; ++m)
#pragma unroll
                for (int n = 0; n < 2; ++n) acc[a][b][m][n] = (f32x4){0.f, 0.f, 0.f, 0.f};
    bf16x8 At[4][2], B0[2][2], B1[2][2];
    const char* cA = (const char*)g.A + (size_t)cur.pm * tstep; const char* cB = (const char*)g.Bt + (size_t)cur.pn * tstep;
    S.a_ready(cur);
    if constexpr (SP2) {
        PG8_STAGE(PG8_SB(0, 0), cB, voffB); PG8_STAGE(PG8_SB(0, 1), cB + hstep, voffB); PG8_STAGE(PG8_SA(0, 0), cA, voffA); PG8_STAGE(PG8_SA(0, 1), cA + hstep, voffA);
        if (wr == 1) PG8_BAR;
        PG8_WAIT_V(2); PG8_BAR;
        PG8_STAGE(PG8_SB(1, 0), cB + kstep, voffB); PG8_STAGE(PG8_SA(1, 0), cA + kstep, voffA); PG8_STAGE(PG8_SB(1, 1), cB + hstep + kstep, voffB);
        PG8_WAIT_V(6); PG8_BAR;
    } else {
        PG8_STAGE(PG8_SB(0, 0), cB, voffB); PG8_STAGE(PG8_SA(0, 0), cA, voffA); PG8_STAGE(PG8_SB(0, 1), cB + hstep, voffB); PG8_STAGE(PG8_SA(0, 1), cA + hstep, voffA);
        if (wr == 1) PG8_BAR;
        PG8_WAIT_V(4); PG8_BAR;
        PG8_STAGE(PG8_SB(1, 0), cB + kstep, voffB); PG8_STAGE(PG8_SA(1, 0), cA + kstep, voffA); PG8_STAGE(PG8_SB(1, 1), cB + hstep + kstep, voffB);
        PG8_WAIT_V(6); PG8_BAR;
    }
    for (;;) {
        const bool has_next = S.next(ui + 1, nxt);
        const char* nA = has_next ? (const char*)g.A + (size_t)nxt.pm * tstep : cA; const char* nB = has_next ? (const char*)g.Bt + (size_t)nxt.pn * tstep : cB;
        for (int t = 0; t < nt; t += 2) {
            const bool last = (t == nt - 2);
            const char* a1 = cA + (size_t)(t + 1) * kstep;
            const char* a2 = last ? nA : cA + (size_t)(t + 2) * kstep; const char* b2 = last ? nB : cB + (size_t)(t + 2) * kstep;
            const char* a3 = a2 + kstep; const char* b3 = b2 + kstep;
            if (last && has_next) S.a_ready(nxt);
            if constexpr (SP2) {
            PG8_LDB(B0, 0, 0); PG8_LDB(B1, 0, 1); PG8_SCHED; PG8_LDA(At, 0, 0); PG8_STAGE(PG8_SA(1, 1), a1 + hstep, voffA);
            PG8_WAIT_V(8); PG8_WAIT_L(0); PG8_BAR; PG8_MMA(0, 0, At, B0); PG8_MMA(0, 1, At, B1); PG8_BAR; PG8_SCHED;
            PG8_LDA(At, 0, 1); PG8_STAGE(PG8_SB(0, 0), b2, voffB); PG8_STAGE(PG8_SB(0, 1), b2 + hstep, voffB); PG8_STAGE(PG8_SA(0, 0), a2, voffA);
            PG8_WAIT_V(8); PG8_WAIT_L(0); PG8_BAR; PG8_MMA(1, 0, At, B0); PG8_MMA(1, 1, At, B1); PG8_BAR; PG8_SCHED;
            PG8_LDB(B0, 1, 0); PG8_LDB(B1, 1, 1); PG8_SCHED; PG8_LDA(At, 1, 0); PG8_STAGE(PG8_SA(0, 1), a2 + hstep, voffA);
            PG8_WAIT_V(8); PG8_WAIT_L(0); PG8_BAR; PG8_MMA(0, 0, At, B0); PG8_MMA(0, 1, At, B1); PG8_BAR; PG8_SCHED;
            PG8_LDA(At, 1, 1); PG8_STAGE(PG8_SB(1, 0), b3, voffB); PG8_STAGE(PG8_SB(1, 1), b3 + hstep, voffB); PG8_STAGE(PG8_SA(1, 0), a3, voffA);
            PG8_WAIT_V(8); PG8_WAIT_L(0); PG8_BAR; PG8_MMA(1, 0, At, B0); PG8_MMA(1, 1, At, B1); PG8_BAR; PG8_SCHED;
            } else {
            PG8_LDB(B0, 0, 0); PG8_SCHED; PG8_LDA(At, 0, 0); PG8_STAGE(PG8_SA(1, 1), a1 + hstep, voffA);
            PG8_WAIT_L(8); PG8_BAR; PG8_WAIT_L(0); PG8_MMA(0, 0, At, B0); PG8_BAR; PG8_SCHED;
            PG8_LDB(B1, 0, 1); PG8_STAGE(PG8_SB(0, 0), b2, voffB);
            PG8_BAR; PG8_WAIT_L(0); PG8_MMA(0, 1, At, B1); PG8_BAR;
            PG8_LDA(At, 0, 1); PG8_STAGE(PG8_SA(0, 0), a2, voffA);
            PG8_BAR; PG8_WAIT_L(0); PG8_MMA(1, 0, At, B0); PG8_BAR; PG8_SCHED;
            PG8_STAGE(PG8_SB(0, 1), b2 + hstep, voffB);
            PG8_WAIT_V(6); PG8_BAR; PG8_MMA(1, 1, At, B1); PG8_BAR;
            PG8_LDB(B0, 1, 0); PG8_SCHED; PG8_LDA(At, 1, 0); PG8_STAGE(PG8_SA(0, 1), a2 + hstep, voffA);
            PG8_WAIT_L(8); PG8_BAR; PG8_WAIT_L(0); PG8_MMA(0, 0, At, B0); PG8_BAR; PG8_SCHED;
            PG8_LDB(B1, 1, 1); PG8_STAGE(PG8_SB(1, 0), b3, voffB);
            PG8_BAR; PG8_WAIT_L(0); PG8_MMA(0, 1, At, B1); PG8_BAR;
            PG8_LDA(At, 1, 1); PG8_STAGE(PG8_SA(1, 0), a3, voffA);
            PG8_BAR; PG8_WAIT_L(0); PG8_MMA(1, 0, At, B0); PG8_BAR; PG8_SCHED;
            PG8_STAGE(PG8_SB(1, 1), b3 + hstep, voffB);
            PG8_WAIT_V(6); PG8_BAR; PG8_MMA(1, 1, At, B1); PG8_BAR;
            }
        }
        if constexpr (ALIGN_EPI) { if (wr == 0) PG8_BAR; }
        if constexpr (!Epi::AFTER_DRAIN) { E(acc, cur, wr, wc, fr, fq); S.done(cur); }
        if (!has_next) break;
#pragma unroll
        for (int a = 0; a < 2; ++a)
#pragma unroll
            for (int b = 0; b < 2; ++b)
#pragma unroll
                for (int m = 0; m < 4; ++m)
#pragma unroll
                    for (int n = 0; n < 2; ++n) acc[a][b][m][n] = (f32x4){0.f, 0.f, 0.f, 0.f};
        cur = nxt; cA = nA; cB = nB; ++ui;
        if constexpr (ALIGN_EPI) { if (wr == 1) PG8_BAR; }
    }
    PG8_WAIT_V(0);
    if constexpr (!ALIGN_EPI) { if (wr == 0) PG8_BAR; }
    PG8_BAR;
#undef PG8_SA
#undef PG8_SB
#undef PG8_STAGE
#undef PG8_LDA
#undef PG8_LDB
#undef PG8_MMA
#undef PG8_WAIT_V
#undef PG8_WAIT_L
#undef PG8_BAR
#undef PG8_SCHED
}
}

#define XB_TMO      128
#define XB_XCNT(j)  (256  + 64 * (j))
#define XB_XSUB(j)  (1280 + 64 * (j))
#define XB_XGEN(j)  (2304 + 64 * (j))
#define XB_TOP      3328
#define XB_TOPGEN   3392
#define XCD_BAR_WORDS 3456
#define XB_SPIN_CAP (1u << 18)
__device__ __forceinline__ unsigned xb_ld(unsigned* p)              { return __hip_atomic_load(p, __ATOMIC_RELAXED, __HIP_MEMORY_SCOPE_AGENT); }
__device__ __forceinline__ unsigned xb_add(unsigned* p, unsigned v) { return __hip_atomic_fetch_add(p, v, __ATOMIC_RELAXED, __HIP_MEMORY_SCOPE_AGENT); }
__device__ __forceinline__ unsigned xb_xcc_id() { return (unsigned)__builtin_amdgcn_s_getreg((3 << 11) | 20) & 0xFu; }
#define XB_SPIN(cond, bar) do { unsigned _sp = 0; while (cond) { __builtin_amdgcn_s_sleep(1); \
    if ((++_sp & 255u) == 0u) { if (xb_ld(&(bar)[XB_TMO])) break; if (_sp > XB_SPIN_CAP) { atomicAdd(&(bar)[XB_TMO], 1u); break; } } } } while (0)
struct XcdBarrier { unsigned* bar; unsigned x; volatile LAS unsigned* st; int wave; };
__device__ __forceinline__ XcdBarrier xcd_barrier_post(unsigned* bar, volatile LAS unsigned* st, int wave) {
    XcdBarrier b; b.bar = bar; b.x = xb_xcc_id(); b.st = st; b.wave = wave;
    if (wave == 0 && fresh_lane() == 0) (void)xb_add(&bar[XB_XCNT(b.x)], 1u);
    return b;
}
__device__ __forceinline__ void xcd_barrier_complete(unsigned* bar, unsigned x, unsigned& nloc, unsigned& nx) {
    const unsigned G = gridDim.x * gridDim.y * gridDim.z;
    unsigned sum, cnt, mine, sp = 0u;
    for (;;) {
        sum = 0u; cnt = 0u; mine = 0u;
#pragma unroll
        for (unsigned j = 0; j < 16; ++j) { const unsigned c = xb_ld(&bar[XB_XCNT(j)]); sum += c; cnt += (c > 0u) ? 1u : 0u; mine = (j == x) ? c : mine; }
        if (sum == G) break;
        __builtin_amdgcn_s_sleep(1);
        if ((++sp & 255u) == 0u) { if (xb_ld(&bar[XB_TMO])) break; if (sp > XB_SPIN_CAP) { atomicAdd(&bar[XB_TMO], 1u); break; } }
    }
    nloc = mine > 0u ? mine : 1u; nx = cnt > 0u ? cnt : 1u;
}
__device__ __forceinline__ void xcd_barrier(const XcdBarrier& b) {
    asm volatile("s_waitcnt vmcnt(0)" ::: "memory");
    __syncthreads();
    if (b.wave == 0 && fresh_lane() == 0) {
        unsigned* bar = b.bar;
        __builtin_amdgcn_s_waitcnt(0);
        unsigned nloc = b.st[0], nx = b.st[1];
        if (nloc == 0u) { xcd_barrier_complete(bar, b.x, nloc, nx); b.st[0] = nloc; b.st[1] = nx; }
        const unsigned old = xb_add(&bar[XB_XSUB(b.x)], 1u);
        const unsigned gen = old / nloc;
        if (old + 1u == (gen + 1u) * nloc) {
            __builtin_amdgcn_fence(__ATOMIC_RELEASE, "agent");
            asm volatile("s_waitcnt vmcnt(0)" ::: "memory");
            const unsigned og = xb_add(&bar[XB_TOP], 1u);
            const unsigned tg = og / nx;
            if (og + 1u == (tg + 1u) * nx) xb_add(&bar[XB_TOPGEN], 1u);
            else XB_SPIN(xb_ld(&bar[XB_TOPGEN]) == tg, bar);
            __builtin_amdgcn_fence(__ATOMIC_ACQUIRE, "agent");
            xb_add(&bar[XB_XGEN(b.x)], 1u);
            asm volatile("s_waitcnt vmcnt(0)" ::: "memory");
        } else {
            XB_SPIN(xb_ld(&bar[XB_XGEN(b.x)]) == gen, bar);
            __builtin_amdgcn_fence(__ATOMIC_ACQUIRE, "agent");
            asm volatile("s_waitcnt vmcnt(0)" ::: "memory");
        }
    }
    __syncthreads();
}

__device__ __forceinline__ void p0_ada_item(const float* cvec, const float* w_ada, const float* b_ada, float* mod, LAS unsigned char* lds, int item, int tid, int wave, int lane) {
    LAS float* sc = (LAS float*)(lds + wave * 8192);
    LAS float* red = (LAS float*)(lds + 65536);
    const int k0 = wave * 256;
    { float cv[32];
#pragma unroll
      for (int j = 0; j < 32; ++j) { const int i = lane + 64 * j; cv[j] = cvec[(i & 7) * DM + k0 + (i >> 3)]; }
#pragma unroll
      for (int j = 0; j < 32; ++j) { const int i = lane + 64 * j; const float v = cv[j]; sc[(i >> 3) * 8 + (i & 7)] = v * __builtin_amdgcn_rcpf(1.f + __builtin_amdgcn_exp2f(-v * LOG2E)); } }
    LDS_WAIT();
    const int rg = lane >> 4, cq = lane & 15;
    float acc[8][4];
#pragma unroll
    for (int b = 0; b < 8; ++b)
#pragma unroll
        for (int i = 0; i < 4; ++i) acc[b][i] = 0.f;
    const float* wp = w_ada + (size_t)(k0 + rg) * MODW + item * 64 + 4 * cq;
#pragma unroll 32
    for (int it = 0; it < 64; ++it) {
        const f32x4 w4 = *(const f32x4*)(wp + (size_t)it * 4 * MODW);
        const int kk = it * 4 + rg;
        const f32x4 s0 = *(const LAS f32x4*)(sc + kk * 8), s1 = *(const LAS f32x4*)(sc + kk * 8 + 4);
#pragma unroll
        for (int i = 0; i < 4; ++i) {
            acc[0][i] += s0[0] * w4[i]; acc[1][i] += s0[1] * w4[i]; acc[2][i] += s0[2] * w4[i]; acc[3][i] += s0[3] * w4[i];
            acc[4][i] += s1[0] * w4[i]; acc[5][i] += s1[1] * w4[i]; acc[6][i] += s1[2] * w4[i]; acc[7][i] += s1[3] * w4[i];
        }
    }
#pragma unroll
    for (int b = 0; b < 8; ++b)
#pragma unroll
        for (int i = 0; i < 4; ++i) acc[b][i] = xrow_sum(acc[b][i]);
    if (rg == 0) {
#pragma unroll
        for (int b = 0; b < 8; ++b)
#pragma unroll
            for (int i = 0; i < 4; ++i) red[(wave * 8 + b) * 64 + 4 * cq + i] = acc[b][i];
    }
    LDS_WAIT();
    __syncthreads();
    { const int b = tid >> 6, col = tid & 63; float s = b_ada[item * 64 + col];
#pragma unroll
      for (int w = 0; w < 8; ++w) s += red[(w * 8 + b) * 64 + col];
      mod[b * MODW + item * 64 + col] = s; }
    LDS_WAIT();
    __syncthreads();
}
__device__ __forceinline__ void p0_transpose_item(const float* W, int K, int N, bf16_t* WT, LAS float* scr, int item, int lane) {
    const int nblk = N / 32, kb = item / nblk, nb = item % nblk, k0 = 64 * kb, n0 = 32 * nb;
#pragma unroll 8
    for (int i = 0; i < 32; ++i) { const int kk = 2 * i + (lane >> 5); scr[kk * 33 + (lane & 31)] = W[(size_t)(k0 + kk) * N + n0 + (lane & 31)]; }
    LDS_WAIT(); asm volatile("" ::: "memory");
    const int c = lane & 7;
#pragma unroll
    for (int j = 0; j < 4; ++j) { const int n = (lane >> 3) + 8 * j; const LAS float* s = scr + (8 * c) * 33 + n;
        u32x4 o; o.x = cvtpk(s[0 * 33], s[1 * 33]); o.y = cvtpk(s[2 * 33], s[3 * 33]); o.z = cvtpk(s[4 * 33], s[5 * 33]); o.w = cvtpk(s[6 * 33], s[7 * 33]);
        *(u32x4*)(WT + (size_t)(n0 + n) * K + k0 + 8 * c) = o; }
    LDS_WAIT(); asm volatile("" ::: "memory");
}
__device__ __forceinline__ void p0_colmax_item(const float* W, int N, unsigned* cmax, int item, int lane) {
    const int nblk = N / 32, kb = item / nblk, nb = item % nblk, k0 = 64 * kb, n0 = 32 * nb;
    float am = 0.f;
#pragma unroll
    for (int i = 0; i < 32; ++i) am = fmaxf(am, fabsf(W[(size_t)(k0 + 2 * i + (lane >> 5)) * N + n0 + (lane & 31)]));
    am = fmaxf(am, __shfl_xor(am, 32));
    if (lane < 32) atomicMax(cmax + n0 + lane, __float_as_uint(am));
}
template <bool INTERLEAVE>
__device__ __forceinline__ void p1_transpose_i8_item(const float* W, int K, int N, unsigned char* WT, const unsigned* cmax, LAS float* scr, int item, int lane) {
    const int nblk = N / 32, kb = item / nblk, nb = item % nblk, k0 = 64 * kb, nd0 = 32 * nb;
    int n0 = nd0;
    if (INTERLEAVE && nd0 >= 2560) { const int t = (nd0 - 2560) >> 8, j = (nd0 - 2560) & 255; n0 = j < 128 ? 2560 + 128 * t + j : 3584 + 128 * t + (j - 128); }
    float wv[32];
#pragma unroll
    for (int i = 0; i < 32; ++i) wv[i] = W[(size_t)(k0 + 2 * i + (lane >> 5)) * N + n0 + (lane & 31)];
#pragma unroll
    for (int i = 0; i < 32; ++i) { const int kk = 2 * i + (lane >> 5); scr[kk * 33 + (lane & 31)] = wv[i]; }
    LDS_WAIT(); asm volatile("" ::: "memory");
    const int c4 = lane & 3;
#pragma unroll
    for (int j = 0; j < 2; ++j) { const int n = (lane >> 2) + 16 * j; const LAS float* s = scr + (16 * c4) * 33 + n;
        const float am = __uint_as_float(cmax[n0 + n]); const float inv = am > 0.f ? 127.0f / am : 0.f;
        u32x4 o;
#pragma unroll
        for (int w = 0; w < 4; ++w) o[w] = pack_i8x4((f32x4){s[(4 * w) * 33], s[(4 * w + 1) * 33], s[(4 * w + 2) * 33], s[(4 * w + 3) * 33]}, inv);
        *(u32x4*)(WT + (size_t)(nd0 + n) * K + k0 + 16 * c4) = o; }
    LDS_WAIT(); asm volatile("" ::: "memory");
}
__device__ __forceinline__ void p0_w2_item(const float* w_pq, const float* subkeys, bf16_t* W2, unsigned* cmax, int item, int lane) {
    const int blk = item >> 5, kq = (item >> 4) & 1, dch = item & 15, c = lane & 15, quad = lane >> 4;
    bf16x8 kf[4][4];
    { f32x4 sv[4][4][2];
#pragma unroll
      for (int kt = 0; kt < 4; ++kt) { const float* sp = subkeys + ((size_t)blk * 128 + (kq * 4 + kt) * 16 + c) * 128 + 8 * quad;
#pragma unroll
          for (int ks = 0; ks < 4; ++ks) { sv[kt][ks][0] = *(const f32x4*)(sp + ks * 32); sv[kt][ks][1] = *(const f32x4*)(sp + ks * 32 + 4); } }
#pragma unroll
      for (int kt = 0; kt < 4; ++kt)
#pragma unroll
          for (int ks = 0; ks < 4; ++ks) { const f32x4 a = sv[kt][ks][0], b = sv[kt][ks][1];
              u32x4 w; w.x = cvtpk(a[0], a[1]); w.y = cvtpk(a[2], a[3]); w.z = cvtpk(b[0], b[1]); w.w = cvtpk(b[2], b[3]); kf[kt][ks] = __builtin_bit_cast(bf16x8, w); } }
    float am[4] = {0.f, 0.f, 0.f, 0.f};
#pragma nounroll
    for (int dq = 0; dq < 2; ++dq) {
        f32x4 wv[4][4][2];
#pragma unroll
        for (int j = 0; j < 4; ++j) { const float* wp = w_pq + (size_t)(dch * 128 + (dq * 4 + j) * 16 + c) * DM + blk * 128 + 8 * quad;
#pragma unroll
            for (int ks = 0; ks < 4; ++ks) { wv[j][ks][0] = *(const f32x4*)(wp + ks * 32); wv[j][ks][1] = *(const f32x4*)(wp + ks * 32 + 4); } }
#pragma unroll
        for (int j = 0; j < 4; ++j) { const int d0 = dch * 128 + (dq * 4 + j) * 16;
            bf16x8 wb[4];
#pragma unroll
            for (int ks = 0; ks < 4; ++ks) { const f32x4 a = wv[j][ks][0], b = wv[j][ks][1];
                u32x4 w; w.x = cvtpk(a[0], a[1]); w.y = cvtpk(a[2], a[3]); w.z = cvtpk(b[0], b[1]); w.w = cvtpk(b[2], b[3]); wb[ks] = __builtin_bit_cast(bf16x8, w); }
#pragma unroll
            for (int kt = 0; kt < 4; ++kt) {
                f32x4 acc = (f32x4){0.f, 0.f, 0.f, 0.f};
#pragma unroll
                for (int ks = 0; ks < 4; ++ks) acc = __builtin_amdgcn_mfma_f32_16x16x32_bf16(wb[ks], kf[kt][ks], acc, 0, 0, 0);
                am[kt] = fmaxf(fmaxf(am[kt], fmaxf(fabsf(acc[0]), fabsf(acc[1]))), fmaxf(fabsf(acc[2]), fabsf(acc[3])));
                u32x2 o; o.x = cvtpk(acc[0], acc[1]); o.y = cvtpk(acc[2], acc[3]);
                *(u32x2*)(W2 + (size_t)(blk * 128 + (kq * 4 + kt) * 16 + c) * DM + d0 + 4 * quad) = o; } }
    }
#pragma unroll
    for (int kt = 0; kt < 4; ++kt) { const float a = xrow_max(am[kt]); if (quad == 0) atomicMax(cmax + blk * 128 + (kq * 4 + kt) * 16 + c, __float_as_uint(a)); }
}
__device__ __forceinline__ void p1_w2_row(const bf16_t* W2, unsigned char* WT, const unsigned* cmax, int n, int lane) {
    const float am = __uint_as_float(cmax[n]); const float inv = am > 0.f ? 127.0f / am : 0.f;
#pragma unroll
    for (int j = 0; j < 8; ++j) { const u32x2 v = *(const u32x2*)(W2 + (size_t)n * DM + 256 * j + 4 * lane);
        *(unsigned*)(WT + (size_t)n * DM + 256 * j + 4 * lane) = pack_i8x4((f32x4){bf_lo(v.x), bf_hi(v.x), bf_lo(v.y), bf_hi(v.y)}, inv); }
}
__device__ __forceinline__ void p0_cvt_item(const float* src, bf16_t* dst, size_t base, int lane) {
#pragma unroll
    for (int j = 0; j < 4; ++j) { const size_t o = base + (size_t)j * 512 + lane * 8;
        const f32x4 a = *(const f32x4*)(src + o), b = *(const f32x4*)(src + o + 4);
        u32x4 w; w.x = cvtpk(a[0], a[1]); w.y = cvtpk(a[2], a[3]); w.z = cvtpk(b[0], b[1]); w.w = cvtpk(b[2], b[3]);
        *(u32x4*)(dst + o) = w; }
}
__device__ __forceinline__ size_t tab_off(int row, int col) { return ((size_t)(col >> 7) * PEER_N + row) * 128 + (col & 127); }
__device__ __forceinline__ void p0_fp8_item(const float* src, unsigned char* dst, size_t base, float scale, int lane) {
#pragma unroll
    for (int i = 0; i < 8; ++i) { const size_t o = base + (size_t)i * 256 + lane * 4; const f32x4 a = *(const f32x4*)(src + o);
        int p = 0; p = __builtin_amdgcn_cvt_pk_fp8_f32(a[0] * scale, a[1] * scale, p, false); p = __builtin_amdgcn_cvt_pk_fp8_f32(a[2] * scale, a[3] * scale, p, true);
        *(unsigned*)(dst + tab_off((int)(base >> 11), i * 256 + lane * 4)) = (unsigned)p; }
}
__device__ __forceinline__ void p0_i8_row(const float* src, unsigned char* dst, float* scale, int row, int lane) {
    const float* p = src + (size_t)row * DM + lane * 4;
    f32x4 v[8]; float am = 0.f;
#pragma unroll
    for (int i = 0; i < 8; ++i) { v[i] = *(const f32x4*)(p + i * 256); am = fmaxf(fmaxf(am, fmaxf(fabsf(v[i][0]), fabsf(v[i][1]))), fmaxf(fabsf(v[i][2]), fabsf(v[i][3]))); }
    am = wave_max(am);
    const float inv = am > 0.f ? 127.0f / am : 0.f;
#pragma unroll
    for (int i = 0; i < 8; ++i) *(unsigned*)(dst + tab_off(row, i * 256 + lane * 4)) = pack_i8x4(v[i], inv);
    if (lane == 0) scale[row] = am * (1.0f / 127.0f);
}
__device__ __forceinline__ void p0_tables8(const float* peer_u, const float* peer_v, unsigned char* UB, float* SU, unsigned char* VB, int gw, int ngw, int lane) {
#define P0_TAB_SRC(k) (((k) < 8 ? peer_u : peer_v) + (size_t)(gw + ((k) & 7) * ngw) * DM + lane * 4)
    f32x4 ra[8], rb[8], rc[8];
#pragma unroll
    for (int i = 0; i < 8; ++i) ra[i] = *(const f32x4*)(P0_TAB_SRC(0) + i * 256);
#pragma unroll
    for (int i = 0; i < 8; ++i) rb[i] = *(const f32x4*)(P0_TAB_SRC(1) + i * 256);
#pragma unroll
    for (int k = 0; k < 16; ++k) {
        const int row = gw + (k & 7) * ngw;
        f32x4 (&v)[8] = (k % 3 == 0) ? ra : (k % 3 == 1) ? rb : rc;
        f32x4 (&nn)[8] = (k % 3 == 0) ? rc : (k % 3 == 1) ? ra : rb;
        if (k < 14) {
#pragma unroll
            for (int i = 0; i < 8; ++i) nn[i] = *(const f32x4*)(P0_TAB_SRC(k + 2) + i * 256); }
        if (k < 8) {
            float am = 0.f;
#pragma unroll
            for (int i = 0; i < 8; ++i) am = fmaxf(fmaxf(am, fmaxf(fabsf(v[i][0]), fabsf(v[i][1]))), fmaxf(fabsf(v[i][2]), fabsf(v[i][3])));
            am = wave_max(am);
            const float inv = am > 0.f ? 127.0f / am : 0.f;
            unsigned char* q = UB + (size_t)(lane >> 5) * (PEER_N * 128) + (size_t)row * 128 + (lane & 31) * 4;
#pragma unroll
            for (int i = 0; i < 8; ++i) *(unsigned*)(q + (size_t)i * (2 * PEER_N * 128)) = pack_i8x4(v[i], inv);
            if (lane == 0) SU[row] = am * (1.0f / 127.0f);
        } else {
            unsigned char* q = VB + (size_t)(lane >> 5) * (PEER_N * 128) + (size_t)row * 128 + (lane & 31) * 4;
#pragma unroll
            for (int i = 0; i < 8; ++i) { int p = 0; p = __builtin_amdgcn_cvt_pk_fp8_f32(v[i][0] * V_SCALE, v[i][1] * V_SCALE, p, false); p = __builtin_amdgcn_cvt_pk_fp8_f32(v[i][2] * V_SCALE, v[i][3] * V_SCALE, p, true);
                *(unsigned*)(q + (size_t)i * (2 * PEER_N * 128)) = (unsigned)p; }
        }
    }
#undef P0_TAB_SRC
}
struct TabCtx { const float* src; unsigned char* dst; float* SU; int p; };
__device__ __forceinline__ void tab_row_load(const TabCtx& T, int k, f32x4 (&v)[8], int lane) {
    const float* np = T.src + (size_t)(T.p + 1024 * (k < 15 ? k : 15)) * DM + lane * 4;
#pragma unroll
    for (int i = 0; i < 8; ++i) v[i] = *(const f32x4*)(np + i * 256);
}
template <bool ISV> __device__ __forceinline__ void tab_row_convert(const TabCtx& T, int k, const f32x4 (&v)[8], int lane) {
    const int row = T.p + 1024 * k;
    unsigned char* q = T.dst + (size_t)(lane >> 5) * (PEER_N * 128) + (size_t)row * 128 + (lane & 31) * 4;
    if (!ISV) {
        float am = 0.f;
#pragma unroll
        for (int i = 0; i < 8; ++i) am = fmaxf(fmaxf(am, fmaxf(fabsf(v[i][0]), fabsf(v[i][1]))), fmaxf(fabsf(v[i][2]), fabsf(v[i][3])));
        am = wave_max(am);
        const float inv = am > 0.f ? 127.0f / am : 0.f;
#pragma unroll
        for (int i = 0; i < 8; ++i) *(unsigned*)(q + (size_t)i * (2 * PEER_N * 128)) = pack_i8x4(v[i], inv);
        if (lane == 0) T.SU[row] = am * (1.0f / 127.0f);
    } else {
#pragma unroll
        for (int i = 0; i < 8; ++i) { int p = 0; p = __builtin_amdgcn_cvt_pk_fp8_f32(v[i][0] * V_SCALE, v[i][1] * V_SCALE, p, false); p = __builtin_amdgcn_cvt_pk_fp8_f32(v[i][2] * V_SCALE, v[i][3] * V_SCALE, p, true);
            *(unsigned*)(q + (size_t)i * (2 * PEER_N * 128)) = (unsigned)p; }
    }
}
__device__ __forceinline__ void p0_rope_item(float* rope, int item, int lane) {
    const int idx = item * 64 + lane, pos = idx >> 3, i = idx & 7;
    const double f = (i == 0) ? 0.15915494309189535 : (i == 1) ? 0.03086376340470123 : (i == 2) ? 0.005985185712713705 : (i == 3) ? 0.001160663641240061
                   : (i == 4) ? 0.00022507907903927653 : (i == 5) ? 4.364795279280289e-05 : (i == 6) ? 8.464330808241401e-06 : 1.6414262627950345e-06;
    const double rev = (double)pos * f; const double fr = rev - (double)(long long)rev;
    rope[idx] = __builtin_amdgcn_cosf((float)fr); rope[32768 + idx] = __builtin_amdgcn_sinf((float)fr);
}

__device__ __forceinline__ void norm_rows(const float* src, const float* gain, const float* mod, int off_shift, int off_scale, unsigned char* dst8, float* scale8, int gw, int ngw, int lane) {
    for (int grp = gw; grp < MTOK / 16; grp += ngw) {
        const int row0 = grp * 16; const float* mb = mod + (size_t)(row0 >> 12) * MODW;
        f32x4 A[8], B[8];
#pragma unroll
        for (int j = 0; j < 8; ++j) { const int c = 256 * j + 4 * lane; const f32x4 g = *(const f32x4*)(gain + c), sc = *(const f32x4*)(mb + off_scale + c); A[j] = g * (sc + 1.0f); B[j] = *(const f32x4*)(mb + off_shift + c); }
        f32x4 ra[8], rb[8], rc[8];
#pragma unroll
        for (int j = 0; j < 8; ++j) ra[j] = *(const f32x4*)(src + (size_t)row0 * DM + 4 * lane + 256 * j);
#pragma unroll
        for (int j = 0; j < 8; ++j) rb[j] = *(const f32x4*)(src + (size_t)(row0 + 1) * DM + 4 * lane + 256 * j);
#pragma unroll
        for (int r = 0; r < 16; ++r) {
            f32x4 (&cur)[8] = (r % 3 == 0) ? ra : (r % 3 == 1) ? rb : rc;
            f32x4 (&nn)[8] = (r % 3 == 0) ? rc : (r % 3 == 1) ? ra : rb;
            f32x4 v[8]; float ss = 0.f;
#pragma unroll
            for (int j = 0; j < 8; ++j) { v[j] = cur[j]; ss += (v[j][0] * v[j][0] + v[j][1] * v[j][1]) + (v[j][2] * v[j][2] + v[j][3] * v[j][3]); }
            if (r < 14) { const float* xn = src + (size_t)(row0 + r + 2) * DM + 4 * lane;
#pragma unroll
              for (int j = 0; j < 8; ++j) nn[j] = *(const f32x4*)(xn + 256 * j); }
            const float rstd = 1.0f / sqrtf(wave_sum(ss) * (1.0f / DM) + EPS);
            float am = 0.f;
#pragma unroll
            for (int j = 0; j < 8; ++j) { const f32x4 o = v[j] * rstd * A[j] + B[j]; v[j] = o; am = fmaxf(fmaxf(am, fmaxf(fabsf(o[0]), fabsf(o[1]))), fmaxf(fabsf(o[2]), fabsf(o[3]))); }
            am = wave_max(am); const float inv = am > 0.f ? 127.0f / am : 0.f;
            unsigned* q = (unsigned*)(dst8 + (size_t)(row0 + r) * DM + 4 * lane);
#pragma unroll
            for (int j = 0; j < 8; ++j) q[64 * j] = pack_i8x4(v[j], inv);
            if (lane == 0) scale8[row0 + r] = am * (1.0f / 127.0f);
        }
    }
}

__device__ __forceinline__ void norm_rows_bf16(const bf16_t* src, const float* gain, const float* mod, int off_shift, int off_scale, unsigned char* dst8, float* scale8, int gw, int ngw, int lane) {
    for (int grp = gw; grp < MTOK / 16; grp += ngw) {
        const int row0 = grp * 16; const float* mb = mod + (size_t)(row0 >> 12) * MODW;
        f32x4 A[8], B[8];
#pragma unroll
        for (int j = 0; j < 8; ++j) { const int c = 512 * (j >> 1) + 8 * lane + 4 * (j & 1); const f32x4 g = *(const f32x4*)(gain + c), sc = *(const f32x4*)(mb + off_scale + c); A[j] = g * (sc + 1.0f); B[j] = *(const f32x4*)(mb + off_shift + c); }
        u32x4 ra[4], rb[4], rc[4];
#pragma unroll
        for (int j = 0; j < 4; ++j) ra[j] = *(const u32x4*)(src + (size_t)row0 * DM + 8 * lane + 512 * j);
#pragma unroll
        for (int j = 0; j < 4; ++j) rb[j] = *(const u32x4*)(src + (size_t)(row0 + 1) * DM + 8 * lane + 512 * j);
#pragma unroll
        for (int r = 0; r < 16; ++r) {
            u32x4 (&cur)[4] = (r % 3 == 0) ? ra : (r % 3 == 1) ? rb : rc;
            u32x4 (&nn)[4] = (r % 3 == 0) ? rc : (r % 3 == 1) ? ra : rb;
            f32x4 v[8]; float ss = 0.f;
#pragma unroll
            for (int j = 0; j < 4; ++j) { const u32x4 t = cur[j]; v[2 * j] = (f32x4){bf_lo(t.x), bf_hi(t.x), bf_lo(t.y), bf_hi(t.y)}; v[2 * j + 1] = (f32x4){bf_lo(t.z), bf_hi(t.z), bf_lo(t.w), bf_hi(t.w)}; }
#pragma unroll
            for (int j = 0; j < 8; ++j) ss += (v[j][0] * v[j][0] + v[j][1] * v[j][1]) + (v[j][2] * v[j][2] + v[j][3] * v[j][3]);
            if (r < 14) { const bf16_t* xn = src + (size_t)(row0 + r + 2) * DM + 8 * lane;
#pragma unroll
              for (int j = 0; j < 4; ++j) nn[j] = *(const u32x4*)(xn + 512 * j); }
            const float rstd = __builtin_amdgcn_rsqf(wave_sum(ss) * (1.0f / DM) + EPS);
            float am = 0.f;
#pragma unroll
            for (int j = 0; j < 8; ++j) { const f32x4 o = v[j] * rstd * A[j] + B[j]; v[j] = o; am = fmaxf(fmaxf(am, fmaxf(fabsf(o[0]), fabsf(o[1]))), fmaxf(fabsf(o[2]), fabsf(o[3]))); }
            am = wave_max(am); const float inv = am > 0.f ? 127.0f / am : 0.f;
            unsigned char* q = dst8 + (size_t)(row0 + r) * DM + 8 * lane;
#pragma unroll
            for (int j = 0; j < 4; ++j) { u32x2 o; o.x = pack_i8x4(v[2 * j], inv); o.y = pack_i8x4(v[2 * j + 1], inv); *(u32x2*)(q + 512 * j) = o; }
            if (lane == 0) scale8[row0 + r] = am * (1.0f / 127.0f);
        }
    }
}

struct TrItem { const float* W; int N; unsigned char* WT; const unsigned* cmax; int k0, n0, nd0; };
__device__ __forceinline__ TrItem tr_item(int r, const float* w_in, const float* w_out, unsigned char* WIN, unsigned char* WOUT, const unsigned* cmx_in, const unsigned* cmx_out) {
    constexpr int I_IN = (DM / 64) * (INC / 32);
    const bool isin = r < I_IN; const int rr = isin ? r : r - I_IN, N = isin ? INC : DM, nblk = N / 32, kb = rr / nblk, nb = rr - kb * nblk, nd0 = 32 * nb;
    int n0 = nd0;
    if (isin && nd0 >= 2560) { const int t = (nd0 - 2560) >> 8, j = (nd0 - 2560) & 255; n0 = j < 128 ? 2560 + 128 * t + j : 3584 + 128 * t + (j - 128); }
    return TrItem{isin ? w_in : w_out, N, isin ? WIN : WOUT, isin ? cmx_in : cmx_out, 64 * kb, n0, nd0};
}
__device__ __forceinline__ void tr_load(const TrItem& T, float (&wv)[32], int lane) {
#pragma unroll
    for (int i = 0; i < 32; ++i) wv[i] = T.W[(size_t)(T.k0 + 2 * i + (lane >> 5)) * T.N + T.n0 + (lane & 31)];
}
__device__ __forceinline__ void tr_store(const TrItem& T, const float (&wv)[32], LAS float* scr, int lane) {
#pragma unroll
    for (int i = 0; i < 32; ++i) { const int kk = 2 * i + (lane >> 5); scr[kk * 33 + (lane & 31)] = wv[i]; }
    LDS_WAIT(); asm volatile("" ::: "memory");
    const int c4 = lane & 3;
#pragma unroll
    for (int j = 0; j < 2; ++j) { const int n = (lane >> 2) + 16 * j; const LAS float* s = scr + (16 * c4) * 33 + n;
        const float am = __uint_as_float(T.cmax[T.n0 + n]); const float inv = am > 0.f ? 127.0f / am : 0.f;
        u32x4 o;
#pragma unroll
        for (int w = 0; w < 4; ++w) o[w] = pack_i8x4((f32x4){s[(4 * w) * 33], s[(4 * w + 1) * 33], s[(4 * w + 2) * 33], s[(4 * w + 3) * 33]}, inv);
        *(u32x4*)(T.WT + (size_t)(T.nd0 + n) * DM + T.k0 + 16 * c4) = o; }
    LDS_WAIT(); asm volatile("" ::: "memory");
}
__device__ __forceinline__ void p1_norm_tr(const float* src, const float* gain, const float* mod, int off_shift, int off_scale, unsigned char* dst8, float* scale8, int gw, int lane,
                                           const float* w_in, const float* w_out, unsigned char* WIN, unsigned char* WOUT, const unsigned* cmx_in, const unsigned* cmx_out, LAS float* scr) {
    const int row0 = gw * 16; const float* mb = mod + (size_t)(row0 >> 12) * MODW;
    f32x4 A[8], B[8];
#pragma unroll
    for (int j = 0; j < 8; ++j) { const int c = 256 * j + 4 * lane; const f32x4 g = *(const f32x4*)(gain + c), sc = *(const f32x4*)(mb + off_scale + c); A[j] = g * (sc + 1.0f); B[j] = *(const f32x4*)(mb + off_shift + c); }
    f32x4 nx[8];
#pragma unroll
    for (int j = 0; j < 8; ++j) nx[j] = *(const f32x4*)(src + (size_t)row0 * DM + 4 * lane + 256 * j);
    float wv[32]; TrItem it{};
#pragma unroll
    for (int r = 0; r < 16; ++r) {
        f32x4 v[8]; float ss = 0.f;
#pragma unroll
        for (int j = 0; j < 8; ++j) { v[j] = nx[j]; ss += (v[j][0] * v[j][0] + v[j][1] * v[j][1]) + (v[j][2] * v[j][2] + v[j][3] * v[j][3]); }
        if (r < 15) { const float* xn = src + (size_t)(row0 + r + 1) * DM + 4 * lane;
#pragma unroll
          for (int j = 0; j < 8; ++j) nx[j] = *(const f32x4*)(xn + 256 * j); }
        if (r % 5 == 0 && r < 15) { it = tr_item(gw + 2048 * (r / 5), w_in, w_out, WIN, WOUT, cmx_in, cmx_out); tr_load(it, wv, lane); }
        const float rstd = 1.0f / sqrtf(wave_sum(ss) * (1.0f / DM) + EPS);
        float am = 0.f;
#pragma unroll
        for (int j = 0; j < 8; ++j) { const f32x4 o = v[j] * rstd * A[j] + B[j]; v[j] = o; am = fmaxf(fmaxf(am, fmaxf(fabsf(o[0]), fabsf(o[1]))), fmaxf(fabsf(o[2]), fabsf(o[3]))); }
        am = wave_max(am); const float inv = am > 0.f ? 127.0f / am : 0.f;
        unsigned* q = (unsigned*)(dst8 + (size_t)(row0 + r) * DM + 4 * lane);
#pragma unroll
        for (int j = 0; j < 8; ++j) q[64 * j] = pack_i8x4(v[j], inv);
        if (lane == 0) scale8[row0 + r] = am * (1.0f / 127.0f);
        if (r % 5 == 3) tr_store(it, wv, scr, lane);
    }
}

constexpr int KS_PITCH = 72;
constexpr int VT_PITCH = 264;
constexpr int LDS_KS = 0, LDS_VT = 256 * KS_PITCH * 2, LDS_RT = LDS_VT + 64 * VT_PITCH * 2;
constexpr int LDS_QS = LDS_RT + 8192, LDS_QS_HI = LDSCTL_OFF + 1024;
__device__ __forceinline__ int qstash_off(int wave) { return wave < 6 ? LDS_QS + wave * 8192 : LDS_QS_HI + (wave - 6) * 8192; }
static_assert(LDS_QS + 6 * 8192 <= LDSCTL_OFF && LDS_QS_HI + 2 * 8192 <= LDS_BYTES, "Q stash placement");
template <bool HOST, bool ISV>
__device__ __forceinline__ void attn_unit(int b, int hk, int n, const bf16_t* PROJ, const float* g_q, const float* g_k, const float* sinks, const float* g_oa, const float* rope, unsigned char* MIXED,
                                          LAS unsigned char* lds, int tid, int wave, int lane, const TabCtx& T, int tabk0, f32x4 (&tcur)[8], f32x4 (&tnx)[8]) {
    LAS bf16_t* Ks = (LAS bf16_t*)(lds + LDS_KS); LAS bf16_t* Vt = (LAS bf16_t*)(lds + LDS_VT); LAS float* RT = (LAS float*)(lds + LDS_RT);
    const size_t rowb = (size_t)b * SEQ;
    const int c = lane & 15, quad = lane >> 4, g = wave >> 1, hf = wave & 1, head = hk * 4 + g;
    const bf16_t* qsrc = PROJ + (rowb + n * 128 + hf * 64 + c) * INC + head * 64 + 8 * quad;
#pragma unroll
    for (int qt = 0; qt < 4; ++qt)
#pragma unroll
        for (int k = 0; k < 2; ++k)
            __builtin_amdgcn_global_load_lds((const unsigned*)(qsrc + (size_t)qt * 16 * INC + k * 32), (LAS unsigned*)(lds + qstash_off(wave) + (qt * 2 + k) * 1024), 16, 0, 0);
    u32x4 kr[2][2]; f32x4 kcs[2][4]; u32x4 vr[4];
    const int part = tid & 3;
#pragma unroll
    for (int it = 0; it < 2; ++it) {
        const int row = (tid + 512 * it) >> 2, pos = (n - 1) * 128 + row, posc = pos >= 0 ? pos : 0;
        const bf16_t* src = PROJ + (rowb + posc) * INC + COL_K + hk * 64 + 16 * part;
        kr[it][0] = *(const u32x4*)src; kr[it][1] = *(const u32x4*)(src + 8);
        const float* rp = rope + posc * 8;
        kcs[it][0] = *(const f32x4*)rp; kcs[it][1] = *(const f32x4*)(rp + 4); kcs[it][2] = *(const f32x4*)(rp + 32768); kcs[it][3] = *(const f32x4*)(rp + 32768 + 4);
    }
#pragma unroll
    for (int it = 0; it < 4; ++it) {
        const int task = tid + 512 * it, row = task & 255, ch = task >> 8, pos = (n - 1) * 128 + row, posc = pos >= 0 ? pos : 0;
        vr[it] = *(const u32x4*)(PROJ + (rowb + posc) * INC + COL_V + hk * 64 + 8 * ch);
    }
    const f32x4 rv = *(const f32x4*)(rope + ((tid & 3) >> 1) * 32768 + (size_t)(n * 128 + (tid >> 2)) * 8 + (tid & 1) * 4);
    f32x4 gk[4], gq[4], goa[4];
#pragma unroll
    for (int i = 0; i < 4; ++i) gk[i] = *(const f32x4*)(g_k + 16 * part + 4 * i);
    gq[0] = *(const f32x4*)(g_q + 8 * quad); gq[1] = *(const f32x4*)(g_q + 8 * quad + 4); gq[2] = *(const f32x4*)(g_q + 32 + 8 * quad); gq[3] = *(const f32x4*)(g_q + 32 + 8 * quad + 4);
#pragma unroll
    for (int dt = 0; dt < 4; ++dt) goa[dt] = *(const f32x4*)(g_oa + head * 64 + dt * 16 + 4 * quad);
    const float sinkv = sinks[head] * LOG2E;
    *(LAS f32x4*)(RT + (tid >> 2) * 16 + (tid & 3) * 4) = rv;
#pragma unroll
    for (int it = 0; it < 2; ++it) {
        const int row = (tid + 512 * it) >> 2; const bool valid = (n - 1) * 128 + row >= 0;
        const u32x4 r0 = kr[it][0], r1 = kr[it][1];
        float x[16];
#pragma unroll
        for (int i = 0; i < 4; ++i) { x[2 * i] = bf_lo(r0[i]); x[2 * i + 1] = bf_hi(r0[i]); x[8 + 2 * i] = bf_lo(r1[i]); x[8 + 2 * i + 1] = bf_hi(r1[i]); }
        float ss = 0.f;
#pragma unroll
        for (int i = 0; i < 16; ++i) ss += x[i] * x[i];
        ss = dpp_add<0xB1>(ss); ss = dpp_add<0x4E>(ss);
        const float rstd = 1.0f / sqrtf(ss * (1.0f / 64.0f) + EPS);
#pragma unroll
        for (int i = 0; i < 16; ++i) x[i] = x[i] * rstd * gk[i >> 2][i & 3];
#pragma unroll
        for (int i = 0; i < 8; ++i) { const float cs = kcs[it][i >> 2][i & 3], sn = kcs[it][2 + (i >> 2)][i & 3]; const float t1 = x[i], t2 = x[8 + i];
            x[i] = part == 0 ? t1 * cs - t2 * sn : t1; x[8 + i] = part == 0 ? t2 * cs + t1 * sn : t2; }
        u32x4 w0, w1;
#pragma unroll
        for (int i = 0; i < 4; ++i) { w0[i] = valid ? cvtpk(x[2 * i], x[2 * i + 1]) : 0u; w1[i] = valid ? cvtpk(x[8 + 2 * i], x[8 + 2 * i + 1]) : 0u; }
        LAS bf16_t* d = Ks + row * KS_PITCH + 16 * part;
        *(LAS u32x4*)d = w0; *(LAS u32x4*)(d + 8) = w1;
    }
#pragma unroll
    for (int it = 0; it < 4; ++it) {
        const int task = tid + 512 * it, row = task & 255, ch = task >> 8; const bool valid = (n - 1) * 128 + row >= 0;
        u32x4 r = vr[it];
        if (!valid) r = (u32x4){0u, 0u, 0u, 0u};
#pragma unroll
        for (int i = 0; i < 4; ++i) { Vt[(8 * ch + 2 * i) * VT_PITCH + row] = (bf16_t)(r[i] & 0xffffu); Vt[(8 * ch + 2 * i + 1) * VT_PITCH + row] = (bf16_t)(r[i] >> 16); }
    }
    VM_WAIT();
    LDS_WAIT();
    __syncthreads();
#pragma unroll
    for (int i = 0; i < 4; ++i) { gq[i] = gq[i] * (0.125f * LOG2E); asm volatile("" : "+v"(gq[i])); asm volatile("" : "+v"(goa[i])); }
    const int lq = 4 * quad - c;
    const LAS unsigned char* qstash = lds + qstash_off(wave) + lane * 16;
    for (int qt = 0; qt < 4; ++qt) {
        const int qi0 = hf * 64 + qt * 16, kt0 = (qi0 >> 4) & ~1, qi = qi0 + c, pos = n * 128 + qi;
        const size_t tq = rowb + pos;
        bf16x8 qf[2];
        {
            const u32x4 r0 = *(const LAS u32x4*)(qstash + qt * 2048), r1 = *(const LAS u32x4*)(qstash + qt * 2048 + 1024);
            float x0[8], x1[8];
#pragma unroll
            for (int i = 0; i < 4; ++i) { x0[2 * i] = bf_lo(r0[i]); x0[2 * i + 1] = bf_hi(r0[i]); x1[2 * i] = bf_lo(r1[i]); x1[2 * i + 1] = bf_hi(r1[i]); }
            float ss = 0.f;
#pragma unroll
            for (int i = 0; i < 8; ++i) ss += x0[i] * x0[i] + x1[i] * x1[i];
            ss = xrow_sum(ss);
            const float rstd = __builtin_amdgcn_rsqf(ss * (1.0f / 64.0f) + EPS);
#pragma unroll
            for (int i = 0; i < 8; ++i) { x0[i] = x0[i] * rstd * gq[i >> 2][i & 3]; x1[i] = x1[i] * rstd * gq[2 + (i >> 2)][i & 3]; }
            const LAS float* rt = RT + qi * 16;
            const f32x4 rc0 = *(const LAS f32x4*)rt, rc1 = *(const LAS f32x4*)(rt + 4), rs0 = *(const LAS f32x4*)(rt + 8), rs1 = *(const LAS f32x4*)(rt + 12);
#pragma unroll
            for (int i = 0; i < 8; ++i) {
                const float other = xrow16_other(x0[i], (quad & 1) != 0);
                const float cs = i < 4 ? rc0[i & 3] : rc1[i & 3], sn = i < 4 ? rs0[i & 3] : rs1[i & 3];
                const float rot = (quad == 0) ? (x0[i] * cs - other * sn) : (x0[i] * cs + other * sn);
                x0[i] = (quad < 2) ? rot : x0[i];
            }
            u32x4 w0, w1;
#pragma unroll
            for (int i = 0; i < 4; ++i) { w0[i] = cvtpk(x0[2 * i], x0[2 * i + 1]); w1[i] = cvtpk(x1[2 * i], x1[2 * i + 1]); }
            qf[0] = __builtin_bit_cast(bf16x8, w0); qf[1] = __builtin_bit_cast(bf16x8, w1);
        }
        f32x4 s[10];
#pragma unroll
        for (int t = 0; t < 10; ++t) {
            s[t] = (f32x4){0.f, 0.f, 0.f, 0.f};
            const LAS bf16_t* kp = Ks + ((kt0 + t) * 16 + c) * KS_PITCH + 8 * quad;
#pragma unroll
            for (int ks = 0; ks < 2; ++ks) { const bf16x8 kf = *(const LAS bf16x8*)(kp + ks * 32); s[t] = __builtin_amdgcn_mfma_f32_16x16x32_bf16(kf, qf[ks], s[t], 0, 0, 0); }
        }
        if (n == 0) {
#pragma unroll
            for (int t = 0; t < 10; ++t)
#pragma unroll
                for (int r = 0; r < 4; ++r) { const int kj = (kt0 + t) * 16 + 4 * quad + r; const bool ok = (kj >= qi + 1) && (kj <= qi + 128) && kj >= 128; s[t][r] = ok ? s[t][r] : -1e30f; }
        } else {
            const int L = kt0 * 16 - qi0 + lq;
#pragma unroll
            for (int t = 0; t < 2; ++t)
#pragma unroll
                for (int r = 0; r < 4; ++r) { s[t][r] = (L >= 1 - (16 * t + r)) ? s[t][r] : -1e30f; s[8 + t][r] = (L <= 128 - (16 * (8 + t) + r)) ? s[8 + t][r] : -1e30f; }
        }
        float m = sinkv;
#pragma unroll
        for (int t = 0; t < 10; ++t)
#pragma unroll
            for (int r = 0; r < 4; ++r) m = __builtin_amdgcn_fmed3f(m, s[t][r], __builtin_inff());
        m = xrow_max(m);
#pragma unroll
        for (int t = 0; t < 10; ++t)
#pragma unroll
            for (int r = 0; r < 4; ++r) s[t][r] = __builtin_amdgcn_exp2f(s[t][r] - m);
        bf16x8 pf[5];
#pragma unroll
        for (int i = 0; i < 5; ++i) { u32x4 w; w.x = cvtpk(s[2 * i][0], s[2 * i][1]); w.y = cvtpk(s[2 * i][2], s[2 * i][3]);
            w.z = cvtpk(s[2 * i + 1][0], s[2 * i + 1][1]); w.w = cvtpk(s[2 * i + 1][2], s[2 * i + 1][3]); pf[i] = __builtin_bit_cast(bf16x8, w); }
        f32x4 osum = (f32x4){0.f, 0.f, 0.f, 0.f};
        { const unsigned ow = (c & 3) == 0 ? 0x3F803F80u : 0u; const bf16x8 onesA = __builtin_bit_cast(bf16x8, (u32x4){ow, ow, ow, ow});
#pragma unroll
          for (int i = 0; i < 5; ++i) osum = __builtin_amdgcn_mfma_f32_16x16x32_bf16(onesA, pf[i], osum, 0, 0, 0); }
        const float inv = __builtin_amdgcn_rcpf(osum[0] + __builtin_amdgcn_exp2f(sinkv - m));
        f32x4 o[4]; float ss = 0.f;
#pragma unroll
        for (int dt = 0; dt < 4; ++dt) {
            o[dt] = (f32x4){0.f, 0.f, 0.f, 0.f};
            const LAS bf16_t* vp = Vt + (dt * 16 + c) * VT_PITCH + kt0 * 16 + 4 * quad;
#pragma unroll
            for (int i = 0; i < 5; ++i) { const u32x2 lo = *(const LAS u32x2*)(vp + i * 32), hi = *(const LAS u32x2*)(vp + i * 32 + 16);
                u32x4 w; w.x = lo.x; w.y = lo.y; w.z = hi.x; w.w = hi.y;
                o[dt] = __builtin_amdgcn_mfma_f32_16x16x32_bf16(__builtin_bit_cast(bf16x8, w), pf[i], o[dt], 0, 0, 0); }
            ss += (o[dt][0] * o[dt][0] + o[dt][1] * o[dt][1]) + (o[dt][2] * o[dt][2] + o[dt][3] * o[dt][3]);
        }
        ss = xrow_sum(ss);
        const float fac = inv * __builtin_amdgcn_rsqf(inv * inv * ss * (1.0f / 64.0f) + EPS) * MIX_SCALE;
        if (HOST) {
            tab_row_convert<ISV>(T, tabk0 + qt, tnx, lane);
            tab_row_load(T, tabk0 + qt + 1, tnx, lane);
        }
        unsigned char* orow = MIXED + tq * DM + head * 64 + 4 * quad;
#pragma unroll
        for (int dt = 0; dt < 4; ++dt) *(unsigned*)(orow + dt * 16) = pack_i8x4_sat(o[dt] * goa[dt], fac);
    }
    __syncthreads();
}
__device__ __forceinline__ void conv_item(int item, const bf16_t* PROJ, const float* conv_w, const float* g_oc, unsigned char* MIXED, int lane) {
    const int t0 = item * 16, ch = 16 * lane;
    float w0[16], w1[16], w2[16], gg[16], up2[16], up1[16];
#pragma unroll
    for (int i = 0; i < 16; ++i) { w0[i] = conv_w[ch + i]; w1[i] = conv_w[1024 + ch + i]; w2[i] = conv_w[2048 + ch + i]; gg[i] = g_oc[ch + i]; up2[i] = 0.f; up1[i] = 0.f; }
    if ((t0 & (SEQ - 1)) != 0) {
#pragma unroll
        for (int h = 0; h < 2; ++h) {
            const bf16_t* pr = PROJ + (size_t)(t0 - 2 + h) * INC + ch;
            const u32x4 c0 = *(const u32x4*)(pr + COL_C), c1 = *(const u32x4*)(pr + COL_C + 8);
#pragma unroll
            for (int i = 0; i < 4; ++i) {
                const float u0 = bf_lo(c0[i]), u1 = bf_hi(c0[i]), u2 = bf_lo(c1[i]), u3 = bf_hi(c1[i]);
                if (h == 0) { up2[2 * i] = u0; up2[2 * i + 1] = u1; up2[8 + 2 * i] = u2; up2[8 + 2 * i + 1] = u3; }
                else        { up1[2 * i] = u0; up1[2 * i + 1] = u1; up1[8 + 2 * i] = u2; up1[8 + 2 * i + 1] = u3; }
            }
        }
    }
    u32x4 nb0, nb1, nc0, nc1;
    { const bf16_t* pr = PROJ + (size_t)t0 * INC + ch; nb0 = *(const u32x4*)(pr + COL_B); nb1 = *(const u32x4*)(pr + COL_B + 8); nc0 = *(const u32x4*)(pr + COL_C); nc1 = *(const u32x4*)(pr + COL_C + 8); }
#pragma unroll
    for (int r = 0; r < 16; ++r) {
        const u32x4 b0 = nb0, b1 = nb1, c0 = nc0, c1 = nc1;
        { const bf16_t* pr = PROJ + (size_t)(t0 + (r < 15 ? r + 1 : r)) * INC + ch; nb0 = *(const u32x4*)(pr + COL_B); nb1 = *(const u32x4*)(pr + COL_B + 8); nc0 = *(const u32x4*)(pr + COL_C); nc1 = *(const u32x4*)(pr + COL_C + 8); }
        float u[16], bg[16], y[16];
#pragma unroll
        for (int i = 0; i < 4; ++i) {
            u[2 * i] = bf_lo(c0[i]); u[2 * i + 1] = bf_hi(c0[i]); u[8 + 2 * i] = bf_lo(c1[i]); u[8 + 2 * i + 1] = bf_hi(c1[i]);
            bg[2 * i] = bf_lo(b0[i]); bg[2 * i + 1] = bf_hi(b0[i]); bg[8 + 2 * i] = bf_lo(b1[i]); bg[8 + 2 * i + 1] = bf_hi(b1[i]);
        }
        float ss = 0.f;
#pragma unroll
        for (int i = 0; i < 16; ++i) { y[i] = bg[i] * (w0[i] * up2[i] + w1[i] * up1[i] + w2[i] * u[i]); ss += y[i] * y[i]; up2[i] = up1[i]; up1[i] = u[i]; }
        ss += __shfl_xor(ss, 1); ss += __shfl_xor(ss, 2);
        const float rstd = 1.0f / sqrtf(ss * (1.0f / 64.0f) + EPS);
        u32x4 o0;
#pragma unroll
        for (int i = 0; i < 4; ++i) o0[i] = pack_i8x4_sat((f32x4){y[4 * i] * rstd * gg[4 * i], y[4 * i + 1] * rstd * gg[4 * i + 1], y[4 * i + 2] * rstd * gg[4 * i + 2], y[4 * i + 3] * rstd * gg[4 * i + 3]}, MIX_SCALE);
        *(u32x4*)(MIXED + (size_t)(t0 + r) * DM + 1024 + ch) = o0;
    }
}

__device__ __forceinline__ void ins16(float (&L)[16], float x) {
#pragma unroll
    for (int j = 0; j < 16; ++j) { const float hi = fmaxf(L[j], x); x = fminf(L[j], x); L[j] = hi; }
}
template <int C> __device__ __forceinline__ float pack7(float s, unsigned q32) { unsigned t; asm("v_and_b32 %0, 0xffffff80, %1\n\tv_or3_b32 %0, %0, %2, %3" : "=&v"(t) : "v"(s), "v"(q32), "n"(C)); return __uint_as_float(t); }
template <int C> __device__ __forceinline__ float pack8(float s) { unsigned t; asm("v_and_b32 %0, 0xffffff00, %1\n\tv_or_b32 %0, %2, %0" : "=&v"(t) : "v"(s), "n"(C)); return __uint_as_float(t); }
template <int KEY> __device__ __forceinline__ float pack_lo(unsigned u) { unsigned t; asm("v_lshlrev_b32 %0, 16, %1\n\tv_or_b32 %0, %2, %0" : "=&v"(t) : "v"(u), "n"(KEY)); return __uint_as_float(t); }
template <int KEY> __device__ __forceinline__ float pack_hi(unsigned u) { unsigned t; asm("v_and_b32 %0, 0xffff0000, %1\n\tv_or_b32 %0, %2, %0" : "=&v"(t) : "v"(u), "n"(KEY)); return __uint_as_float(t); }
__device__ __forceinline__ unsigned key_of(unsigned x) { return ((x >> 2) & 7u) * 16u + (x >> 5) * 4u + (x & 3u); }
#define CE_DESC(a, b) do { const float hi_ = fmaxf(a, b), lo_ = fminf(a, b); a = hi_; b = lo_; } while (0)
__device__ __forceinline__ void bitonic_tail16(float (&L)[16]) {
#pragma unroll
    for (int d = 8; d >= 1; d >>= 1)
#pragma unroll
        for (int i = 0; i < 16; ++i) if ((i & d) == 0) CE_DESC(L[i], L[i + d]);
}
__device__ __forceinline__ void sort16_desc(float (&L)[16]) {
#define SN(i, j) CE_DESC(L[i], L[j]);
    SN(0,13) SN(1,12) SN(2,15) SN(3,14) SN(4,8) SN(5,6) SN(7,11) SN(9,10)
    SN(0,5) SN(1,7) SN(2,9) SN(3,4) SN(6,13) SN(8,14) SN(10,15) SN(11,12)
    SN(0,1) SN(2,3) SN(4,5) SN(6,8) SN(7,9) SN(10,11) SN(12,13) SN(14,15)
    SN(0,2) SN(1,3) SN(4,10) SN(5,11) SN(6,7) SN(8,9) SN(12,14) SN(13,15)
    SN(1,2) SN(3,12) SN(4,6) SN(5,7) SN(8,10) SN(9,11) SN(13,14)
    SN(1,4) SN(2,6) SN(5,8) SN(7,10) SN(9,13) SN(11,14)
    SN(2,4) SN(3,6) SN(9,12) SN(11,13)
    SN(3,5) SN(6,8) SN(7,9) SN(10,12)
    SN(3,4) SN(5,6) SN(7,8) SN(9,10) SN(11,12)
    SN(6,7) SN(8,9)
#undef SN
}
__device__ __forceinline__ void top16_of_two(float (&A)[16], const float (&B)[16]) {
#pragma unroll
    for (int j = 0; j < 16; ++j) A[j] = fmaxf(A[j], B[15 - j]);
    bitonic_tail16(A);
}
__device__ __forceinline__ void merge16(float (&L)[16], int mask) {
    float P[16];
#pragma unroll
    for (int j = 0; j < 16; ++j) P[j] = __shfl_xor(L[j], mask);
    top16_of_two(L, P);
}
constexpr int SKT_OFF = 8192 + 512, SKT_PITCH = 272;
__device__ __forceinline__ void peer_chunk(int tokb, const bf16_t* QP, const bf16_t* SK, const unsigned char* H8, const float* SH, const unsigned char* UB, const float* SU, const unsigned char* VB, const float* mod, const bf16_t* X1B, float* out,
                                           LAS unsigned char* lds, int tid, int wave, int lane) {
    LAS unsigned char* wl = lds + wave * 16384;
    int tok0 = tokb + wave * 16;
    LAS bf16_t* eidx = (LAS bf16_t*)wl; LAS bf16_t* gate = (LAS bf16_t*)(wl + 4096); LAS float* accL = (LAS float*)(wl + 8192); LAS unsigned char* ids = wl + 8192;
#pragma nounroll
    for (int rep7a_ = 0; rep7a_ < REP7A; ++rep7a_) {
#pragma nounroll
    for (int i2 = 0; i2 < 2; ++i2) {
        const int p = tid + 512 * i2, tkn = p & 127, h = p >> 7;
        const u32x4* srow = (const u32x4*)QP + (size_t)(h * 32) * MTOK + tokb + tkn;
        float T0[16], T1[16];
#pragma unroll
        for (int hf = 0; hf < 2; ++hf) {
            float L[16], Bv[16];
#define PKC(ch, DST) { const u32x4 a_ = srow[(size_t)(hf * 16 + 2 * (ch)) * MTOK], b_ = srow[(size_t)(hf * 16 + 2 * (ch) + 1) * MTOK]; \
                DST[0] = pack_lo<(ch) * 16 + 0>(a_.x); DST[1] = pack_hi<(ch) * 16 + 1>(a_.x); DST[2] = pack_lo<(ch) * 16 + 2>(a_.y); DST[3] = pack_hi<(ch) * 16 + 3>(a_.y); \
                DST[4] = pack_lo<(ch) * 16 + 4>(a_.z); DST[5] = pack_hi<(ch) * 16 + 5>(a_.z); DST[6] = pack_lo<(ch) * 16 + 6>(a_.w); DST[7] = pack_hi<(ch) * 16 + 7>(a_.w); \
                DST[8] = pack_lo<(ch) * 16 + 8>(b_.x); DST[9] = pack_hi<(ch) * 16 + 9>(b_.x); DST[10] = pack_lo<(ch) * 16 + 10>(b_.y); DST[11] = pack_hi<(ch) * 16 + 11>(b_.y); \
                DST[12] = pack_lo<(ch) * 16 + 12>(b_.z); DST[13] = pack_hi<(ch) * 16 + 13>(b_.z); DST[14] = pack_lo<(ch) * 16 + 14>(b_.w); DST[15] = pack_hi<(ch) * 16 + 15>(b_.w); }
            PKC(0, L) sort16_desc(L);
            PKC(1, Bv) sort16_desc(Bv); top16_of_two(L, Bv);
            PKC(2, Bv) sort16_desc(Bv); top16_of_two(L, Bv);
            PKC(3, Bv) sort16_desc(Bv); top16_of_two(L, Bv);
            PKC(4, Bv) sort16_desc(Bv); top16_of_two(L, Bv);
            PKC(5, Bv) sort16_desc(Bv); top16_of_two(L, Bv);
            PKC(6, Bv) sort16_desc(Bv); top16_of_two(L, Bv);
            PKC(7, Bv) sort16_desc(Bv); top16_of_two(L, Bv);
#undef PKC
#pragma unroll
            for (int j = 0; j < 16; ++j) { if (hf == 0) T0[j] = L[j]; else T1[j] = L[j]; }
        }
        float R[16], Bc[16], Cc[16];
#define CAND(i, j) pack8<(i) * 16 + (j)>(T0[i] + T1[j])
#pragma unroll
        for (int j = 0; j < 16; ++j) R[j] = __uint_as_float((__float_as_uint(T0[0] + T1[j]) & 0xFFFFFF00u) | (unsigned)j);
        Bc[0] = CAND(1, 0); Bc[1] = CAND(1, 1); Bc[2] = CAND(1, 2); Bc[3] = CAND(1, 3); Bc[4] = CAND(1, 4); Bc[5] = CAND(1, 5); Bc[6] = CAND(1, 6); Bc[7] = CAND(1, 7);
        Bc[8] = CAND(2, 0); Bc[9] = CAND(2, 1); Bc[10] = CAND(2, 2); Bc[11] = CAND(2, 3); Bc[12] = CAND(2, 4); Bc[13] = CAND(3, 0); Bc[14] = CAND(3, 1); Bc[15] = CAND(3, 2);
        Cc[0] = CAND(3, 3); Cc[1] = CAND(4, 0); Cc[2] = CAND(4, 1); Cc[3] = CAND(4, 2); Cc[4] = CAND(5, 0); Cc[5] = CAND(5, 1); Cc[6] = CAND(6, 0); Cc[7] = CAND(6, 1);
        Cc[8] = CAND(7, 0); Cc[9] = CAND(7, 1); Cc[10] = CAND(8, 0); Cc[11] = CAND(9, 0); Cc[12] = CAND(10, 0); Cc[13] = CAND(11, 0); Cc[14] = CAND(12, 0); Cc[15] = CAND(13, 0);
        sort16_desc(Bc); sort16_desc(Cc); top16_of_two(R, Bc); top16_of_two(R, Cc);
        ins16(R, CAND(14, 0)); ins16(R, CAND(15, 0));
#undef CAND
        {
            LAS unsigned char* idb = lds + wave * 16384 + 8192 + lane * 32;
            u32x4 i0, i1;
#pragma unroll
            for (int w = 0; w < 4; ++w) {
                i0[w] = (__float_as_uint(T0[4 * w]) & 0x7Fu) | ((__float_as_uint(T0[4 * w + 1]) & 0x7Fu) << 8) | ((__float_as_uint(T0[4 * w + 2]) & 0x7Fu) << 16) | ((__float_as_uint(T0[4 * w + 3]) & 0x7Fu) << 24);
                i1[w] = (__float_as_uint(T1[4 * w]) & 0x7Fu) | ((__float_as_uint(T1[4 * w + 1]) & 0x7Fu) << 8) | ((__float_as_uint(T1[4 * w + 2]) & 0x7Fu) << 16) | ((__float_as_uint(T1[4 * w + 3]) & 0x7Fu) << 24); }
            *(LAS u32x4*)idb = i0; *(LAS u32x4*)(idb + 16) = i1;
            float e[16], sum = 0.f;
#pragma unroll
            for (int k = 0; k < 16; ++k) { e[k] = __builtin_amdgcn_exp2f((R[k] - R[0]) * LOG2E); sum += e[k]; }
            const float inv = 1.0f / sum;
            LDS_WAIT(); asm volatile("" ::: "memory");
            unsigned ex[16];
#pragma unroll
            for (int k = 0; k < 16; ++k) { const unsigned code = __float_as_uint(R[k]) & 0xFFu; ex[k] = (unsigned)idb[code >> 4] * 128u + (unsigned)idb[16 + (code & 15u)]; }
            LAS unsigned char* tb = lds + (tkn >> 4) * 16384 + ((tkn & 15) * 128 + h * 16) * 2;
            u32x4 ea, eb, ga, gb;
#pragma unroll
            for (int w = 0; w < 4; ++w) { ea[w] = ex[2 * w] | (ex[2 * w + 1] << 16); eb[w] = ex[8 + 2 * w] | (ex[8 + 2 * w + 1] << 16);
                ga[w] = cvtpk(e[2 * w] * inv, e[2 * w + 1] * inv); gb[w] = cvtpk(e[8 + 2 * w] * inv, e[8 + 2 * w + 1] * inv); }
            *(LAS u32x4*)tb = ea; *(LAS u32x4*)(tb + 16) = eb; *(LAS u32x4*)(tb + 4096) = ga; *(LAS u32x4*)(tb + 4096 + 16) = gb;
        }
    }
    LDS_WAIT();
    __syncthreads();
    }
    LDS_WAIT(); asm volatile("" ::: "memory");
    int lane_b = lane; asm volatile("" : "+v"(lane_b));
    const int g = lane_b >> 3, k = lane_b & 7; const unsigned k16 = (unsigned)k * 16u;
    LAS int* accI = (LAS int*)accL;
#pragma nounroll
    for (int rep7u_ = 0; rep7u_ < REP7U; ++rep7u_) {
    LDS_WAIT(); asm volatile("" ::: "memory");
    for (int i = lane; i < 2048; i += 64) accI[i] = 0;
    LDS_WAIT(); asm volatile("" ::: "memory");
    asm volatile("" : "+s"(tok0));
    const unsigned char* hbase = H8 + (size_t)(tok0 + g) * DM + k * 16;
    u32x4 hn = *(const u32x4*)hbase;
    for (int s = 0; s < 16; ++s) {
        const unsigned char* Us = UB + (size_t)s * (PEER_N * 128);
#pragma unroll
        for (int r = 0; r < 2; ++r) {
            const int tl = r * 8 + g;
            const u32x4 hq = hn;
            { const int sn = r ? s + 1 : s, rn = r ^ 1; if (sn < 16) hn = *(const u32x4*)(hbase + (size_t)rn * 8 * DM + sn * 128); }
            const LAS bf16_t* ei = eidx + tl * 128;
            LAS int* ap = accI + tl * 128 + k;
#pragma nounroll
            for (int ib2 = 0; ib2 < 8; ++ib2) {
                u32x4 uv[16];
#pragma unroll
                for (int q = 0; q < 16; ++q) { const unsigned e = ei[ib2 * 16 + q]; uv[q] = *(const u32x4*)(Us + (size_t)(unsigned)((e << 7) + k16)); }
#pragma unroll
                for (int hb = 0; hb < 2; ++hb) {
                    int p[8];
#pragma unroll
                    for (int ii = 0; ii < 8; ++ii) { const u32x4 v = uv[hb * 8 + ii];
                        p[ii] = __builtin_amdgcn_sdot4((int)v.x, (int)hq.x, __builtin_amdgcn_sdot4((int)v.y, (int)hq.y, __builtin_amdgcn_sdot4((int)v.z, (int)hq.z, __builtin_amdgcn_sdot4((int)v.w, (int)hq.w, 0, false), false), false), false); }
                    int a4[4], a2[2];
#pragma unroll
                    for (int j = 0; j < 4; ++j) { const int send = (k & 4) ? p[j] : p[j + 4], keep = (k & 4) ? p[j + 4] : p[j]; a4[j] = keep + dpp_movi<0x141>(send); }
#pragma unroll
                    for (int j = 0; j < 2; ++j) { const int send = (k & 2) ? a4[j] : a4[j + 2], keep = (k & 2) ? a4[j + 2] : a4[j]; a2[j] = keep + dpp_movi<0x1B>(send); }
                    const int send = (k & 1) ? a2[0] : a2[1], keep = (k & 1) ? a2[1] : a2[0];
                    const int tot = keep + dpp_movi<0xB1>(send);
                    __hip_atomic_fetch_add(ap + ib2 * 16 + hb * 8, tot, __ATOMIC_RELAXED, __HIP_MEMORY_SCOPE_WORKGROUP);
                }
            }
        }
    }
    }
    LDS_WAIT(); asm volatile("" ::: "memory");
    LAS bf16_t* wgt = gate;
    for (int i = lane; i < 2048; i += 64) {
        const float a = (float)accI[i] * SU[eidx[i]] * SH[tok0 + (i >> 7)];
        const float ge = 0.5f * a * (1.0f + erff(a * 0.70710678118654752f));
        wgt[i] = (bf16_t)(cvtpk(bf_lo((unsigned)gate[i]) * ge * (1.0f / V_SCALE), 0.f) & 0xffffu);
    }
    LDS_WAIT(); asm volatile("" ::: "memory");
    const float* g2 = mod + (size_t)(tok0 >> 12) * MODW + 5 * DM;
#pragma nounroll
    for (int rep7v_ = 0; rep7v_ < REP7V; ++rep7v_)
    for (int s = 0; s < 16; ++s) {
        const unsigned char* Vs = VB + (size_t)s * (PEER_N * 128);
        f32x4 gvv[4];
#pragma unroll
        for (int q = 0; q < 4; ++q) gvv[q] = *(const f32x4*)(g2 + s * 128 + k * 16 + 4 * q);
#pragma unroll
        for (int r = 0; r < 2; ++r) {
            const int tl = r * 8 + g;
            float* orow = out + (size_t)(tok0 + tl) * DM + s * 128 + k * 16;
            const bf16_t* xrow = X1B + (size_t)(tok0 + tl) * DM + s * 128 + k * 16;
            const u32x4 xb0 = *(const u32x4*)xrow, xb1 = *(const u32x4*)(xrow + 8);
            const LAS bf16_t* ei = eidx + tl * 128; const LAS bf16_t* wi = wgt + tl * 128;
            float y[16];
#pragma unroll
            for (int i = 0; i < 16; ++i) y[i] = 0.f;
#pragma nounroll
            for (int b = 0; b < 8; ++b) {
                u32x4 vq[16];
#pragma unroll
                for (int q = 0; q < 16; ++q) { const unsigned e = ei[b * 16 + q]; vq[q] = *(const u32x4*)(Vs + (size_t)(unsigned)((e << 7) + k16)); }
#pragma unroll
                for (int q = 0; q < 16; ++q) {
                    const float wf = bf_lo((unsigned)wi[b * 16 + q]); const u32x4 vv = vq[q];
#pragma unroll
                    for (int w = 0; w < 4; ++w) { const f32x2 f01 = __builtin_amdgcn_cvt_pk_f32_fp8(vv[w], false), f23 = __builtin_amdgcn_cvt_pk_f32_fp8(vv[w], true);
                        y[4 * w] = fmaf(wf, f01.x, y[4 * w]); y[4 * w + 1] = fmaf(wf, f01.y, y[4 * w + 1]); y[4 * w + 2] = fmaf(wf, f23.x, y[4 * w + 2]); y[4 * w + 3] = fmaf(wf, f23.y, y[4 * w + 3]); }
                }
            }
#pragma unroll
            for (int q = 0; q < 4; ++q) { f32x4 o; const f32x4 gv = gvv[q];
                const u32x4 xb = q < 2 ? xb0 : xb1; const unsigned xlo = (q & 1) ? xb.z : xb.x, xhi = (q & 1) ? xb.w : xb.y;
                const float x1v[4] = {bf_lo(xlo), bf_hi(xlo), bf_lo(xhi), bf_hi(xhi)};
#pragma unroll
                for (int i = 0; i < 4; ++i) o[i] = x1v[i] + gv[i] * y[4 * q + i];
                if (rep7v_ == REP7V - 1) *(f32x4*)(orow + 4 * q) = o; else asm volatile("" :: "v"(o)); }
        }
    }
}

constexpr int N_PHASES = 8;
struct Args { const float* in[18]; float* out; unsigned char* ws; int ph_lo, ph_hi; };
__global__ void __launch_bounds__(NWAVES * 64, 2) hymba_fwd(Args args) {
    extern __shared__ __attribute__((aligned(16))) unsigned char lds_raw[];
    LAS unsigned char* lds = (LAS unsigned char*)lds_raw;
    volatile LAS unsigned* MISC = (volatile LAS unsigned*)(lds + MISC_OFF);
    const int wave = __builtin_amdgcn_readfirstlane((int)threadIdx.x >> 6);
    const int G = gridDim.x, bx = blockIdx.x;
    const int gw = bx * NWAVES + wave, NGW = G * NWAVES;
#define FRESH_IDS() const int lane = fresh_lane(); const int tid = wave * 64 + lane; (void)tid
    unsigned char* ws = args.ws;
    const float* x = args.in[0]; const float* cvec = args.in[1]; const float* w_ada = args.in[2]; const float* b_ada = args.in[3]; const float* g_norm1 = args.in[4];
    const float* w_in = args.in[5]; const float* g_q = args.in[6]; const float* g_k = args.in[7]; const float* sinks = args.in[8]; const float* conv_w = args.in[9];
    const float* g_oa = args.in[10]; const float* g_oc = args.in[11]; const float* w_out = args.in[12]; const float* g_norm2 = args.in[13]; const float* w_pq = args.in[14];
    const float* subkeys = args.in[15]; const float* peer_u = args.in[16]; const float* peer_v = args.in[17];
    float* out = args.out;
    float* mod = (float*)(ws + WS_MOD); float* rope = (float*)(ws + WS_ROPE);
    bf16_t* SK = (bf16_t*)(ws + WS_SK); bf16_t* WIN = (bf16_t*)(ws + WS_WIN); bf16_t* WOUT = (bf16_t*)(ws + WS_WOUT); bf16_t* WPQ = (bf16_t*)(ws + WS_WPQ);
    unsigned char* UB = ws + WS_UB; unsigned char* VB = ws + WS_VB; unsigned char* H8 = ws + WS_H8; float* SU = (float*)(ws + WS_SU); float* SH = (float*)(ws + WS_SH); bf16_t* XN = (bf16_t*)(ws + WS_XN); bf16_t* PROJ = (bf16_t*)(ws + WS_PROJ);
    bf16_t* QP = (bf16_t*)(ws + WS_QP); bf16_t* X1B = (bf16_t*)(ws + WS_X1B); unsigned char* MIXED = ws + WS_MIXED; unsigned char* XN8 = ws + WS_XN; float* SX1 = (float*)(ws + WS_SX1); bf16_t* W2 = (bf16_t*)(ws + WS_XN + 64 * MiB);
    unsigned* ctl = (unsigned*)(ws + WS_CTL);

    { FRESH_IDS(); for (int u = tid; u < (LDS_BYTES - LDSCTL_OFF) / 4; u += NWAVES * 64) ((LAS unsigned*)(lds + LDSCTL_OFF))[u] = 0u; }
    __syncthreads();
    XcdBarrier bar; bar.bar = ctl + CW_BAR; bar.x = 0; bar.st = nullptr; bar.wave = wave;
    if (MK_N_LAUNCHES == 1) bar = xcd_barrier_post(ctl + CW_BAR, MISC + 8, wave);
    const int lo = args.ph_lo, hi = args.ph_hi;
#define IN(k) (lo <= (k) && (k) < hi)
#define SEAM(k) do { if (IN(k) && IN((k) + 1)) xcd_barrier(bar); } while (0)

#pragma nounroll
    for (int rep_ = 0; rep_ < REP0; ++rep_) { if (rep_) xcd_barrier(bar);
    if (IN(0)) { FRESH_IDS();
#pragma nounroll
        for (int ra_ = 0; ra_ < REP0A; ++ra_)
        for (int it = bx; it < MODW / 64; it += G) p0_ada_item(cvec, w_ada, b_ada, mod, lds, it, tid, wave, lane);
        LAS float* scr = (LAS float*)(lds + wave * 16384);
        constexpr int I_IN = (DM / 64) * (INC / 32), I_SQ = (DM / 64) * (DM / 32), I_TAB = PEER_N * DM / 2048, I_W2 = 512, I_ROPE = 512;
        (void)scr;
        { const int nfree = G > MODW / 64 ? (G - MODW / 64) * NWAVES : 0;
          if (nfree > 0) { if (bx >= MODW / 64) for (int r = (bx - MODW / 64) * NWAVES + wave; r < I_W2; r += nfree) p0_w2_item(w_pq, subkeys, W2, ctl + CW_CMX_PQ, r, lane); }
          else for (int r = gw; r < I_W2; r += NGW) p0_w2_item(w_pq, subkeys, W2, ctl + CW_CMX_PQ, r, lane); }
#pragma nounroll
        for (int rc_ = 0; rc_ < REP0C; ++rc_)
        for (int r = gw; r < I_IN + I_SQ; r += NGW) { if (r < I_IN) p0_colmax_item(w_in, INC, ctl + CW_CMX_IN, r, lane); else p0_colmax_item(w_out, DM, ctl + CW_CMX_OUT, r - I_IN, lane); }
        for (int r = gw; r < I_ROPE; r += NGW) p0_rope_item(rope, r, lane);
        if (G == 256) {   }
        else if (NGW * 8 == I_TAB) p0_tables8(peer_u, peer_v, UB, SU, VB, gw, NGW, lane);
        else for (int r = gw; r < 2 * I_TAB; r += NGW) { if (r < I_TAB) p0_i8_row(peer_u, UB, SU, r, lane); else p0_fp8_item(peer_v, VB, (size_t)(r - I_TAB) * 2048, V_SCALE, lane); }
    }
    }
    SEAM(0);
#pragma nounroll
    for (int rep_ = 0; rep_ < REP1; ++rep_) { if (rep_) xcd_barrier(bar);
    if (IN(1)) { FRESH_IDS();
        LAS float* scr = (LAS float*)(lds + wave * 16384);
        constexpr int I_IN = (DM / 64) * (INC / 32), I_SQ = (DM / 64) * (DM / 32);
        const bool weave = (NGW == MTOK / 16);
        if (weave) p1_norm_tr(x, g_norm1, mod, 0 * DM, 1 * DM, XN8, SX1, gw, lane, w_in, w_out, (unsigned char*)WIN, (unsigned char*)WOUT, ctl + CW_CMX_IN, ctl + CW_CMX_OUT, scr);
        else norm_rows(x, g_norm1, mod, 0 * DM, 1 * DM, XN8, SX1, gw, NGW, lane);
        for (int it = weave ? gw + 3 * NGW : gw; it < I_IN + I_SQ + DM; it += NGW) {
            int r = it;
            if (r < I_IN) { p1_transpose_i8_item<true>(w_in, DM, INC, (unsigned char*)WIN, ctl + CW_CMX_IN, scr, r, lane); continue; } r -= I_IN;
            if (r < I_SQ) { p1_transpose_i8_item<false>(w_out, DM, DM, (unsigned char*)WOUT, ctl + CW_CMX_OUT, scr, r, lane); continue; } r -= I_SQ;
            p1_w2_row(W2, (unsigned char*)WPQ, ctl + CW_CMX_PQ, r, lane);
        }
    }
    }
    SEAM(1);
#if REP2 > 1
    if (IN(2)) {
        pg8::Gemm g{(const bf16_t*)XN8, (const bf16_t*)WIN, MTOK, INC, DM / 2}; pg8::StaticOrder S; S.init(MTOK, INC, G, bx);
        pg8::EpiProjI8 E{PROJ, INC, SX1, ctl + CW_CMX_IN};
        pg8::gemm_phase<pg8::EpiProjI8, pg8::StaticOrder, true, true, true>(lds, g, S, E, wave);
    }
    xcd_barrier(bar);
#endif
    if (IN(2)) {
        pg8::Gemm g{(const bf16_t*)XN8, (const bf16_t*)WIN, MTOK, INC, DM / 2}; pg8::StaticOrder S; S.init(MTOK, INC, G, bx);
        pg8::EpiProjI8 E{PROJ, INC, SX1, ctl + CW_CMX_IN};
        pg8::gemm_phase<pg8::EpiProjI8, pg8::StaticOrder, true, true, true>(lds, g, S, E, wave);
    }
    SEAM(2);
#pragma nounroll
    for (int rep_ = 0; rep_ < REP3; ++rep_) { if (rep_) xcd_barrier(bar);
    if (IN(3)) { FRESH_IDS();
#ifndef REP3A
#define REP3A 1
#endif
#pragma nounroll
        for (int ra_ = 0; ra_ < REP3A; ++ra_)
        { f32x4 tcur[8], tnx[8];
          if (G != 256) {
              const TabCtx T{peer_u, UB, SU, 0};
              for (int u = bx; u < BATCH * 4 * 32; u += G) attn_unit<false, false>(u >> 7, (u >> 5) & 3, u & 31, PROJ, g_q, g_k, sinks, g_oa, rope, MIXED, lds, tid, wave, lane, T, 0, tcur, tnx);
          } else if (wave & 1) {
              const TabCtx T{peer_v, VB, SU, gw >> 1};
              tab_row_load(T, 0, tnx, lane);
              int ui = 0;
              for (int u = bx; u < BATCH * 4 * 32; u += G, ++ui) attn_unit<true, true>(u >> 7, (u >> 5) & 3, u & 31, PROJ, g_q, g_k, sinks, g_oa, rope, MIXED, lds, tid, wave, lane, T, ui * 4, tcur, tnx);
          } else {
              const TabCtx T{peer_u, UB, SU, gw >> 1};
              tab_row_load(T, 0, tnx, lane);
              int ui = 0;
              for (int u = bx; u < BATCH * 4 * 32; u += G, ++ui) attn_unit<true, false>(u >> 7, (u >> 5) & 3, u & 31, PROJ, g_q, g_k, sinks, g_oa, rope, MIXED, lds, tid, wave, lane, T, ui * 4, tcur, tnx);
          } }
        for (int it = gw; it < MTOK / 16; it += NGW) conv_item(it, PROJ, conv_w, g_oc, MIXED, lane);
    }
    }
    SEAM(3);
#if REP4 > 1
    if (IN(4)) {
        pg8::Gemm g{(const bf16_t*)MIXED, (const bf16_t*)WOUT, MTOK, DM, DM / 2}; pg8::StaticOrder S; S.init(MTOK, DM, G, bx);
        pg8::EpiResGateBf16I8 E{x, X1B, DM, mod + 2 * DM, MODW, 1.0f / MIX_SCALE, ctl + CW_CMX_OUT};
        pg8::gemm_phase<pg8::EpiResGateBf16I8, pg8::StaticOrder, true, true, true>(lds, g, S, E, wave);
    }
    xcd_barrier(bar);
#endif
    if (IN(4)) {
        pg8::Gemm g{(const bf16_t*)MIXED, (const bf16_t*)WOUT, MTOK, DM, DM / 2}; pg8::StaticOrder S; S.init(MTOK, DM, G, bx);
        pg8::EpiResGateBf16I8 E{x, X1B, DM, mod + 2 * DM, MODW, 1.0f / MIX_SCALE, ctl + CW_CMX_OUT};
        pg8::gemm_phase<pg8::EpiResGateBf16I8, pg8::StaticOrder, true, true, true>(lds, g, S, E, wave);
    }
    SEAM(4);
#pragma nounroll
    for (int rep_ = 0; rep_ < REP5; ++rep_) { if (rep_) xcd_barrier(bar);
    if (IN(5)) { FRESH_IDS(); norm_rows_bf16(X1B, g_norm2, mod, 3 * DM, 4 * DM, H8, SH, gw, NGW, lane); }
    }
    SEAM(5);
#if REP6 > 1
    if (IN(6)) {
        pg8::Gemm g{(const bf16_t*)H8, (const bf16_t*)WPQ, MTOK, DM, DM / 2}; pg8::StaticOrder S; S.init(MTOK, DM, G, bx);
        pg8::EpiScoresI8 E{QP, MTOK, SH, ctl + CW_CMX_PQ};
        pg8::gemm_phase<pg8::EpiScoresI8, pg8::StaticOrder, true, true, true>(lds, g, S, E, wave);
    }
    xcd_barrier(bar);
#endif
    if (IN(6)) {
        pg8::Gemm g{(const bf16_t*)H8, (const bf16_t*)WPQ, MTOK, DM, DM / 2}; pg8::StaticOrder S; S.init(MTOK, DM, G, bx);
        pg8::EpiScoresI8 E{QP, MTOK, SH, ctl + CW_CMX_PQ};
        pg8::gemm_phase<pg8::EpiScoresI8, pg8::StaticOrder, true, true, true>(lds, g, S, E, wave);
    }
    SEAM(6);
    if (IN(7)) { FRESH_IDS();
        for (int chunk = bx; chunk < MTOK / 128; chunk += G) peer_chunk(chunk * 128, QP, SK, H8, SH, UB, SU, VB, mod, X1B, out, lds, tid, wave, lane);
    }
#undef IN
#undef SEAM
}

extern "C" void kernel_launch(void* const* d_in, const int* in_sizes, int n_in, void* d_out, int out_size, void* d_ws, size_t ws_size, hipStream_t stream) {
    static int grid = 0;
    if (grid == 0) {
        if (n_in != 18 || in_sizes[0] != MTOK * DM || out_size != MTOK * DM || ws_size < WS_END) { fprintf(stderr, "kernel_launch: unexpected shapes (n_in %d, in0 %d, out %d, ws %zu)\n", n_in, n_in > 0 ? in_sizes[0] : -1, out_size, ws_size); grid = -1; return; }
        int dev = 0, cus = 0, per_cu = 0;
        if (hipGetDevice(&dev) != hipSuccess || hipDeviceGetAttribute(&cus, hipDeviceAttributeMultiprocessorCount, dev) != hipSuccess) { grid = -1; return; }
        if (hipFuncSetAttribute((const void*)hymba_fwd, hipFuncAttributeMaxDynamicSharedMemorySize, LDS_BYTES) != hipSuccess) { fprintf(stderr, "kernel_launch: hipFuncSetAttribute failed\n"); grid = -1; return; }
        if (hipOccupancyMaxActiveBlocksPerMultiprocessor(&per_cu, (const void*)hymba_fwd, NWAVES * 64, LDS_BYTES) != hipSuccess || per_cu < 1) { fprintf(stderr, "kernel_launch: occupancy query says %d blocks per CU\n", per_cu); per_cu = 1; }
        (void)hipGetLastError();
        grid = cus;
    }
    if (grid < 0) return;
    (void)hipMemsetAsync((char*)d_ws + WS_CTL, 0, CTL_ZERO_BYTES, stream);
    Args a{};
    for (int i = 0; i < 18; ++i) a.in[i] = (const float*)d_in[i];
    a.out = (float*)d_out; a.ws = (unsigned char*)d_ws;
    if (MK_N_LAUNCHES == 1) {
        a.ph_lo = 0; a.ph_hi = N_PHASES;
        hipLaunchKernelGGL(hymba_fwd, dim3(grid), dim3(NWAVES * 64), LDS_BYTES, stream, a);
    } else {
        for (int p = 0; p < N_PHASES; ++p) { a.ph_lo = p; a.ph_hi = p + 1; hipLaunchKernelGGL(hymba_fwd, dim3(grid), dim3(NWAVES * 64), LDS_BYTES, stream, a); }
    }
}
```

```cpp
#include <hip/hip_runtime.h>
#include <cstdio>
#include <cstdint>

#ifndef MK_N_LAUNCHES
#define MK_N_LAUNCHES 1
#endif

#ifndef REP0
#define REP0 1
#endif
#ifndef REP0A
#define REP0A 1
#endif
#ifndef REP0C
#define REP0C 1
#endif
#ifndef REP1
#define REP1 1
#endif
#ifndef REP2
#define REP2 1
#endif
#ifndef REP3
#define REP3 1
#endif
#ifndef REP4
#define REP4 1
#endif
#ifndef REP5
#define REP5 1
#endif
#ifndef REP6
#define REP6 1
#endif
#ifndef REP7A
#define REP7A 1
#endif
#ifndef REP7U
#define REP7U 1
#endif
#ifndef REPSEL
#define REPSEL 1
#endif
#ifndef REP7V
#define REP7V 1
#endif
#ifndef REPSC
#define REPSC 1
#endif

#define LAS __attribute__((address_space(3)))
#define GAS __attribute__((address_space(1)))
typedef unsigned short bf16_t;
typedef short bf16x8 __attribute__((ext_vector_type(8)));
typedef short s16x4 __attribute__((ext_vector_type(4)));
typedef float f32x4 __attribute__((ext_vector_type(4)));
typedef float f32x2 __attribute__((ext_vector_type(2)));
typedef unsigned u32x4 __attribute__((ext_vector_type(4)));
typedef unsigned u32x2 __attribute__((ext_vector_type(2)));
typedef int i32x4 __attribute__((ext_vector_type(4)));
typedef __bf16 bf16x2_t __attribute__((ext_vector_type(2)));

constexpr int DM = 2048, BATCH = 8, SEQ = 4096, MTOK = BATCH * SEQ;
constexpr int INC = 4608;
constexpr int COL_K = 1024, COL_V = 1280, COL_B = 1536, COL_C = 2560, COL_H = 3584;
constexpr int MODW = 6 * DM;
constexpr int PEER_N = 16384;
constexpr float EPS = 1e-6f;
constexpr float LOG2E = 1.4426950408889634f;
constexpr float MIX_SCALE = 127.0f / 6.0f;
constexpr float V_SCALE = 16.0f;

constexpr size_t MiB = 1u << 20;
constexpr size_t WS_CTL = 0, CTL_ZERO_BYTES = 1 * MiB;
constexpr size_t WS_MOD = 1 * MiB;
constexpr size_t WS_ROPE = 1 * MiB + 512 * 1024;
constexpr size_t WS_SK = 2 * MiB;
constexpr size_t WS_WIN = 4 * MiB;
constexpr size_t WS_WOUT = 22 * MiB;
constexpr size_t WS_WPQ = 30 * MiB;
constexpr size_t WS_SU = 3 * MiB;
constexpr size_t WS_SH = 3 * MiB + 256 * 1024;
constexpr size_t WS_SX1 = 3 * MiB + 512 * 1024;
constexpr size_t WS_UB = 40 * MiB;
constexpr size_t WS_VB = 104 * MiB;
constexpr size_t WS_XN = 168 * MiB;
constexpr size_t WS_PROJ = 296 * MiB;
constexpr size_t WS_QP = WS_PROJ;
constexpr size_t WS_X1B = WS_PROJ + 128 * MiB;
constexpr size_t WS_MIXED = 584 * MiB;
constexpr size_t WS_H8 = 712 * MiB;
constexpr size_t WS_END = 776 * MiB;
constexpr int CW_BAR = 4096;
constexpr int CW_CMX_IN = 32768, CW_CMX_OUT = CW_CMX_IN + 4608, CW_CMX_PQ = CW_CMX_OUT + 2048;

constexpr int RING_BYTES = 131072;
constexpr int LDSCTL_OFF = RING_BYTES, MISC_OFF = LDSCTL_OFF + 320;
constexpr int LDS_BYTES = 148480;
constexpr int NWAVES = 8;

#define LDS_WAIT() asm volatile("s_waitcnt lgkmcnt(0)" ::: "memory")
#define VM_WAIT() asm volatile("s_waitcnt vmcnt(0)" ::: "memory")

__device__ __forceinline__ unsigned cvtpk(float lo, float hi) { f32x2 v = {lo, hi}; bf16x2_t b = __builtin_convertvector(v, bf16x2_t); return __builtin_bit_cast(unsigned, b); }
__device__ __forceinline__ float bf_lo(unsigned u) { return __uint_as_float(u << 16); }
__device__ __forceinline__ float bf_hi(unsigned u) { return __uint_as_float(u & 0xffff0000u); }
__device__ __forceinline__ float dot2bf(unsigned a, unsigned b, float c) { return __builtin_amdgcn_fdot2_f32_bf16(__builtin_bit_cast(bf16x2_t, a), __builtin_bit_cast(bf16x2_t, b), c, false); }
__device__ __forceinline__ int fresh_lane() { int l = (int)__builtin_amdgcn_mbcnt_hi(~0u, __builtin_amdgcn_mbcnt_lo(~0u, 0u)); asm volatile("" : "+v"(l)); return l; }
__device__ __forceinline__ float xrow_sum(float v) {
    const u32x2 a = __builtin_amdgcn_permlane16_swap(__float_as_uint(v), __float_as_uint(v), false, false); v = __uint_as_float(a.x) + __uint_as_float(a.y);
    const u32x2 b = __builtin_amdgcn_permlane32_swap(__float_as_uint(v), __float_as_uint(v), false, false); return __uint_as_float(b.x) + __uint_as_float(b.y);
}
__device__ __forceinline__ float xrow_max(float v) {
    const u32x2 a = __builtin_amdgcn_permlane16_swap(__float_as_uint(v), __float_as_uint(v), false, false); v = fmaxf(__uint_as_float(a.x), __uint_as_float(a.y));
    const u32x2 b = __builtin_amdgcn_permlane32_swap(__float_as_uint(v), __float_as_uint(v), false, false); return fmaxf(__uint_as_float(b.x), __uint_as_float(b.y));
}
__device__ __forceinline__ float xrow16_other(float v, bool odd_row) {
    const u32x2 a = __builtin_amdgcn_permlane16_swap(__float_as_uint(v), __float_as_uint(v), false, false); return __uint_as_float(odd_row ? a.x : a.y);
}

template <int CTRL> __device__ __forceinline__ float dpp_add(float v) { return v + __int_as_float(__builtin_amdgcn_update_dpp(0, __float_as_int(v), CTRL, 0xF, 0xF, false)); }
template <int CTRL> __device__ __forceinline__ float dpp_mov(float v) { return __int_as_float(__builtin_amdgcn_update_dpp(0, __float_as_int(v), CTRL, 0xF, 0xF, true)); }
__device__ __forceinline__ float allred8(float v) { v = dpp_add<0x141>(v); v = dpp_add<0x1B>(v); v = dpp_add<0xB1>(v); return v; }

template <int CTRL> __device__ __forceinline__ float dpp_max(float v) { return fmaxf(v, __int_as_float(__builtin_amdgcn_update_dpp(0, __float_as_int(v), CTRL, 0xF, 0xF, false))); }
__device__ __forceinline__ float wave_sum(float v) { v = dpp_add<0xB1>(v); v = dpp_add<0x4E>(v); v = dpp_add<0x141>(v); v = dpp_add<0x140>(v); return xrow_sum(v); }
__device__ __forceinline__ float wave_max(float v) { v = dpp_max<0xB1>(v); v = dpp_max<0x4E>(v); v = dpp_max<0x141>(v); v = dpp_max<0x140>(v); return xrow_max(v); }
__device__ __forceinline__ unsigned pack_i8x4_sat(f32x4 x, float inv) {
    const int a = (int)rintf(fminf(fmaxf(x[0] * inv, -127.f), 127.f)), b = (int)rintf(fminf(fmaxf(x[1] * inv, -127.f), 127.f)), c = (int)rintf(fminf(fmaxf(x[2] * inv, -127.f), 127.f)), d = (int)rintf(fminf(fmaxf(x[3] * inv, -127.f), 127.f));
    return ((unsigned)a & 0xffu) | (((unsigned)b & 0xffu) << 8) | (((unsigned)c & 0xffu) << 16) | ((unsigned)d << 24);
}
__device__ __forceinline__ unsigned pack_i8x4(f32x4 x, float inv) {
    const int a = (int)rintf(x[0] * inv), b = (int)rintf(x[1] * inv), c = (int)rintf(x[2] * inv), d = (int)rintf(x[3] * inv);
    return ((unsigned)a & 0xffu) | (((unsigned)b & 0xffu) << 8) | (((unsigned)c & 0xffu) << 16) | ((unsigned)d << 24);
}
template <int CTRL> __device__ __forceinline__ int dpp_movi(int v) { return __builtin_amdgcn_update_dpp(0, v, CTRL, 0xF, 0xF, true); }

namespace pg8 {
#define PG8_LAS __attribute__((address_space(3)))
constexpr int BM = 256, BK = 64, HALF = 128, HTB = HALF * BK * 2, STAGE_BYTES = 8 * HTB, NXCD = 8, WGM = 4;
__host__ __device__ __forceinline__ int lds_byte(int r, int c) { const int st = (r >> 4) * 2 + (c >> 5), rr = r & 15, cc = c & 31, ob = rr * 64 + cc * 2; return st * 1024 + (ob ^ (((ob >> 9) & 1) << 5)); }
__host__ __device__ __forceinline__ void stage_rc(int b, int& R, int& C) { const int st = b / 1024, sb = b % 1024, swz = sb ^ (((sb >> 9) & 1) << 5); R = (st >> 1) * 16 + swz / 64; C = (st & 1) * 32 + (swz % 64) / 2; }
__host__ __device__ __forceinline__ int perm32(int rho) { const int n = rho >> 4, i = rho & 15; return 8 * (i >> 2) + 4 * n + (i & 3); }
struct Unit { int pm, pn; };
struct Gemm { const bf16_t* A; const bf16_t* Bt; int M, N, K; };
struct StaticOrder {
    int nM, nN, nwg, G, c;
    __host__ __device__ void init(int M, int N, int G_, int c_) { nM = M / BM; nN = N / BM; nwg = nM * nN; G = G_; c = c_; }
    __host__ __device__ bool next(int i, Unit& u) const {
        const long L = (long)i * G + c; if (L >= nwg) return false;
        int wgid = (int)L; { const int q = nwg / NXCD, r = nwg % NXCD, xcd = wgid % NXCD, off = wgid / NXCD; wgid = (xcd < r ? xcd * (q + 1) : r * (q + 1) + (xcd - r) * q) + off; }
        const int nig = WGM * nN, gid = wgid / nig, fm = gid * WGM, gsz = (nM - fm) < WGM ? (nM - fm) : WGM;
        u.pm = fm + ((wgid % nig) % gsz); u.pn = (wgid % nig) / gsz; return true;
    }
    __device__ __forceinline__ void a_ready(const Unit&) const {}
    __device__ __forceinline__ void done(const Unit&) const {}
};
__device__ __forceinline__ unsigned cvt_pk_bf16(float lo, float hi) { unsigned r; asm volatile("v_cvt_pk_bf16_f32 %0, %1, %2" : "=v"(r) : "v"(lo), "v"(hi)); return r; }

struct EpiBf16 {
    static constexpr bool PERM = true, AFTER_DRAIN = false;
    bf16_t* O; int ldc;
    __device__ __forceinline__ void operator()(const f32x4 (&acc)[2][2][4][2], const Unit& u, int wr, int wc, int fr, int fq) const {
        const int row0 = u.pm * BM + wr * 64 + fr, col0 = u.pn * BM + wc * 32 + 8 * fq;
#pragma unroll
        for (int ai = 0; ai < 2; ++ai)
#pragma unroll
            for (int m = 0; m < 4; ++m) { bf16_t* rowp = O + (size_t)(row0 + ai * HALF + m * 16) * ldc + col0;
#pragma unroll
                for (int bj = 0; bj < 2; ++bj) { const f32x4 v0 = acc[ai][bj][m][0], v1 = acc[ai][bj][m][1];
                    u32x4 w; w.x = cvt_pk_bf16(v0[0], v0[1]); w.y = cvt_pk_bf16(v0[2], v0[3]); w.z = cvt_pk_bf16(v1[0], v1[1]); w.w = cvt_pk_bf16(v1[2], v1[3]);
                    *(u32x4*)(rowp + bj * HALF) = w; } }
    }
};
struct EpiBf16I8 {
    static constexpr bool PERM = true, AFTER_DRAIN = false;
    bf16_t* O; int ldc; const float* srow; const unsigned* cmax;
    __device__ __forceinline__ void operator()(const f32x4 (&acc)[2][2][4][2], const Unit& u, int wr, int wc, int fr, int fq) const {
        const int row0 = u.pm * BM + wr * 64 + fr, col0 = u.pn * BM + wc * 32 + 8 * fq;
        f32x4 sc[2][2];
#pragma unroll
        for (int bj = 0; bj < 2; ++bj)
#pragma unroll
            for (int n = 0; n < 2; ++n) { const u32x4 b = *(const u32x4*)(cmax + col0 + bj * HALF + 4 * n);
#pragma unroll
                for (int i = 0; i < 4; ++i) sc[bj][n][i] = __uint_as_float(b[i]) * (1.0f / 127.0f); }
        float srv[2][4];
#pragma unroll
        for (int ai = 0; ai < 2; ++ai)
#pragma unroll
            for (int m = 0; m < 4; ++m) srv[ai][m] = srow[row0 + ai * HALF + m * 16];
#pragma unroll
        for (int ai = 0; ai < 2; ++ai)
#pragma unroll
            for (int m = 0; m < 4; ++m) { const int row = row0 + ai * HALF + m * 16; const float sr = srv[ai][m]; bf16_t* rowp = O + (size_t)row * ldc + col0;
#pragma unroll
                for (int bj = 0; bj < 2; ++bj) { const i32x4 a0 = __builtin_bit_cast(i32x4, acc[ai][bj][m][0]), a1 = __builtin_bit_cast(i32x4, acc[ai][bj][m][1]);
                    f32x4 v0, v1;
#pragma unroll
                    for (int i = 0; i < 4; ++i) { v0[i] = (float)a0[i] * sr * sc[bj][0][i]; v1[i] = (float)a1[i] * sr * sc[bj][1][i]; }
                    u32x4 w; w.x = cvt_pk_bf16(v0[0], v0[1]); w.y = cvt_pk_bf16(v0[2], v0[3]); w.z = cvt_pk_bf16(v1[0], v1[1]); w.w = cvt_pk_bf16(v1[2], v1[3]);
                    *(u32x4*)(rowp + bj * HALF) = w; } }
    }
};
struct EpiScoresI8 {
    static constexpr bool PERM = true, AFTER_DRAIN = false;
    bf16_t* O; int M; const float* srow; const unsigned* cmax;
    __device__ __forceinline__ void operator()(const f32x4 (&acc)[2][2][4][2], const Unit& u, int wr, int wc, int fr, int fq) const {
        const int row0 = u.pm * BM + wr * 64 + fr, col0 = u.pn * BM + wc * 32 + 8 * fq;
        f32x4 sc[2][2];
#pragma unroll
        for (int bj = 0; bj < 2; ++bj)
#pragma unroll
            for (int n = 0; n < 2; ++n) { const u32x4 b = *(const u32x4*)(cmax + col0 + bj * HALF + 4 * n);
#pragma unroll
                for (int i = 0; i < 4; ++i) sc[bj][n][i] = __uint_as_float(b[i]) * (1.0f / 127.0f); }
        float srv[2][4];
#pragma unroll
        for (int ai = 0; ai < 2; ++ai)
#pragma unroll
            for (int m = 0; m < 4; ++m) srv[ai][m] = srow[row0 + ai * HALF + m * 16];
#pragma unroll
        for (int ai = 0; ai < 2; ++ai)
#pragma unroll
            for (int m = 0; m < 4; ++m) { const int row = row0 + ai * HALF + m * 16; const float sr = srv[ai][m];
#pragma unroll
                for (int bj = 0; bj < 2; ++bj) { const i32x4 a0 = __builtin_bit_cast(i32x4, acc[ai][bj][m][0]), a1 = __builtin_bit_cast(i32x4, acc[ai][bj][m][1]);
                    f32x4 v0, v1;
#pragma unroll
                    for (int i = 0; i < 4; ++i) { v0[i] = (float)a0[i] * sr * sc[bj][0][i]; v1[i] = (float)a1[i] * sr * sc[bj][1][i]; }
                    u32x4 w; w.x = cvt_pk_bf16(v0[0], v0[1]); w.y = cvt_pk_bf16(v0[2], v0[3]); w.z = cvt_pk_bf16(v1[0], v1[1]); w.w = cvt_pk_bf16(v1[2], v1[3]);
                    *(u32x4*)(O + ((size_t)(u.pn * 32 + bj * 16 + wc * 4 + fq) * M + row) * 8) = w; } }
    }
};
struct EpiProjI8 {
    static constexpr bool PERM = true, AFTER_DRAIN = false;
    bf16_t* O; int ldc; const float* srow; const unsigned* cmax;
    __device__ __forceinline__ void operator()(const f32x4 (&acc)[2][2][4][2], const Unit& u, int wr, int wc, int fr, int fq) const {
        const int row0 = u.pm * BM + wr * 64 + fr;
        const bool prod = u.pn >= 10;
        const int col0 = prod ? 2560 + (u.pn - 10) * 128 + wc * 32 + 8 * fq : u.pn * BM + wc * 32 + 8 * fq;
        const int sc0 = col0, sc1 = prod ? col0 + 1024 : col0 + HALF;
        f32x4 sc[2][2];
#pragma unroll
        for (int n = 0; n < 2; ++n) { const u32x4 b0 = *(const u32x4*)(cmax + sc0 + 4 * n), b1 = *(const u32x4*)(cmax + sc1 + 4 * n);
#pragma unroll
            for (int i = 0; i < 4; ++i) { sc[0][n][i] = __uint_as_float(b0[i]) * (1.0f / 127.0f); sc[1][n][i] = __uint_as_float(b1[i]) * (1.0f / 127.0f); } }
        float srv[2][4];
#pragma unroll
        for (int ai = 0; ai < 2; ++ai)
#pragma unroll
            for (int m = 0; m < 4; ++m) srv[ai][m] = srow[row0 + ai * HALF + m * 16];
#pragma unroll
        for (int ai = 0; ai < 2; ++ai)
#pragma unroll
            for (int m = 0; m < 4; ++m) { const float sr = srv[ai][m]; bf16_t* rowp = O + (size_t)(row0 + ai * HALF + m * 16) * ldc + col0;
                f32x4 v[2][2];
#pragma unroll
                for (int bj = 0; bj < 2; ++bj) { const i32x4 a0 = __builtin_bit_cast(i32x4, acc[ai][bj][m][0]), a1 = __builtin_bit_cast(i32x4, acc[ai][bj][m][1]);
#pragma unroll
                    for (int i = 0; i < 4; ++i) { v[bj][0][i] = (float)a0[i] * sr * sc[bj][0][i]; v[bj][1][i] = (float)a1[i] * sr * sc[bj][1][i]; } }
                if (prod) { const f32x4 p0 = v[0][0] * v[1][0], p1 = v[0][1] * v[1][1];
                    u32x4 w; w.x = cvt_pk_bf16(p0[0], p0[1]); w.y = cvt_pk_bf16(p0[2], p0[3]); w.z = cvt_pk_bf16(p1[0], p1[1]); w.w = cvt_pk_bf16(p1[2], p1[3]);
                    *(u32x4*)rowp = w;
                } else {
#pragma unroll
                    for (int bj = 0; bj < 2; ++bj) { u32x4 w; w.x = cvt_pk_bf16(v[bj][0][0], v[bj][0][1]); w.y = cvt_pk_bf16(v[bj][0][2], v[bj][0][3]); w.z = cvt_pk_bf16(v[bj][1][0], v[bj][1][1]); w.w = cvt_pk_bf16(v[bj][1][2], v[bj][1][3]);
                        *(u32x4*)(rowp + bj * HALF) = w; } }
            }
    }
};
struct EpiResGateI8 {
    static constexpr bool PERM = false, AFTER_DRAIN = false;
    const float* base; float* out; int ldc; const float* gate; int gate_stride; float srow_const; const unsigned* cmax;
    __device__ __forceinline__ void operator()(const f32x4 (&acc)[2][2][4][2], const Unit& u, int wr, int wc, int fr, int fq) const {
        const int row0 = u.pm * BM + wr * 64 + fr, col0 = u.pn * BM + wc * 32 + 4 * fq;
        const float* g = gate + (size_t)((u.pm * BM) >> 12) * gate_stride + col0;
        f32x4 gv[2][2];
#pragma unroll
        for (int bj = 0; bj < 2; ++bj)
#pragma unroll
            for (int n = 0; n < 2; ++n) { const f32x4 gg = *(const f32x4*)(g + bj * HALF + n * 16); const u32x4 b = *(const u32x4*)(cmax + col0 + bj * HALF + n * 16);
#pragma unroll
                for (int i = 0; i < 4; ++i) gv[bj][n][i] = gg[i] * __uint_as_float(b[i]) * (srow_const * (1.0f / 127.0f)); }
#pragma unroll
        for (int g2 = 0; g2 < 4; ++g2) {
            const int ai = g2 >> 1, m0 = (g2 & 1) * 2;
            f32x4 bs[2][2][2];
#pragma unroll
            for (int mm = 0; mm < 2; ++mm)
#pragma unroll
                for (int bj = 0; bj < 2; ++bj)
#pragma unroll
                    for (int n = 0; n < 2; ++n) bs[mm][bj][n] = *(const f32x4*)(base + (size_t)(row0 + ai * HALF + (m0 + mm) * 16) * ldc + col0 + bj * HALF + n * 16);
            asm volatile("" ::: "memory");
#pragma unroll
            for (int mm = 0; mm < 2; ++mm) { const size_t off = (size_t)(row0 + ai * HALF + (m0 + mm) * 16) * ldc + col0;
#pragma unroll
                for (int bj = 0; bj < 2; ++bj)
#pragma unroll
                    for (int n = 0; n < 2; ++n) { const i32x4 a = __builtin_bit_cast(i32x4, acc[ai][bj][m0 + mm][n]);
                        f32x4 o;
#pragma unroll
                        for (int i = 0; i < 4; ++i) o[i] = bs[mm][bj][n][i] + gv[bj][n][i] * (float)a[i];
                        *(f32x4*)(out + off + bj * HALF + n * 16) = o; } }
            asm volatile("" ::: "memory");
        }
    }
};
struct EpiResGateBf16I8 {
    static constexpr bool PERM = true, AFTER_DRAIN = false;
    const float* base; bf16_t* O; int ldc; const float* gate; int gate_stride; float srow_const; const unsigned* cmax;
    __device__ __forceinline__ void operator()(const f32x4 (&acc)[2][2][4][2], const Unit& u, int wr, int wc, int fr, int fq) const {
        const int row0 = u.pm * BM + wr * 64 + fr, col0 = u.pn * BM + wc * 32 + 8 * fq;
        const float* g = gate + (size_t)((u.pm * BM) >> 12) * gate_stride + col0;
        f32x4 gv[2][2];
#pragma unroll
        for (int bj = 0; bj < 2; ++bj)
#pragma unroll
            for (int n = 0; n < 2; ++n) { const f32x4 gg = *(const f32x4*)(g + bj * HALF + 4 * n); const u32x4 b = *(const u32x4*)(cmax + col0 + bj * HALF + 4 * n);
#pragma unroll
                for (int i = 0; i < 4; ++i) gv[bj][n][i] = gg[i] * __uint_as_float(b[i]) * (srow_const * (1.0f / 127.0f)); }
#pragma unroll
        for (int g2 = 0; g2 < 2; ++g2) {
            const int ai = g2, m0 = 0;
            f32x4 bs[4][2][2];
#pragma unroll
            for (int mm = 0; mm < 4; ++mm)
#pragma unroll
                for (int bj = 0; bj < 2; ++bj)
#pragma unroll
                    for (int n = 0; n < 2; ++n) bs[mm][bj][n] = *(const f32x4*)(base + (size_t)(row0 + ai * HALF + (m0 + mm) * 16) * ldc + col0 + bj * HALF + 4 * n);
            asm volatile("" ::: "memory");
#pragma unroll
            for (int mm = 0; mm < 4; ++mm) { bf16_t* rowp = O + (size_t)(row0 + ai * HALF + (m0 + mm) * 16) * ldc + col0;
#pragma unroll
                for (int bj = 0; bj < 2; ++bj) { const i32x4 a0 = __builtin_bit_cast(i32x4, acc[ai][bj][m0 + mm][0]), a1 = __builtin_bit_cast(i32x4, acc[ai][bj][m0 + mm][1]);
                    f32x4 v0, v1;
#pragma unroll
                    for (int i = 0; i < 4; ++i) { v0[i] = bs[mm][bj][0][i] + gv[bj][0][i] * (float)a0[i]; v1[i] = bs[mm][bj][1][i] + gv[bj][1][i] * (float)a1[i]; }
                    u32x4 w; w.x = cvt_pk_bf16(v0[0], v0[1]); w.y = cvt_pk_bf16(v0[2], v0[3]); w.z = cvt_pk_bf16(v1[0], v1[1]); w.w = cvt_pk_bf16(v1[2], v1[3]);
                    *(u32x4*)(rowp + bj * HALF) = w; } }
            asm volatile("" ::: "memory");
        }
    }
};
struct EpiResGate {
    static constexpr bool PERM = false, AFTER_DRAIN = false;
    const float* base; float* out; int ldc; const float* gate; int gate_stride;
    __device__ __forceinline__ void operator()(const f32x4 (&acc)[2][2][4][2], const Unit& u, int wr, int wc, int fr, int fq) const {
        const int row0 = u.pm * BM + wr * 64 + fr, col0 = u.pn * BM + wc * 32 + 4 * fq;
        const float* g = gate + (size_t)((u.pm * BM) >> 12) * gate_stride + col0;
        f32x4 gv[2][2];
#pragma unroll
        for (int bj = 0; bj < 2; ++bj)
#pragma unroll
            for (int n = 0; n < 2; ++n) gv[bj][n] = *(const f32x4*)(g + bj * HALF + n * 16);
#pragma unroll
        for (int ai = 0; ai < 2; ++ai)
#pragma unroll
            for (int m = 0; m < 4; ++m) { const size_t off = (size_t)(row0 + ai * HALF + m * 16) * ldc + col0;
#pragma unroll
                for (int bj = 0; bj < 2; ++bj)
#pragma unroll
                    for (int n = 0; n < 2; ++n) { const f32x4 bs = *(const f32x4*)(base + off + bj * HALF + n * 16); *(f32x4*)(out + off + bj * HALF + n * 16) = bs + gv[bj][n] * acc[ai][bj][m][n]; }
                asm volatile("" ::: "memory"); }
    }
};

template <class Epi, class Sched, bool ALIGN_EPI = false, bool SP2 = false, bool I8 = false>
__device__ __forceinline__ void gemm_phase(PG8_LAS unsigned char* lds, const Gemm g, const Sched& S, const Epi& E, const int wid) {
    const int lane = fresh_lane(), tid = wid * 64 + lane, wr = wid >> 2, wc = wid & 3, fr = lane & 15, fq = lane >> 4;
    const int K = g.K, nt = K / BK;
    unsigned voffA[2], voffB[2];
#pragma unroll
    for (int i = 0; i < 2; ++i) { int R, C; stage_rc(tid * 16 + i * 8192, R, C); const int Rb = Epi::PERM ? ((R & ~31) + perm32(R & 31)) : R;
        voffA[i] = (unsigned)(R * K + C) * 2u; voffB[i] = (unsigned)(Rb * K + C) * 2u; }
    const size_t kstep = (size_t)(BK * 2);
    const size_t hstep = (size_t)HALF * K * 2;
    const size_t tstep = 2 * hstep;
    const unsigned ldsw = (unsigned)wid * 1024u;
    const int aoff = lds_byte(wr * 64 + fr, fq * 8), boff = lds_byte(wc * 32 + fr, fq * 8);
#define PG8_SA(b, h) (((b) * 2 + (h)) * HTB)
#define PG8_SB(b, h) ((4 + (b) * 2 + (h)) * HTB)
#define PG8_STAGE(bufoff, gbase, voff) do { _Pragma("unroll") for (int _i = 0; _i < 2; ++_i) \
        __builtin_amdgcn_global_load_lds((const unsigned*)((const char*)(gbase) + (voff)[_i]), (PG8_LAS unsigned*)(lds + (bufoff) + ldsw + _i * 8192), 16, 0, 0); } while (0)
#define PG8_LDA(dst, b, h) do { _Pragma("unroll") for (int m = 0; m < 4; ++m) _Pragma("unroll") for (int k = 0; k < 2; ++k) dst[m][k] = *(const PG8_LAS bf16x8*)(lds + PG8_SA(b, h) + aoff + m * 2048 + k * 1024); } while (0)
#define PG8_LDB(dst, b, h) do { _Pragma("unroll") for (int n = 0; n < 2; ++n) _Pragma("unroll") for (int k = 0; k < 2; ++k) dst[n][k] = *(const PG8_LAS bf16x8*)(lds + PG8_SB(b, h) + boff + n * 2048 + k * 1024); } while (0)
#define PG8_MMA(ai, bj, At, Bt) do { __builtin_amdgcn_s_setprio(1); _Pragma("unroll") for (int m = 0; m < 4; ++m) _Pragma("unroll") for (int n = 0; n < 2; ++n) _Pragma("unroll") for (int k = 0; k < 2; ++k) { \
        if constexpr (I8) acc[ai][bj][m][n] = __builtin_bit_cast(f32x4, __builtin_amdgcn_mfma_i32_16x16x64_i8(__builtin_bit_cast(i32x4, Bt[n][k]), __builtin_bit_cast(i32x4, At[m][k]), __builtin_bit_cast(i32x4, acc[ai][bj][m][n]), 0, 0, 0)); \
        else acc[ai][bj][m][n] = __builtin_amdgcn_mfma_f32_16x16x32_bf16(Bt[n][k], At[m][k], acc[ai][bj][m][n], 0, 0, 0); } __builtin_amdgcn_s_setprio(0); } while (0)
#define PG8_WAIT_V(n) asm volatile("s_waitcnt vmcnt(" #n ")" ::: "memory")
#define PG8_WAIT_L(n) asm volatile("s_waitcnt lgkmcnt(" #n ")" ::: "memory")
#define PG8_BAR __builtin_amdgcn_s_barrier()
#define PG8_SCHED __builtin_amdgcn_sched_barrier(0)
    Unit cur, nxt; int ui = 0;
    if (!S.next(0, cur)) return;
    f32x4 acc[2][2][4][2];
#pragma unroll
    for (int a = 0; a < 2; ++a)
#pragma unroll
        for (int b = 0; b < 2; ++b)
#pragma unroll
            for (int m = 0; m < 4; ++m)
#pragma unroll
                for (int n = 0; n < 2; ++n) acc[a][b][m][n] = (f32x4){0.f, 0.f, 0.f, 0.f};
    bf16x8 At[4][2], B0[2][2], B1[2][2];
    const char* cA = (const char*)g.A + (size_t)cur.pm * tstep; const char* cB = (const char*)g.Bt + (size_t)cur.pn * tstep;
    S.a_ready(cur);
    if constexpr (SP2) {
        PG8_STAGE(PG8_SB(0, 0), cB, voffB); PG8_STAGE(PG8_SB(0, 1), cB + hstep, voffB); PG8_STAGE(PG8_SA(0, 0), cA, voffA); PG8_STAGE(PG8_SA(0, 1), cA + hstep, voffA);
        if (wr == 1) PG8_BAR;
        PG8_WAIT_V(2); PG8_BAR;
        PG8_STAGE(PG8_SB(1, 0), cB + kstep, voffB); PG8_STAGE(PG8_SA(1, 0), cA + kstep, voffA); PG8_STAGE(PG8_SB(1, 1), cB + hstep + kstep, voffB);
        PG8_WAIT_V(6); PG8_BAR;
    } else {
        PG8_STAGE(PG8_SB(0, 0), cB, voffB); PG8_STAGE(PG8_SA(0, 0), cA, voffA); PG8_STAGE(PG8_SB(0, 1), cB + hstep, voffB); PG8_STAGE(PG8_SA(0, 1), cA + hstep, voffA);
        if (wr == 1) PG8_BAR;
        PG8_WAIT_V(4); PG8_BAR;
        PG8_STAGE(PG8_SB(1, 0), cB + kstep, voffB); PG8_STAGE(PG8_SA(1, 0), cA + kstep, voffA); PG8_STAGE(PG8_SB(1, 1), cB + hstep + kstep, voffB);
        PG8_WAIT_V(6); PG8_BAR;
    }
    for (;;) {
        const bool has_next = S.next(ui + 1, nxt);
        const char* nA = has_next ? (const char*)g.A + (size_t)nxt.pm * tstep : cA; const char* nB = has_next ? (const char*)g.Bt + (size_t)nxt.pn * tstep : cB;
        for (int t = 0; t < nt; t += 2) {
            const bool last = (t == nt - 2);
            const char* a1 = cA + (size_t)(t + 1) * kstep;
            const char* a2 = last ? nA : cA + (size_t)(t + 2) * kstep; const char* b2 = last ? nB : cB + (size_t)(t + 2) * kstep;
            const char* a3 = a2 + kstep; const char* b3 = b2 + kstep;
            if (last && has_next) S.a_ready(nxt);
            if constexpr (SP2) {
            PG8_LDB(B0, 0, 0); PG8_LDB(B1, 0, 1); PG8_SCHED; PG8_LDA(At, 0, 0); PG8_STAGE(PG8_SA(1, 1), a1 + hstep, voffA);
            PG8_WAIT_V(8); PG8_WAIT_L(0); PG8_BAR; PG8_MMA(0, 0, At, B0); PG8_MMA(0, 1, At, B1); PG8_BAR; PG8_SCHED;
            PG8_LDA(At, 0, 1); PG8_STAGE(PG8_SB(0, 0), b2, voffB); PG8_STAGE(PG8_SB(0, 1), b2 + hstep, voffB); PG8_STAGE(PG8_SA(0, 0), a2, voffA);
            PG8_WAIT_V(8); PG8_WAIT_L(0); PG8_BAR; PG8_MMA(1, 0, At, B0); PG8_MMA(1, 1, At, B1); PG8_BAR; PG8_SCHED;
            PG8_LDB(B0, 1, 0); PG8_LDB(B1, 1, 1); PG8_SCHED; PG8_LDA(At, 1, 0); PG8_STAGE(PG8_SA(0, 1), a2 + hstep, voffA);
            PG8_WAIT_V(8); PG8_WAIT_L(0); PG8_BAR; PG8_MMA(0, 0, At, B0); PG8_MMA(0, 1, At, B1); PG8_BAR; PG8_SCHED;
            PG8_LDA(At, 1, 1); PG8_STAGE(PG8_SB(1, 0), b3, voffB); PG8_STAGE(PG8_SB(1, 1), b3 + hstep, voffB); PG8_STAGE(PG8_SA(1, 0), a3, voffA);
            PG8_WAIT_V(8); PG8_WAIT_L(0); PG8_BAR; PG8_MMA(1, 0, At, B0); PG8_MMA(1, 1, At, B1); PG8_BAR; PG8_SCHED;
            } else {
            PG8_LDB(B0, 0, 0); PG8_SCHED; PG8_LDA(At, 0, 0); PG8_STAGE(PG8_SA(1, 1), a1 + hstep, voffA);
            PG8_WAIT_L(8); PG8_BAR; PG8_WAIT_L(0); PG8_MMA(0, 0, At, B0); PG8_BAR; PG8_SCHED;
            PG8_LDB(B1, 0, 1); PG8_STAGE(PG8_SB(0, 0), b2, voffB);
            PG8_BAR; PG8_WAIT_L(0); PG8_MMA(0, 1, At, B1); PG8_BAR;
            PG8_LDA(At, 0, 1); PG8_STAGE(PG8_SA(0, 0), a2, voffA);
            PG8_BAR; PG8_WAIT_L(0); PG8_MMA(1, 0, At, B0); PG8_BAR; PG8_SCHED;
            PG8_STAGE(PG8_SB(0, 1), b2 + hstep, voffB);
            PG8_WAIT_V(6); PG8_BAR; PG8_MMA(1, 1, At, B1); PG8_BAR;
            PG8_LDB(B0, 1, 0); PG8_SCHED; PG8_LDA(At, 1, 0); PG8_STAGE(PG8_SA(0, 1), a2 + hstep, voffA);
            PG8_WAIT_L(8); PG8_BAR; PG8_WAIT_L(0); PG8_MMA(0, 0, At, B0); PG8_BAR; PG8_SCHED;
            PG8_LDB(B1, 1, 1); PG8_STAGE(PG8_SB(1, 0), b3, voffB);
            PG8_BAR; PG8_WAIT_L(0); PG8_MMA(0, 1, At, B1); PG8_BAR;
            PG8_LDA(At, 1, 1); PG8_STAGE(PG8_SA(1, 0), a3, voffA);
            PG8_BAR; PG8_WAIT_L(0); PG8_MMA(1, 0, At, B0); PG8_BAR; PG8_SCHED;
            PG8_STAGE(PG8_SB(1, 1), b3 + hstep, voffB);
            PG8_WAIT_V(6); PG8_BAR; PG8_MMA(1, 1, At, B1); PG8_BAR;
            }
        }
        if constexpr (ALIGN_EPI) { if (wr == 0) PG8_BAR; }
        if constexpr (!Epi::AFTER_DRAIN) { E(acc, cur, wr, wc, fr, fq); S.done(cur); }
        if (!has_next) break;
#pragma unroll
        for (int a = 0; a < 2; ++a)
#pragma unroll
            for (int b = 0; b < 2; ++b)
#pragma unroll
                for (int m = 0; m < 4; ++m)
#pragma unroll
                    for (int n = 0; n < 2; ++n) acc[a][b][m][n] = (f32x4){0.f, 0.f, 0.f, 0.f};
        cur = nxt; cA = nA; cB = nB; ++ui;
        if constexpr (ALIGN_EPI) { if (wr == 1) PG8_BAR; }
    }
    PG8_WAIT_V(0);
    if constexpr (!ALIGN_EPI) { if (wr == 0) PG8_BAR; }
    PG8_BAR;
#undef PG8_SA
#undef PG8_SB
#undef PG8_STAGE
#undef PG8_LDA
#undef PG8_LDB
#undef PG8_MMA
#undef PG8_WAIT_V
#undef PG8_WAIT_L
#undef PG8_BAR
#undef PG8_SCHED
}
}

#define XB_TMO      128
#define XB_XCNT(j)  (256  + 64 * (j))
#define XB_XSUB(j)  (1280 + 64 * (j))
#define XB_XGEN(j)  (2304 + 64 * (j))
#define XB_TOP      3328
#define XB_TOPGEN   3392
#define XCD_BAR_WORDS 3456
#define XB_SPIN_CAP (1u << 18)
__device__ __forceinline__ unsigned xb_ld(unsigned* p)              { return __hip_atomic_load(p, __ATOMIC_RELAXED, __HIP_MEMORY_SCOPE_AGENT); }
__device__ __forceinline__ unsigned xb_add(unsigned* p, unsigned v) { return __hip_atomic_fetch_add(p, v, __ATOMIC_RELAXED, __HIP_MEMORY_SCOPE_AGENT); }
__device__ __forceinline__ unsigned xb_xcc_id() { return (unsigned)__builtin_amdgcn_s_getreg((3 << 11) | 20) & 0xFu; }
#define XB_SPIN(cond, bar) do { unsigned _sp = 0; while (cond) { __builtin_amdgcn_s_sleep(1); \
    if ((++_sp & 255u) == 0u) { if (xb_ld(&(bar)[XB_TMO])) break; if (_sp > XB_SPIN_CAP) { atomicAdd(&(bar)[XB_TMO], 1u); break; } } } } while (0)
struct XcdBarrier { unsigned* bar; unsigned x; volatile LAS unsigned* st; int wave; };
__device__ __forceinline__ XcdBarrier xcd_barrier_post(unsigned* bar, volatile LAS unsigned* st, int wave) {
    XcdBarrier b; b.bar = bar; b.x = xb_xcc_id(); b.st = st; b.wave = wave;
    if (wave == 0 && fresh_lane() == 0) (void)xb_add(&bar[XB_XCNT(b.x)], 1u);
    return b;
}
__device__ __forceinline__ void xcd_barrier_complete(unsigned* bar, unsigned x, unsigned& nloc, unsigned& nx) {
    const unsigned G = gridDim.x * gridDim.y * gridDim.z;
    unsigned sum, cnt, mine, sp = 0u;
    for (;;) {
        sum = 0u; cnt = 0u; mine = 0u;
#pragma unroll
        for (unsigned j = 0; j < 16; ++j) { const unsigned c = xb_ld(&bar[XB_XCNT(j)]); sum += c; cnt += (c > 0u) ? 1u : 0u; mine = (j == x) ? c : mine; }
        if (sum == G) break;
        __builtin_amdgcn_s_sleep(1);
        if ((++sp & 255u) == 0u) { if (xb_ld(&bar[XB_TMO])) break; if (sp > XB_SPIN_CAP) { atomicAdd(&bar[XB_TMO], 1u); break; } }
    }
    nloc = mine > 0u ? mine : 1u; nx = cnt > 0u ? cnt : 1u;
}
__device__ __forceinline__ void xcd_barrier(const XcdBarrier& b) {
    asm volatile("s_waitcnt vmcnt(0)" ::: "memory");
    __syncthreads();
    if (b.wave == 0 && fresh_lane() == 0) {
        unsigned* bar = b.bar;
        __builtin_amdgcn_s_waitcnt(0);
        unsigned nloc = b.st[0], nx = b.st[1];
        if (nloc == 0u) { xcd_barrier_complete(bar, b.x, nloc, nx); b.st[0] = nloc; b.st[1] = nx; }
        const unsigned old = xb_add(&bar[XB_XSUB(b.x)], 1u);
        const unsigned gen = old / nloc, target = (gen + 1u) * nx;
        if (old + 1u == (gen + 1u) * nloc) {
            __builtin_amdgcn_fence(__ATOMIC_RELEASE, "agent");
            asm volatile("s_waitcnt vmcnt(0)" ::: "memory");
            const unsigned og = xb_add(&bar[XB_TOP], 1u);
            if (og + 1u != target) XB_SPIN(xb_ld(&bar[XB_TOP]) < target, bar);
        } else {
            XB_SPIN(xb_ld(&bar[XB_TOP]) < target, bar);
        }
        __builtin_amdgcn_fence(__ATOMIC_ACQUIRE, "agent");
        asm volatile("s_waitcnt vmcnt(0)" ::: "memory");
    }
    __syncthreads();
}

__device__ __forceinline__ void p0_ada_item(const float* cvec, const float* w_ada, const float* b_ada, float* mod, LAS unsigned char* lds, int item, int tid, int wave, int lane) {
    LAS float* sc = (LAS float*)(lds + wave * 8192);
    LAS float* red = (LAS float*)(lds + 65536);
    const int k0 = wave * 256;
    { float cv[32];
#pragma unroll
      for (int j = 0; j < 32; ++j) { const int i = lane + 64 * j; cv[j] = cvec[(i & 7) * DM + k0 + (i >> 3)]; }
#pragma unroll
      for (int j = 0; j < 32; ++j) { const int i = lane + 64 * j; const float v = cv[j]; sc[(i >> 3) * 8 + (i & 7)] = v * __builtin_amdgcn_rcpf(1.f + __builtin_amdgcn_exp2f(-v * LOG2E)); } }
    LDS_WAIT();
    const int rg = lane >> 4, cq = lane & 15;
    float acc[8][4];
#pragma unroll
    for (int b = 0; b < 8; ++b)
#pragma unroll
        for (int i = 0; i < 4; ++i) acc[b][i] = 0.f;
    const float* wp = w_ada + (size_t)(k0 + rg) * MODW + item * 64 + 4 * cq;
#pragma unroll 32
    for (int it = 0; it < 64; ++it) {
        const f32x4 w4 = *(const f32x4*)(wp + (size_t)it * 4 * MODW);
        const int kk = it * 4 + rg;
        const f32x4 s0 = *(const LAS f32x4*)(sc + kk * 8), s1 = *(const LAS f32x4*)(sc + kk * 8 + 4);
#pragma unroll
        for (int i = 0; i < 4; ++i) {
            acc[0][i] += s0[0] * w4[i]; acc[1][i] += s0[1] * w4[i]; acc[2][i] += s0[2] * w4[i]; acc[3][i] += s0[3] * w4[i];
            acc[4][i] += s1[0] * w4[i]; acc[5][i] += s1[1] * w4[i]; acc[6][i] += s1[2] * w4[i]; acc[7][i] += s1[3] * w4[i];
        }
    }
#pragma unroll
    for (int b = 0; b < 8; ++b)
#pragma unroll
        for (int i = 0; i < 4; ++i) acc[b][i] = xrow_sum(acc[b][i]);
    if (rg == 0) {
#pragma unroll
        for (int b = 0; b < 8; ++b)
#pragma unroll
            for (int i = 0; i < 4; ++i) red[(wave * 8 + b) * 64 + 4 * cq + i] = acc[b][i];
    }
    LDS_WAIT();
    __syncthreads();
    { const int b = tid >> 6, col = tid & 63; float s = b_ada[item * 64 + col];
#pragma unroll
      for (int w = 0; w < 8; ++w) s += red[(w * 8 + b) * 64 + col];
      mod[b * MODW + item * 64 + col] = s; }
    LDS_WAIT();
    __syncthreads();
}
__device__ __forceinline__ void p0_transpose_item(const float* W, int K, int N, bf16_t* WT, LAS float* scr, int item, int lane) {
    const int nblk = N / 32, kb = item / nblk, nb = item % nblk, k0 = 64 * kb, n0 = 32 * nb;
#pragma unroll 8
    for (int i = 0; i < 32; ++i) { const int kk = 2 * i + (lane >> 5); scr[kk * 33 + (lane & 31)] = W[(size_t)(k0 + kk) * N + n0 + (lane & 31)]; }
    LDS_WAIT(); asm volatile("" ::: "memory");
    const int c = lane & 7;
#pragma unroll
    for (int j = 0; j < 4; ++j) { const int n = (lane >> 3) + 8 * j; const LAS float* s = scr + (8 * c) * 33 + n;
        u32x4 o; o.x = cvtpk(s[0 * 33], s[1 * 33]); o.y = cvtpk(s[2 * 33], s[3 * 33]); o.z = cvtpk(s[4 * 33], s[5 * 33]); o.w = cvtpk(s[6 * 33], s[7 * 33]);
        *(u32x4*)(WT + (size_t)(n0 + n) * K + k0 + 8 * c) = o; }
    LDS_WAIT(); asm volatile("" ::: "memory");
}
__device__ __forceinline__ void p0_colmax_item(const float* W, int N, unsigned* cmax, int item, int lane) {
    const int nblk = N / 32, kb = item / nblk, nb = item % nblk, k0 = 64 * kb, n0 = 32 * nb;
    float am = 0.f;
#pragma unroll
    for (int i = 0; i < 32; ++i) am = fmaxf(am, fabsf(W[(size_t)(k0 + 2 * i + (lane >> 5)) * N + n0 + (lane & 31)]));
    am = fmaxf(am, __shfl_xor(am, 32));
    if (lane < 32) atomicMax(cmax + n0 + lane, __float_as_uint(am));
}
template <bool INTERLEAVE>
__device__ __forceinline__ void p1_transpose_i8_item(const float* W, int K, int N, unsigned char* WT, const unsigned* cmax, LAS float* scr, int item, int lane) {
    const int nblk = N / 32, kb = item / nblk, nb = item % nblk, k0 = 64 * kb, nd0 = 32 * nb;
    int n0 = nd0;
    if (INTERLEAVE && nd0 >= 2560) { const int t = (nd0 - 2560) >> 8, j = (nd0 - 2560) & 255; n0 = j < 128 ? 2560 + 128 * t + j : 3584 + 128 * t + (j - 128); }
    float wv[32];
#pragma unroll
    for (int i = 0; i < 32; ++i) wv[i] = W[(size_t)(k0 + 2 * i + (lane >> 5)) * N + n0 + (lane & 31)];
#pragma unroll
    for (int i = 0; i < 32; ++i) { const int kk = 2 * i + (lane >> 5); scr[kk * 33 + (lane & 31)] = wv[i]; }
    LDS_WAIT(); asm volatile("" ::: "memory");
    const int c4 = lane & 3;
#pragma unroll
    for (int j = 0; j < 2; ++j) { const int n = (lane >> 2) + 16 * j; const LAS float* s = scr + (16 * c4) * 33 + n;
        const float am = __uint_as_float(cmax[n0 + n]); const float inv = am > 0.f ? 127.0f / am : 0.f;
        u32x4 o;
#pragma unroll
        for (int w = 0; w < 4; ++w) o[w] = pack_i8x4((f32x4){s[(4 * w) * 33], s[(4 * w + 1) * 33], s[(4 * w + 2) * 33], s[(4 * w + 3) * 33]}, inv);
        *(u32x4*)(WT + (size_t)(nd0 + n) * K + k0 + 16 * c4) = o; }
    LDS_WAIT(); asm volatile("" ::: "memory");
}
__device__ __forceinline__ void p0_w2_item(const float* w_pq, const float* subkeys, bf16_t* W2, unsigned* cmax, int item, int lane) {
    const int blk = item >> 5, kq = (item >> 4) & 1, dch = item & 15, c = lane & 15, quad = lane >> 4;
    bf16x8 kf[4][4];
    { f32x4 sv[4][4][2];
#pragma unroll
      for (int kt = 0; kt < 4; ++kt) { const float* sp = subkeys + ((size_t)blk * 128 + (kq * 4 + kt) * 16 + c) * 128 + 8 * quad;
#pragma unroll
          for (int ks = 0; ks < 4; ++ks) { sv[kt][ks][0] = *(const f32x4*)(sp + ks * 32); sv[kt][ks][1] = *(const f32x4*)(sp + ks * 32 + 4); } }
#pragma unroll
      for (int kt = 0; kt < 4; ++kt)
#pragma unroll
          for (int ks = 0; ks < 4; ++ks) { const f32x4 a = sv[kt][ks][0], b = sv[kt][ks][1];
              u32x4 w; w.x = cvtpk(a[0], a[1]); w.y = cvtpk(a[2], a[3]); w.z = cvtpk(b[0], b[1]); w.w = cvtpk(b[2], b[3]); kf[kt][ks] = __builtin_bit_cast(bf16x8, w); } }
    float am[4] = {0.f, 0.f, 0.f, 0.f};
#pragma nounroll
    for (int dq = 0; dq < 2; ++dq) {
        f32x4 wv[4][4][2];
#pragma unroll
        for (int j = 0; j < 4; ++j) { const float* wp = w_pq + (size_t)(dch * 128 + (dq * 4 + j) * 16 + c) * DM + blk * 128 + 8 * quad;
#pragma unroll
            for (int ks = 0; ks < 4; ++ks) { wv[j][ks][0] = *(const f32x4*)(wp + ks * 32); wv[j][ks][1] = *(const f32x4*)(wp + ks * 32 + 4); } }
#pragma unroll
        for (int j = 0; j < 4; ++j) { const int d0 = dch * 128 + (dq * 4 + j) * 16;
            bf16x8 wb[4];
#pragma unroll
            for (int ks = 0; ks < 4; ++ks) { const f32x4 a = wv[j][ks][0], b = wv[j][ks][1];
                u32x4 w; w.x = cvtpk(a[0], a[1]); w.y = cvtpk(a[2], a[3]); w.z = cvtpk(b[0], b[1]); w.w = cvtpk(b[2], b[3]); wb[ks] = __builtin_bit_cast(bf16x8, w); }
#pragma unroll
            for (int kt = 0; kt < 4; ++kt) {
                f32x4 acc = (f32x4){0.f, 0.f, 0.f, 0.f};
#pragma unroll
                for (int ks = 0; ks < 4; ++ks) acc = __builtin_amdgcn_mfma_f32_16x16x32_bf16(wb[ks], kf[kt][ks], acc, 0, 0, 0);
                am[kt] = fmaxf(fmaxf(am[kt], fmaxf(fabsf(acc[0]), fabsf(acc[1]))), fmaxf(fabsf(acc[2]), fabsf(acc[3])));
                u32x2 o; o.x = cvtpk(acc[0], acc[1]); o.y = cvtpk(acc[2], acc[3]);
                *(u32x2*)(W2 + (size_t)(blk * 128 + (kq * 4 + kt) * 16 + c) * DM + d0 + 4 * quad) = o; } }
    }
#pragma unroll
    for (int kt = 0; kt < 4; ++kt) { const float a = xrow_max(am[kt]); if (quad == 0) atomicMax(cmax + blk * 128 + (kq * 4 + kt) * 16 + c, __float_as_uint(a)); }
}
__device__ __forceinline__ void p1_w2_row(const bf16_t* W2, unsigned char* WT, const unsigned* cmax, int n, int lane) {
    const float am = __uint_as_float(cmax[n]); const float inv = am > 0.f ? 127.0f / am : 0.f;
#pragma unroll
    for (int j = 0; j < 8; ++j) { const u32x2 v = *(const u32x2*)(W2 + (size_t)n * DM + 256 * j + 4 * lane);
        *(unsigned*)(WT + (size_t)n * DM + 256 * j + 4 * lane) = pack_i8x4((f32x4){bf_lo(v.x), bf_hi(v.x), bf_lo(v.y), bf_hi(v.y)}, inv); }
}
__device__ __forceinline__ void p0_cvt_item(const float* src, bf16_t* dst, size_t base, int lane) {
#pragma unroll
    for (int j = 0; j < 4; ++j) { const size_t o = base + (size_t)j * 512 + lane * 8;
        const f32x4 a = *(const f32x4*)(src + o), b = *(const f32x4*)(src + o + 4);
        u32x4 w; w.x = cvtpk(a[0], a[1]); w.y = cvtpk(a[2], a[3]); w.z = cvtpk(b[0], b[1]); w.w = cvtpk(b[2], b[3]);
        *(u32x4*)(dst + o) = w; }
}
__device__ __forceinline__ size_t tab_off(int row, int col) { return ((size_t)(col >> 7) * PEER_N + row) * 128 + (col & 127); }
__device__ __forceinline__ void p0_fp8_item(const float* src, unsigned char* dst, size_t base, float scale, int lane) {
#pragma unroll
    for (int i = 0; i < 8; ++i) { const size_t o = base + (size_t)i * 256 + lane * 4; const f32x4 a = *(const f32x4*)(src + o);
        int p = 0; p = __builtin_amdgcn_cvt_pk_fp8_f32(a[0] * scale, a[1] * scale, p, false); p = __builtin_amdgcn_cvt_pk_fp8_f32(a[2] * scale, a[3] * scale, p, true);
        *(unsigned*)(dst + tab_off((int)(base >> 11), i * 256 + lane * 4)) = (unsigned)p; }
}
__device__ __forceinline__ void p0_i8_row(const float* src, unsigned char* dst, float* scale, int row, int lane) {
    const float* p = src + (size_t)row * DM + lane * 4;
    f32x4 v[8]; float am = 0.f;
#pragma unroll
    for (int i = 0; i < 8; ++i) { v[i] = *(const f32x4*)(p + i * 256); am = fmaxf(fmaxf(am, fmaxf(fabsf(v[i][0]), fabsf(v[i][1]))), fmaxf(fabsf(v[i][2]), fabsf(v[i][3]))); }
    am = wave_max(am);
    const float inv = am > 0.f ? 127.0f / am : 0.f;
#pragma unroll
    for (int i = 0; i < 8; ++i) *(unsigned*)(dst + tab_off(row, i * 256 + lane * 4)) = pack_i8x4(v[i], inv);
    if (lane == 0) scale[row] = am * (1.0f / 127.0f);
}
__device__ __forceinline__ void p0_tables8(const float* peer_u, const float* peer_v, unsigned char* UB, float* SU, unsigned char* VB, int gw, int ngw, int lane) {
#define P0_TAB_SRC(k) (((k) < 8 ? peer_u : peer_v) + (size_t)(gw + ((k) & 7) * ngw) * DM + lane * 4)
    f32x4 ra[8], rb[8], rc[8];
#pragma unroll
    for (int i = 0; i < 8; ++i) ra[i] = *(const f32x4*)(P0_TAB_SRC(0) + i * 256);
#pragma unroll
    for (int i = 0; i < 8; ++i) rb[i] = *(const f32x4*)(P0_TAB_SRC(1) + i * 256);
#pragma unroll
    for (int k = 0; k < 16; ++k) {
        const int row = gw + (k & 7) * ngw;
        f32x4 (&v)[8] = (k % 3 == 0) ? ra : (k % 3 == 1) ? rb : rc;
        f32x4 (&nn)[8] = (k % 3 == 0) ? rc : (k % 3 == 1) ? ra : rb;
        if (k < 14) {
#pragma unroll
            for (int i = 0; i < 8; ++i) nn[i] = *(const f32x4*)(P0_TAB_SRC(k + 2) + i * 256); }
        if (k < 8) {
            float am = 0.f;
#pragma unroll
            for (int i = 0; i < 8; ++i) am = fmaxf(fmaxf(am, fmaxf(fabsf(v[i][0]), fabsf(v[i][1]))), fmaxf(fabsf(v[i][2]), fabsf(v[i][3])));
            am = wave_max(am);
            const float inv = am > 0.f ? 127.0f / am : 0.f;
            unsigned char* q = UB + (size_t)(lane >> 5) * (PEER_N * 128) + (size_t)row * 128 + (lane & 31) * 4;
#pragma unroll
            for (int i = 0; i < 8; ++i) *(unsigned*)(q + (size_t)i * (2 * PEER_N * 128)) = pack_i8x4(v[i], inv);
            if (lane == 0) SU[row] = am * (1.0f / 127.0f);
        } else {
            unsigned char* q = VB + (size_t)(lane >> 5) * (PEER_N * 128) + (size_t)row * 128 + (lane & 31) * 4;
#pragma unroll
            for (int i = 0; i < 8; ++i) { int p = 0; p = __builtin_amdgcn_cvt_pk_fp8_f32(v[i][0] * V_SCALE, v[i][1] * V_SCALE, p, false); p = __builtin_amdgcn_cvt_pk_fp8_f32(v[i][2] * V_SCALE, v[i][3] * V_SCALE, p, true);
                *(unsigned*)(q + (size_t)i * (2 * PEER_N * 128)) = (unsigned)p; }
        }
    }
#undef P0_TAB_SRC
}
struct TabCtx { const float* src; unsigned char* dst; float* SU; int p; };
__device__ __forceinline__ void tab_row_load(const TabCtx& T, int k, f32x4 (&v)[8], int lane) {
    const float* np = T.src + (size_t)(T.p + 1024 * (k < 15 ? k : 15)) * DM + lane * 4;
#pragma unroll
    for (int i = 0; i < 8; ++i) v[i] = *(const f32x4*)(np + i * 256);
}
template <bool ISV> __device__ __forceinline__ void tab_row_convert(const TabCtx& T, int k, const f32x4 (&v)[8], int lane) {
    const int row = T.p + 1024 * k;
    unsigned char* q = T.dst + (size_t)(lane >> 5) * (PEER_N * 128) + (size_t)row * 128 + (lane & 31) * 4;
    if (!ISV) {
        float am = 0.f;
#pragma unroll
        for (int i = 0; i < 8; ++i) am = fmaxf(fmaxf(am, fmaxf(fabsf(v[i][0]), fabsf(v[i][1]))), fmaxf(fabsf(v[i][2]), fabsf(v[i][3])));
        am = wave_max(am);
        const float inv = am > 0.f ? 127.0f / am : 0.f;
#pragma unroll
        for (int i = 0; i < 8; ++i) *(unsigned*)(q + (size_t)i * (2 * PEER_N * 128)) = pack_i8x4(v[i], inv);
        if (lane == 0) T.SU[row] = am * (1.0f / 127.0f);
    } else {
#pragma unroll
        for (int i = 0; i < 8; ++i) { int p = 0; p = __builtin_amdgcn_cvt_pk_fp8_f32(v[i][0] * V_SCALE, v[i][1] * V_SCALE, p, false); p = __builtin_amdgcn_cvt_pk_fp8_f32(v[i][2] * V_SCALE, v[i][3] * V_SCALE, p, true);
            *(unsigned*)(q + (size_t)i * (2 * PEER_N * 128)) = (unsigned)p; }
    }
}
__device__ __forceinline__ void p0_rope_item(float* rope, int item, int lane) {
    const int idx = item * 64 + lane, pos = idx >> 3, i = idx & 7;
    const double f = (i == 0) ? 0.15915494309189535 : (i == 1) ? 0.03086376340470123 : (i == 2) ? 0.005985185712713705 : (i == 3) ? 0.001160663641240061
                   : (i == 4) ? 0.00022507907903927653 : (i == 5) ? 4.364795279280289e-05 : (i == 6) ? 8.464330808241401e-06 : 1.6414262627950345e-06;
    const double rev = (double)pos * f; const double fr = rev - (double)(long long)rev;
    rope[idx] = __builtin_amdgcn_cosf((float)fr); rope[32768 + idx] = __builtin_amdgcn_sinf((float)fr);
}

__device__ __forceinline__ void norm_rows(const float* src, const float* gain, const float* mod, int off_shift, int off_scale, unsigned char* dst8, float* scale8, int gw, int ngw, int lane) {
    for (int grp = gw; grp < MTOK / 16; grp += ngw) {
        const int row0 = grp * 16; const float* mb = mod + (size_t)(row0 >> 12) * MODW;
        f32x4 A[8], B[8];
#pragma unroll
        for (int j = 0; j < 8; ++j) { const int c = 256 * j + 4 * lane; const f32x4 g = *(const f32x4*)(gain + c), sc = *(const f32x4*)(mb + off_scale + c); A[j] = g * (sc + 1.0f); B[j] = *(const f32x4*)(mb + off_shift + c); }
        f32x4 ra[8], rb[8], rc[8];
#pragma unroll
        for (int j = 0; j < 8; ++j) ra[j] = *(const f32x4*)(src + (size_t)row0 * DM + 4 * lane + 256 * j);
#pragma unroll
        for (int j = 0; j < 8; ++j) rb[j] = *(const f32x4*)(src + (size_t)(row0 + 1) * DM + 4 * lane + 256 * j);
#pragma unroll
        for (int r = 0; r < 16; ++r) {
            f32x4 (&cur)[8] = (r % 3 == 0) ? ra : (r % 3 == 1) ? rb : rc;
            f32x4 (&nn)[8] = (r % 3 == 0) ? rc : (r % 3 == 1) ? ra : rb;
            f32x4 v[8]; float ss = 0.f;
#pragma unroll
            for (int j = 0; j < 8; ++j) { v[j] = cur[j]; ss += (v[j][0] * v[j][0] + v[j][1] * v[j][1]) + (v[j][2] * v[j][2] + v[j][3] * v[j][3]); }
            if (r < 14) { const float* xn = src + (size_t)(row0 + r + 2) * DM + 4 * lane;
#pragma unroll
              for (int j = 0; j < 8; ++j) nn[j] = *(const f32x4*)(xn + 256 * j); }
            const float rstd = 1.0f / sqrtf(wave_sum(ss) * (1.0f / DM) + EPS);
            float am = 0.f;
#pragma unroll
            for (int j = 0; j < 8; ++j) { const f32x4 o = v[j] * rstd * A[j] + B[j]; v[j] = o; am = fmaxf(fmaxf(am, fmaxf(fabsf(o[0]), fabsf(o[1]))), fmaxf(fabsf(o[2]), fabsf(o[3]))); }
            am = wave_max(am); const float inv = am > 0.f ? 127.0f / am : 0.f;
            unsigned* q = (unsigned*)(dst8 + (size_t)(row0 + r) * DM + 4 * lane);
#pragma unroll
            for (int j = 0; j < 8; ++j) q[64 * j] = pack_i8x4(v[j], inv);
            if (lane == 0) scale8[row0 + r] = am * (1.0f / 127.0f);
        }
    }
}

__device__ __forceinline__ void norm_rows_bf16(const bf16_t* src, const float* gain, const float* mod, int off_shift, int off_scale, unsigned char* dst8, float* scale8, int gw, int ngw, int lane) {
    for (int grp = gw; grp < MTOK / 16; grp += ngw) {
        const int row0 = grp * 16; const float* mb = mod + (size_t)(row0 >> 12) * MODW;
        f32x4 A[8], B[8];
#pragma unroll
        for (int j = 0; j < 8; ++j) { const int c = 512 * (j >> 1) + 8 * lane + 4 * (j & 1); const f32x4 g = *(const f32x4*)(gain + c), sc = *(const f32x4*)(mb + off_scale + c); A[j] = g * (sc + 1.0f); B[j] = *(const f32x4*)(mb + off_shift + c); }
        u32x4 ra[4], rb[4], rc[4];
#pragma unroll
        for (int j = 0; j < 4; ++j) ra[j] = *(const u32x4*)(src + (size_t)row0 * DM + 8 * lane + 512 * j);
#pragma unroll
        for (int j = 0; j < 4; ++j) rb[j] = *(const u32x4*)(src + (size_t)(row0 + 1) * DM + 8 * lane + 512 * j);
#pragma unroll
        for (int r = 0; r < 16; ++r) {
            u32x4 (&cur)[4] = (r % 3 == 0) ? ra : (r % 3 == 1) ? rb : rc;
            u32x4 (&nn)[4] = (r % 3 == 0) ? rc : (r % 3 == 1) ? ra : rb;
            f32x4 v[8]; float ss = 0.f;
#pragma unroll
            for (int j = 0; j < 4; ++j) { const u32x4 t = cur[j]; v[2 * j] = (f32x4){bf_lo(t.x), bf_hi(t.x), bf_lo(t.y), bf_hi(t.y)}; v[2 * j + 1] = (f32x4){bf_lo(t.z), bf_hi(t.z), bf_lo(t.w), bf_hi(t.w)}; }
#pragma unroll
            for (int j = 0; j < 8; ++j) ss += (v[j][0] * v[j][0] + v[j][1] * v[j][1]) + (v[j][2] * v[j][2] + v[j][3] * v[j][3]);
            if (r < 14) { const bf16_t* xn = src + (size_t)(row0 + r + 2) * DM + 8 * lane;
#pragma unroll
              for (int j = 0; j < 4; ++j) nn[j] = *(const u32x4*)(xn + 512 * j); }
            const float rstd = __builtin_amdgcn_rsqf(wave_sum(ss) * (1.0f / DM) + EPS);
            float am = 0.f;
#pragma unroll
            for (int j = 0; j < 8; ++j) { const f32x4 o = v[j] * rstd * A[j] + B[j]; v[j] = o; am = fmaxf(fmaxf(am, fmaxf(fabsf(o[0]), fabsf(o[1]))), fmaxf(fabsf(o[2]), fabsf(o[3]))); }
            am = wave_max(am); const float inv = am > 0.f ? 127.0f / am : 0.f;
            unsigned char* q = dst8 + (size_t)(row0 + r) * DM + 8 * lane;
#pragma unroll
            for (int j = 0; j < 4; ++j) { u32x2 o; o.x = pack_i8x4(v[2 * j], inv); o.y = pack_i8x4(v[2 * j + 1], inv); *(u32x2*)(q + 512 * j) = o; }
            if (lane == 0) scale8[row0 + r] = am * (1.0f / 127.0f);
        }
    }
}

constexpr int KS_PITCH = 72;
constexpr int VT_PITCH = 264;
constexpr int LDS_KS = 0, LDS_VT = 256 * KS_PITCH * 2, LDS_RT = LDS_VT + 64 * VT_PITCH * 2;
constexpr int LDS_QS = LDS_RT + 8192, LDS_QS_HI = LDSCTL_OFF + 1024;
__device__ __forceinline__ int qstash_off(int wave) { return wave < 6 ? LDS_QS + wave * 8192 : LDS_QS_HI + (wave - 6) * 8192; }
static_assert(LDS_QS + 6 * 8192 <= LDSCTL_OFF && LDS_QS_HI + 2 * 8192 <= LDS_BYTES, "Q stash placement");
template <bool HOST, bool ISV>
__device__ __forceinline__ void attn_unit(int b, int hk, int n, const bf16_t* PROJ, const float* g_q, const float* g_k, const float* sinks, const float* g_oa, const float* rope, unsigned char* MIXED,
                                          LAS unsigned char* lds, int tid, int wave, int lane, const TabCtx& T, int tabk0, f32x4 (&tcur)[8], f32x4 (&tnx)[8]) {
    LAS bf16_t* Ks = (LAS bf16_t*)(lds + LDS_KS); LAS bf16_t* Vt = (LAS bf16_t*)(lds + LDS_VT); LAS float* RT = (LAS float*)(lds + LDS_RT);
    const size_t rowb = (size_t)b * SEQ;
    const int c = lane & 15, quad = lane >> 4, g = wave >> 1, hf = wave & 1, head = hk * 4 + g;
    const bf16_t* qsrc = PROJ + (rowb + n * 128 + hf * 64 + c) * INC + head * 64 + 8 * quad;
#pragma unroll
    for (int qt = 0; qt < 4; ++qt)
#pragma unroll
        for (int k = 0; k < 2; ++k)
            __builtin_amdgcn_global_load_lds((const unsigned*)(qsrc + (size_t)qt * 16 * INC + k * 32), (LAS unsigned*)(lds + qstash_off(wave) + (qt * 2 + k) * 1024), 16, 0, 0);
    u32x4 kr[2][2]; f32x4 kcs[2][4]; u32x4 vr[4];
    const int part = tid & 3;
#pragma unroll
    for (int it = 0; it < 2; ++it) {
        const int row = (tid + 512 * it) >> 2, pos = (n - 1) * 128 + row, posc = pos >= 0 ? pos : 0;
        const bf16_t* src = PROJ + (rowb + posc) * INC + COL_K + hk * 64 + 16 * part;
        kr[it][0] = *(const u32x4*)src; kr[it][1] = *(const u32x4*)(src + 8);
        const float* rp = rope + posc * 8;
        kcs[it][0] = *(const f32x4*)rp; kcs[it][1] = *(const f32x4*)(rp + 4); kcs[it][2] = *(const f32x4*)(rp + 32768); kcs[it][3] = *(const f32x4*)(rp + 32768 + 4);
    }
#pragma unroll
    for (int it = 0; it < 4; ++it) {
        const int task = tid + 512 * it, row = task & 255, ch = task >> 8, pos = (n - 1) * 128 + row, posc = pos >= 0 ? pos : 0;
        vr[it] = *(const u32x4*)(PROJ + (rowb + posc) * INC + COL_V + hk * 64 + 8 * ch);
    }
    const f32x4 rv = *(const f32x4*)(rope + ((tid & 3) >> 1) * 32768 + (size_t)(n * 128 + (tid >> 2)) * 8 + (tid & 1) * 4);
    f32x4 gk[4], gq[4], goa[4];
#pragma unroll
    for (int i = 0; i < 4; ++i) gk[i] = *(const f32x4*)(g_k + 16 * part + 4 * i);
    gq[0] = *(const f32x4*)(g_q + 8 * quad); gq[1] = *(const f32x4*)(g_q + 8 * quad + 4); gq[2] = *(const f32x4*)(g_q + 32 + 8 * quad); gq[3] = *(const f32x4*)(g_q + 32 + 8 * quad + 4);
#pragma unroll
    for (int dt = 0; dt < 4; ++dt) goa[dt] = *(const f32x4*)(g_oa + head * 64 + dt * 16 + 4 * quad);
    const float sinkv = sinks[head] * LOG2E;
    *(LAS f32x4*)(RT + (tid >> 2) * 16 + (tid & 3) * 4) = rv;
#pragma unroll
    for (int it = 0; it < 2; ++it) {
        const int row = (tid + 512 * it) >> 2; const bool valid = (n - 1) * 128 + row >= 0;
        const u32x4 r0 = kr[it][0], r1 = kr[it][1];
        float x[16];
#pragma unroll
        for (int i = 0; i < 4; ++i) { x[2 * i] = bf_lo(r0[i]); x[2 * i + 1] = bf_hi(r0[i]); x[8 + 2 * i] = bf_lo(r1[i]); x[8 + 2 * i + 1] = bf_hi(r1[i]); }
        float ss = 0.f;
#pragma unroll
        for (int i = 0; i < 16; ++i) ss += x[i] * x[i];
        ss = dpp_add<0xB1>(ss); ss = dpp_add<0x4E>(ss);
        const float rstd = 1.0f / sqrtf(ss * (1.0f / 64.0f) + EPS);
#pragma unroll
        for (int i = 0; i < 16; ++i) x[i] = x[i] * rstd * gk[i >> 2][i & 3];
#pragma unroll
        for (int i = 0; i < 8; ++i) { const float cs = kcs[it][i >> 2][i & 3], sn = kcs[it][2 + (i >> 2)][i & 3]; const float t1 = x[i], t2 = x[8 + i];
            x[i] = part == 0 ? t1 * cs - t2 * sn : t1; x[8 + i] = part == 0 ? t2 * cs + t1 * sn : t2; }
        u32x4 w0, w1;
#pragma unroll
        for (int i = 0; i < 4; ++i) { w0[i] = valid ? cvtpk(x[2 * i], x[2 * i + 1]) : 0u; w1[i] = valid ? cvtpk(x[8 + 2 * i], x[8 + 2 * i + 1]) : 0u; }
        LAS bf16_t* d = Ks + row * KS_PITCH + 16 * part;
        *(LAS u32x4*)d = w0; *(LAS u32x4*)(d + 8) = w1;
    }
#pragma unroll
    for (int it = 0; it < 4; ++it) {
        const int task = tid + 512 * it, row = task & 255, ch = task >> 8; const bool valid = (n - 1) * 128 + row >= 0;
        u32x4 r = vr[it];
        if (!valid) r = (u32x4){0u, 0u, 0u, 0u};
#pragma unroll
        for (int i = 0; i < 4; ++i) { Vt[(8 * ch + 2 * i) * VT_PITCH + row] = (bf16_t)(r[i] & 0xffffu); Vt[(8 * ch + 2 * i + 1) * VT_PITCH + row] = (bf16_t)(r[i] >> 16); }
    }
    VM_WAIT();
    LDS_WAIT();
    __syncthreads();
#pragma unroll
    for (int i = 0; i < 4; ++i) { gq[i] = gq[i] * (0.125f * LOG2E); asm volatile("" : "+v"(gq[i])); asm volatile("" : "+v"(goa[i])); }
    const int lq = 4 * quad - c;
    const LAS unsigned char* qstash = lds + qstash_off(wave) + lane * 16;
    for (int qt = 0; qt < 4; ++qt) {
        const int qi0 = hf * 64 + qt * 16, kt0 = (qi0 >> 4) & ~1, qi = qi0 + c, pos = n * 128 + qi;
        const size_t tq = rowb + pos;
        bf16x8 qf[2];
        {
            const u32x4 r0 = *(const LAS u32x4*)(qstash + qt * 2048), r1 = *(const LAS u32x4*)(qstash + qt * 2048 + 1024);
            float x0[8], x1[8];
#pragma unroll
            for (int i = 0; i < 4; ++i) { x0[2 * i] = bf_lo(r0[i]); x0[2 * i + 1] = bf_hi(r0[i]); x1[2 * i] = bf_lo(r1[i]); x1[2 * i + 1] = bf_hi(r1[i]); }
            float ss = 0.f;
#pragma unroll
            for (int i = 0; i < 8; ++i) ss += x0[i] * x0[i] + x1[i] * x1[i];
            ss = xrow_sum(ss);
            const float rstd = __builtin_amdgcn_rsqf(ss * (1.0f / 64.0f) + EPS);
#pragma unroll
            for (int i = 0; i < 8; ++i) { x0[i] = x0[i] * rstd * gq[i >> 2][i & 3]; x1[i] = x1[i] * rstd * gq[2 + (i >> 2)][i & 3]; }
            const LAS float* rt = RT + qi * 16;
            const f32x4 rc0 = *(const LAS f32x4*)rt, rc1 = *(const LAS f32x4*)(rt + 4), rs0 = *(const LAS f32x4*)(rt + 8), rs1 = *(const LAS f32x4*)(rt + 12);
#pragma unroll
            for (int i = 0; i < 8; ++i) {
                const float other = xrow16_other(x0[i], (quad & 1) != 0);
                const float cs = i < 4 ? rc0[i & 3] : rc1[i & 3], sn = i < 4 ? rs0[i & 3] : rs1[i & 3];
                const float rot = (quad == 0) ? (x0[i] * cs - other * sn) : (x0[i] * cs + other * sn);
                x0[i] = (quad < 2) ? rot : x0[i];
            }
            u32x4 w0, w1;
#pragma unroll
            for (int i = 0; i < 4; ++i) { w0[i] = cvtpk(x0[2 * i], x0[2 * i + 1]); w1[i] = cvtpk(x1[2 * i], x1[2 * i + 1]); }
            qf[0] = __builtin_bit_cast(bf16x8, w0); qf[1] = __builtin_bit_cast(bf16x8, w1);
        }
        f32x4 s[10];
#pragma unroll
        for (int t = 0; t < 10; ++t) {
            s[t] = (f32x4){0.f, 0.f, 0.f, 0.f};
            const LAS bf16_t* kp = Ks + ((kt0 + t) * 16 + c) * KS_PITCH + 8 * quad;
#pragma unroll
            for (int ks = 0; ks < 2; ++ks) { const bf16x8 kf = *(const LAS bf16x8*)(kp + ks * 32); s[t] = __builtin_amdgcn_mfma_f32_16x16x32_bf16(kf, qf[ks], s[t], 0, 0, 0); }
        }
        if (n == 0) {
#pragma unroll
            for (int t = 0; t < 10; ++t)
#pragma unroll
                for (int r = 0; r < 4; ++r) { const int kj = (kt0 + t) * 16 + 4 * quad + r; const bool ok = (kj >= qi + 1) && (kj <= qi + 128) && kj >= 128; s[t][r] = ok ? s[t][r] : -1e30f; }
        } else {
            const int L = kt0 * 16 - qi0 + lq;
#pragma unroll
            for (int t = 0; t < 2; ++t)
#pragma unroll
                for (int r = 0; r < 4; ++r) { s[t][r] = (L >= 1 - (16 * t + r)) ? s[t][r] : -1e30f; s[8 + t][r] = (L <= 128 - (16 * (8 + t) + r)) ? s[8 + t][r] : -1e30f; }
        }
        float m = sinkv;
#pragma unroll
        for (int t = 0; t < 10; ++t)
#pragma unroll
            for (int r = 0; r < 4; ++r) m = __builtin_amdgcn_fmed3f(m, s[t][r], __builtin_inff());
        m = xrow_max(m);
#pragma unroll
        for (int t = 0; t < 10; ++t)
#pragma unroll
            for (int r = 0; r < 4; ++r) s[t][r] = __builtin_amdgcn_exp2f(s[t][r] - m);
        bf16x8 pf[5];
#pragma unroll
        for (int i = 0; i < 5; ++i) { u32x4 w; w.x = cvtpk(s[2 * i][0], s[2 * i][1]); w.y = cvtpk(s[2 * i][2], s[2 * i][3]);
            w.z = cvtpk(s[2 * i + 1][0], s[2 * i + 1][1]); w.w = cvtpk(s[2 * i + 1][2], s[2 * i + 1][3]); pf[i] = __builtin_bit_cast(bf16x8, w); }
        f32x4 osum = (f32x4){0.f, 0.f, 0.f, 0.f};
        { const unsigned ow = (c & 3) == 0 ? 0x3F803F80u : 0u; const bf16x8 onesA = __builtin_bit_cast(bf16x8, (u32x4){ow, ow, ow, ow});
#pragma unroll
          for (int i = 0; i < 5; ++i) osum = __builtin_amdgcn_mfma_f32_16x16x32_bf16(onesA, pf[i], osum, 0, 0, 0); }
        const float inv = __builtin_amdgcn_rcpf(osum[0] + __builtin_amdgcn_exp2f(sinkv - m));
        f32x4 o[4]; float ss = 0.f;
#pragma unroll
        for (int dt = 0; dt < 4; ++dt) {
            o[dt] = (f32x4){0.f, 0.f, 0.f, 0.f};
            const LAS bf16_t* vp = Vt + (dt * 16 + c) * VT_PITCH + kt0 * 16 + 4 * quad;
#pragma unroll
            for (int i = 0; i < 5; ++i) { const u32x2 lo = *(const LAS u32x2*)(vp + i * 32), hi = *(const LAS u32x2*)(vp + i * 32 + 16);
                u32x4 w; w.x = lo.x; w.y = lo.y; w.z = hi.x; w.w = hi.y;
                o[dt] = __builtin_amdgcn_mfma_f32_16x16x32_bf16(__builtin_bit_cast(bf16x8, w), pf[i], o[dt], 0, 0, 0); }
            ss += (o[dt][0] * o[dt][0] + o[dt][1] * o[dt][1]) + (o[dt][2] * o[dt][2] + o[dt][3] * o[dt][3]);
        }
        ss = xrow_sum(ss);
        const float fac = inv * __builtin_amdgcn_rsqf(inv * inv * ss * (1.0f / 64.0f) + EPS) * MIX_SCALE;
        if (HOST) {
            tab_row_convert<ISV>(T, tabk0 + qt, tnx, lane);
            tab_row_load(T, tabk0 + qt + 1, tnx, lane);
        }
        unsigned char* orow = MIXED + tq * DM + head * 64 + 4 * quad;
#pragma unroll
        for (int dt = 0; dt < 4; ++dt) *(unsigned*)(orow + dt * 16) = pack_i8x4_sat(o[dt] * goa[dt], fac);
    }
    __syncthreads();
}
__device__ __forceinline__ void conv_item(int item, const bf16_t* PROJ, const float* conv_w, const float* g_oc, unsigned char* MIXED, int lane) {
    const int t0 = item * 16, ch = 16 * lane;
    float w0[16], w1[16], w2[16], gg[16], up2[16], up1[16];
#pragma unroll
    for (int i = 0; i < 16; ++i) { w0[i] = conv_w[ch + i]; w1[i] = conv_w[1024 + ch + i]; w2[i] = conv_w[2048 + ch + i]; gg[i] = g_oc[ch + i]; up2[i] = 0.f; up1[i] = 0.f; }
    if ((t0 & (SEQ - 1)) != 0) {
#pragma unroll
        for (int h = 0; h < 2; ++h) {
            const bf16_t* pr = PROJ + (size_t)(t0 - 2 + h) * INC + ch;
            const u32x4 c0 = *(const u32x4*)(pr + COL_C), c1 = *(const u32x4*)(pr + COL_C + 8);
#pragma unroll
            for (int i = 0; i < 4; ++i) {
                const float u0 = bf_lo(c0[i]), u1 = bf_hi(c0[i]), u2 = bf_lo(c1[i]), u3 = bf_hi(c1[i]);
                if (h == 0) { up2[2 * i] = u0; up2[2 * i + 1] = u1; up2[8 + 2 * i] = u2; up2[8 + 2 * i + 1] = u3; }
                else        { up1[2 * i] = u0; up1[2 * i + 1] = u1; up1[8 + 2 * i] = u2; up1[8 + 2 * i + 1] = u3; }
            }
        }
    }
    u32x4 nb0, nb1, nc0, nc1;
    { const bf16_t* pr = PROJ + (size_t)t0 * INC + ch; nb0 = *(const u32x4*)(pr + COL_B); nb1 = *(const u32x4*)(pr + COL_B + 8); nc0 = *(const u32x4*)(pr + COL_C); nc1 = *(const u32x4*)(pr + COL_C + 8); }
#pragma unroll
    for (int r = 0; r < 16; ++r) {
        const u32x4 b0 = nb0, b1 = nb1, c0 = nc0, c1 = nc1;
        { const bf16_t* pr = PROJ + (size_t)(t0 + (r < 15 ? r + 1 : r)) * INC + ch; nb0 = *(const u32x4*)(pr + COL_B); nb1 = *(const u32x4*)(pr + COL_B + 8); nc0 = *(const u32x4*)(pr + COL_C); nc1 = *(const u32x4*)(pr + COL_C + 8); }
        float u[16], bg[16], y[16];
#pragma unroll
        for (int i = 0; i < 4; ++i) {
            u[2 * i] = bf_lo(c0[i]); u[2 * i + 1] = bf_hi(c0[i]); u[8 + 2 * i] = bf_lo(c1[i]); u[8 + 2 * i + 1] = bf_hi(c1[i]);
            bg[2 * i] = bf_lo(b0[i]); bg[2 * i + 1] = bf_hi(b0[i]); bg[8 + 2 * i] = bf_lo(b1[i]); bg[8 + 2 * i + 1] = bf_hi(b1[i]);
        }
        float ss = 0.f;
#pragma unroll
        for (int i = 0; i < 16; ++i) { y[i] = bg[i] * (w0[i] * up2[i] + w1[i] * up1[i] + w2[i] * u[i]); ss += y[i] * y[i]; up2[i] = up1[i]; up1[i] = u[i]; }
        ss += __shfl_xor(ss, 1); ss += __shfl_xor(ss, 2);
        const float rstd = 1.0f / sqrtf(ss * (1.0f / 64.0f) + EPS);
        u32x4 o0;
#pragma unroll
        for (int i = 0; i < 4; ++i) o0[i] = pack_i8x4_sat((f32x4){y[4 * i] * rstd * gg[4 * i], y[4 * i + 1] * rstd * gg[4 * i + 1], y[4 * i + 2] * rstd * gg[4 * i + 2], y[4 * i + 3] * rstd * gg[4 * i + 3]}, MIX_SCALE);
        *(u32x4*)(MIXED + (size_t)(t0 + r) * DM + 1024 + ch) = o0;
    }
}

__device__ __forceinline__ void ins16(float (&L)[16], float x) {
#pragma unroll
    for (int j = 0; j < 16; ++j) { const float hi = fmaxf(L[j], x); x = fminf(L[j], x); L[j] = hi; }
}
template <int C> __device__ __forceinline__ float pack7(float s, unsigned q32) { unsigned t; asm("v_and_b32 %0, 0xffffff80, %1\n\tv_or3_b32 %0, %0, %2, %3" : "=&v"(t) : "v"(s), "v"(q32), "n"(C)); return __uint_as_float(t); }
template <int C> __device__ __forceinline__ float pack8(float s) { unsigned t; asm("v_and_b32 %0, 0xffffff00, %1\n\tv_or_b32 %0, %2, %0" : "=&v"(t) : "v"(s), "n"(C)); return __uint_as_float(t); }
template <int KEY> __device__ __forceinline__ float pack_lo(unsigned u) { unsigned t; asm("v_lshlrev_b32 %0, 16, %1\n\tv_or_b32 %0, %2, %0" : "=&v"(t) : "v"(u), "n"(KEY)); return __uint_as_float(t); }
template <int KEY> __device__ __forceinline__ float pack_hi(unsigned u) { unsigned t; asm("v_and_b32 %0, 0xffff0000, %1\n\tv_or_b32 %0, %2, %0" : "=&v"(t) : "v"(u), "n"(KEY)); return __uint_as_float(t); }
__device__ __forceinline__ unsigned key_of(unsigned x) { return ((x >> 2) & 7u) * 16u + (x >> 5) * 4u + (x & 3u); }
#define CE_DESC(a, b) do { const float hi_ = fmaxf(a, b), lo_ = fminf(a, b); a = hi_; b = lo_; } while (0)
__device__ __forceinline__ void bitonic_tail16(float (&L)[16]) {
#pragma unroll
    for (int d = 8; d >= 1; d >>= 1)
#pragma unroll
        for (int i = 0; i < 16; ++i) if ((i & d) == 0) CE_DESC(L[i], L[i + d]);
}
__device__ __forceinline__ void sort16_desc(float (&L)[16]) {
#define SN(i, j) CE_DESC(L[i], L[j]);
    SN(0,13) SN(1,12) SN(2,15) SN(3,14) SN(4,8) SN(5,6) SN(7,11) SN(9,10)
    SN(0,5) SN(1,7) SN(2,9) SN(3,4) SN(6,13) SN(8,14) SN(10,15) SN(11,12)
    SN(0,1) SN(2,3) SN(4,5) SN(6,8) SN(7,9) SN(10,11) SN(12,13) SN(14,15)
    SN(0,2) SN(1,3) SN(4,10) SN(5,11) SN(6,7) SN(8,9) SN(12,14) SN(13,15)
    SN(1,2) SN(3,12) SN(4,6) SN(5,7) SN(8,10) SN(9,11) SN(13,14)
    SN(1,4) SN(2,6) SN(5,8) SN(7,10) SN(9,13) SN(11,14)
    SN(2,4) SN(3,6) SN(9,12) SN(11,13)
    SN(3,5) SN(6,8) SN(7,9) SN(10,12)
    SN(3,4) SN(5,6) SN(7,8) SN(9,10) SN(11,12)
    SN(6,7) SN(8,9)
#undef SN
}
__device__ __forceinline__ void top16_of_two(float (&A)[16], const float (&B)[16]) {
#pragma unroll
    for (int j = 0; j < 16; ++j) A[j] = fmaxf(A[j], B[15 - j]);
    bitonic_tail16(A);
}
__device__ __forceinline__ void merge16(float (&L)[16], int mask) {
    float P[16];
#pragma unroll
    for (int j = 0; j < 16; ++j) P[j] = __shfl_xor(L[j], mask);
    top16_of_two(L, P);
}
constexpr int SKT_OFF = 8192 + 512, SKT_PITCH = 272;
__device__ __forceinline__ void peer_chunk(int tokb, const bf16_t* QP, const bf16_t* SK, const unsigned char* H8, const float* SH, const unsigned char* UB, const float* SU, const unsigned char* VB, const float* mod, const bf16_t* X1B, float* out,
                                           LAS unsigned char* lds, int tid, int wave, int lane) {
    LAS unsigned char* wl = lds + wave * 16384;
    int tok0 = tokb + wave * 16;
    LAS bf16_t* eidx = (LAS bf16_t*)wl; LAS bf16_t* gate = (LAS bf16_t*)(wl + 4096); LAS float* accL = (LAS float*)(wl + 8192); LAS unsigned char* ids = wl + 8192;
#pragma nounroll
    for (int rep7a_ = 0; rep7a_ < REP7A; ++rep7a_) {
#pragma nounroll
    for (int i2 = 0; i2 < 2; ++i2) {
        const int p = tid + 512 * i2, tkn = p & 127, h = p >> 7;
        const u32x4* srow = (const u32x4*)QP + (size_t)(h * 32) * MTOK + tokb + tkn;
        float T0[16], T1[16];
#pragma unroll
        for (int hf = 0; hf < 2; ++hf) {
            float L[16], Bv[16];
#define PKC(ch, DST) { const u32x4 a_ = srow[(size_t)(hf * 16 + 2 * (ch)) * MTOK], b_ = srow[(size_t)(hf * 16 + 2 * (ch) + 1) * MTOK]; \
                DST[0] = pack_lo<(ch) * 16 + 0>(a_.x); DST[1] = pack_hi<(ch) * 16 + 1>(a_.x); DST[2] = pack_lo<(ch) * 16 + 2>(a_.y); DST[3] = pack_hi<(ch) * 16 + 3>(a_.y); \
                DST[4] = pack_lo<(ch) * 16 + 4>(a_.z); DST[5] = pack_hi<(ch) * 16 + 5>(a_.z); DST[6] = pack_lo<(ch) * 16 + 6>(a_.w); DST[7] = pack_hi<(ch) * 16 + 7>(a_.w); \
                DST[8] = pack_lo<(ch) * 16 + 8>(b_.x); DST[9] = pack_hi<(ch) * 16 + 9>(b_.x); DST[10] = pack_lo<(ch) * 16 + 10>(b_.y); DST[11] = pack_hi<(ch) * 16 + 11>(b_.y); \
                DST[12] = pack_lo<(ch) * 16 + 12>(b_.z); DST[13] = pack_hi<(ch) * 16 + 13>(b_.z); DST[14] = pack_lo<(ch) * 16 + 14>(b_.w); DST[15] = pack_hi<(ch) * 16 + 15>(b_.w); }
            PKC(0, L) sort16_desc(L);
            PKC(1, Bv) sort16_desc(Bv); top16_of_two(L, Bv);
            PKC(2, Bv) sort16_desc(Bv); top16_of_two(L, Bv);
            PKC(3, Bv) sort16_desc(Bv); top16_of_two(L, Bv);
            PKC(4, Bv) sort16_desc(Bv); top16_of_two(L, Bv);
            PKC(5, Bv) sort16_desc(Bv); top16_of_two(L, Bv);
            PKC(6, Bv) sort16_desc(Bv); top16_of_two(L, Bv);
            PKC(7, Bv) sort16_desc(Bv); top16_of_two(L, Bv);
#undef PKC
#pragma unroll
            for (int j = 0; j < 16; ++j) { if (hf == 0) T0[j] = L[j]; else T1[j] = L[j]; }
        }
        float R[16], Bc[16], Cc[16];
#define CAND(i, j) pack8<(i) * 16 + (j)>(T0[i] + T1[j])
#pragma unroll
        for (int j = 0; j < 16; ++j) R[j] = __uint_as_float((__float_as_uint(T0[0] + T1[j]) & 0xFFFFFF00u) | (unsigned)j);
        Bc[0] = CAND(1, 0); Bc[1] = CAND(1, 1); Bc[2] = CAND(1, 2); Bc[3] = CAND(1, 3); Bc[4] = CAND(1, 4); Bc[5] = CAND(1, 5); Bc[6] = CAND(1, 6); Bc[7] = CAND(1, 7);
        Bc[8] = CAND(2, 0); Bc[9] = CAND(2, 1); Bc[10] = CAND(2, 2); Bc[11] = CAND(2, 3); Bc[12] = CAND(2, 4); Bc[13] = CAND(3, 0); Bc[14] = CAND(3, 1); Bc[15] = CAND(3, 2);
        Cc[0] = CAND(3, 3); Cc[1] = CAND(4, 0); Cc[2] = CAND(4, 1); Cc[3] = CAND(4, 2); Cc[4] = CAND(5, 0); Cc[5] = CAND(5, 1); Cc[6] = CAND(6, 0); Cc[7] = CAND(6, 1);
        Cc[8] = CAND(7, 0); Cc[9] = CAND(7, 1); Cc[10] = CAND(8, 0); Cc[11] = CAND(9, 0); Cc[12] = CAND(10, 0); Cc[13] = CAND(11, 0); Cc[14] = CAND(12, 0); Cc[15] = CAND(13, 0);
        sort16_desc(Bc); sort16_desc(Cc); top16_of_two(R, Bc); top16_of_two(R, Cc);
        ins16(R, CAND(14, 0)); ins16(R, CAND(15, 0));
#undef CAND
        {
            LAS unsigned char* idb = lds + wave * 16384 + 8192 + lane * 32;
            u32x4 i0, i1;
#pragma unroll
            for (int w = 0; w < 4; ++w) {
                i0[w] = (__float_as_uint(T0[4 * w]) & 0x7Fu) | ((__float_as_uint(T0[4 * w + 1]) & 0x7Fu) << 8) | ((__float_as_uint(T0[4 * w + 2]) & 0x7Fu) << 16) | ((__float_as_uint(T0[4 * w + 3]) & 0x7Fu) << 24);
                i1[w] = (__float_as_uint(T1[4 * w]) & 0x7Fu) | ((__float_as_uint(T1[4 * w + 1]) & 0x7Fu) << 8) | ((__float_as_uint(T1[4 * w + 2]) & 0x7Fu) << 16) | ((__float_as_uint(T1[4 * w + 3]) & 0x7Fu) << 24); }
            *(LAS u32x4*)idb = i0; *(LAS u32x4*)(idb + 16) = i1;
            float e[16], sum = 0.f;
#pragma unroll
            for (int k = 0; k < 16; ++k) { e[k] = __builtin_amdgcn_exp2f((R[k] - R[0]) * LOG2E); sum += e[k]; }
            const float inv = 1.0f / sum;
            LDS_WAIT(); asm volatile("" ::: "memory");
            unsigned ex[16];
#pragma unroll
            for (int k = 0; k < 16; ++k) { const unsigned code = __float_as_uint(R[k]) & 0xFFu; ex[k] = (unsigned)idb[code >> 4] * 128u + (unsigned)idb[16 + (code & 15u)]; }
            LAS unsigned char* tb = lds + (tkn >> 4) * 16384 + ((tkn & 15) * 128 + h * 16) * 2;
            u32x4 ea, eb, ga, gb;
#pragma unroll
            for (int w = 0; w < 4; ++w) { ea[w] = ex[2 * w] | (ex[2 * w + 1] << 16); eb[w] = ex[8 + 2 * w] | (ex[8 + 2 * w + 1] << 16);
                ga[w] = cvtpk(e[2 * w] * inv, e[2 * w + 1] * inv); gb[w] = cvtpk(e[8 + 2 * w] * inv, e[8 + 2 * w + 1] * inv); }
            *(LAS u32x4*)tb = ea; *(LAS u32x4*)(tb + 16) = eb; *(LAS u32x4*)(tb + 4096) = ga; *(LAS u32x4*)(tb + 4096 + 16) = gb;
        }
    }
    LDS_WAIT();
    __syncthreads();
    }
    LDS_WAIT(); asm volatile("" ::: "memory");
    int lane_b = lane; asm volatile("" : "+v"(lane_b));
    const int g = lane_b >> 3, k = lane_b & 7; const unsigned k16 = (unsigned)k * 16u;
    LAS int* accI = (LAS int*)accL;
#pragma nounroll
    for (int rep7u_ = 0; rep7u_ < REP7U; ++rep7u_) {
    LDS_WAIT(); asm volatile("" ::: "memory");
    for (int i = lane; i < 2048; i += 64) accI[i] = 0;
    LDS_WAIT(); asm volatile("" ::: "memory");
    asm volatile("" : "+s"(tok0));
    const unsigned char* hbase = H8 + (size_t)(tok0 + g) * DM + k * 16;
    u32x4 hn = *(const u32x4*)hbase;
    for (int s = 0; s < 16; ++s) {
        const unsigned char* Us = UB + (size_t)s * (PEER_N * 128);
#pragma unroll
        for (int r = 0; r < 2; ++r) {
            const int tl = r * 8 + g;
            const u32x4 hq = hn;
            { const int sn = r ? s + 1 : s, rn = r ^ 1; if (sn < 16) hn = *(const u32x4*)(hbase + (size_t)rn * 8 * DM + sn * 128); }
            const LAS bf16_t* ei = eidx + tl * 128;
            LAS int* ap = accI + tl * 128 + k;
#pragma nounroll
            for (int ib2 = 0; ib2 < 8; ++ib2) {
                u32x4 uv[16];
#pragma unroll
                for (int q = 0; q < 16; ++q) { const unsigned e = ei[ib2 * 16 + q]; uv[q] = *(const u32x4*)(Us + (size_t)(unsigned)((e << 7) + k16)); }
#pragma unroll
                for (int hb = 0; hb < 2; ++hb) {
                    int p[8];
#pragma unroll
                    for (int ii = 0; ii < 8; ++ii) { const u32x4 v = uv[hb * 8 + ii];
                        p[ii] = __builtin_amdgcn_sdot4((int)v.x, (int)hq.x, __builtin_amdgcn_sdot4((int)v.y, (int)hq.y, __builtin_amdgcn_sdot4((int)v.z, (int)hq.z, __builtin_amdgcn_sdot4((int)v.w, (int)hq.w, 0, false), false), false), false); }
                    int a4[4], a2[2];
#pragma unroll
                    for (int j = 0; j < 4; ++j) { const int send = (k & 4) ? p[j] : p[j + 4], keep = (k & 4) ? p[j + 4] : p[j]; a4[j] = keep + dpp_movi<0x141>(send); }
#pragma unroll
                    for (int j = 0; j < 2; ++j) { const int send = (k & 2) ? a4[j] : a4[j + 2], keep = (k & 2) ? a4[j + 2] : a4[j]; a2[j] = keep + dpp_movi<0x1B>(send); }
                    const int send = (k & 1) ? a2[0] : a2[1], keep = (k & 1) ? a2[1] : a2[0];
                    const int tot = keep + dpp_movi<0xB1>(send);
                    __hip_atomic_fetch_add(ap + ib2 * 16 + hb * 8, tot, __ATOMIC_RELAXED, __HIP_MEMORY_SCOPE_WORKGROUP);
                }
            }
        }
    }
    }
    LDS_WAIT(); asm volatile("" ::: "memory");
    LAS bf16_t* wgt = gate;
    for (int i = lane; i < 2048; i += 64) {
        const float a = (float)accI[i] * SU[eidx[i]] * SH[tok0 + (i >> 7)];
        const float ge = 0.5f * a * (1.0f + erff(a * 0.70710678118654752f));
        wgt[i] = (bf16_t)(cvtpk(bf_lo((unsigned)gate[i]) * ge * (1.0f / V_SCALE), 0.f) & 0xffffu);
    }
    LDS_WAIT(); asm volatile("" ::: "memory");
    const float* g2 = mod + (size_t)(tok0 >> 12) * MODW + 5 * DM;
#pragma nounroll
    for (int rep7v_ = 0; rep7v_ < REP7V; ++rep7v_)
    for (int s = 0; s < 16; ++s) {
        const unsigned char* Vs = VB + (size_t)s * (PEER_N * 128);
        f32x4 gvv[4];
#pragma unroll
        for (int q = 0; q < 4; ++q) gvv[q] = *(const f32x4*)(g2 + s * 128 + k * 16 + 4 * q);
#pragma unroll
        for (int r = 0; r < 2; ++r) {
            const int tl = r * 8 + g;
            float* orow = out + (size_t)(tok0 + tl) * DM + s * 128 + k * 16;
            const bf16_t* xrow = X1B + (size_t)(tok0 + tl) * DM + s * 128 + k * 16;
            const u32x4 xb0 = *(const u32x4*)xrow, xb1 = *(const u32x4*)(xrow + 8);
            const LAS bf16_t* ei = eidx + tl * 128; const LAS bf16_t* wi = wgt + tl * 128;
            float y[16];
#pragma unroll
            for (int i = 0; i < 16; ++i) y[i] = 0.f;
#pragma nounroll
            for (int b = 0; b < 8; ++b) {
                u32x4 vq[16];
#pragma unroll
                for (int q = 0; q < 16; ++q) { const unsigned e = ei[b * 16 + q]; vq[q] = *(const u32x4*)(Vs + (size_t)(unsigned)((e << 7) + k16)); }
#pragma unroll
                for (int q = 0; q < 16; ++q) {
                    const float wf = bf_lo((unsigned)wi[b * 16 + q]); const u32x4 vv = vq[q];
#pragma unroll
                    for (int w = 0; w < 4; ++w) { const f32x2 f01 = __builtin_amdgcn_cvt_pk_f32_fp8(vv[w], false), f23 = __builtin_amdgcn_cvt_pk_f32_fp8(vv[w], true);
                        y[4 * w] = fmaf(wf, f01.x, y[4 * w]); y[4 * w + 1] = fmaf(wf, f01.y, y[4 * w + 1]); y[4 * w + 2] = fmaf(wf, f23.x, y[4 * w + 2]); y[4 * w + 3] = fmaf(wf, f23.y, y[4 * w + 3]); }
                }
            }
#pragma unroll
            for (int q = 0; q < 4; ++q) { f32x4 o; const f32x4 gv = gvv[q];
                const u32x4 xb = q < 2 ? xb0 : xb1; const unsigned xlo = (q & 1) ? xb.z : xb.x, xhi = (q & 1) ? xb.w : xb.y;
                const float x1v[4] = {bf_lo(xlo), bf_hi(xlo), bf_lo(xhi), bf_hi(xhi)};
#pragma unroll
                for (int i = 0; i < 4; ++i) o[i] = x1v[i] + gv[i] * y[4 * q + i];
                if (rep7v_ == REP7V - 1) *(f32x4*)(orow + 4 * q) = o; else asm volatile("" :: "v"(o)); }
        }
    }
}

constexpr int N_PHASES = 8;
struct Args { const float* in[18]; float* out; unsigned char* ws; int ph_lo, ph_hi; };
__global__ void __launch_bounds__(NWAVES * 64, 2) hymba_fwd(Args args) {
    extern __shared__ __attribute__((aligned(16))) unsigned char lds_raw[];
    LAS unsigned char* lds = (LAS unsigned char*)lds_raw;
    volatile LAS unsigned* MISC = (volatile LAS unsigned*)(lds + MISC_OFF);
    const int wave = __builtin_amdgcn_readfirstlane((int)threadIdx.x >> 6);
    const int G = gridDim.x, bx = blockIdx.x;
    const int gw = bx * NWAVES + wave, NGW = G * NWAVES;
#define FRESH_IDS() const int lane = fresh_lane(); const int tid = wave * 64 + lane; (void)tid
    unsigned char* ws = args.ws;
    const float* x = args.in[0]; const float* cvec = args.in[1]; const float* w_ada = args.in[2]; const float* b_ada = args.in[3]; const float* g_norm1 = args.in[4];
    const float* w_in = args.in[5]; const float* g_q = args.in[6]; const float* g_k = args.in[7]; const float* sinks = args.in[8]; const float* conv_w = args.in[9];
    const float* g_oa = args.in[10]; const float* g_oc = args.in[11]; const float* w_out = args.in[12]; const float* g_norm2 = args.in[13]; const float* w_pq = args.in[14];
    const float* subkeys = args.in[15]; const float* peer_u = args.in[16]; const float* peer_v = args.in[17];
    float* out = args.out;
    float* mod = (float*)(ws + WS_MOD); float* rope = (float*)(ws + WS_ROPE);
    bf16_t* SK = (bf16_t*)(ws + WS_SK); bf16_t* WIN = (bf16_t*)(ws + WS_WIN); bf16_t* WOUT = (bf16_t*)(ws + WS_WOUT); bf16_t* WPQ = (bf16_t*)(ws + WS_WPQ);
    unsigned char* UB = ws + WS_UB; unsigned char* VB = ws + WS_VB; unsigned char* H8 = ws + WS_H8; float* SU = (float*)(ws + WS_SU); float* SH = (float*)(ws + WS_SH); bf16_t* XN = (bf16_t*)(ws + WS_XN); bf16_t* PROJ = (bf16_t*)(ws + WS_PROJ);
    bf16_t* QP = (bf16_t*)(ws + WS_QP); bf16_t* X1B = (bf16_t*)(ws + WS_X1B); unsigned char* MIXED = ws + WS_MIXED; unsigned char* XN8 = ws + WS_XN; float* SX1 = (float*)(ws + WS_SX1); bf16_t* W2 = (bf16_t*)(ws + WS_XN + 64 * MiB);
    unsigned* ctl = (unsigned*)(ws + WS_CTL);

    { FRESH_IDS(); for (int u = tid; u < (LDS_BYTES - LDSCTL_OFF) / 4; u += NWAVES * 64) ((LAS unsigned*)(lds + LDSCTL_OFF))[u] = 0u; }
    __syncthreads();
    XcdBarrier bar; bar.bar = ctl + CW_BAR; bar.x = 0; bar.st = nullptr; bar.wave = wave;
    if (MK_N_LAUNCHES == 1) bar = xcd_barrier_post(ctl + CW_BAR, MISC + 8, wave);
    const int lo = args.ph_lo, hi = args.ph_hi;
#define IN(k) (lo <= (k) && (k) < hi)
#define SEAM(k) do { if (IN(k) && IN((k) + 1)) xcd_barrier(bar); } while (0)

#pragma nounroll
    for (int rep_ = 0; rep_ < REP0; ++rep_) { if (rep_) xcd_barrier(bar);
    if (IN(0)) { FRESH_IDS();
#pragma nounroll
        for (int ra_ = 0; ra_ < REP0A; ++ra_)
        for (int it = bx; it < MODW / 64; it += G) p0_ada_item(cvec, w_ada, b_ada, mod, lds, it, tid, wave, lane);
        LAS float* scr = (LAS float*)(lds + wave * 16384);
        constexpr int I_IN = (DM / 64) * (INC / 32), I_SQ = (DM / 64) * (DM / 32), I_TAB = PEER_N * DM / 2048, I_W2 = 512, I_ROPE = 512;
        (void)scr;
        { const int nfree = G > MODW / 64 ? (G - MODW / 64) * NWAVES : 0;
          if (nfree > 0) { if (bx >= MODW / 64) for (int r = (bx - MODW / 64) * NWAVES + wave; r < I_W2; r += nfree) p0_w2_item(w_pq, subkeys, W2, ctl + CW_CMX_PQ, r, lane); }
          else for (int r = gw; r < I_W2; r += NGW) p0_w2_item(w_pq, subkeys, W2, ctl + CW_CMX_PQ, r, lane); }
#pragma nounroll
        for (int rc_ = 0; rc_ < REP0C; ++rc_)
        for (int r = gw; r < I_IN + I_SQ; r += NGW) { if (r < I_IN) p0_colmax_item(w_in, INC, ctl + CW_CMX_IN, r, lane); else p0_colmax_item(w_out, DM, ctl + CW_CMX_OUT, r - I_IN, lane); }
        for (int r = gw; r < I_ROPE; r += NGW) p0_rope_item(rope, r, lane);
        if (G == 256) {   }
        else if (NGW * 8 == I_TAB) p0_tables8(peer_u, peer_v, UB, SU, VB, gw, NGW, lane);
        else for (int r = gw; r < 2 * I_TAB; r += NGW) { if (r < I_TAB) p0_i8_row(peer_u, UB, SU, r, lane); else p0_fp8_item(peer_v, VB, (size_t)(r - I_TAB) * 2048, V_SCALE, lane); }
    }
    }
    SEAM(0);
#pragma nounroll
    for (int rep_ = 0; rep_ < REP1; ++rep_) { if (rep_) xcd_barrier(bar);
    if (IN(1)) { FRESH_IDS(); norm_rows(x, g_norm1, mod, 0 * DM, 1 * DM, XN8, SX1, gw, NGW, lane);
        LAS float* scr = (LAS float*)(lds + wave * 16384);
        constexpr int I_IN = (DM / 64) * (INC / 32), I_SQ = (DM / 64) * (DM / 32);
        for (int it = gw; it < I_IN + I_SQ + DM; it += NGW) {
            int r = it;
            if (r < I_IN) { p1_transpose_i8_item<true>(w_in, DM, INC, (unsigned char*)WIN, ctl + CW_CMX_IN, scr, r, lane); continue; } r -= I_IN;
            if (r < I_SQ) { p1_transpose_i8_item<false>(w_out, DM, DM, (unsigned char*)WOUT, ctl + CW_CMX_OUT, scr, r, lane); continue; } r -= I_SQ;
            p1_w2_row(W2, (unsigned char*)WPQ, ctl + CW_CMX_PQ, r, lane);
        }
    }
    }
    SEAM(1);
#if REP2 > 1
    if (IN(2)) {
        pg8::Gemm g{(const bf16_t*)XN8, (const bf16_t*)WIN, MTOK, INC, DM / 2}; pg8::StaticOrder S; S.init(MTOK, INC, G, bx);
        pg8::EpiProjI8 E{PROJ, INC, SX1, ctl + CW_CMX_IN};
        pg8::gemm_phase<pg8::EpiProjI8, pg8::StaticOrder, true, true, true>(lds, g, S, E, wave);
    }
    xcd_barrier(bar);
#endif
    if (IN(2)) {
        pg8::Gemm g{(const bf16_t*)XN8, (const bf16_t*)WIN, MTOK, INC, DM / 2}; pg8::StaticOrder S; S.init(MTOK, INC, G, bx);
        pg8::EpiProjI8 E{PROJ, INC, SX1, ctl + CW_CMX_IN};
        pg8::gemm_phase<pg8::EpiProjI8, pg8::StaticOrder, true, true, true>(lds, g, S, E, wave);
    }
    SEAM(2);
#pragma nounroll
    for (int rep_ = 0; rep_ < REP3; ++rep_) { if (rep_) xcd_barrier(bar);
    if (IN(3)) { FRESH_IDS();
#ifndef REP3A
#define REP3A 1
#endif
#pragma nounroll
        for (int ra_ = 0; ra_ < REP3A; ++ra_)
        { f32x4 tcur[8], tnx[8];
          if (G != 256) {
              const TabCtx T{peer_u, UB, SU, 0};
              for (int u = bx; u < BATCH * 4 * 32; u += G) attn_unit<false, false>(u >> 7, (u >> 5) & 3, u & 31, PROJ, g_q, g_k, sinks, g_oa, rope, MIXED, lds, tid, wave, lane, T, 0, tcur, tnx);
          } else if (wave & 1) {
              const TabCtx T{peer_v, VB, SU, gw >> 1};
              tab_row_load(T, 0, tnx, lane);
              int ui = 0;
              for (int u = bx; u < BATCH * 4 * 32; u += G, ++ui) attn_unit<true, true>(u >> 7, (u >> 5) & 3, u & 31, PROJ, g_q, g_k, sinks, g_oa, rope, MIXED, lds, tid, wave, lane, T, ui * 4, tcur, tnx);
          } else {
              const TabCtx T{peer_u, UB, SU, gw >> 1};
              tab_row_load(T, 0, tnx, lane);
              int ui = 0;
              for (int u = bx; u < BATCH * 4 * 32; u += G, ++ui) attn_unit<true, false>(u >> 7, (u >> 5) & 3, u & 31, PROJ, g_q, g_k, sinks, g_oa, rope, MIXED, lds, tid, wave, lane, T, ui * 4, tcur, tnx);
          } }
        for (int it = gw; it < MTOK / 16; it += NGW) conv_item(it, PROJ, conv_w, g_oc, MIXED, lane);
    }
    }
    SEAM(3);
#if REP4 > 1
    if (IN(4)) {
        pg8::Gemm g{(const bf16_t*)MIXED, (const bf16_t*)WOUT, MTOK, DM, DM / 2}; pg8::StaticOrder S; S.init(MTOK, DM, G, bx);
        pg8::EpiResGateBf16I8 E{x, X1B, DM, mod + 2 * DM, MODW, 1.0f / MIX_SCALE, ctl + CW_CMX_OUT};
        pg8::gemm_phase<pg8::EpiResGateBf16I8, pg8::StaticOrder, true, true, true>(lds, g, S, E, wave);
    }
    xcd_barrier(bar);
#endif
    if (IN(4)) {
        pg8::Gemm g{(const bf16_t*)MIXED, (const bf16_t*)WOUT, MTOK, DM, DM / 2}; pg8::StaticOrder S; S.init(MTOK, DM, G, bx);
        pg8::EpiResGateBf16I8 E{x, X1B, DM, mod + 2 * DM, MODW, 1.0f / MIX_SCALE, ctl + CW_CMX_OUT};
        pg8::gemm_phase<pg8::EpiResGateBf16I8, pg8::StaticOrder, true, true, true>(lds, g, S, E, wave);
    }
    SEAM(4);
#pragma nounroll
    for (int rep_ = 0; rep_ < REP5; ++rep_) { if (rep_) xcd_barrier(bar);
    if (IN(5)) { FRESH_IDS(); norm_rows_bf16(X1B, g_norm2, mod, 3 * DM, 4 * DM, H8, SH, gw, NGW, lane); }
    }
    SEAM(5);
#if REP6 > 1
    if (IN(6)) {
        pg8::Gemm g{(const bf16_t*)H8, (const bf16_t*)WPQ, MTOK, DM, DM / 2}; pg8::StaticOrder S; S.init(MTOK, DM, G, bx);
        pg8::EpiScoresI8 E{QP, MTOK, SH, ctl + CW_CMX_PQ};
        pg8::gemm_phase<pg8::EpiScoresI8, pg8::StaticOrder, true, true, true>(lds, g, S, E, wave);
    }
    xcd_barrier(bar);
#endif
    if (IN(6)) {
        pg8::Gemm g{(const bf16_t*)H8, (const bf16_t*)WPQ, MTOK, DM, DM / 2}; pg8::StaticOrder S; S.init(MTOK, DM, G, bx);
        pg8::EpiScoresI8 E{QP, MTOK, SH, ctl + CW_CMX_PQ};
        pg8::gemm_phase<pg8::EpiScoresI8, pg8::StaticOrder, true, true, true>(lds, g, S, E, wave);
    }
    SEAM(6);
    if (IN(7)) { FRESH_IDS();
        for (int chunk = bx; chunk < MTOK / 128; chunk += G) peer_chunk(chunk * 128, QP, SK, H8, SH, UB, SU, VB, mod, X1B, out, lds, tid, wave, lane);
    }
#undef IN
#undef SEAM
}

extern "C" void kernel_launch(void* const* d_in, const int* in_sizes, int n_in, void* d_out, int out_size, void* d_ws, size_t ws_size, hipStream_t stream) {
    static int grid = 0;
    if (grid == 0) {
        if (n_in != 18 || in_sizes[0] != MTOK * DM || out_size != MTOK * DM || ws_size < WS_END) { fprintf(stderr, "kernel_launch: unexpected shapes (n_in %d, in0 %d, out %d, ws %zu)\n", n_in, n_in > 0 ? in_sizes[0] : -1, out_size, ws_size); grid = -1; return; }
        int dev = 0, cus = 0, per_cu = 0;
        if (hipGetDevice(&dev) != hipSuccess || hipDeviceGetAttribute(&cus, hipDeviceAttributeMultiprocessorCount, dev) != hipSuccess) { grid = -1; return; }
        if (hipFuncSetAttribute((const void*)hymba_fwd, hipFuncAttributeMaxDynamicSharedMemorySize, LDS_BYTES) != hipSuccess) { fprintf(stderr, "kernel_launch: hipFuncSetAttribute failed\n"); grid = -1; return; }
        if (hipOccupancyMaxActiveBlocksPerMultiprocessor(&per_cu, (const void*)hymba_fwd, NWAVES * 64, LDS_BYTES) != hipSuccess || per_cu < 1) { fprintf(stderr, "kernel_launch: occupancy query says %d blocks per CU\n", per_cu); per_cu = 1; }
        (void)hipGetLastError();
        grid = cus;
    }
    if (grid < 0) return;
    (void)hipMemsetAsync((char*)d_ws + WS_CTL, 0, CTL_ZERO_BYTES, stream);
    Args a{};
    for (int i = 0; i < 18; ++i) a.in[i] = (const float*)d_in[i];
    a.out = (float*)d_out; a.ws = (unsigned char*)d_ws;
    if (MK_N_LAUNCHES == 1) {
        a.ph_lo = 0; a.ph_hi = N_PHASES;
        hipLaunchKernelGGL(hymba_fwd, dim3(grid), dim3(NWAVES * 64), LDS_BYTES, stream, a);
    } else {
        for (int p = 0; p < N_PHASES; ++p) { a.ph_lo = p; a.ph_hi = p + 1; hipLaunchKernelGGL(hymba_fwd, dim3(grid), dim3(NWAVES * 64), LDS_BYTES, stream, a); }
    }
}
```

```cpp
#include <hip/hip_runtime.h>
#include <cstdio>
#include <cstdint>

#ifndef MK_N_LAUNCHES
#define MK_N_LAUNCHES 1
#endif

#ifndef REP0
#define REP0 1
#endif
#ifndef REP0A
#define REP0A 1
#endif
#ifndef REP0C
#define REP0C 1
#endif
#ifndef REP1
#define REP1 1
#endif
#ifndef REP2
#define REP2 1
#endif
#ifndef REP3
#define REP3 1
#endif
#ifndef REP4
#define REP4 1
#endif
#ifndef REP5
#define REP5 1
#endif
#ifndef REP6
#define REP6 1
#endif
#ifndef REP7A
#define REP7A 1
#endif
#ifndef REP7U
#define REP7U 1
#endif
#ifndef REPSEL
#define REPSEL 1
#endif
#ifndef REP7V
#define REP7V 1
#endif
#ifndef REPSC
#define REPSC 1
#endif

#define LAS __attribute__((address_space(3)))
#define GAS __attribute__((address_space(1)))
typedef unsigned short bf16_t;
typedef short bf16x8 __attribute__((ext_vector_type(8)));
typedef short s16x4 __attribute__((ext_vector_type(4)));
typedef float f32x4 __attribute__((ext_vector_type(4)));
typedef float f32x2 __attribute__((ext_vector_type(2)));
typedef unsigned u32x4 __attribute__((ext_vector_type(4)));
typedef unsigned u32x2 __attribute__((ext_vector_type(2)));
typedef int i32x4 __attribute__((ext_vector_type(4)));
typedef __bf16 bf16x2_t __attribute__((ext_vector_type(2)));

constexpr int DM = 2048, BATCH = 8, SEQ = 4096, MTOK = BATCH * SEQ;
constexpr int INC = 4608;
constexpr int COL_K = 1024, COL_V = 1280, COL_B = 1536, COL_C = 2560, COL_H = 3584;
constexpr int MODW = 6 * DM;
constexpr int PEER_N = 16384;
constexpr float EPS = 1e-6f;
constexpr float LOG2E = 1.4426950408889634f;
constexpr float MIX_SCALE = 127.0f / 6.0f;
constexpr float V_SCALE = 16.0f;

constexpr size_t MiB = 1u << 20;
constexpr size_t WS_CTL = 0, CTL_ZERO_BYTES = 1 * MiB;
constexpr size_t WS_MOD = 1 * MiB;
constexpr size_t WS_ROPE = 1 * MiB + 512 * 1024;
constexpr size_t WS_SK = 2 * MiB;
constexpr size_t WS_WIN = 4 * MiB;
constexpr size_t WS_WOUT = 22 * MiB;
constexpr size_t WS_WPQ = 30 * MiB;
constexpr size_t WS_SU = 3 * MiB;
constexpr size_t WS_SH = 3 * MiB + 256 * 1024;
constexpr size_t WS_SX1 = 3 * MiB + 512 * 1024;
constexpr size_t WS_UB = 40 * MiB;
constexpr size_t WS_VB = 104 * MiB;
constexpr size_t WS_XN = 168 * MiB;
constexpr size_t WS_PROJ = 296 * MiB;
constexpr size_t WS_QP = WS_PROJ;
constexpr size_t WS_X1B = WS_PROJ + 128 * MiB;
constexpr size_t WS_MIXED = 584 * MiB;
constexpr size_t WS_H8 = 712 * MiB;
constexpr size_t WS_END = 776 * MiB;
constexpr int CW_BAR = 4096;
constexpr int CW_CMX_IN = 32768, CW_CMX_OUT = CW_CMX_IN + 4608, CW_CMX_PQ = CW_CMX_OUT + 2048;

constexpr int RING_BYTES = 131072;
constexpr int LDSCTL_OFF = RING_BYTES, MISC_OFF = LDSCTL_OFF + 320;
constexpr int LDS_BYTES = 148480;
constexpr int NWAVES = 8;

#define LDS_WAIT() asm volatile("s_waitcnt lgkmcnt(0)" ::: "memory")
#define VM_WAIT() asm volatile("s_waitcnt vmcnt(0)" ::: "memory")

__device__ __forceinline__ unsigned cvtpk(float lo, float hi) { f32x2 v = {lo, hi}; bf16x2_t b = __builtin_convertvector(v, bf16x2_t); return __builtin_bit_cast(unsigned, b); }
__device__ __forceinline__ float bf_lo(unsigned u) { return __uint_as_float(u << 16); }
__device__ __forceinline__ float bf_hi(unsigned u) { return __uint_as_float(u & 0xffff0000u); }
__device__ __forceinline__ float dot2bf(unsigned a, unsigned b, float c) { return __builtin_amdgcn_fdot2_f32_bf16(__builtin_bit_cast(bf16x2_t, a), __builtin_bit_cast(bf16x2_t, b), c, false); }
__device__ __forceinline__ int fresh_lane() { int l = (int)__builtin_amdgcn_mbcnt_hi(~0u, __builtin_amdgcn_mbcnt_lo(~0u, 0u)); asm volatile("" : "+v"(l)); return l; }
__device__ __forceinline__ float xrow_sum(float v) {
    const u32x2 a = __builtin_amdgcn_permlane16_swap(__float_as_uint(v), __float_as_uint(v), false, false); v = __uint_as_float(a.x) + __uint_as_float(a.y);
    const u32x2 b = __builtin_amdgcn_permlane32_swap(__float_as_uint(v), __float_as_uint(v), false, false); return __uint_as_float(b.x) + __uint_as_float(b.y);
}
__device__ __forceinline__ float xrow_max(float v) {
    const u32x2 a = __builtin_amdgcn_permlane16_swap(__float_as_uint(v), __float_as_uint(v), false, false); v = fmaxf(__uint_as_float(a.x), __uint_as_float(a.y));
    const u32x2 b = __builtin_amdgcn_permlane32_swap(__float_as_uint(v), __float_as_uint(v), false, false); return fmaxf(__uint_as_float(b.x), __uint_as_float(b.y));
}
__device__ __forceinline__ float xrow16_other(float v, bool odd_row) {
    const u32x2 a = __builtin_amdgcn_permlane16_swap(__float_as_uint(v), __float_as_uint(v), false, false); return __uint_as_float(odd_row ? a.x : a.y);
}

template <int CTRL> __device__ __forceinline__ float dpp_add(float v) { return v + __int_as_float(__builtin_amdgcn_update_dpp(0, __float_as_int(v), CTRL, 0xF, 0xF, false)); }
template <int CTRL> __device__ __forceinline__ float dpp_mov(float v) { return __int_as_float(__builtin_amdgcn_update_dpp(0, __float_as_int(v), CTRL, 0xF, 0xF, true)); }
__device__ __forceinline__ float allred8(float v) { v = dpp_add<0x141>(v); v = dpp_add<0x1B>(v); v = dpp_add<0xB1>(v); return v; }

template <int CTRL> __device__ __forceinline__ float dpp_max(float v) { return fmaxf(v, __int_as_float(__builtin_amdgcn_update_dpp(0, __float_as_int(v), CTRL, 0xF, 0xF, false))); }
__device__ __forceinline__ float wave_sum(float v) { v = dpp_add<0xB1>(v); v = dpp_add<0x4E>(v); v = dpp_add<0x141>(v); v = dpp_add<0x140>(v); return xrow_sum(v); }
__device__ __forceinline__ float wave_max(float v) { v = dpp_max<0xB1>(v); v = dpp_max<0x4E>(v); v = dpp_max<0x141>(v); v = dpp_max<0x140>(v); return xrow_max(v); }
__device__ __forceinline__ unsigned pack_i8x4_sat(f32x4 x, float inv) {
    const int a = (int)rintf(fminf(fmaxf(x[0] * inv, -127.f), 127.f)), b = (int)rintf(fminf(fmaxf(x[1] * inv, -127.f), 127.f)), c = (int)rintf(fminf(fmaxf(x[2] * inv, -127.f), 127.f)), d = (int)rintf(fminf(fmaxf(x[3] * inv, -127.f), 127.f));
    return ((unsigned)a & 0xffu) | (((unsigned)b & 0xffu) << 8) | (((unsigned)c & 0xffu) << 16) | ((unsigned)d << 24);
}
__device__ __forceinline__ unsigned pack_i8x4(f32x4 x, float inv) {
    const int a = (int)rintf(x[0] * inv), b = (int)rintf(x[1] * inv), c = (int)rintf(x[2] * inv), d = (int)rintf(x[3] * inv);
    return ((unsigned)a & 0xffu) | (((unsigned)b & 0xffu) << 8) | (((unsigned)c & 0xffu) << 16) | ((unsigned)d << 24);
}
template <int CTRL> __device__ __forceinline__ int dpp_movi(int v) { return __builtin_amdgcn_update_dpp(0, v, CTRL, 0xF, 0xF, true); }

namespace pg8 {
#define PG8_LAS __attribute__((address_space(3)))
constexpr int BM = 256, BK = 64, HALF = 128, HTB = HALF * BK * 2, STAGE_BYTES = 8 * HTB, NXCD = 8, WGM = 4;
__host__ __device__ __forceinline__ int lds_byte(int r, int c) { const int st = (r >> 4) * 2 + (c >> 5), rr = r & 15, cc = c & 31, ob = rr * 64 + cc * 2; return st * 1024 + (ob ^ (((ob >> 9) & 1) << 5)); }
__host__ __device__ __forceinline__ void stage_rc(int b, int& R, int& C) { const int st = b / 1024, sb = b % 1024, swz = sb ^ (((sb >> 9) & 1) << 5); R = (st >> 1) * 16 + swz / 64; C = (st & 1) * 32 + (swz % 64) / 2; }
__host__ __device__ __forceinline__ int perm32(int rho) { const int n = rho >> 4, i = rho & 15; return 8 * (i >> 2) + 4 * n + (i & 3); }
struct Unit { int pm, pn; };
struct Gemm { const bf16_t* A; const bf16_t* Bt; int M, N, K; };
struct StaticOrder {
    int nM, nN, nwg, G, c;
    __host__ __device__ void init(int M, int N, int G_, int c_) { nM = M / BM; nN = N / BM; nwg = nM * nN; G = G_; c = c_; }
    __host__ __device__ bool next(int i, Unit& u) const {
        const long L = (long)i * G + c; if (L >= nwg) return false;
        int wgid = (int)L; { const int q = nwg / NXCD, r = nwg % NXCD, xcd = wgid % NXCD, off = wgid / NXCD; wgid = (xcd < r ? xcd * (q + 1) : r * (q + 1) + (xcd - r) * q) + off; }
        const int nig = WGM * nN, gid = wgid / nig, fm = gid * WGM, gsz = (nM - fm) < WGM ? (nM - fm) : WGM;
        u.pm = fm + ((wgid % nig) % gsz); u.pn = (wgid % nig) / gsz; return true;
    }
    __device__ __forceinline__ void a_ready(const Unit&) const {}
    __device__ __forceinline__ void done(const Unit&) const {}
};
__device__ __forceinline__ unsigned cvt_pk_bf16(float lo, float hi) { unsigned r; asm volatile("v_cvt_pk_bf16_f32 %0, %1, %2" : "=v"(r) : "v"(lo), "v"(hi)); return r; }

struct EpiBf16 {
    static constexpr bool PERM = true, AFTER_DRAIN = false;
    bf16_t* O; int ldc;
    __device__ __forceinline__ void operator()(const f32x4 (&acc)[2][2][4][2], const Unit& u, int wr, int wc, int fr, int fq) const {
        const int row0 = u.pm * BM + wr * 64 + fr, col0 = u.pn * BM + wc * 32 + 8 * fq;
#pragma unroll
        for (int ai = 0; ai < 2; ++ai)
#pragma unroll
            for (int m = 0; m < 4; ++m) { bf16_t* rowp = O + (size_t)(row0 + ai * HALF + m * 16) * ldc + col0;
#pragma unroll
                for (int bj = 0; bj < 2; ++bj) { const f32x4 v0 = acc[ai][bj][m][0], v1 = acc[ai][bj][m][1];
                    u32x4 w; w.x = cvt_pk_bf16(v0[0], v0[1]); w.y = cvt_pk_bf16(v0[2], v0[3]); w.z = cvt_pk_bf16(v1[0], v1[1]); w.w = cvt_pk_bf16(v1[2], v1[3]);
                    *(u32x4*)(rowp + bj * HALF) = w; } }
    }
};
struct EpiBf16I8 {
    static constexpr bool PERM = true, AFTER_DRAIN = false;
    bf16_t* O; int ldc; const float* srow; const unsigned* cmax;
    __device__ __forceinline__ void operator()(const f32x4 (&acc)[2][2][4][2], const Unit& u, int wr, int wc, int fr, int fq) const {
        const int row0 = u.pm * BM + wr * 64 + fr, col0 = u.pn * BM + wc * 32 + 8 * fq;
        f32x4 sc[2][2];
#pragma unroll
        for (int bj = 0; bj < 2; ++bj)
#pragma unroll
            for (int n = 0; n < 2; ++n) { const u32x4 b = *(const u32x4*)(cmax + col0 + bj * HALF + 4 * n);
#pragma unroll
                for (int i = 0; i < 4; ++i) sc[bj][n][i] = __uint_as_float(b[i]) * (1.0f / 127.0f); }
        float srv[2][4];
#pragma unroll
        for (int ai = 0; ai < 2; ++ai)
#pragma unroll
            for (int m = 0; m < 4; ++m) srv[ai][m] = srow[row0 + ai * HALF + m * 16];
#pragma unroll
        for (int ai = 0; ai < 2; ++ai)
#pragma unroll
            for (int m = 0; m < 4; ++m) { const int row = row0 + ai * HALF + m * 16; const float sr = srv[ai][m]; bf16_t* rowp = O + (size_t)row * ldc + col0;
#pragma unroll
                for (int bj = 0; bj < 2; ++bj) { const i32x4 a0 = __builtin_bit_cast(i32x4, acc[ai][bj][m][0]), a1 = __builtin_bit_cast(i32x4, acc[ai][bj][m][1]);
                    f32x4 v0, v1;
#pragma unroll
                    for (int i = 0; i < 4; ++i) { v0[i] = (float)a0[i] * sr * sc[bj][0][i]; v1[i] = (float)a1[i] * sr * sc[bj][1][i]; }
                    u32x4 w; w.x = cvt_pk_bf16(v0[0], v0[1]); w.y = cvt_pk_bf16(v0[2], v0[3]); w.z = cvt_pk_bf16(v1[0], v1[1]); w.w = cvt_pk_bf16(v1[2], v1[3]);
                    *(u32x4*)(rowp + bj * HALF) = w; } }
    }
};
struct EpiScoresI8 {
    static constexpr bool PERM = true, AFTER_DRAIN = false;
    bf16_t* O; int M; const float* srow; const unsigned* cmax;
    __device__ __forceinline__ void operator()(const f32x4 (&acc)[2][2][4][2], const Unit& u, int wr, int wc, int fr, int fq) const {
        const int row0 = u.pm * BM + wr * 64 + fr, col0 = u.pn * BM + wc * 32 + 8 * fq;
        f32x4 sc[2][2];
#pragma unroll
        for (int bj = 0; bj < 2; ++bj)
#pragma unroll
            for (int n = 0; n < 2; ++n) { const u32x4 b = *(const u32x4*)(cmax + col0 + bj * HALF + 4 * n);
#pragma unroll
                for (int i = 0; i < 4; ++i) sc[bj][n][i] = __uint_as_float(b[i]) * (1.0f / 127.0f); }
        float srv[2][4];
#pragma unroll
        for (int ai = 0; ai < 2; ++ai)
#pragma unroll
            for (int m = 0; m < 4; ++m) srv[ai][m] = srow[row0 + ai * HALF + m * 16];
#pragma unroll
        for (int ai = 0; ai < 2; ++ai)
#pragma unroll
            for (int m = 0; m < 4; ++m) { const int row = row0 + ai * HALF + m * 16; const float sr = srv[ai][m];
#pragma unroll
                for (int bj = 0; bj < 2; ++bj) { const i32x4 a0 = __builtin_bit_cast(i32x4, acc[ai][bj][m][0]), a1 = __builtin_bit_cast(i32x4, acc[ai][bj][m][1]);
                    f32x4 v0, v1;
#pragma unroll
                    for (int i = 0; i < 4; ++i) { v0[i] = (float)a0[i] * sr * sc[bj][0][i]; v1[i] = (float)a1[i] * sr * sc[bj][1][i]; }
                    u32x4 w; w.x = cvt_pk_bf16(v0[0], v0[1]); w.y = cvt_pk_bf16(v0[2], v0[3]); w.z = cvt_pk_bf16(v1[0], v1[1]); w.w = cvt_pk_bf16(v1[2], v1[3]);
                    *(u32x4*)(O + ((size_t)(u.pn * 32 + bj * 16 + wc * 4 + fq) * M + row) * 8) = w; } }
    }
};
struct EpiProjI8 {
    static constexpr bool PERM = true, AFTER_DRAIN = false;
    bf16_t* O; int ldc; const float* srow; const unsigned* cmax;
    __device__ __forceinline__ void operator()(const f32x4 (&acc)[2][2][4][2], const Unit& u, int wr, int wc, int fr, int fq) const {
        const int row0 = u.pm * BM + wr * 64 + fr;
        const bool prod = u.pn >= 10;
        const int col0 = prod ? 2560 + (u.pn - 10) * 128 + wc * 32 + 8 * fq : u.pn * BM + wc * 32 + 8 * fq;
        const int sc0 = col0, sc1 = prod ? col0 + 1024 : col0 + HALF;
        f32x4 sc[2][2];
#pragma unroll
        for (int n = 0; n < 2; ++n) { const u32x4 b0 = *(const u32x4*)(cmax + sc0 + 4 * n), b1 = *(const u32x4*)(cmax + sc1 + 4 * n);
#pragma unroll
            for (int i = 0; i < 4; ++i) { sc[0][n][i] = __uint_as_float(b0[i]) * (1.0f / 127.0f); sc[1][n][i] = __uint_as_float(b1[i]) * (1.0f / 127.0f); } }
        float srv[2][4];
#pragma unroll
        for (int ai = 0; ai < 2; ++ai)
#pragma unroll
            for (int m = 0; m < 4; ++m) srv[ai][m] = srow[row0 + ai * HALF + m * 16];
#pragma unroll
        for (int ai = 0; ai < 2; ++ai)
#pragma unroll
            for (int m = 0; m < 4; ++m) { const float sr = srv[ai][m]; bf16_t* rowp = O + (size_t)(row0 + ai * HALF + m * 16) * ldc + col0;
                f32x4 v[2][2];
#pragma unroll
                for (int bj = 0; bj < 2; ++bj) { const i32x4 a0 = __builtin_bit_cast(i32x4, acc[ai][bj][m][0]), a1 = __builtin_bit_cast(i32x4, acc[ai][bj][m][1]);
#pragma unroll
                    for (int i = 0; i < 4; ++i) { v[bj][0][i] = (float)a0[i] * sr * sc[bj][0][i]; v[bj][1][i] = (float)a1[i] * sr * sc[bj][1][i]; } }
                if (prod) { const f32x4 p0 = v[0][0] * v[1][0], p1 = v[0][1] * v[1][1];
                    u32x4 w; w.x = cvt_pk_bf16(p0[0], p0[1]); w.y = cvt_pk_bf16(p0[2], p0[3]); w.z = cvt_pk_bf16(p1[0], p1[1]); w.w = cvt_pk_bf16(p1[2], p1[3]);
                    *(u32x4*)rowp = w;
                } else {
#pragma unroll
                    for (int bj = 0; bj < 2; ++bj) { u32x4 w; w.x = cvt_pk_bf16(v[bj][0][0], v[bj][0][1]); w.y = cvt_pk_bf16(v[bj][0][2], v[bj][0][3]); w.z = cvt_pk_bf16(v[bj][1][0], v[bj][1][1]); w.w = cvt_pk_bf16(v[bj][1][2], v[bj][1][3]);
                        *(u32x4*)(rowp + bj * HALF) = w; } }
            }
    }
};
struct EpiResGateI8 {
    static constexpr bool PERM = false, AFTER_DRAIN = false;
    const float* base; float* out; int ldc; const float* gate; int gate_stride; float srow_const; const unsigned* cmax;
    __device__ __forceinline__ void operator()(const f32x4 (&acc)[2][2][4][2], const Unit& u, int wr, int wc, int fr, int fq) const {
        const int row0 = u.pm * BM + wr * 64 + fr, col0 = u.pn * BM + wc * 32 + 4 * fq;
        const float* g = gate + (size_t)((u.pm * BM) >> 12) * gate_stride + col0;
        f32x4 gv[2][2];
#pragma unroll
        for (int bj = 0; bj < 2; ++bj)
#pragma unroll
            for (int n = 0; n < 2; ++n) { const f32x4 gg = *(const f32x4*)(g + bj * HALF + n * 16); const u32x4 b = *(const u32x4*)(cmax + col0 + bj * HALF + n * 16);
#pragma unroll
                for (int i = 0; i < 4; ++i) gv[bj][n][i] = gg[i] * __uint_as_float(b[i]) * (srow_const * (1.0f / 127.0f)); }
#pragma unroll
        for (int g2 = 0; g2 < 4; ++g2) {
            const int ai = g2 >> 1, m0 = (g2 & 1) * 2;
            f32x4 bs[2][2][2];
#pragma unroll
            for (int mm = 0; mm < 2; ++mm)
#pragma unroll
                for (int bj = 0; bj < 2; ++bj)
#pragma unroll
                    for (int n = 0; n < 2; ++n) bs[mm][bj][n] = *(const f32x4*)(base + (size_t)(row0 + ai * HALF + (m0 + mm) * 16) * ldc + col0 + bj * HALF + n * 16);
            asm volatile("" ::: "memory");
#pragma unroll
            for (int mm = 0; mm < 2; ++mm) { const size_t off = (size_t)(row0 + ai * HALF + (m0 + mm) * 16) * ldc + col0;
#pragma unroll
                for (int bj = 0; bj < 2; ++bj)
#pragma unroll
                    for (int n = 0; n < 2; ++n) { const i32x4 a = __builtin_bit_cast(i32x4, acc[ai][bj][m0 + mm][n]);
                        f32x4 o;
#pragma unroll
                        for (int i = 0; i < 4; ++i) o[i] = bs[mm][bj][n][i] + gv[bj][n][i] * (float)a[i];
                        *(f32x4*)(out + off + bj * HALF + n * 16) = o; } }
            asm volatile("" ::: "memory");
        }
    }
};
struct EpiResGateBf16I8 {
    static constexpr bool PERM = true, AFTER_DRAIN = false;
    const float* base; bf16_t* O; int ldc; const float* gate; int gate_stride; float srow_const; const unsigned* cmax;
    __device__ __forceinline__ void operator()(const f32x4 (&acc)[2][2][4][2], const Unit& u, int wr, int wc, int fr, int fq) const {
        const int row0 = u.pm * BM + wr * 64 + fr, col0 = u.pn * BM + wc * 32 + 8 * fq;
        const float* g = gate + (size_t)((u.pm * BM) >> 12) * gate_stride + col0;
        f32x4 gv[2][2];
#pragma unroll
        for (int bj = 0; bj < 2; ++bj)
#pragma unroll
            for (int n = 0; n < 2; ++n) { const f32x4 gg = *(const f32x4*)(g + bj * HALF + 4 * n); const u32x4 b = *(const u32x4*)(cmax + col0 + bj * HALF + 4 * n);
#pragma unroll
                for (int i = 0; i < 4; ++i) gv[bj][n][i] = gg[i] * __uint_as_float(b[i]) * (srow_const * (1.0f / 127.0f)); }
#pragma unroll
        for (int g2 = 0; g2 < 2; ++g2) {
            const int ai = g2, m0 = 0;
            f32x4 bs[4][2][2];
#pragma unroll
            for (int mm = 0; mm < 4; ++mm)
#pragma unroll
                for (int bj = 0; bj < 2; ++bj)
#pragma unroll
                    for (int n = 0; n < 2; ++n) bs[mm][bj][n] = *(const f32x4*)(base + (size_t)(row0 + ai * HALF + (m0 + mm) * 16) * ldc + col0 + bj * HALF + 4 * n);
            asm volatile("" ::: "memory");
#pragma unroll
            for (int mm = 0; mm < 4; ++mm) { bf16_t* rowp = O + (size_t)(row0 + ai * HALF + (m0 + mm) * 16) * ldc + col0;
#pragma unroll
                for (int bj = 0; bj < 2; ++bj) { const i32x4 a0 = __builtin_bit_cast(i32x4, acc[ai][bj][m0 + mm][0]), a1 = __builtin_bit_cast(i32x4, acc[ai][bj][m0 + mm][1]);
                    f32x4 v0, v1;
#pragma unroll
                    for (int i = 0; i < 4; ++i) { v0[i] = bs[mm][bj][0][i] + gv[bj][0][i] * (float)a0[i]; v1[i] = bs[mm][bj][1][i] + gv[bj][1][i] * (float)a1[i]; }
                    u32x4 w; w.x = cvt_pk_bf16(v0[0], v0[1]); w.y = cvt_pk_bf16(v0[2], v0[3]); w.z = cvt_pk_bf16(v1[0], v1[1]); w.w = cvt_pk_bf16(v1[2], v1[3]);
                    *(u32x4*)(rowp + bj * HALF) = w; } }
            asm volatile("" ::: "memory");
        }
    }
};
struct EpiResGate {
    static constexpr bool PERM = false, AFTER_DRAIN = false;
    const float* base; float* out; int ldc; const float* gate; int gate_stride;
    __device__ __forceinline__ void operator()(const f32x4 (&acc)[2][2][4][2], const Unit& u, int wr, int wc, int fr, int fq) const {
        const int row0 = u.pm * BM + wr * 64 + fr, col0 = u.pn * BM + wc * 32 + 4 * fq;
        const float* g = gate + (size_t)((u.pm * BM) >> 12) * gate_stride + col0;
        f32x4 gv[2][2];
#pragma unroll
        for (int bj = 0; bj < 2; ++bj)
#pragma unroll
            for (int n = 0; n < 2; ++n) gv[bj][n] = *(const f32x4*)(g + bj * HALF + n * 16);
#pragma unroll
        for (int ai = 0; ai < 2; ++ai)
#pragma unroll
            for (int m = 0; m < 4; ++m) { const size_t off = (size_t)(row0 + ai * HALF + m * 16) * ldc + col0;
#pragma unroll
                for (int bj = 0; bj < 2; ++bj)
#pragma unroll
                    for (int n = 0; n < 2; ++n) { const f32x4 bs = *(const f32x4*)(base + off + bj * HALF + n * 16); *(f32x4*)(out + off + bj * HALF + n * 16) = bs + gv[bj][n] * acc[ai][bj][m][n]; }
                asm volatile("" ::: "memory"); }
    }
};

template <class Epi, class Sched, bool ALIGN_EPI = false, bool SP2 = false, bool I8 = false>
__device__ __forceinline__ void gemm_phase(PG8_LAS unsigned char* lds, const Gemm g, const Sched& S, const Epi& E, const int wid) {
    const int lane = fresh_lane(), tid = wid * 64 + lane, wr = wid >> 2, wc = wid & 3, fr = lane & 15, fq = lane >> 4;
    const int K = g.K, nt = K / BK;
    unsigned voffA[2], voffB[2];
#pragma unroll
    for (int i = 0; i < 2; ++i) { int R, C; stage_rc(tid * 16 + i * 8192, R, C); const int Rb = Epi::PERM ? ((R & ~31) + perm32(R & 31)) : R;
        voffA[i] = (unsigned)(R * K + C) * 2u; voffB[i] = (unsigned)(Rb * K + C) * 2u; }
    const size_t kstep = (size_t)(BK * 2);
    const size_t hstep = (size_t)HALF * K * 2;
    const size_t tstep = 2 * hstep;
    const unsigned ldsw = (unsigned)wid * 1024u;
    const int aoff = lds_byte(wr * 64 + fr, fq * 8), boff = lds_byte(wc * 32 + fr, fq * 8);
#define PG8_SA(b, h) (((b) * 2 + (h)) * HTB)
#define PG8_SB(b, h) ((4 + (b) * 2 + (h)) * HTB)
#define PG8_STAGE(bufoff, gbase, voff) do { _Pragma("unroll") for (int _i = 0; _i < 2; ++_i) \
        __builtin_amdgcn_global_load_lds((const unsigned*)((const char*)(gbase) + (voff)[_i]), (PG8_LAS unsigned*)(lds + (bufoff) + ldsw + _i * 8192), 16, 0, 0); } while (0)
#define PG8_LDA(dst, b, h) do { _Pragma("unroll") for (int m = 0; m < 4; ++m) _Pragma("unroll") for (int k = 0; k < 2; ++k) dst[m][k] = *(const PG8_LAS bf16x8*)(lds + PG8_SA(b, h) + aoff + m * 2048 + k * 1024); } while (0)
#define PG8_LDB(dst, b, h) do { _Pragma("unroll") for (int n = 0; n < 2; ++n) _Pragma("unroll") for (int k = 0; k < 2; ++k) dst[n][k] = *(const PG8_LAS bf16x8*)(lds + PG8_SB(b, h) + boff + n * 2048 + k * 1024); } while (0)
#define PG8_MMA(ai, bj, At, Bt) do { __builtin_amdgcn_s_setprio(1); _Pragma("unroll") for (int m = 0; m < 4; ++m) _Pragma("unroll") for (int n = 0; n < 2; ++n) _Pragma("unroll") for (int k = 0; k < 2; ++k) { \
        if constexpr (I8) acc[ai][bj][m][n] = __builtin_bit_cast(f32x4, __builtin_amdgcn_mfma_i32_16x16x64_i8(__builtin_bit_cast(i32x4, Bt[n][k]), __builtin_bit_cast(i32x4, At[m][k]), __builtin_bit_cast(i32x4, acc[ai][bj][m][n]), 0, 0, 0)); \
        else acc[ai][bj][m][n] = __builtin_amdgcn_mfma_f32_16x16x32_bf16(Bt[n][k], At[m][k], acc[ai][bj][m][n], 0, 0, 0); } __builtin_amdgcn_s_setprio(0); } while (0)
#define PG8_WAIT_V(n) asm volatile("s_waitcnt vmcnt(" #n ")" ::: "memory")
#define PG8_WAIT_L(n) asm volatile("s_waitcnt lgkmcnt(" #n ")" ::: "memory")
#define PG8_BAR __builtin_amdgcn_s_barrier()
#define PG8_SCHED __builtin_amdgcn_sched_barrier(0)
    Unit cur, nxt; int ui = 0;
    if (!S.next(0, cur)) return;
    f32x4 acc[2][2][4][2];
#pragma unroll
    for (int a = 0; a < 2; ++a)
#pragma unroll
        for (int b = 0; b < 2; ++b)
#pragma unroll
            for (int m = 0; m < 4; ++m)
#pragma unroll
                for (int n = 0; n < 2; ++n) acc[a][b][m][n] = (f32x4){0.f, 0.f, 0.f, 0.f};
    bf16x8 At[4][2], B0[2][2], B1[2][2];
    const char* cA = (const char*)g.A + (size_t)cur.pm * tstep; const char* cB = (const char*)g.Bt + (size_t)cur.pn * tstep;
    S.a_ready(cur);
    if constexpr (SP2) {
        PG8_STAGE(PG8_SB(0, 0), cB, voffB); PG8_STAGE(PG8_SB(0, 1), cB + hstep, voffB); PG8_STAGE(PG8_SA(0, 0), cA, voffA); PG8_STAGE(PG8_SA(0, 1), cA + hstep, voffA);
        if (wr == 1) PG8_BAR;
        PG8_WAIT_V(2); PG8_BAR;
        PG8_STAGE(PG8_SB(1, 0), cB + kstep, voffB); PG8_STAGE(PG8_SA(1, 0), cA + kstep, voffA); PG8_STAGE(PG8_SB(1, 1), cB + hstep + kstep, voffB);
        PG8_WAIT_V(6); PG8_BAR;
    } else {
        PG8_STAGE(PG8_SB(0, 0), cB, voffB); PG8_STAGE(PG8_SA(0, 0), cA, voffA); PG8_STAGE(PG8_SB(0, 1), cB + hstep, voffB); PG8_STAGE(PG8_SA(0, 1), cA + hstep, voffA);
        if (wr == 1) PG8_BAR;
        PG8_WAIT_V(4); PG8_BAR;
        PG8_STAGE(PG8_SB(1, 0), cB + kstep, voffB); PG8_STAGE(PG8_SA(1, 0), cA + kstep, voffA); PG8_STAGE(PG8_SB(1, 1), cB + hstep + kstep, voffB);
        PG8_WAIT_V(6); PG8_BAR;
    }
    for (;;) {
        const bool has_next = S.next(ui + 1, nxt);
        const char* nA = has_next ? (const char*)g.A + (size_t)nxt.pm * tstep : cA; const char* nB = has_next ? (const char*)g.Bt + (size_t)nxt.pn * tstep : cB;
        for (int t = 0; t < nt; t += 2) {
            const bool last = (t == nt - 2);
            const char* a1 = cA + (size_t)(t + 1) * kstep;
            const char* a2 = last ? nA : cA + (size_t)(t + 2) * kstep; const char* b2 = last ? nB : cB + (size_t)(t + 2) * kstep;
            const char* a3 = a2 + kstep; const char* b3 = b2 + kstep;
            if (last && has_next) S.a_ready(nxt);
            if constexpr (SP2) {
            PG8_LDB(B0, 0, 0); PG8_LDB(B1, 0, 1); PG8_SCHED; PG8_LDA(At, 0, 0); PG8_STAGE(PG8_SA(1, 1), a1 + hstep, voffA);
            PG8_WAIT_V(8); PG8_WAIT_L(0); PG8_BAR; PG8_MMA(0, 0, At, B0); PG8_MMA(0, 1, At, B1); PG8_BAR; PG8_SCHED;
            PG8_LDA(At, 0, 1); PG8_STAGE(PG8_SB(0, 0), b2, voffB); PG8_STAGE(PG8_SB(0, 1), b2 + hstep, voffB); PG8_STAGE(PG8_SA(0, 0), a2, voffA);
            PG8_WAIT_V(8); PG8_WAIT_L(0); PG8_BAR; PG8_MMA(1, 0, At, B0); PG8_MMA(1, 1, At, B1); PG8_BAR; PG8_SCHED;
            PG8_LDB(B0, 1, 0); PG8_LDB(B1, 1, 1); PG8_SCHED; PG8_LDA(At, 1, 0); PG8_STAGE(PG8_SA(0, 1), a2 + hstep, voffA);
            PG8_WAIT_V(8); PG8_WAIT_L(0); PG8_BAR; PG8_MMA(0, 0, At, B0); PG8_MMA(0, 1, At, B1); PG8_BAR; PG8_SCHED;
            PG8_LDA(At, 1, 1); PG8_STAGE(PG8_SB(1, 0), b3, voffB); PG8_STAGE(PG8_SB(1, 1), b3 + hstep, voffB); PG8_STAGE(PG8_SA(1, 0), a3, voffA);
            PG8_WAIT_V(8); PG8_WAIT_L(0); PG8_BAR; PG8_MMA(1, 0, At, B0); PG8_MMA(1, 1, At, B1); PG8_BAR; PG8_SCHED;
            } else {
            PG8_LDB(B0, 0, 0); PG8_SCHED; PG8_LDA(At, 0, 0); PG8_STAGE(PG8_SA(1, 1), a1 + hstep, voffA);
            PG8_WAIT_L(8); PG8_BAR; PG8_WAIT_L(0); PG8_MMA(0, 0, At, B0); PG8_BAR; PG8_SCHED;
            PG8_LDB(B1, 0, 1); PG8_STAGE(PG8_SB(0, 0), b2, voffB);
            PG8_BAR; PG8_WAIT_L(0); PG8_MMA(0, 1, At, B1); PG8_BAR;
            PG8_LDA(At, 0, 1); PG8_STAGE(PG8_SA(0, 0), a2, voffA);
            PG8_BAR; PG8_WAIT_L(0); PG8_MMA(1, 0, At, B0); PG8_BAR; PG8_SCHED;
            PG8_STAGE(PG8_SB(0, 1), b2 + hstep, voffB);
            PG8_WAIT_V(6); PG8_BAR; PG8_MMA(1, 1, At, B1); PG8_BAR;
            PG8_LDB(B0, 1, 0); PG8_SCHED; PG8_LDA(At, 1, 0); PG8_STAGE(PG8_SA(0, 1), a2 + hstep, voffA);
            PG8_WAIT_L(8); PG8_BAR; PG8_WAIT_L(0); PG8_MMA(0, 0, At, B0); PG8_BAR; PG8_SCHED;
            PG8_LDB(B1, 1, 1); PG8_STAGE(PG8_SB(1, 0), b3, voffB);
            PG8_BAR; PG8_WAIT_L(0); PG8_MMA(0, 1, At, B1); PG8_BAR;
            PG8_LDA(At, 1, 1); PG8_STAGE(PG8_SA(1, 0), a3, voffA);
            PG8_BAR; PG8_WAIT_L(0); PG8_MMA(1, 0, At, B0); PG8_BAR; PG8_SCHED;
            PG8_STAGE(PG8_SB(1, 1), b3 + hstep, voffB);
            PG8_WAIT_V(6); PG8_BAR; PG8_MMA(1, 1, At, B1); PG8_BAR;
            }
        }
        if constexpr (ALIGN_EPI) { if (wr == 0) PG8_BAR; }
        if constexpr (!Epi::AFTER_DRAIN) { E(acc, cur, wr, wc, fr, fq); S.done(cur); }
        if (!has_next) break;
#pragma unroll
        for (int a = 0; a < 2; ++a)
#pragma unroll
            for (int b = 0; b < 2; ++b)
#pragma unroll
                for (int m = 0; m < 4; ++m)
#pragma unroll
                    for (int n = 0; n < 2; ++n) acc[a][b][m][n] = (f32x4){0.f, 0.f, 0.f, 0.f};
        cur = nxt; cA = nA; cB = nB; ++ui;
        if constexpr (ALIGN_EPI) { if (wr == 1) PG8_BAR; }
    }
    PG8_WAIT_V(0);
    if constexpr (!ALIGN_EPI) { if (wr == 0) PG8_BAR; }
    PG8_BAR;
#undef PG8_SA
#undef PG8_SB
#undef PG8_STAGE
#undef PG8_LDA
#undef PG8_LDB
#undef PG8_MMA
#undef PG8_WAIT_V
#undef PG8_WAIT_L
#undef PG8_BAR
#undef PG8_SCHED
}
}

#define XB_TMO      128
#define XB_XCNT(j)  (256  + 64 * (j))
#define XB_XSUB(j)  (1280 + 64 * (j))
#define XB_XGEN(j)  (2304 + 64 * (j))
#define XB_TOP      3328
#define XB_TOPGEN   3392
#define XCD_BAR_WORDS 3456
#define XB_SPIN_CAP (1u << 18)
__device__ __forceinline__ unsigned xb_ld(unsigned* p)              { return __hip_atomic_load(p, __ATOMIC_RELAXED, __HIP_MEMORY_SCOPE_AGENT); }
__device__ __forceinline__ unsigned xb_add(unsigned* p, unsigned v) { return __hip_atomic_fetch_add(p, v, __ATOMIC_RELAXED, __HIP_MEMORY_SCOPE_AGENT); }
__device__ __forceinline__ unsigned xb_xcc_id() { return (unsigned)__builtin_amdgcn_s_getreg((3 << 11) | 20) & 0xFu; }
#define XB_SPIN(cond, bar) do { unsigned _sp = 0; while (cond) { __builtin_amdgcn_s_sleep(1); \
    if ((++_sp & 255u) == 0u) { if (xb_ld(&(bar)[XB_TMO])) break; if (_sp > XB_SPIN_CAP) { atomicAdd(&(bar)[XB_TMO], 1u); break; } } } } while (0)
struct XcdBarrier { unsigned* bar; unsigned x; volatile LAS unsigned* st; int wave; };
__device__ __forceinline__ XcdBarrier xcd_barrier_post(unsigned* bar, volatile LAS unsigned* st, int wave) {
    XcdBarrier b; b.bar = bar; b.x = xb_xcc_id(); b.st = st; b.wave = wave;
    if (wave == 0 && fresh_lane() == 0) (void)xb_add(&bar[XB_XCNT(b.x)], 1u);
    return b;
}
__device__ __forceinline__ void xcd_barrier_complete(unsigned* bar, unsigned x, unsigned& nloc, unsigned& nx) {
    const unsigned G = gridDim.x * gridDim.y * gridDim.z;
    unsigned sum, cnt, mine, sp = 0u;
    for (;;) {
        sum = 0u; cnt = 0u; mine = 0u;
#pragma unroll
        for (unsigned j = 0; j < 16; ++j) { const unsigned c = xb_ld(&bar[XB_XCNT(j)]); sum += c; cnt += (c > 0u) ? 1u : 0u; mine = (j == x) ? c : mine; }
        if (sum == G) break;
        __builtin_amdgcn_s_sleep(1);
        if ((++sp & 255u) == 0u) { if (xb_ld(&bar[XB_TMO])) break; if (sp > XB_SPIN_CAP) { atomicAdd(&bar[XB_TMO], 1u); break; } }
    }
    nloc = mine > 0u ? mine : 1u; nx = cnt > 0u ? cnt : 1u;
}
__device__ __forceinline__ void xcd_barrier(const XcdBarrier& b) {
    asm volatile("s_waitcnt vmcnt(0)" ::: "memory");
    __syncthreads();
    if (b.wave == 0 && fresh_lane() == 0) {
        unsigned* bar = b.bar;
        __builtin_amdgcn_s_waitcnt(0);
        unsigned nloc = b.st[0], nx = b.st[1];
        if (nloc == 0u) { xcd_barrier_complete(bar, b.x, nloc, nx); b.st[0] = nloc; b.st[1] = nx; }
        const unsigned old = xb_add(&bar[XB_XSUB(b.x)], 1u);
        const unsigned gen = old / nloc, target = (gen + 1u) * nx;
        if (old + 1u == (gen + 1u) * nloc) {
            __builtin_amdgcn_fence(__ATOMIC_RELEASE, "agent");
            asm volatile("s_waitcnt vmcnt(0)" ::: "memory");
            const unsigned og = xb_add(&bar[XB_TOP], 1u);
            if (og + 1u != target) XB_SPIN(xb_ld(&bar[XB_TOP]) < target, bar);
        } else {
            XB_SPIN(xb_ld(&bar[XB_TOP]) < target, bar);
        }
        __builtin_amdgcn_fence(__ATOMIC_ACQUIRE, "agent");
        asm volatile("s_waitcnt vmcnt(0)" ::: "memory");
    }
    __syncthreads();
}

__device__ __forceinline__ void p0_ada_item(const float* cvec, const float* w_ada, const float* b_ada, float* mod, LAS unsigned char* lds, int item, int tid, int wave, int lane) {
    LAS float* sc = (LAS float*)(lds + wave * 8192);
    LAS float* red = (LAS float*)(lds + 65536);
    const int k0 = wave * 256;
    { float cv[32];
#pragma unroll
      for (int j = 0; j < 32; ++j) { const int i = lane + 64 * j; cv[j] = cvec[(i & 7) * DM + k0 + (i >> 3)]; }
#pragma unroll
      for (int j = 0; j < 32; ++j) { const int i = lane + 64 * j; const float v = cv[j]; sc[(i >> 3) * 8 + (i & 7)] = v * __builtin_amdgcn_rcpf(1.f + __builtin_amdgcn_exp2f(-v * LOG2E)); } }
    LDS_WAIT();
    const int rg = lane >> 4, cq = lane & 15;
    float acc[8][4];
#pragma unroll
    for (int b = 0; b < 8; ++b)
#pragma unroll
        for (int i = 0; i < 4; ++i) acc[b][i] = 0.f;
    const float* wp = w_ada + (size_t)(k0 + rg) * MODW + item * 64 + 4 * cq;
#pragma unroll 32
    for (int it = 0; it < 64; ++it) {
        const f32x4 w4 = __builtin_nontemporal_load((const f32x4*)(wp + (size_t)it * 4 * MODW));
        const int kk = it * 4 + rg;
        const f32x4 s0 = *(const LAS f32x4*)(sc + kk * 8), s1 = *(const LAS f32x4*)(sc + kk * 8 + 4);
#pragma unroll
        for (int i = 0; i < 4; ++i) {
            acc[0][i] += s0[0] * w4[i]; acc[1][i] += s0[1] * w4[i]; acc[2][i] += s0[2] * w4[i]; acc[3][i] += s0[3] * w4[i];
            acc[4][i] += s1[0] * w4[i]; acc[5][i] += s1[1] * w4[i]; acc[6][i] += s1[2] * w4[i]; acc[7][i] += s1[3] * w4[i];
        }
    }
#pragma unroll
    for (int b = 0; b < 8; ++b)
#pragma unroll
        for (int i = 0; i < 4; ++i) acc[b][i] = xrow_sum(acc[b][i]);
    if (rg == 0) {
#pragma unroll
        for (int b = 0; b < 8; ++b)
#pragma unroll
            for (int i = 0; i < 4; ++i) red[(wave * 8 + b) * 64 + 4 * cq + i] = acc[b][i];
    }
    LDS_WAIT();
    __syncthreads();
    { const int b = tid >> 6, col = tid & 63; float s = b_ada[item * 64 + col];
#pragma unroll
      for (int w = 0; w < 8; ++w) s += red[(w * 8 + b) * 64 + col];
      mod[b * MODW + item * 64 + col] = s; }
    LDS_WAIT();
    __syncthreads();
}
__device__ __forceinline__ void p0_transpose_item(const float* W, int K, int N, bf16_t* WT, LAS float* scr, int item, int lane) {
    const int nblk = N / 32, kb = item / nblk, nb = item % nblk, k0 = 64 * kb, n0 = 32 * nb;
#pragma unroll 8
    for (int i = 0; i < 32; ++i) { const int kk = 2 * i + (lane >> 5); scr[kk * 33 + (lane & 31)] = W[(size_t)(k0 + kk) * N + n0 + (lane & 31)]; }
    LDS_WAIT(); asm volatile("" ::: "memory");
    const int c = lane & 7;
#pragma unroll
    for (int j = 0; j < 4; ++j) { const int n = (lane >> 3) + 8 * j; const LAS float* s = scr + (8 * c) * 33 + n;
        u32x4 o; o.x = cvtpk(s[0 * 33], s[1 * 33]); o.y = cvtpk(s[2 * 33], s[3 * 33]); o.z = cvtpk(s[4 * 33], s[5 * 33]); o.w = cvtpk(s[6 * 33], s[7 * 33]);
        *(u32x4*)(WT + (size_t)(n0 + n) * K + k0 + 8 * c) = o; }
    LDS_WAIT(); asm volatile("" ::: "memory");
}
__device__ __forceinline__ void p0_colmax_item(const float* W, int N, unsigned* cmax, int item, int lane) {
    const int nblk = N / 32, kb = item / nblk, nb = item % nblk, k0 = 64 * kb, n0 = 32 * nb;
    float am = 0.f;
#pragma unroll
    for (int i = 0; i < 32; ++i) am = fmaxf(am, fabsf(W[(size_t)(k0 + 2 * i + (lane >> 5)) * N + n0 + (lane & 31)]));
    am = fmaxf(am, __shfl_xor(am, 32));
    if (lane < 32) atomicMax(cmax + n0 + lane, __float_as_uint(am));
}
template <bool INTERLEAVE>
__device__ __forceinline__ void p1_transpose_i8_item(const float* W, int K, int N, unsigned char* WT, const unsigned* cmax, LAS float* scr, int item, int lane) {
    const int nblk = N / 32, kb = item / nblk, nb = item % nblk, k0 = 64 * kb, nd0 = 32 * nb;
    int n0 = nd0;
    if (INTERLEAVE && nd0 >= 2560) { const int t = (nd0 - 2560) >> 8, j = (nd0 - 2560) & 255; n0 = j < 128 ? 2560 + 128 * t + j : 3584 + 128 * t + (j - 128); }
    float wv[32];
#pragma unroll
    for (int i = 0; i < 32; ++i) wv[i] = W[(size_t)(k0 + 2 * i + (lane >> 5)) * N + n0 + (lane & 31)];
#pragma unroll
    for (int i = 0; i < 32; ++i) { const int kk = 2 * i + (lane >> 5); scr[kk * 33 + (lane & 31)] = wv[i]; }
    LDS_WAIT(); asm volatile("" ::: "memory");
    const int c4 = lane & 3;
#pragma unroll
    for (int j = 0; j < 2; ++j) { const int n = (lane >> 2) + 16 * j; const LAS float* s = scr + (16 * c4) * 33 + n;
        const float am = __uint_as_float(cmax[n0 + n]); const float inv = am > 0.f ? 127.0f / am : 0.f;
        u32x4 o;
#pragma unroll
        for (int w = 0; w < 4; ++w) o[w] = pack_i8x4((f32x4){s[(4 * w) * 33], s[(4 * w + 1) * 33], s[(4 * w + 2) * 33], s[(4 * w + 3) * 33]}, inv);
        *(u32x4*)(WT + (size_t)(nd0 + n) * K + k0 + 16 * c4) = o; }
    LDS_WAIT(); asm volatile("" ::: "memory");
}
__device__ __forceinline__ void p0_w2_item(const float* w_pq, const float* subkeys, bf16_t* W2, unsigned* cmax, int item, int lane) {
    const int blk = item >> 5, kq = (item >> 4) & 1, dch = item & 15, c = lane & 15, quad = lane >> 4;
    bf16x8 kf[4][4];
    { f32x4 sv[4][4][2];
#pragma unroll
      for (int kt = 0; kt < 4; ++kt) { const float* sp = subkeys + ((size_t)blk * 128 + (kq * 4 + kt) * 16 + c) * 128 + 8 * quad;
#pragma unroll
          for (int ks = 0; ks < 4; ++ks) { sv[kt][ks][0] = *(const f32x4*)(sp + ks * 32); sv[kt][ks][1] = *(const f32x4*)(sp + ks * 32 + 4); } }
#pragma unroll
      for (int kt = 0; kt < 4; ++kt)
#pragma unroll
          for (int ks = 0; ks < 4; ++ks) { const f32x4 a = sv[kt][ks][0], b = sv[kt][ks][1];
              u32x4 w; w.x = cvtpk(a[0], a[1]); w.y = cvtpk(a[2], a[3]); w.z = cvtpk(b[0], b[1]); w.w = cvtpk(b[2], b[3]); kf[kt][ks] = __builtin_bit_cast(bf16x8, w); } }
    float am[4] = {0.f, 0.f, 0.f, 0.f};
#pragma nounroll
    for (int dq = 0; dq < 2; ++dq) {
        f32x4 wv[4][4][2];
#pragma unroll
        for (int j = 0; j < 4; ++j) { const float* wp = w_pq + (size_t)(dch * 128 + (dq * 4 + j) * 16 + c) * DM + blk * 128 + 8 * quad;
#pragma unroll
            for (int ks = 0; ks < 4; ++ks) { wv[j][ks][0] = *(const f32x4*)(wp + ks * 32); wv[j][ks][1] = *(const f32x4*)(wp + ks * 32 + 4); } }
#pragma unroll
        for (int j = 0; j < 4; ++j) { const int d0 = dch * 128 + (dq * 4 + j) * 16;
            bf16x8 wb[4];
#pragma unroll
            for (int ks = 0; ks < 4; ++ks) { const f32x4 a = wv[j][ks][0], b = wv[j][ks][1];
                u32x4 w; w.x = cvtpk(a[0], a[1]); w.y = cvtpk(a[2], a[3]); w.z = cvtpk(b[0], b[1]); w.w = cvtpk(b[2], b[3]); wb[ks] = __builtin_bit_cast(bf16x8, w); }
#pragma unroll
            for (int kt = 0; kt < 4; ++kt) {
                f32x4 acc = (f32x4){0.f, 0.f, 0.f, 0.f};
#pragma unroll
                for (int ks = 0; ks < 4; ++ks) acc = __builtin_amdgcn_mfma_f32_16x16x32_bf16(wb[ks], kf[kt][ks], acc, 0, 0, 0);
                am[kt] = fmaxf(fmaxf(am[kt], fmaxf(fabsf(acc[0]), fabsf(acc[1]))), fmaxf(fabsf(acc[2]), fabsf(acc[3])));
                u32x2 o; o.x = cvtpk(acc[0], acc[1]); o.y = cvtpk(acc[2], acc[3]);
                *(u32x2*)(W2 + (size_t)(blk * 128 + (kq * 4 + kt) * 16 + c) * DM + d0 + 4 * quad) = o; } }
    }
#pragma unroll
    for (int kt = 0; kt < 4; ++kt) { const float a = xrow_max(am[kt]); if (quad == 0) atomicMax(cmax + blk * 128 + (kq * 4 + kt) * 16 + c, __float_as_uint(a)); }
}
__device__ __forceinline__ void p1_w2_row(const bf16_t* W2, unsigned char* WT, const unsigned* cmax, int n, int lane) {
    const float am = __uint_as_float(cmax[n]); const float inv = am > 0.f ? 127.0f / am : 0.f;
#pragma unroll
    for (int j = 0; j < 8; ++j) { const u32x2 v = *(const u32x2*)(W2 + (size_t)n * DM + 256 * j + 4 * lane);
        *(unsigned*)(WT + (size_t)n * DM + 256 * j + 4 * lane) = pack_i8x4((f32x4){bf_lo(v.x), bf_hi(v.x), bf_lo(v.y), bf_hi(v.y)}, inv); }
}
__device__ __forceinline__ void p0_cvt_item(const float* src, bf16_t* dst, size_t base, int lane) {
#pragma unroll
    for (int j = 0; j < 4; ++j) { const size_t o = base + (size_t)j * 512 + lane * 8;
        const f32x4 a = *(const f32x4*)(src + o), b = *(const f32x4*)(src + o + 4);
        u32x4 w; w.x = cvtpk(a[0], a[1]); w.y = cvtpk(a[2], a[3]); w.z = cvtpk(b[0], b[1]); w.w = cvtpk(b[2], b[3]);
        *(u32x4*)(dst + o) = w; }
}
__device__ __forceinline__ size_t tab_off(int row, int col) { return ((size_t)(col >> 7) * PEER_N + row) * 128 + (col & 127); }
__device__ __forceinline__ void p0_fp8_item(const float* src, unsigned char* dst, size_t base, float scale, int lane) {
#pragma unroll
    for (int i = 0; i < 8; ++i) { const size_t o = base + (size_t)i * 256 + lane * 4; const f32x4 a = *(const f32x4*)(src + o);
        int p = 0; p = __builtin_amdgcn_cvt_pk_fp8_f32(a[0] * scale, a[1] * scale, p, false); p = __builtin_amdgcn_cvt_pk_fp8_f32(a[2] * scale, a[3] * scale, p, true);
        *(unsigned*)(dst + tab_off((int)(base >> 11), i * 256 + lane * 4)) = (unsigned)p; }
}
__device__ __forceinline__ void p0_i8_row(const float* src, unsigned char* dst, float* scale, int row, int lane) {
    const float* p = src + (size_t)row * DM + lane * 4;
    f32x4 v[8]; float am = 0.f;
#pragma unroll
    for (int i = 0; i < 8; ++i) { v[i] = *(const f32x4*)(p + i * 256); am = fmaxf(fmaxf(am, fmaxf(fabsf(v[i][0]), fabsf(v[i][1]))), fmaxf(fabsf(v[i][2]), fabsf(v[i][3]))); }
    am = wave_max(am);
    const float inv = am > 0.f ? 127.0f / am : 0.f;
#pragma unroll
    for (int i = 0; i < 8; ++i) *(unsigned*)(dst + tab_off(row, i * 256 + lane * 4)) = pack_i8x4(v[i], inv);
    if (lane == 0) scale[row] = am * (1.0f / 127.0f);
}
__device__ __forceinline__ void p0_tables8(const float* peer_u, const float* peer_v, unsigned char* UB, float* SU, unsigned char* VB, int gw, int ngw, int lane) {
#define P0_TAB_SRC(k) (((k) < 8 ? peer_u : peer_v) + (size_t)(gw + ((k) & 7) * ngw) * DM + lane * 4)
    f32x4 ra[8], rb[8], rc[8];
#pragma unroll
    for (int i = 0; i < 8; ++i) ra[i] = *(const f32x4*)(P0_TAB_SRC(0) + i * 256);
#pragma unroll
    for (int i = 0; i < 8; ++i) rb[i] = *(const f32x4*)(P0_TAB_SRC(1) + i * 256);
#pragma unroll
    for (int k = 0; k < 16; ++k) {
        const int row = gw + (k & 7) * ngw;
        f32x4 (&v)[8] = (k % 3 == 0) ? ra : (k % 3 == 1) ? rb : rc;
        f32x4 (&nn)[8] = (k % 3 == 0) ? rc : (k % 3 == 1) ? ra : rb;
        if (k < 14) {
#pragma unroll
            for (int i = 0; i < 8; ++i) nn[i] = *(const f32x4*)(P0_TAB_SRC(k + 2) + i * 256); }
        if (k < 8) {
            float am = 0.f;
#pragma unroll
            for (int i = 0; i < 8; ++i) am = fmaxf(fmaxf(am, fmaxf(fabsf(v[i][0]), fabsf(v[i][1]))), fmaxf(fabsf(v[i][2]), fabsf(v[i][3])));
            am = wave_max(am);
            const float inv = am > 0.f ? 127.0f / am : 0.f;
            unsigned char* q = UB + (size_t)(lane >> 5) * (PEER_N * 128) + (size_t)row * 128 + (lane & 31) * 4;
#pragma unroll
            for (int i = 0; i < 8; ++i) *(unsigned*)(q + (size_t)i * (2 * PEER_N * 128)) = pack_i8x4(v[i], inv);
            if (lane == 0) SU[row] = am * (1.0f / 127.0f);
        } else {
            unsigned char* q = VB + (size_t)(lane >> 5) * (PEER_N * 128) + (size_t)row * 128 + (lane & 31) * 4;
#pragma unroll
            for (int i = 0; i < 8; ++i) { int p = 0; p = __builtin_amdgcn_cvt_pk_fp8_f32(v[i][0] * V_SCALE, v[i][1] * V_SCALE, p, false); p = __builtin_amdgcn_cvt_pk_fp8_f32(v[i][2] * V_SCALE, v[i][3] * V_SCALE, p, true);
                *(unsigned*)(q + (size_t)i * (2 * PEER_N * 128)) = (unsigned)p; }
        }
    }
#undef P0_TAB_SRC
}
struct TabCtx { const float* src; unsigned char* dst; float* SU; int p; };
__device__ __forceinline__ void tab_row_load(const TabCtx& T, int k, f32x4 (&v)[8], int lane) {
    const float* np = T.src + (size_t)(T.p + 1024 * (k < 15 ? k : 15)) * DM + lane * 4;
#pragma unroll
    for (int i = 0; i < 8; ++i) v[i] = __builtin_nontemporal_load((const f32x4*)(np + i * 256));
}
template <bool ISV> __device__ __forceinline__ void tab_row_convert(const TabCtx& T, int k, const f32x4 (&v)[8], int lane) {
    const int row = T.p + 1024 * k;
    unsigned char* q = T.dst + (size_t)(lane >> 5) * (PEER_N * 128) + (size_t)row * 128 + (lane & 31) * 4;
    if (!ISV) {
        float am = 0.f;
#pragma unroll
        for (int i = 0; i < 8; ++i) am = fmaxf(fmaxf(am, fmaxf(fabsf(v[i][0]), fabsf(v[i][1]))), fmaxf(fabsf(v[i][2]), fabsf(v[i][3])));
        am = wave_max(am);
        const float inv = am > 0.f ? 127.0f / am : 0.f;
#pragma unroll
        for (int i = 0; i < 8; ++i) *(unsigned*)(q + (size_t)i * (2 * PEER_N * 128)) = pack_i8x4(v[i], inv);
        if (lane == 0) T.SU[row] = am * (1.0f / 127.0f);
    } else {
#pragma unroll
        for (int i = 0; i < 8; ++i) { int p = 0; p = __builtin_amdgcn_cvt_pk_fp8_f32(v[i][0] * V_SCALE, v[i][1] * V_SCALE, p, false); p = __builtin_amdgcn_cvt_pk_fp8_f32(v[i][2] * V_SCALE, v[i][3] * V_SCALE, p, true);
            *(unsigned*)(q + (size_t)i * (2 * PEER_N * 128)) = (unsigned)p; }
    }
}
__device__ __forceinline__ void p0_rope_item(float* rope, int item, int lane) {
    const int idx = item * 64 + lane, pos = idx >> 3, i = idx & 7;
    const double f = (i == 0) ? 0.15915494309189535 : (i == 1) ? 0.03086376340470123 : (i == 2) ? 0.005985185712713705 : (i == 3) ? 0.001160663641240061
                   : (i == 4) ? 0.00022507907903927653 : (i == 5) ? 4.364795279280289e-05 : (i == 6) ? 8.464330808241401e-06 : 1.6414262627950345e-06;
    const double rev = (double)pos * f; const double fr = rev - (double)(long long)rev;
    rope[idx] = __builtin_amdgcn_cosf((float)fr); rope[32768 + idx] = __builtin_amdgcn_sinf((float)fr);
}

__device__ __forceinline__ void norm_rows(const float* src, const float* gain, const float* mod, int off_shift, int off_scale, unsigned char* dst8, float* scale8, int gw, int ngw, int lane) {
    for (int grp = gw; grp < MTOK / 16; grp += ngw) {
        const int row0 = grp * 16; const float* mb = mod + (size_t)(row0 >> 12) * MODW;
        f32x4 A[8], B[8];
#pragma unroll
        for (int j = 0; j < 8; ++j) { const int c = 256 * j + 4 * lane; const f32x4 g = *(const f32x4*)(gain + c), sc = *(const f32x4*)(mb + off_scale + c); A[j] = g * (sc + 1.0f); B[j] = *(const f32x4*)(mb + off_shift + c); }
        f32x4 ra[8], rb[8], rc[8];
#pragma unroll
        for (int j = 0; j < 8; ++j) ra[j] = __builtin_nontemporal_load((const f32x4*)(src + (size_t)row0 * DM + 4 * lane + 256 * j));
#pragma unroll
        for (int j = 0; j < 8; ++j) rb[j] = __builtin_nontemporal_load((const f32x4*)(src + (size_t)(row0 + 1) * DM + 4 * lane + 256 * j));
#pragma unroll
        for (int r = 0; r < 16; ++r) {
            f32x4 (&cur)[8] = (r % 3 == 0) ? ra : (r % 3 == 1) ? rb : rc;
            f32x4 (&nn)[8] = (r % 3 == 0) ? rc : (r % 3 == 1) ? ra : rb;
            f32x4 v[8]; float ss = 0.f;
#pragma unroll
            for (int j = 0; j < 8; ++j) { v[j] = cur[j]; ss += (v[j][0] * v[j][0] + v[j][1] * v[j][1]) + (v[j][2] * v[j][2] + v[j][3] * v[j][3]); }
            if (r < 14) { const float* xn = src + (size_t)(row0 + r + 2) * DM + 4 * lane;
#pragma unroll
              for (int j = 0; j < 8; ++j) nn[j] = __builtin_nontemporal_load((const f32x4*)(xn + 256 * j)); }
            const float rstd = 1.0f / sqrtf(wave_sum(ss) * (1.0f / DM) + EPS);
            float am = 0.f;
#pragma unroll
            for (int j = 0; j < 8; ++j) { const f32x4 o = v[j] * rstd * A[j] + B[j]; v[j] = o; am = fmaxf(fmaxf(am, fmaxf(fabsf(o[0]), fabsf(o[1]))), fmaxf(fabsf(o[2]), fabsf(o[3]))); }
            am = wave_max(am); const float inv = am > 0.f ? 127.0f / am : 0.f;
            unsigned* q = (unsigned*)(dst8 + (size_t)(row0 + r) * DM + 4 * lane);
#pragma unroll
            for (int j = 0; j < 8; ++j) q[64 * j] = pack_i8x4(v[j], inv);
            if (lane == 0) scale8[row0 + r] = am * (1.0f / 127.0f);
        }
    }
}

__device__ __forceinline__ void norm_rows_bf16(const bf16_t* src, const float* gain, const float* mod, int off_shift, int off_scale, unsigned char* dst8, float* scale8, int gw, int ngw, int lane) {
    for (int grp = gw; grp < MTOK / 16; grp += ngw) {
        const int row0 = grp * 16; const float* mb = mod + (size_t)(row0 >> 12) * MODW;
        f32x4 A[8], B[8];
#pragma unroll
        for (int j = 0; j < 8; ++j) { const int c = 512 * (j >> 1) + 8 * lane + 4 * (j & 1); const f32x4 g = *(const f32x4*)(gain + c), sc = *(const f32x4*)(mb + off_scale + c); A[j] = g * (sc + 1.0f); B[j] = *(const f32x4*)(mb + off_shift + c); }
        u32x4 ra[4], rb[4], rc[4];
#pragma unroll
        for (int j = 0; j < 4; ++j) ra[j] = __builtin_nontemporal_load((const u32x4*)(src + (size_t)row0 * DM + 8 * lane + 512 * j));
#pragma unroll
        for (int j = 0; j < 4; ++j) rb[j] = __builtin_nontemporal_load((const u32x4*)(src + (size_t)(row0 + 1) * DM + 8 * lane + 512 * j));
#pragma unroll
        for (int r = 0; r < 16; ++r) {
            u32x4 (&cur)[4] = (r % 3 == 0) ? ra : (r % 3 == 1) ? rb : rc;
            u32x4 (&nn)[4] = (r % 3 == 0) ? rc : (r % 3 == 1) ? ra : rb;
            f32x4 v[8]; float ss = 0.f;
#pragma unroll
            for (int j = 0; j < 4; ++j) { const u32x4 t = cur[j]; v[2 * j] = (f32x4){bf_lo(t.x), bf_hi(t.x), bf_lo(t.y), bf_hi(t.y)}; v[2 * j + 1] = (f32x4){bf_lo(t.z), bf_hi(t.z), bf_lo(t.w), bf_hi(t.w)}; }
#pragma unroll
            for (int j = 0; j < 8; ++j) ss += (v[j][0] * v[j][0] + v[j][1] * v[j][1]) + (v[j][2] * v[j][2] + v[j][3] * v[j][3]);
            if (r < 14) { const bf16_t* xn = src + (size_t)(row0 + r + 2) * DM + 8 * lane;
#pragma unroll
              for (int j = 0; j < 4; ++j) nn[j] = __builtin_nontemporal_load((const u32x4*)(xn + 512 * j)); }
            const float rstd = __builtin_amdgcn_rsqf(wave_sum(ss) * (1.0f / DM) + EPS);
            float am = 0.f;
#pragma unroll
            for (int j = 0; j < 8; ++j) { const f32x4 o = v[j] * rstd * A[j] + B[j]; v[j] = o; am = fmaxf(fmaxf(am, fmaxf(fabsf(o[0]), fabsf(o[1]))), fmaxf(fabsf(o[2]), fabsf(o[3]))); }
            am = wave_max(am); const float inv = am > 0.f ? 127.0f / am : 0.f;
            unsigned char* q = dst8 + (size_t)(row0 + r) * DM + 8 * lane;
#pragma unroll
            for (int j = 0; j < 4; ++j) { u32x2 o; o.x = pack_i8x4(v[2 * j], inv); o.y = pack_i8x4(v[2 * j + 1], inv); *(u32x2*)(q + 512 * j) = o; }
            if (lane == 0) scale8[row0 + r] = am * (1.0f / 127.0f);
        }
    }
}

constexpr int KS_PITCH = 72;
constexpr int VT_PITCH = 264;
constexpr int LDS_KS = 0, LDS_VT = 256 * KS_PITCH * 2, LDS_RT = LDS_VT + 64 * VT_PITCH * 2;
constexpr int LDS_QS = LDS_RT + 8192, LDS_QS_HI = LDSCTL_OFF + 1024;
__device__ __forceinline__ int qstash_off(int wave) { return wave < 6 ? LDS_QS + wave * 8192 : LDS_QS_HI + (wave - 6) * 8192; }
static_assert(LDS_QS + 6 * 8192 <= LDSCTL_OFF && LDS_QS_HI + 2 * 8192 <= LDS_BYTES, "Q stash placement");
template <bool HOST, bool ISV>
__device__ __forceinline__ void attn_unit(int b, int hk, int n, const bf16_t* PROJ, const float* g_q, const float* g_k, const float* sinks, const float* g_oa, const float* rope, unsigned char* MIXED,
                                          LAS unsigned char* lds, int tid, int wave, int lane, const TabCtx& T, int tabk0, f32x4 (&tcur)[8], f32x4 (&tnx)[8]) {
    LAS bf16_t* Ks = (LAS bf16_t*)(lds + LDS_KS); LAS bf16_t* Vt = (LAS bf16_t*)(lds + LDS_VT); LAS float* RT = (LAS float*)(lds + LDS_RT);
    const size_t rowb = (size_t)b * SEQ;
    const int c = lane & 15, quad = lane >> 4, g = wave >> 1, hf = wave & 1, head = hk * 4 + g;
    const bf16_t* qsrc = PROJ + (rowb + n * 128 + hf * 64 + c) * INC + head * 64 + 8 * quad;
#pragma unroll
    for (int qt = 0; qt < 4; ++qt)
#pragma unroll
        for (int k = 0; k < 2; ++k)
            __builtin_amdgcn_global_load_lds((const unsigned*)(qsrc + (size_t)qt * 16 * INC + k * 32), (LAS unsigned*)(lds + qstash_off(wave) + (qt * 2 + k) * 1024), 16, 0, 0);
    u32x4 kr[2][2]; f32x4 kcs[2][4]; u32x4 vr[4];
    const int part = tid & 3;
#pragma unroll
    for (int it = 0; it < 2; ++it) {
        const int row = (tid + 512 * it) >> 2, pos = (n - 1) * 128 + row, posc = pos >= 0 ? pos : 0;
        const bf16_t* src = PROJ + (rowb + posc) * INC + COL_K + hk * 64 + 16 * part;
        kr[it][0] = *(const u32x4*)src; kr[it][1] = *(const u32x4*)(src + 8);
        const float* rp = rope + posc * 8;
        kcs[it][0] = *(const f32x4*)rp; kcs[it][1] = *(const f32x4*)(rp + 4); kcs[it][2] = *(const f32x4*)(rp + 32768); kcs[it][3] = *(const f32x4*)(rp + 32768 + 4);
    }
#pragma unroll
    for (int it = 0; it < 4; ++it) {
        const int task = tid + 512 * it, row = task & 255, ch = task >> 8, pos = (n - 1) * 128 + row, posc = pos >= 0 ? pos : 0;
        vr[it] = *(const u32x4*)(PROJ + (rowb + posc) * INC + COL_V + hk * 64 + 8 * ch);
    }
    const f32x4 rv = *(const f32x4*)(rope + ((tid & 3) >> 1) * 32768 + (size_t)(n * 128 + (tid >> 2)) * 8 + (tid & 1) * 4);
    f32x4 gk[4], gq[4], goa[4];
#pragma unroll
    for (int i = 0; i < 4; ++i) gk[i] = *(const f32x4*)(g_k + 16 * part + 4 * i);
    gq[0] = *(const f32x4*)(g_q + 8 * quad); gq[1] = *(const f32x4*)(g_q + 8 * quad + 4); gq[2] = *(const f32x4*)(g_q + 32 + 8 * quad); gq[3] = *(const f32x4*)(g_q + 32 + 8 * quad + 4);
#pragma unroll
    for (int dt = 0; dt < 4; ++dt) goa[dt] = *(const f32x4*)(g_oa + head * 64 + dt * 16 + 4 * quad);
    const float sinkv = sinks[head] * LOG2E;
    *(LAS f32x4*)(RT + (tid >> 2) * 16 + (tid & 3) * 4) = rv;
#pragma unroll
    for (int it = 0; it < 2; ++it) {
        const int row = (tid + 512 * it) >> 2; const bool valid = (n - 1) * 128 + row >= 0;
        const u32x4 r0 = kr[it][0], r1 = kr[it][1];
        float x[16];
#pragma unroll
        for (int i = 0; i < 4; ++i) { x[2 * i] = bf_lo(r0[i]); x[2 * i + 1] = bf_hi(r0[i]); x[8 + 2 * i] = bf_lo(r1[i]); x[8 + 2 * i + 1] = bf_hi(r1[i]); }
        float ss = 0.f;
#pragma unroll
        for (int i = 0; i < 16; ++i) ss += x[i] * x[i];
        ss = dpp_add<0xB1>(ss); ss = dpp_add<0x4E>(ss);
        const float rstd = 1.0f / sqrtf(ss * (1.0f / 64.0f) + EPS);
#pragma unroll
        for (int i = 0; i < 16; ++i) x[i] = x[i] * rstd * gk[i >> 2][i & 3];
#pragma unroll
        for (int i = 0; i < 8; ++i) { const float cs = kcs[it][i >> 2][i & 3], sn = kcs[it][2 + (i >> 2)][i & 3]; const float t1 = x[i], t2 = x[8 + i];
            x[i] = part == 0 ? t1 * cs - t2 * sn : t1; x[8 + i] = part == 0 ? t2 * cs + t1 * sn : t2; }
        u32x4 w0, w1;
#pragma unroll
        for (int i = 0; i < 4; ++i) { w0[i] = valid ? cvtpk(x[2 * i], x[2 * i + 1]) : 0u; w1[i] = valid ? cvtpk(x[8 + 2 * i], x[8 + 2 * i + 1]) : 0u; }
        LAS bf16_t* d = Ks + row * KS_PITCH + 16 * part;
        *(LAS u32x4*)d = w0; *(LAS u32x4*)(d + 8) = w1;
    }
#pragma unroll
    for (int it = 0; it < 4; ++it) {
        const int task = tid + 512 * it, row = task & 255, ch = task >> 8; const bool valid = (n - 1) * 128 + row >= 0;
        u32x4 r = vr[it];
        if (!valid) r = (u32x4){0u, 0u, 0u, 0u};
#pragma unroll
        for (int i = 0; i < 4; ++i) { Vt[(8 * ch + 2 * i) * VT_PITCH + row] = (bf16_t)(r[i] & 0xffffu); Vt[(8 * ch + 2 * i + 1) * VT_PITCH + row] = (bf16_t)(r[i] >> 16); }
    }
    VM_WAIT();
    LDS_WAIT();
    __syncthreads();
#pragma unroll
    for (int i = 0; i < 4; ++i) { gq[i] = gq[i] * (0.125f * LOG2E); asm volatile("" : "+v"(gq[i])); asm volatile("" : "+v"(goa[i])); }
    const int lq = 4 * quad - c;
    const LAS unsigned char* qstash = lds + qstash_off(wave) + lane * 16;
    for (int qt = 0; qt < 4; ++qt) {
        const int qi0 = hf * 64 + qt * 16, kt0 = (qi0 >> 4) & ~1, qi = qi0 + c, pos = n * 128 + qi;
        const size_t tq = rowb + pos;
        bf16x8 qf[2];
        {
            const u32x4 r0 = *(const LAS u32x4*)(qstash + qt * 2048), r1 = *(const LAS u32x4*)(qstash + qt * 2048 + 1024);
            float x0[8], x1[8];
#pragma unroll
            for (int i = 0; i < 4; ++i) { x0[2 * i] = bf_lo(r0[i]); x0[2 * i + 1] = bf_hi(r0[i]); x1[2 * i] = bf_lo(r1[i]); x1[2 * i + 1] = bf_hi(r1[i]); }
            float ss = 0.f;
#pragma unroll
            for (int i = 0; i < 8; ++i) ss += x0[i] * x0[i] + x1[i] * x1[i];
            ss = xrow_sum(ss);
            const float rstd = __builtin_amdgcn_rsqf(ss * (1.0f / 64.0f) + EPS);
#pragma unroll
            for (int i = 0; i < 8; ++i) { x0[i] = x0[i] * rstd * gq[i >> 2][i & 3]; x1[i] = x1[i] * rstd * gq[2 + (i >> 2)][i & 3]; }
            const LAS float* rt = RT + qi * 16;
            const f32x4 rc0 = *(const LAS f32x4*)rt, rc1 = *(const LAS f32x4*)(rt + 4), rs0 = *(const LAS f32x4*)(rt + 8), rs1 = *(const LAS f32x4*)(rt + 12);
#pragma unroll
            for (int i = 0; i < 8; ++i) {
                const float other = xrow16_other(x0[i], (quad & 1) != 0);
                const float cs = i < 4 ? rc0[i & 3] : rc1[i & 3], sn = i < 4 ? rs0[i & 3] : rs1[i & 3];
                const float rot = (quad == 0) ? (x0[i] * cs - other * sn) : (x0[i] * cs + other * sn);
                x0[i] = (quad < 2) ? rot : x0[i];
            }
            u32x4 w0, w1;
#pragma unroll
            for (int i = 0; i < 4; ++i) { w0[i] = cvtpk(x0[2 * i], x0[2 * i + 1]); w1[i] = cvtpk(x1[2 * i], x1[2 * i + 1]); }
            qf[0] = __builtin_bit_cast(bf16x8, w0); qf[1] = __builtin_bit_cast(bf16x8, w1);
        }
        f32x4 s[10];
#pragma unroll
        for (int t = 0; t < 10; ++t) {
            s[t] = (f32x4){0.f, 0.f, 0.f, 0.f};
            const LAS bf16_t* kp = Ks + ((kt0 + t) * 16 + c) * KS_PITCH + 8 * quad;
#pragma unroll
            for (int ks = 0; ks < 2; ++ks) { const bf16x8 kf = *(const LAS bf16x8*)(kp + ks * 32); s[t] = __builtin_amdgcn_mfma_f32_16x16x32_bf16(kf, qf[ks], s[t], 0, 0, 0); }
        }
        if (n == 0) {
#pragma unroll
            for (int t = 0; t < 10; ++t)
#pragma unroll
                for (int r = 0; r < 4; ++r) { const int kj = (kt0 + t) * 16 + 4 * quad + r; const bool ok = (kj >= qi + 1) && (kj <= qi + 128) && kj >= 128; s[t][r] = ok ? s[t][r] : -1e30f; }
        } else {
            const int L = kt0 * 16 - qi0 + lq;
#pragma unroll
            for (int t = 0; t < 2; ++t)
#pragma unroll
                for (int r = 0; r < 4; ++r) { s[t][r] = (L >= 1 - (16 * t + r)) ? s[t][r] : -1e30f; s[8 + t][r] = (L <= 128 - (16 * (8 + t) + r)) ? s[8 + t][r] : -1e30f; }
        }
        float m = sinkv;
#pragma unroll
        for (int t = 0; t < 10; ++t)
#pragma unroll
            for (int r = 0; r < 4; ++r) m = __builtin_amdgcn_fmed3f(m, s[t][r], __builtin_inff());
        m = xrow_max(m);
#pragma unroll
        for (int t = 0; t < 10; ++t)
#pragma unroll
            for (int r = 0; r < 4; ++r) s[t][r] = __builtin_amdgcn_exp2f(s[t][r] - m);
        bf16x8 pf[5];
#pragma unroll
        for (int i = 0; i < 5; ++i) { u32x4 w; w.x = cvtpk(s[2 * i][0], s[2 * i][1]); w.y = cvtpk(s[2 * i][2], s[2 * i][3]);
            w.z = cvtpk(s[2 * i + 1][0], s[2 * i + 1][1]); w.w = cvtpk(s[2 * i + 1][2], s[2 * i + 1][3]); pf[i] = __builtin_bit_cast(bf16x8, w); }
        f32x4 osum = (f32x4){0.f, 0.f, 0.f, 0.f};
        { const unsigned ow = (c & 3) == 0 ? 0x3F803F80u : 0u; const bf16x8 onesA = __builtin_bit_cast(bf16x8, (u32x4){ow, ow, ow, ow});
#pragma unroll
          for (int i = 0; i < 5; ++i) osum = __builtin_amdgcn_mfma_f32_16x16x32_bf16(onesA, pf[i], osum, 0, 0, 0); }
        const float inv = __builtin_amdgcn_rcpf(osum[0] + __builtin_amdgcn_exp2f(sinkv - m));
        f32x4 o[4]; float ss = 0.f;
#pragma unroll
        for (int dt = 0; dt < 4; ++dt) {
            o[dt] = (f32x4){0.f, 0.f, 0.f, 0.f};
            const LAS bf16_t* vp = Vt + (dt * 16 + c) * VT_PITCH + kt0 * 16 + 4 * quad;
#pragma unroll
            for (int i = 0; i < 5; ++i) { const u32x2 lo = *(const LAS u32x2*)(vp + i * 32), hi = *(const LAS u32x2*)(vp + i * 32 + 16);
                u32x4 w; w.x = lo.x; w.y = lo.y; w.z = hi.x; w.w = hi.y;
                o[dt] = __builtin_amdgcn_mfma_f32_16x16x32_bf16(__builtin_bit_cast(bf16x8, w), pf[i], o[dt], 0, 0, 0); }
            ss += (o[dt][0] * o[dt][0] + o[dt][1] * o[dt][1]) + (o[dt][2] * o[dt][2] + o[dt][3] * o[dt][3]);
        }
        ss = xrow_sum(ss);
        const float fac = inv * __builtin_amdgcn_rsqf(inv * inv * ss * (1.0f / 64.0f) + EPS) * MIX_SCALE;
        if (HOST) {
            tab_row_convert<ISV>(T, tabk0 + qt, tnx, lane);
            tab_row_load(T, tabk0 + qt + 1, tnx, lane);
        }
        unsigned char* orow = MIXED + tq * DM + head * 64 + 4 * quad;
#pragma unroll
        for (int dt = 0; dt < 4; ++dt) *(unsigned*)(orow + dt * 16) = pack_i8x4_sat(o[dt] * goa[dt], fac);
    }
    __syncthreads();
}
__device__ __forceinline__ void conv_item(int item, const bf16_t* PROJ, const float* conv_w, const float* g_oc, unsigned char* MIXED, int lane) {
    const int t0 = item * 16, ch = 16 * lane;
    float w0[16], w1[16], w2[16], gg[16], up2[16], up1[16];
#pragma unroll
    for (int i = 0; i < 16; ++i) { w0[i] = conv_w[ch + i]; w1[i] = conv_w[1024 + ch + i]; w2[i] = conv_w[2048 + ch + i]; gg[i] = g_oc[ch + i]; up2[i] = 0.f; up1[i] = 0.f; }
    if ((t0 & (SEQ - 1)) != 0) {
#pragma unroll
        for (int h = 0; h < 2; ++h) {
            const bf16_t* pr = PROJ + (size_t)(t0 - 2 + h) * INC + ch;
            const u32x4 c0 = *(const u32x4*)(pr + COL_C), c1 = *(const u32x4*)(pr + COL_C + 8);
#pragma unroll
            for (int i = 0; i < 4; ++i) {
                const float u0 = bf_lo(c0[i]), u1 = bf_hi(c0[i]), u2 = bf_lo(c1[i]), u3 = bf_hi(c1[i]);
                if (h == 0) { up2[2 * i] = u0; up2[2 * i + 1] = u1; up2[8 + 2 * i] = u2; up2[8 + 2 * i + 1] = u3; }
                else        { up1[2 * i] = u0; up1[2 * i + 1] = u1; up1[8 + 2 * i] = u2; up1[8 + 2 * i + 1] = u3; }
            }
        }
    }
    u32x4 nb0, nb1, nc0, nc1;
    { const bf16_t* pr = PROJ + (size_t)t0 * INC + ch; nb0 = __builtin_nontemporal_load((const u32x4*)(pr + COL_B)); nb1 = __builtin_nontemporal_load((const u32x4*)(pr + COL_B + 8)); nc0 = __builtin_nontemporal_load((const u32x4*)(pr + COL_C)); nc1 = __builtin_nontemporal_load((const u32x4*)(pr + COL_C + 8)); }
#pragma unroll
    for (int r = 0; r < 16; ++r) {
        const u32x4 b0 = nb0, b1 = nb1, c0 = nc0, c1 = nc1;
        { const bf16_t* pr = PROJ + (size_t)(t0 + (r < 15 ? r + 1 : r)) * INC + ch; nb0 = __builtin_nontemporal_load((const u32x4*)(pr + COL_B)); nb1 = __builtin_nontemporal_load((const u32x4*)(pr + COL_B + 8)); nc0 = __builtin_nontemporal_load((const u32x4*)(pr + COL_C)); nc1 = __builtin_nontemporal_load((const u32x4*)(pr + COL_C + 8)); }
        float u[16], bg[16], y[16];
#pragma unroll
        for (int i = 0; i < 4; ++i) {
            u[2 * i] = bf_lo(c0[i]); u[2 * i + 1] = bf_hi(c0[i]); u[8 + 2 * i] = bf_lo(c1[i]); u[8 + 2 * i + 1] = bf_hi(c1[i]);
            bg[2 * i] = bf_lo(b0[i]); bg[2 * i + 1] = bf_hi(b0[i]); bg[8 + 2 * i] = bf_lo(b1[i]); bg[8 + 2 * i + 1] = bf_hi(b1[i]);
        }
        float ss = 0.f;
#pragma unroll
        for (int i = 0; i < 16; ++i) { y[i] = bg[i] * (w0[i] * up2[i] + w1[i] * up1[i] + w2[i] * u[i]); ss += y[i] * y[i]; up2[i] = up1[i]; up1[i] = u[i]; }
        ss += __shfl_xor(ss, 1); ss += __shfl_xor(ss, 2);
        const float rstd = 1.0f / sqrtf(ss * (1.0f / 64.0f) + EPS);
        u32x4 o0;
#pragma unroll
        for (int i = 0; i < 4; ++i) o0[i] = pack_i8x4_sat((f32x4){y[4 * i] * rstd * gg[4 * i], y[4 * i + 1] * rstd * gg[4 * i + 1], y[4 * i + 2] * rstd * gg[4 * i + 2], y[4 * i + 3] * rstd * gg[4 * i + 3]}, MIX_SCALE);
        *(u32x4*)(MIXED + (size_t)(t0 + r) * DM + 1024 + ch) = o0;
    }
}

__device__ __forceinline__ void ins16(float (&L)[16], float x) {
#pragma unroll
    for (int j = 0; j < 16; ++j) { const float hi = fmaxf(L[j], x); x = fminf(L[j], x); L[j] = hi; }
}
template <int C> __device__ __forceinline__ float pack7(float s, unsigned q32) { unsigned t; asm("v_and_b32 %0, 0xffffff80, %1\n\tv_or3_b32 %0, %0, %2, %3" : "=&v"(t) : "v"(s), "v"(q32), "n"(C)); return __uint_as_float(t); }
template <int C> __device__ __forceinline__ float pack8(float s) { unsigned t; asm("v_and_b32 %0, 0xffffff00, %1\n\tv_or_b32 %0, %2, %0" : "=&v"(t) : "v"(s), "n"(C)); return __uint_as_float(t); }
template <int KEY> __device__ __forceinline__ float pack_lo(unsigned u) { unsigned t; asm("v_lshlrev_b32 %0, 16, %1\n\tv_or_b32 %0, %2, %0" : "=&v"(t) : "v"(u), "n"(KEY)); return __uint_as_float(t); }
template <int KEY> __device__ __forceinline__ float pack_hi(unsigned u) { unsigned t; asm("v_and_b32 %0, 0xffff0000, %1\n\tv_or_b32 %0, %2, %0" : "=&v"(t) : "v"(u), "n"(KEY)); return __uint_as_float(t); }
__device__ __forceinline__ unsigned key_of(unsigned x) { return ((x >> 2) & 7u) * 16u + (x >> 5) * 4u + (x & 3u); }
#define CE_DESC(a, b) do { const float hi_ = fmaxf(a, b), lo_ = fminf(a, b); a = hi_; b = lo_; } while (0)
__device__ __forceinline__ void bitonic_tail16(float (&L)[16]) {
#pragma unroll
    for (int d = 8; d >= 1; d >>= 1)
#pragma unroll
        for (int i = 0; i < 16; ++i) if ((i & d) == 0) CE_DESC(L[i], L[i + d]);
}
__device__ __forceinline__ void sort16_desc(float (&L)[16]) {
#define SN(i, j) CE_DESC(L[i], L[j]);
    SN(0,13) SN(1,12) SN(2,15) SN(3,14) SN(4,8) SN(5,6) SN(7,11) SN(9,10)
    SN(0,5) SN(1,7) SN(2,9) SN(3,4) SN(6,13) SN(8,14) SN(10,15) SN(11,12)
    SN(0,1) SN(2,3) SN(4,5) SN(6,8) SN(7,9) SN(10,11) SN(12,13) SN(14,15)
    SN(0,2) SN(1,3) SN(4,10) SN(5,11) SN(6,7) SN(8,9) SN(12,14) SN(13,15)
    SN(1,2) SN(3,12) SN(4,6) SN(5,7) SN(8,10) SN(9,11) SN(13,14)
    SN(1,4) SN(2,6) SN(5,8) SN(7,10) SN(9,13) SN(11,14)
    SN(2,4) SN(3,6) SN(9,12) SN(11,13)
    SN(3,5) SN(6,8) SN(7,9) SN(10,12)
    SN(3,4) SN(5,6) SN(7,8) SN(9,10) SN(11,12)
    SN(6,7) SN(8,9)
#undef SN
}
__device__ __forceinline__ void top16_of_two(float (&A)[16], const float (&B)[16]) {
#pragma unroll
    for (int j = 0; j < 16; ++j) A[j] = fmaxf(A[j], B[15 - j]);
    bitonic_tail16(A);
}
__device__ __forceinline__ void merge16(float (&L)[16], int mask) {
    float P[16];
#pragma unroll
    for (int j = 0; j < 16; ++j) P[j] = __shfl_xor(L[j], mask);
    top16_of_two(L, P);
}
constexpr int SKT_OFF = 8192 + 512, SKT_PITCH = 272;
__device__ __forceinline__ void peer_chunk(int tokb, const bf16_t* QP, const bf16_t* SK, const unsigned char* H8, const float* SH, const unsigned char* UB, const float* SU, const unsigned char* VB, const float* mod, const bf16_t* X1B, float* out,
                                           LAS unsigned char* lds, int tid, int wave, int lane) {
    LAS unsigned char* wl = lds + wave * 16384;
    int tok0 = tokb + wave * 16;
    LAS bf16_t* eidx = (LAS bf16_t*)wl; LAS bf16_t* gate = (LAS bf16_t*)(wl + 4096); LAS float* accL = (LAS float*)(wl + 8192); LAS unsigned char* ids = wl + 8192;
#pragma nounroll
    for (int rep7a_ = 0; rep7a_ < REP7A; ++rep7a_) {
#pragma nounroll
    for (int i2 = 0; i2 < 2; ++i2) {
        const int p = tid + 512 * i2, tkn = p & 127, h = p >> 7;
        const u32x4* srow = (const u32x4*)QP + (size_t)(h * 32) * MTOK + tokb + tkn;
        float T0[16], T1[16];
#pragma unroll
        for (int hf = 0; hf < 2; ++hf) {
            float L[16], Bv[16];
#define PKC(ch, DST) { const u32x4 a_ = srow[(size_t)(hf * 16 + 2 * (ch)) * MTOK], b_ = srow[(size_t)(hf * 16 + 2 * (ch) + 1) * MTOK]; \
                DST[0] = pack_lo<(ch) * 16 + 0>(a_.x); DST[1] = pack_hi<(ch) * 16 + 1>(a_.x); DST[2] = pack_lo<(ch) * 16 + 2>(a_.y); DST[3] = pack_hi<(ch) * 16 + 3>(a_.y); \
                DST[4] = pack_lo<(ch) * 16 + 4>(a_.z); DST[5] = pack_hi<(ch) * 16 + 5>(a_.z); DST[6] = pack_lo<(ch) * 16 + 6>(a_.w); DST[7] = pack_hi<(ch) * 16 + 7>(a_.w); \
                DST[8] = pack_lo<(ch) * 16 + 8>(b_.x); DST[9] = pack_hi<(ch) * 16 + 9>(b_.x); DST[10] = pack_lo<(ch) * 16 + 10>(b_.y); DST[11] = pack_hi<(ch) * 16 + 11>(b_.y); \
                DST[12] = pack_lo<(ch) * 16 + 12>(b_.z); DST[13] = pack_hi<(ch) * 16 + 13>(b_.z); DST[14] = pack_lo<(ch) * 16 + 14>(b_.w); DST[15] = pack_hi<(ch) * 16 + 15>(b_.w); }
            PKC(0, L) sort16_desc(L);
            PKC(1, Bv) sort16_desc(Bv); top16_of_two(L, Bv);
            PKC(2, Bv) sort16_desc(Bv); top16_of_two(L, Bv);
            PKC(3, Bv) sort16_desc(Bv); top16_of_two(L, Bv);
            PKC(4, Bv) sort16_desc(Bv); top16_of_two(L, Bv);
            PKC(5, Bv) sort16_desc(Bv); top16_of_two(L, Bv);
            PKC(6, Bv) sort16_desc(Bv); top16_of_two(L, Bv);
            PKC(7, Bv) sort16_desc(Bv); top16_of_two(L, Bv);
#undef PKC
#pragma unroll
            for (int j = 0; j < 16; ++j) { if (hf == 0) T0[j] = L[j]; else T1[j] = L[j]; }
        }
        float R[16], Bc[16], Cc[16];
#define CAND(i, j) pack8<(i) * 16 + (j)>(T0[i] + T1[j])
#pragma unroll
        for (int j = 0; j < 16; ++j) R[j] = __uint_as_float((__float_as_uint(T0[0] + T1[j]) & 0xFFFFFF00u) | (unsigned)j);
        Bc[0] = CAND(1, 0); Bc[1] = CAND(1, 1); Bc[2] = CAND(1, 2); Bc[3] = CAND(1, 3); Bc[4] = CAND(1, 4); Bc[5] = CAND(1, 5); Bc[6] = CAND(1, 6); Bc[7] = CAND(1, 7);
        Bc[8] = CAND(2, 0); Bc[9] = CAND(2, 1); Bc[10] = CAND(2, 2); Bc[11] = CAND(2, 3); Bc[12] = CAND(2, 4); Bc[13] = CAND(3, 0); Bc[14] = CAND(3, 1); Bc[15] = CAND(3, 2);
        Cc[0] = CAND(3, 3); Cc[1] = CAND(4, 0); Cc[2] = CAND(4, 1); Cc[3] = CAND(4, 2); Cc[4] = CAND(5, 0); Cc[5] = CAND(5, 1); Cc[6] = CAND(6, 0); Cc[7] = CAND(6, 1);
        Cc[8] = CAND(7, 0); Cc[9] = CAND(7, 1); Cc[10] = CAND(8, 0); Cc[11] = CAND(9, 0); Cc[12] = CAND(10, 0); Cc[13] = CAND(11, 0); Cc[14] = CAND(12, 0); Cc[15] = CAND(13, 0);
        sort16_desc(Bc); sort16_desc(Cc); top16_of_two(R, Bc); top16_of_two(R, Cc);
        ins16(R, CAND(14, 0)); ins16(R, CAND(15, 0));
#undef CAND
        {
            LAS unsigned char* idb = lds + wave * 16384 + 8192 + lane * 32;
            u32x4 i0, i1;
#pragma unroll
            for (int w = 0; w < 4; ++w) {
                i0[w] = (__float_as_uint(T0[4 * w]) & 0x7Fu) | ((__float_as_uint(T0[4 * w + 1]) & 0x7Fu) << 8) | ((__float_as_uint(T0[4 * w + 2]) & 0x7Fu) << 16) | ((__float_as_uint(T0[4 * w + 3]) & 0x7Fu) << 24);
                i1[w] = (__float_as_uint(T1[4 * w]) & 0x7Fu) | ((__float_as_uint(T1[4 * w + 1]) & 0x7Fu) << 8) | ((__float_as_uint(T1[4 * w + 2]) & 0x7Fu) << 16) | ((__float_as_uint(T1[4 * w + 3]) & 0x7Fu) << 24); }
            *(LAS u32x4*)idb = i0; *(LAS u32x4*)(idb + 16) = i1;
            float e[16], sum = 0.f;
#pragma unroll
            for (int k = 0; k < 16; ++k) { e[k] = __builtin_amdgcn_exp2f((R[k] - R[0]) * LOG2E); sum += e[k]; }
            const float inv = 1.0f / sum;
            LDS_WAIT(); asm volatile("" ::: "memory");
            unsigned ex[16];
#pragma unroll
            for (int k = 0; k < 16; ++k) { const unsigned code = __float_as_uint(R[k]) & 0xFFu; ex[k] = (unsigned)idb[code >> 4] * 128u + (unsigned)idb[16 + (code & 15u)]; }
            LAS unsigned char* tb = lds + (tkn >> 4) * 16384 + ((tkn & 15) * 128 + h * 16) * 2;
            u32x4 ea, eb, ga, gb;
#pragma unroll
            for (int w = 0; w < 4; ++w) { ea[w] = ex[2 * w] | (ex[2 * w + 1] << 16); eb[w] = ex[8 + 2 * w] | (ex[8 + 2 * w + 1] << 16);
                ga[w] = cvtpk(e[2 * w] * inv, e[2 * w + 1] * inv); gb[w] = cvtpk(e[8 + 2 * w] * inv, e[8 + 2 * w + 1] * inv); }
            *(LAS u32x4*)tb = ea; *(LAS u32x4*)(tb + 16) = eb; *(LAS u32x4*)(tb + 4096) = ga; *(LAS u32x4*)(tb + 4096 + 16) = gb;
        }
    }
    LDS_WAIT();
    __syncthreads();
    }
    LDS_WAIT(); asm volatile("" ::: "memory");
    int lane_b = lane; asm volatile("" : "+v"(lane_b));
    const int g = lane_b >> 3, k = lane_b & 7; const unsigned k16 = (unsigned)k * 16u;
    LAS int* accI = (LAS int*)accL;
#pragma nounroll
    for (int rep7u_ = 0; rep7u_ < REP7U; ++rep7u_) {
    LDS_WAIT(); asm volatile("" ::: "memory");
    for (int i = lane; i < 2048; i += 64) accI[i] = 0;
    LDS_WAIT(); asm volatile("" ::: "memory");
    asm volatile("" : "+s"(tok0));
    const unsigned char* hbase = H8 + (size_t)(tok0 + g) * DM + k * 16;
    u32x4 hn = __builtin_nontemporal_load((const u32x4*)hbase);
    for (int s = 0; s < 16; ++s) {
        const unsigned char* Us = UB + (size_t)s * (PEER_N * 128);
#pragma unroll
        for (int r = 0; r < 2; ++r) {
            const int tl = r * 8 + g;
            const u32x4 hq = hn;
            { const int sn = r ? s + 1 : s, rn = r ^ 1; if (sn < 16) hn = __builtin_nontemporal_load((const u32x4*)(hbase + (size_t)rn * 8 * DM + sn * 128)); }
            const LAS bf16_t* ei = eidx + tl * 128;
            LAS int* ap = accI + tl * 128 + k;
#pragma nounroll
            for (int ib2 = 0; ib2 < 8; ++ib2) {
                u32x4 uv[16];
#pragma unroll
                for (int q = 0; q < 16; ++q) { const unsigned e = ei[ib2 * 16 + q]; uv[q] = *(const u32x4*)(Us + (size_t)(unsigned)((e << 7) + k16)); }
#pragma unroll
                for (int hb = 0; hb < 2; ++hb) {
                    int p[8];
#pragma unroll
                    for (int ii = 0; ii < 8; ++ii) { const u32x4 v = uv[hb * 8 + ii];
                        p[ii] = __builtin_amdgcn_sdot4((int)v.x, (int)hq.x, __builtin_amdgcn_sdot4((int)v.y, (int)hq.y, __builtin_amdgcn_sdot4((int)v.z, (int)hq.z, __builtin_amdgcn_sdot4((int)v.w, (int)hq.w, 0, false), false), false), false); }
                    int a4[4], a2[2];
#pragma unroll
                    for (int j = 0; j < 4; ++j) { const int send = (k & 4) ? p[j] : p[j + 4], keep = (k & 4) ? p[j + 4] : p[j]; a4[j] = keep + dpp_movi<0x141>(send); }
#pragma unroll
                    for (int j = 0; j < 2; ++j) { const int send = (k & 2) ? a4[j] : a4[j + 2], keep = (k & 2) ? a4[j + 2] : a4[j]; a2[j] = keep + dpp_movi<0x1B>(send); }
                    const int send = (k & 1) ? a2[0] : a2[1], keep = (k & 1) ? a2[1] : a2[0];
                    const int tot = keep + dpp_movi<0xB1>(send);
                    __hip_atomic_fetch_add(ap + ib2 * 16 + hb * 8, tot, __ATOMIC_RELAXED, __HIP_MEMORY_SCOPE_WORKGROUP);
                }
            }
        }
    }
    }
    LDS_WAIT(); asm volatile("" ::: "memory");
    LAS bf16_t* wgt = gate;
    for (int i = lane; i < 2048; i += 64) {
        const float a = (float)accI[i] * SU[eidx[i]] * SH[tok0 + (i >> 7)];
        const float ge = 0.5f * a * (1.0f + erff(a * 0.70710678118654752f));
        wgt[i] = (bf16_t)(cvtpk(bf_lo((unsigned)gate[i]) * ge * (1.0f / V_SCALE), 0.f) & 0xffffu);
    }
    LDS_WAIT(); asm volatile("" ::: "memory");
    const float* g2 = mod + (size_t)(tok0 >> 12) * MODW + 5 * DM;
#pragma nounroll
    for (int rep7v_ = 0; rep7v_ < REP7V; ++rep7v_)
    for (int s = 0; s < 16; ++s) {
        const unsigned char* Vs = VB + (size_t)s * (PEER_N * 128);
        f32x4 gvv[4];
#pragma unroll
        for (int q = 0; q < 4; ++q) gvv[q] = *(const f32x4*)(g2 + s * 128 + k * 16 + 4 * q);
#pragma unroll
        for (int r = 0; r < 2; ++r) {
            const int tl = r * 8 + g;
            float* orow = out + (size_t)(tok0 + tl) * DM + s * 128 + k * 16;
            const bf16_t* xrow = X1B + (size_t)(tok0 + tl) * DM + s * 128 + k * 16;
            const u32x4 xb0 = __builtin_nontemporal_load((const u32x4*)xrow), xb1 = __builtin_nontemporal_load((const u32x4*)(xrow + 8));
            const LAS bf16_t* ei = eidx + tl * 128; const LAS bf16_t* wi = wgt + tl * 128;
            float y[16];
#pragma unroll
            for (int i = 0; i < 16; ++i) y[i] = 0.f;
#pragma nounroll
            for (int b = 0; b < 8; ++b) {
                u32x4 vq[16];
#pragma unroll
                for (int q = 0; q < 16; ++q) { const unsigned e = ei[b * 16 + q]; vq[q] = *(const u32x4*)(Vs + (size_t)(unsigned)((e << 7) + k16)); }
#pragma unroll
                for (int q = 0; q < 16; ++q) {
                    const float wf = bf_lo((unsigned)wi[b * 16 + q]); const u32x4 vv = vq[q];
#pragma unroll
                    for (int w = 0; w < 4; ++w) { const f32x2 f01 = __builtin_amdgcn_cvt_pk_f32_fp8(vv[w], false), f23 = __builtin_amdgcn_cvt_pk_f32_fp8(vv[w], true);
                        y[4 * w] = fmaf(wf, f01.x, y[4 * w]); y[4 * w + 1] = fmaf(wf, f01.y, y[4 * w + 1]); y[4 * w + 2] = fmaf(wf, f23.x, y[4 * w + 2]); y[4 * w + 3] = fmaf(wf, f23.y, y[4 * w + 3]); }
                }
            }
#pragma unroll
            for (int q = 0; q < 4; ++q) { f32x4 o; const f32x4 gv = gvv[q];
                const u32x4 xb = q < 2 ? xb0 : xb1; const unsigned xlo = (q & 1) ? xb.z : xb.x, xhi = (q & 1) ? xb.w : xb.y;
                const float x1v[4] = {bf_lo(xlo), bf_hi(xlo), bf_lo(xhi), bf_hi(xhi)};
#pragma unroll
                for (int i = 0; i < 4; ++i) o[i] = x1v[i] + gv[i] * y[4 * q + i];
                if (rep7v_ == REP7V - 1) *(f32x4*)(orow + 4 * q) = o; else asm volatile("" :: "v"(o)); }
        }
    }
}

constexpr int N_PHASES = 8;
struct Args { const float* in[18]; float* out; unsigned char* ws; int ph_lo, ph_hi; };
__global__ void __launch_bounds__(NWAVES * 64, 2) hymba_fwd(Args args) {
    extern __shared__ __attribute__((aligned(16))) unsigned char lds_raw[];
    LAS unsigned char* lds = (LAS unsigned char*)lds_raw;
    volatile LAS unsigned* MISC = (volatile LAS unsigned*)(lds + MISC_OFF);
    const int wave = __builtin_amdgcn_readfirstlane((int)threadIdx.x >> 6);
    const int G = gridDim.x, bx = blockIdx.x;
    const int gw = bx * NWAVES + wave, NGW = G * NWAVES;
#define FRESH_IDS() const int lane = fresh_lane(); const int tid = wave * 64 + lane; (void)tid
    unsigned char* ws = args.ws;
    const float* x = args.in[0]; const float* cvec = args.in[1]; const float* w_ada = args.in[2]; const float* b_ada = args.in[3]; const float* g_norm1 = args.in[4];
    const float* w_in = args.in[5]; const float* g_q = args.in[6]; const float* g_k = args.in[7]; const float* sinks = args.in[8]; const float* conv_w = args.in[9];
    const float* g_oa = args.in[10]; const float* g_oc = args.in[11]; const float* w_out = args.in[12]; const float* g_norm2 = args.in[13]; const float* w_pq = args.in[14];
    const float* subkeys = args.in[15]; const float* peer_u = args.in[16]; const float* peer_v = args.in[17];
    float* out = args.out;
    float* mod = (float*)(ws + WS_MOD); float* rope = (float*)(ws + WS_ROPE);
    bf16_t* SK = (bf16_t*)(ws + WS_SK); bf16_t* WIN = (bf16_t*)(ws + WS_WIN); bf16_t* WOUT = (bf16_t*)(ws + WS_WOUT); bf16_t* WPQ = (bf16_t*)(ws + WS_WPQ);
    unsigned char* UB = ws + WS_UB; unsigned char* VB = ws + WS_VB; unsigned char* H8 = ws + WS_H8; float* SU = (float*)(ws + WS_SU); float* SH = (float*)(ws + WS_SH); bf16_t* XN = (bf16_t*)(ws + WS_XN); bf16_t* PROJ = (bf16_t*)(ws + WS_PROJ);
    bf16_t* QP = (bf16_t*)(ws + WS_QP); bf16_t* X1B = (bf16_t*)(ws + WS_X1B); unsigned char* MIXED = ws + WS_MIXED; unsigned char* XN8 = ws + WS_XN; float* SX1 = (float*)(ws + WS_SX1); bf16_t* W2 = (bf16_t*)(ws + WS_XN + 64 * MiB);
    unsigned* ctl = (unsigned*)(ws + WS_CTL);

    { FRESH_IDS(); for (int u = tid; u < (LDS_BYTES - LDSCTL_OFF) / 4; u += NWAVES * 64) ((LAS unsigned*)(lds + LDSCTL_OFF))[u] = 0u; }
    __syncthreads();
    XcdBarrier bar; bar.bar = ctl + CW_BAR; bar.x = 0; bar.st = nullptr; bar.wave = wave;
    if (MK_N_LAUNCHES == 1) bar = xcd_barrier_post(ctl + CW_BAR, MISC + 8, wave);
    const int lo = args.ph_lo, hi = args.ph_hi;
#define IN(k) (lo <= (k) && (k) < hi)
#define SEAM(k) do { if (IN(k) && IN((k) + 1)) xcd_barrier(bar); } while (0)

#pragma nounroll
    for (int rep_ = 0; rep_ < REP0; ++rep_) { if (rep_) xcd_barrier(bar);
    if (IN(0)) { FRESH_IDS();
#pragma nounroll
        for (int ra_ = 0; ra_ < REP0A; ++ra_)
        for (int it = bx; it < MODW / 64; it += G) p0_ada_item(cvec, w_ada, b_ada, mod, lds, it, tid, wave, lane);
        LAS float* scr = (LAS float*)(lds + wave * 16384);
        constexpr int I_IN = (DM / 64) * (INC / 32), I_SQ = (DM / 64) * (DM / 32), I_TAB = PEER_N * DM / 2048, I_W2 = 512, I_ROPE = 512;
        (void)scr;
        { const int nfree = G > MODW / 64 ? (G - MODW / 64) * NWAVES : 0;
          if (nfree > 0) { if (bx >= MODW / 64) for (int r = (bx - MODW / 64) * NWAVES + wave; r < I_W2; r += nfree) p0_w2_item(w_pq, subkeys, W2, ctl + CW_CMX_PQ, r, lane); }
          else for (int r = gw; r < I_W2; r += NGW) p0_w2_item(w_pq, subkeys, W2, ctl + CW_CMX_PQ, r, lane); }
#pragma nounroll
        for (int rc_ = 0; rc_ < REP0C; ++rc_)
        for (int r = gw; r < I_IN + I_SQ; r += NGW) { if (r < I_IN) p0_colmax_item(w_in, INC, ctl + CW_CMX_IN, r, lane); else p0_colmax_item(w_out, DM, ctl + CW_CMX_OUT, r - I_IN, lane); }
        for (int r = gw; r < I_ROPE; r += NGW) p0_rope_item(rope, r, lane);
        if (G == 256) {   }
        else if (NGW * 8 == I_TAB) p0_tables8(peer_u, peer_v, UB, SU, VB, gw, NGW, lane);
        else for (int r = gw; r < 2 * I_TAB; r += NGW) { if (r < I_TAB) p0_i8_row(peer_u, UB, SU, r, lane); else p0_fp8_item(peer_v, VB, (size_t)(r - I_TAB) * 2048, V_SCALE, lane); }
    }
    }
    SEAM(0);
#pragma nounroll
    for (int rep_ = 0; rep_ < REP1; ++rep_) { if (rep_) xcd_barrier(bar);
    if (IN(1)) { FRESH_IDS(); norm_rows(x, g_norm1, mod, 0 * DM, 1 * DM, XN8, SX1, gw, NGW, lane);
        LAS float* scr = (LAS float*)(lds + wave * 16384);
        constexpr int I_IN = (DM / 64) * (INC / 32), I_SQ = (DM / 64) * (DM / 32);
        for (int it = gw; it < I_IN + I_SQ + DM; it += NGW) {
            int r = it;
            if (r < I_IN) { p1_transpose_i8_item<true>(w_in, DM, INC, (unsigned char*)WIN, ctl + CW_CMX_IN, scr, r, lane); continue; } r -= I_IN;
            if (r < I_SQ) { p1_transpose_i8_item<false>(w_out, DM, DM, (unsigned char*)WOUT, ctl + CW_CMX_OUT, scr, r, lane); continue; } r -= I_SQ;
            p1_w2_row(W2, (unsigned char*)WPQ, ctl + CW_CMX_PQ, r, lane);
        }
    }
    }
    SEAM(1);
#if REP2 > 1
    if (IN(2)) {
        pg8::Gemm g{(const bf16_t*)XN8, (const bf16_t*)WIN, MTOK, INC, DM / 2}; pg8::StaticOrder S; S.init(MTOK, INC, G, bx);
        pg8::EpiProjI8 E{PROJ, INC, SX1, ctl + CW_CMX_IN};
        pg8::gemm_phase<pg8::EpiProjI8, pg8::StaticOrder, true, true, true>(lds, g, S, E, wave);
    }
    xcd_barrier(bar);
#endif
    if (IN(2)) {
        pg8::Gemm g{(const bf16_t*)XN8, (const bf16_t*)WIN, MTOK, INC, DM / 2}; pg8::StaticOrder S; S.init(MTOK, INC, G, bx);
        pg8::EpiProjI8 E{PROJ, INC, SX1, ctl + CW_CMX_IN};
        pg8::gemm_phase<pg8::EpiProjI8, pg8::StaticOrder, true, true, true>(lds, g, S, E, wave);
    }
    SEAM(2);
#pragma nounroll
    for (int rep_ = 0; rep_ < REP3; ++rep_) { if (rep_) xcd_barrier(bar);
    if (IN(3)) { FRESH_IDS();
#ifndef REP3A
#define REP3A 1
#endif
#pragma nounroll
        for (int ra_ = 0; ra_ < REP3A; ++ra_)
        { f32x4 tcur[8], tnx[8];
          if (G != 256) {
              const TabCtx T{peer_u, UB, SU, 0};
              for (int u = bx; u < BATCH * 4 * 32; u += G) attn_unit<false, false>(u >> 7, (u >> 5) & 3, u & 31, PROJ, g_q, g_k, sinks, g_oa, rope, MIXED, lds, tid, wave, lane, T, 0, tcur, tnx);
          } else if (wave & 1) {
              const TabCtx T{peer_v, VB, SU, gw >> 1};
              tab_row_load(T, 0, tnx, lane);
              int ui = 0;
              for (int u = bx; u < BATCH * 4 * 32; u += G, ++ui) attn_unit<true, true>(u >> 7, (u >> 5) & 3, u & 31, PROJ, g_q, g_k, sinks, g_oa, rope, MIXED, lds, tid, wave, lane, T, ui * 4, tcur, tnx);
          } else {
              const TabCtx T{peer_u, UB, SU, gw >> 1};
              tab_row_load(T, 0, tnx, lane);
              int ui = 0;
              for (int u = bx; u < BATCH * 4 * 32; u += G, ++ui) attn_unit<true, false>(u >> 7, (u >> 5) & 3, u & 31, PROJ, g_q, g_k, sinks, g_oa, rope, MIXED, lds, tid, wave, lane, T, ui * 4, tcur, tnx);
          } }
        for (int it = gw; it < MTOK / 16; it += NGW) conv_item(it, PROJ, conv_w, g_oc, MIXED, lane);
    }
    }
    SEAM(3);
#if REP4 > 1
    if (IN(4)) {
        pg8::Gemm g{(const bf16_t*)MIXED, (const bf16_t*)WOUT, MTOK, DM, DM / 2}; pg8::StaticOrder S; S.init(MTOK, DM, G, bx);
        pg8::EpiResGateBf16I8 E{x, X1B, DM, mod + 2 * DM, MODW, 1.0f / MIX_SCALE, ctl + CW_CMX_OUT};
        pg8::gemm_phase<pg8::EpiResGateBf16I8, pg8::StaticOrder, true, true, true>(lds, g, S, E, wave);
    }
    xcd_barrier(bar);
#endif
    if (IN(4)) {
        pg8::Gemm g{(const bf16_t*)MIXED, (const bf16_t*)WOUT, MTOK, DM, DM / 2}; pg8::StaticOrder S; S.init(MTOK, DM, G, bx);
        pg8::EpiResGateBf16I8 E{x, X1B, DM, mod + 2 * DM, MODW, 1.0f / MIX_SCALE, ctl + CW_CMX_OUT};
        pg8::gemm_phase<pg8::EpiResGateBf16I8, pg8::StaticOrder, true, true, true>(lds, g, S, E, wave);
    }
    SEAM(4);
#pragma nounroll
    for (int rep_ = 0; rep_ < REP5; ++rep_) { if (rep_) xcd_barrier(bar);
    if (IN(5)) { FRESH_IDS(); norm_rows_bf16(X1B, g_norm2, mod, 3 * DM, 4 * DM, H8, SH, gw, NGW, lane); }
    }
    SEAM(5);
#if REP6 > 1
    if (IN(6)) {
        pg8::Gemm g{(const bf16_t*)H8, (const bf16_t*)WPQ, MTOK, DM, DM / 2}; pg8::StaticOrder S; S.init(MTOK, DM, G, bx);
        pg8::EpiScoresI8 E{QP, MTOK, SH, ctl + CW_CMX_PQ};
        pg8::gemm_phase<pg8::EpiScoresI8, pg8::StaticOrder, true, true, true>(lds, g, S, E, wave);
    }
    xcd_barrier(bar);
#endif
    if (IN(6)) {
        pg8::Gemm g{(const bf16_t*)H8, (const bf16_t*)WPQ, MTOK, DM, DM / 2}; pg8::StaticOrder S; S.init(MTOK, DM, G, bx);
        pg8::EpiScoresI8 E{QP, MTOK, SH, ctl + CW_CMX_PQ};
        pg8::gemm_phase<pg8::EpiScoresI8, pg8::StaticOrder, true, true, true>(lds, g, S, E, wave);
    }
    SEAM(6);
    if (IN(7)) { FRESH_IDS();
        for (int chunk = bx; chunk < MTOK / 128; chunk += G) peer_chunk(chunk * 128, QP, SK, H8, SH, UB, SU, VB, mod, X1B, out, lds, tid, wave, lane);
    }
#undef IN
#undef SEAM
}

extern "C" void kernel_launch(void* const* d_in, const int* in_sizes, int n_in, void* d_out, int out_size, void* d_ws, size_t ws_size, hipStream_t stream) {
    static int grid = 0;
    if (grid == 0) {
        if (n_in != 18 || in_sizes[0] != MTOK * DM || out_size != MTOK * DM || ws_size < WS_END) { fprintf(stderr, "kernel_launch: unexpected shapes (n_in %d, in0 %d, out %d, ws %zu)\n", n_in, n_in > 0 ? in_sizes[0] : -1, out_size, ws_size); grid = -1; return; }
        int dev = 0, cus = 0, per_cu = 0;
        if (hipGetDevice(&dev) != hipSuccess || hipDeviceGetAttribute(&cus, hipDeviceAttributeMultiprocessorCount, dev) != hipSuccess) { grid = -1; return; }
        if (hipFuncSetAttribute((const void*)hymba_fwd, hipFuncAttributeMaxDynamicSharedMemorySize, LDS_BYTES) != hipSuccess) { fprintf(stderr, "kernel_launch: hipFuncSetAttribute failed\n"); grid = -1; return; }
        if (hipOccupancyMaxActiveBlocksPerMultiprocessor(&per_cu, (const void*)hymba_fwd, NWAVES * 64, LDS_BYTES) != hipSuccess || per_cu < 1) { fprintf(stderr, "kernel_launch: occupancy query says %d blocks per CU\n", per_cu); per_cu = 1; }
        (void)hipGetLastError();
        grid = cus;
    }
    if (grid < 0) return;
    (void)hipMemsetAsync((char*)d_ws + WS_CTL, 0, CTL_ZERO_BYTES, stream);
    Args a{};
    for (int i = 0; i < 18; ++i) a.in[i] = (const float*)d_in[i];
    a.out = (float*)d_out; a.ws = (unsigned char*)d_ws;
    if (MK_N_LAUNCHES == 1) {
        a.ph_lo = 0; a.ph_hi = N_PHASES;
        hipLaunchKernelGGL(hymba_fwd, dim3(grid), dim3(NWAVES * 64), LDS_BYTES, stream, a);
    } else {
        for (int p = 0; p < N_PHASES; ++p) { a.ph_lo = p; a.ph_hi = p + 1; hipLaunchKernelGGL(hymba_fwd, dim3(grid), dim3(NWAVES * 64), LDS_BYTES, stream, a); }
    }
}
```

```cpp
#include <hip/hip_runtime.h>
#include <cstdio>
#include <cstdint>

#ifndef MK_N_LAUNCHES
#define MK_N_LAUNCHES 1
#endif

#ifndef REP0
#define REP0 1
#endif
#ifndef REP0A
#define REP0A 1
#endif
#ifndef REP0C
#define REP0C 1
#endif
#ifndef REP1
#define REP1 1
#endif
#ifndef REP2
#define REP2 1
#endif
#ifndef REP3
#define REP3 1
#endif
#ifndef REP4
#define REP4 1
#endif
#ifndef REP5
#define REP5 1
#endif
#ifndef REP6
#define REP6 1
#endif
#ifndef REP7A
#define REP7A 1
#endif
#ifndef REP7U
#define REP7U 1
#endif
#ifndef REPSEL
#define REPSEL 1
#endif
#ifndef REP7V
#define REP7V 1
#endif
#ifndef REPSC
#define REPSC 1
#endif

#define LAS __attribute__((address_space(3)))
#define GAS __attribute__((address_space(1)))
typedef unsigned short bf16_t;
typedef short bf16x8 __attribute__((ext_vector_type(8)));
typedef short s16x4 __attribute__((ext_vector_type(4)));
typedef float f32x4 __attribute__((ext_vector_type(4)));
typedef float f32x2 __attribute__((ext_vector_type(2)));
typedef unsigned u32x4 __attribute__((ext_vector_type(4)));
typedef unsigned u32x2 __attribute__((ext_vector_type(2)));
typedef int i32x4 __attribute__((ext_vector_type(4)));
typedef __bf16 bf16x2_t __attribute__((ext_vector_type(2)));

constexpr int DM = 2048, BATCH = 8, SEQ = 4096, MTOK = BATCH * SEQ;
constexpr int INC = 4608;
constexpr int COL_K = 1024, COL_V = 1280, COL_B = 1536, COL_C = 2560, COL_H = 3584;
constexpr int MODW = 6 * DM;
constexpr int PEER_N = 16384;
constexpr float EPS = 1e-6f;
constexpr float LOG2E = 1.4426950408889634f;
constexpr float MIX_SCALE = 127.0f / 6.0f;
constexpr float V_SCALE = 16.0f;

constexpr size_t MiB = 1u << 20;
constexpr size_t WS_CTL = 0, CTL_ZERO_BYTES = 1 * MiB;
constexpr size_t WS_MOD = 1 * MiB;
constexpr size_t WS_ROPE = 1 * MiB + 512 * 1024;
constexpr size_t WS_SK = 2 * MiB;
constexpr size_t WS_WIN = 4 * MiB;
constexpr size_t WS_WOUT = 22 * MiB;
constexpr size_t WS_WPQ = 30 * MiB;
constexpr size_t WS_SU = 3 * MiB;
constexpr size_t WS_SH = 3 * MiB + 256 * 1024;
constexpr size_t WS_SX1 = 3 * MiB + 512 * 1024;
constexpr size_t WS_UB = 40 * MiB;
constexpr size_t WS_VB = 104 * MiB;
constexpr size_t WS_XN = 168 * MiB;
constexpr size_t WS_PROJ = 296 * MiB;
constexpr size_t WS_QP = WS_PROJ;
constexpr size_t WS_X1B = WS_PROJ + 128 * MiB;
constexpr size_t WS_MIXED = 584 * MiB;
constexpr size_t WS_H8 = 712 * MiB;
constexpr size_t WS_END = 776 * MiB;
constexpr int CW_BAR = 4096;
constexpr int CW_CMX_IN = 32768, CW_CMX_OUT = CW_CMX_IN + 4608, CW_CMX_PQ = CW_CMX_OUT + 2048;

constexpr int RING_BYTES = 131072;
constexpr int LDSCTL_OFF = RING_BYTES, MISC_OFF = LDSCTL_OFF + 320;
constexpr int LDS_BYTES = 148480;
constexpr int NWAVES = 8;

#define LDS_WAIT() asm volatile("s_waitcnt lgkmcnt(0)" ::: "memory")
#define VM_WAIT() asm volatile("s_waitcnt vmcnt(0)" ::: "memory")

__device__ __forceinline__ unsigned cvtpk(float lo, float hi) { f32x2 v = {lo, hi}; bf16x2_t b = __builtin_convertvector(v, bf16x2_t); return __builtin_bit_cast(unsigned, b); }
__device__ __forceinline__ float bf_lo(unsigned u) { return __uint_as_float(u << 16); }
__device__ __forceinline__ float bf_hi(unsigned u) { return __uint_as_float(u & 0xffff0000u); }
__device__ __forceinline__ float dot2bf(unsigned a, unsigned b, float c) { return __builtin_amdgcn_fdot2_f32_bf16(__builtin_bit_cast(bf16x2_t, a), __builtin_bit_cast(bf16x2_t, b), c, false); }
__device__ __forceinline__ int fresh_lane() { int l = (int)__builtin_amdgcn_mbcnt_hi(~0u, __builtin_amdgcn_mbcnt_lo(~0u, 0u)); asm volatile("" : "+v"(l)); return l; }
__device__ __forceinline__ float xrow_sum(float v) {
    const u32x2 a = __builtin_amdgcn_permlane16_swap(__float_as_uint(v), __float_as_uint(v), false, false); v = __uint_as_float(a.x) + __uint_as_float(a.y);
    const u32x2 b = __builtin_amdgcn_permlane32_swap(__float_as_uint(v), __float_as_uint(v), false, false); return __uint_as_float(b.x) + __uint_as_float(b.y);
}
__device__ __forceinline__ float xrow_max(float v) {
    const u32x2 a = __builtin_amdgcn_permlane16_swap(__float_as_uint(v), __float_as_uint(v), false, false); v = fmaxf(__uint_as_float(a.x), __uint_as_float(a.y));
    const u32x2 b = __builtin_amdgcn_permlane32_swap(__float_as_uint(v), __float_as_uint(v), false, false); return fmaxf(__uint_as_float(b.x), __uint_as_float(b.y));
}
__device__ __forceinline__ float xrow16_other(float v, bool odd_row) {
    const u32x2 a = __builtin_amdgcn_permlane16_swap(__float_as_uint(v), __float_as_uint(v), false, false); return __uint_as_float(odd_row ? a.x : a.y);
}

template <int CTRL> __device__ __forceinline__ float dpp_add(float v) { return v + __int_as_float(__builtin_amdgcn_update_dpp(0, __float_as_int(v), CTRL, 0xF, 0xF, false)); }
template <int CTRL> __device__ __forceinline__ float dpp_mov(float v) { return __int_as_float(__builtin_amdgcn_update_dpp(0, __float_as_int(v), CTRL, 0xF, 0xF, true)); }
__device__ __forceinline__ float allred8(float v) { v = dpp_add<0x141>(v); v = dpp_add<0x1B>(v); v = dpp_add<0xB1>(v); return v; }

template <int CTRL> __device__ __forceinline__ float dpp_max(float v) { return fmaxf(v, __int_as_float(__builtin_amdgcn_update_dpp(0, __float_as_int(v), CTRL, 0xF, 0xF, false))); }
__device__ __forceinline__ float wave_sum(float v) { v = dpp_add<0xB1>(v); v = dpp_add<0x4E>(v); v = dpp_add<0x141>(v); v = dpp_add<0x140>(v); return xrow_sum(v); }
__device__ __forceinline__ float wave_max(float v) { v = dpp_max<0xB1>(v); v = dpp_max<0x4E>(v); v = dpp_max<0x141>(v); v = dpp_max<0x140>(v); return xrow_max(v); }
__device__ __forceinline__ unsigned pack_i8x4_sat(f32x4 x, float inv) {
    const int a = (int)rintf(fminf(fmaxf(x[0] * inv, -127.f), 127.f)), b = (int)rintf(fminf(fmaxf(x[1] * inv, -127.f), 127.f)), c = (int)rintf(fminf(fmaxf(x[2] * inv, -127.f), 127.f)), d = (int)rintf(fminf(fmaxf(x[3] * inv, -127.f), 127.f));
    return ((unsigned)a & 0xffu) | (((unsigned)b & 0xffu) << 8) | (((unsigned)c & 0xffu) << 16) | ((unsigned)d << 24);
}
__device__ __forceinline__ unsigned pack_i8x4(f32x4 x, float inv) {
    const int a = (int)rintf(x[0] * inv), b = (int)rintf(x[1] * inv), c = (int)rintf(x[2] * inv), d = (int)rintf(x[3] * inv);
    return ((unsigned)a & 0xffu) | (((unsigned)b & 0xffu) << 8) | (((unsigned)c & 0xffu) << 16) | ((unsigned)d << 24);
}
template <int CTRL> __device__ __forceinline__ int dpp_movi(int v) { return __builtin_amdgcn_update_dpp(0, v, CTRL, 0xF, 0xF, true); }

namespace pg8 {
#define PG8_LAS __attribute__((address_space(3)))
constexpr int BM = 256, BK = 64, HALF = 128, HTB = HALF * BK * 2, STAGE_BYTES = 8 * HTB, NXCD = 8, WGM = 4;
__host__ __device__ __forceinline__ int lds_byte(int r, int c) { const int st = (r >> 4) * 2 + (c >> 5), rr = r & 15, cc = c & 31, ob = rr * 64 + cc * 2; return st * 1024 + (ob ^ (((ob >> 9) & 1) << 5)); }
__host__ __device__ __forceinline__ void stage_rc(int b, int& R, int& C) { const int st = b / 1024, sb = b % 1024, swz = sb ^ (((sb >> 9) & 1) << 5); R = (st >> 1) * 16 + swz / 64; C = (st & 1) * 32 + (swz % 64) / 2; }
__host__ __device__ __forceinline__ int perm32(int rho) { const int n = rho >> 4, i = rho & 15; return 8 * (i >> 2) + 4 * n + (i & 3); }
struct Unit { int pm, pn; };
struct Gemm { const bf16_t* A; const bf16_t* Bt; int M, N, K; };
struct StaticOrder {
    int nM, nN, nwg, G, c;
    __host__ __device__ void init(int M, int N, int G_, int c_) { nM = M / BM; nN = N / BM; nwg = nM * nN; G = G_; c = c_; }
    __host__ __device__ bool next(int i, Unit& u) const {
        const long L = (long)i * G + c; if (L >= nwg) return false;
        int wgid = (int)L; { const int q = nwg / NXCD, r = nwg % NXCD, xcd = wgid % NXCD, off = wgid / NXCD; wgid = (xcd < r ? xcd * (q + 1) : r * (q + 1) + (xcd - r) * q) + off; }
        const int nig = WGM * nN, gid = wgid / nig, fm = gid * WGM, gsz = (nM - fm) < WGM ? (nM - fm) : WGM;
        u.pm = fm + ((wgid % nig) % gsz); u.pn = (wgid % nig) / gsz; return true;
    }
    __device__ __forceinline__ void a_ready(const Unit&) const {}
    __device__ __forceinline__ void done(const Unit&) const {}
};
__device__ __forceinline__ unsigned cvt_pk_bf16(float lo, float hi) { unsigned r; asm volatile("v_cvt_pk_bf16_f32 %0, %1, %2" : "=v"(r) : "v"(lo), "v"(hi)); return r; }

struct EpiBf16 {
    static constexpr bool PERM = true, AFTER_DRAIN = false;
    bf16_t* O; int ldc;
    __device__ __forceinline__ void operator()(const f32x4 (&acc)[2][2][4][2], const Unit& u, int wr, int wc, int fr, int fq) const {
        const int row0 = u.pm * BM + wr * 64 + fr, col0 = u.pn * BM + wc * 32 + 8 * fq;
#pragma unroll
        for (int ai = 0; ai < 2; ++ai)
#pragma unroll
            for (int m = 0; m < 4; ++m) { bf16_t* rowp = O + (size_t)(row0 + ai * HALF + m * 16) * ldc + col0;
#pragma unroll
                for (int bj = 0; bj < 2; ++bj) { const f32x4 v0 = acc[ai][bj][m][0], v1 = acc[ai][bj][m][1];
                    u32x4 w; w.x = cvt_pk_bf16(v0[0], v0[1]); w.y = cvt_pk_bf16(v0[2], v0[3]); w.z = cvt_pk_bf16(v1[0], v1[1]); w.w = cvt_pk_bf16(v1[2], v1[3]);
                    *(u32x4*)(rowp + bj * HALF) = w; } }
    }
};
struct EpiBf16I8 {
    static constexpr bool PERM = true, AFTER_DRAIN = false;
    bf16_t* O; int ldc; const float* srow; const unsigned* cmax;
    __device__ __forceinline__ void operator()(const f32x4 (&acc)[2][2][4][2], const Unit& u, int wr, int wc, int fr, int fq) const {
        const int row0 = u.pm * BM + wr * 64 + fr, col0 = u.pn * BM + wc * 32 + 8 * fq;
        f32x4 sc[2][2];
#pragma unroll
        for (int bj = 0; bj < 2; ++bj)
#pragma unroll
            for (int n = 0; n < 2; ++n) { const u32x4 b = *(const u32x4*)(cmax + col0 + bj * HALF + 4 * n);
#pragma unroll
                for (int i = 0; i < 4; ++i) sc[bj][n][i] = __uint_as_float(b[i]) * (1.0f / 127.0f); }
        float srv[2][4];
#pragma unroll
        for (int ai = 0; ai < 2; ++ai)
#pragma unroll
            for (int m = 0; m < 4; ++m) srv[ai][m] = srow[row0 + ai * HALF + m * 16];
#pragma unroll
        for (int ai = 0; ai < 2; ++ai)
#pragma unroll
            for (int m = 0; m < 4; ++m) { const int row = row0 + ai * HALF + m * 16; const float sr = srv[ai][m]; bf16_t* rowp = O + (size_t)row * ldc + col0;
#pragma unroll
                for (int bj = 0; bj < 2; ++bj) { const i32x4 a0 = __builtin_bit_cast(i32x4, acc[ai][bj][m][0]), a1 = __builtin_bit_cast(i32x4, acc[ai][bj][m][1]);
                    f32x4 v0, v1;
#pragma unroll
                    for (int i = 0; i < 4; ++i) { v0[i] = (float)a0[i] * sr * sc[bj][0][i]; v1[i] = (float)a1[i] * sr * sc[bj][1][i]; }
                    u32x4 w; w.x = cvt_pk_bf16(v0[0], v0[1]); w.y = cvt_pk_bf16(v0[2], v0[3]); w.z = cvt_pk_bf16(v1[0], v1[1]); w.w = cvt_pk_bf16(v1[2], v1[3]);
                    *(u32x4*)(rowp + bj * HALF) = w; } }
    }
};
struct EpiScoresI8 {
    static constexpr bool PERM = true, AFTER_DRAIN = false;
    bf16_t* O; int M; const float* srow; const unsigned* cmax;
    __device__ __forceinline__ void operator()(const f32x4 (&acc)[2][2][4][2], const Unit& u, int wr, int wc, int fr, int fq) const {
        const int row0 = u.pm * BM + wr * 64 + fr, col0 = u.pn * BM + wc * 32 + 8 * fq;
        f32x4 sc[2][2];
#pragma unroll
        for (int bj = 0; bj < 2; ++bj)
#pragma unroll
            for (int n = 0; n < 2; ++n) { const u32x4 b = *(const u32x4*)(cmax + col0 + bj * HALF + 4 * n);
#pragma unroll
                for (int i = 0; i < 4; ++i) sc[bj][n][i] = __uint_as_float(b[i]) * (1.0f / 127.0f); }
        float srv[2][4];
#pragma unroll
        for (int ai = 0; ai < 2; ++ai)
#pragma unroll
            for (int m = 0; m < 4; ++m) srv[ai][m] = srow[row0 + ai * HALF + m * 16];
#pragma unroll
        for (int ai = 0; ai < 2; ++ai)
#pragma unroll
            for (int m = 0; m < 4; ++m) { const int row = row0 + ai * HALF + m * 16; const float sr = srv[ai][m];
#pragma unroll
                for (int bj = 0; bj < 2; ++bj) { const i32x4 a0 = __builtin_bit_cast(i32x4, acc[ai][bj][m][0]), a1 = __builtin_bit_cast(i32x4, acc[ai][bj][m][1]);
                    f32x4 v0, v1;
#pragma unroll
                    for (int i = 0; i < 4; ++i) { v0[i] = (float)a0[i] * sr * sc[bj][0][i]; v1[i] = (float)a1[i] * sr * sc[bj][1][i]; }
                    u32x4 w; w.x = cvt_pk_bf16(v0[0], v0[1]); w.y = cvt_pk_bf16(v0[2], v0[3]); w.z = cvt_pk_bf16(v1[0], v1[1]); w.w = cvt_pk_bf16(v1[2], v1[3]);
                    *(u32x4*)(O + ((size_t)(u.pn * 32 + bj * 16 + wc * 4 + fq) * M + row) * 8) = w; } }
    }
};
struct EpiProjI8 {
    static constexpr bool PERM = true, AFTER_DRAIN = false;
    bf16_t* O; int ldc; const float* srow; const unsigned* cmax;
    __device__ __forceinline__ void operator()(const f32x4 (&acc)[2][2][4][2], const Unit& u, int wr, int wc, int fr, int fq) const {
        const int row0 = u.pm * BM + wr * 64 + fr;
        const bool prod = u.pn >= 10;
        const int col0 = prod ? 2560 + (u.pn - 10) * 128 + wc * 32 + 8 * fq : u.pn * BM + wc * 32 + 8 * fq;
        const int sc0 = col0, sc1 = prod ? col0 + 1024 : col0 + HALF;
        f32x4 sc[2][2];
#pragma unroll
        for (int n = 0; n < 2; ++n) { const u32x4 b0 = *(const u32x4*)(cmax + sc0 + 4 * n), b1 = *(const u32x4*)(cmax + sc1 + 4 * n);
#pragma unroll
            for (int i = 0; i < 4; ++i) { sc[0][n][i] = __uint_as_float(b0[i]) * (1.0f / 127.0f); sc[1][n][i] = __uint_as_float(b1[i]) * (1.0f / 127.0f); } }
        float srv[2][4];
#pragma unroll
        for (int ai = 0; ai < 2; ++ai)
#pragma unroll
            for (int m = 0; m < 4; ++m) srv[ai][m] = srow[row0 + ai * HALF + m * 16];
#pragma unroll
        for (int ai = 0; ai < 2; ++ai)
#pragma unroll
            for (int m = 0; m < 4; ++m) { const float sr = srv[ai][m]; bf16_t* rowp = O + (size_t)(row0 + ai * HALF + m * 16) * ldc + col0;
                f32x4 v[2][2];
#pragma unroll
                for (int bj = 0; bj < 2; ++bj) { const i32x4 a0 = __builtin_bit_cast(i32x4, acc[ai][bj][m][0]), a1 = __builtin_bit_cast(i32x4, acc[ai][bj][m][1]);
#pragma unroll
                    for (int i = 0; i < 4; ++i) { v[bj][0][i] = (float)a0[i] * sr * sc[bj][0][i]; v[bj][1][i] = (float)a1[i] * sr * sc[bj][1][i]; } }
                if (prod) { const f32x4 p0 = v[0][0] * v[1][0], p1 = v[0][1] * v[1][1];
                    u32x4 w; w.x = cvt_pk_bf16(p0[0], p0[1]); w.y = cvt_pk_bf16(p0[2], p0[3]); w.z = cvt_pk_bf16(p1[0], p1[1]); w.w = cvt_pk_bf16(p1[2], p1[3]);
                    *(u32x4*)rowp = w;
                } else {
#pragma unroll
                    for (int bj = 0; bj < 2; ++bj) { u32x4 w; w.x = cvt_pk_bf16(v[bj][0][0], v[bj][0][1]); w.y = cvt_pk_bf16(v[bj][0][2], v[bj][0][3]); w.z = cvt_pk_bf16(v[bj][1][0], v[bj][1][1]); w.w = cvt_pk_bf16(v[bj][1][2], v[bj][1][3]);
                        *(u32x4*)(rowp + bj * HALF) = w; } }
            }
    }
};
struct EpiResGateI8 {
    static constexpr bool PERM = false, AFTER_DRAIN = false;
    const float* base; float* out; int ldc; const float* gate; int gate_stride; float srow_const; const unsigned* cmax;
    __device__ __forceinline__ void operator()(const f32x4 (&acc)[2][2][4][2], const Unit& u, int wr, int wc, int fr, int fq) const {
        const int row0 = u.pm * BM + wr * 64 + fr, col0 = u.pn * BM + wc * 32 + 4 * fq;
        const float* g = gate + (size_t)((u.pm * BM) >> 12) * gate_stride + col0;
        f32x4 gv[2][2];
#pragma unroll
        for (int bj = 0; bj < 2; ++bj)
#pragma unroll
            for (int n = 0; n < 2; ++n) { const f32x4 gg = *(const f32x4*)(g + bj * HALF + n * 16); const u32x4 b = *(const u32x4*)(cmax + col0 + bj * HALF + n * 16);
#pragma unroll
                for (int i = 0; i < 4; ++i) gv[bj][n][i] = gg[i] * __uint_as_float(b[i]) * (srow_const * (1.0f / 127.0f)); }
#pragma unroll
        for (int g2 = 0; g2 < 4; ++g2) {
            const int ai = g2 >> 1, m0 = (g2 & 1) * 2;
            f32x4 bs[2][2][2];
#pragma unroll
            for (int mm = 0; mm < 2; ++mm)
#pragma unroll
                for (int bj = 0; bj < 2; ++bj)
#pragma unroll
                    for (int n = 0; n < 2; ++n) bs[mm][bj][n] = *(const f32x4*)(base + (size_t)(row0 + ai * HALF + (m0 + mm) * 16) * ldc + col0 + bj * HALF + n * 16);
            asm volatile("" ::: "memory");
#pragma unroll
            for (int mm = 0; mm < 2; ++mm) { const size_t off = (size_t)(row0 + ai * HALF + (m0 + mm) * 16) * ldc + col0;
#pragma unroll
                for (int bj = 0; bj < 2; ++bj)
#pragma unroll
                    for (int n = 0; n < 2; ++n) { const i32x4 a = __builtin_bit_cast(i32x4, acc[ai][bj][m0 + mm][n]);
                        f32x4 o;
#pragma unroll
                        for (int i = 0; i < 4; ++i) o[i] = bs[mm][bj][n][i] + gv[bj][n][i] * (float)a[i];
                        *(f32x4*)(out + off + bj * HALF + n * 16) = o; } }
            asm volatile("" ::: "memory");
        }
    }
};
struct EpiResGateBf16I8 {
    static constexpr bool PERM = true, AFTER_DRAIN = false;
    const float* base; bf16_t* O; int ldc; const float* gate; int gate_stride; float srow_const; const unsigned* cmax;
    __device__ __forceinline__ void operator()(const f32x4 (&acc)[2][2][4][2], const Unit& u, int wr, int wc, int fr, int fq) const {
        const int row0 = u.pm * BM + wr * 64 + fr, col0 = u.pn * BM + wc * 32 + 8 * fq;
        const float* g = gate + (size_t)((u.pm * BM) >> 12) * gate_stride + col0;
        f32x4 gv[2][2];
#pragma unroll
        for (int bj = 0; bj < 2; ++bj)
#pragma unroll
            for (int n = 0; n < 2; ++n) { const f32x4 gg = *(const f32x4*)(g + bj * HALF + 4 * n); const u32x4 b = *(const u32x4*)(cmax + col0 + bj * HALF + 4 * n);
#pragma unroll
                for (int i = 0; i < 4; ++i) gv[bj][n][i] = gg[i] * __uint_as_float(b[i]) * (srow_const * (1.0f / 127.0f)); }
#pragma unroll
        for (int g2 = 0; g2 < 2; ++g2) {
            const int ai = g2, m0 = 0;
            f32x4 bs[4][2][2];
#pragma unroll
            for (int mm = 0; mm < 4; ++mm)
#pragma unroll
                for (int bj = 0; bj < 2; ++bj)
#pragma unroll
                    for (int n = 0; n < 2; ++n) bs[mm][bj][n] = __builtin_nontemporal_load((const f32x4*)(base + (size_t)(row0 + ai * HALF + (m0 + mm) * 16) * ldc + col0 + bj * HALF + 4 * n));
            asm volatile("" ::: "memory");
#pragma unroll
            for (int mm = 0; mm < 4; ++mm) { bf16_t* rowp = O + (size_t)(row0 + ai * HALF + (m0 + mm) * 16) * ldc + col0;
#pragma unroll
                for (int bj = 0; bj < 2; ++bj) { const i32x4 a0 = __builtin_bit_cast(i32x4, acc[ai][bj][m0 + mm][0]), a1 = __builtin_bit_cast(i32x4, acc[ai][bj][m0 + mm][1]);
                    f32x4 v0, v1;
#pragma unroll
                    for (int i = 0; i < 4; ++i) { v0[i] = bs[mm][bj][0][i] + gv[bj][0][i] * (float)a0[i]; v1[i] = bs[mm][bj][1][i] + gv[bj][1][i] * (float)a1[i]; }
                    u32x4 w; w.x = cvt_pk_bf16(v0[0], v0[1]); w.y = cvt_pk_bf16(v0[2], v0[3]); w.z = cvt_pk_bf16(v1[0], v1[1]); w.w = cvt_pk_bf16(v1[2], v1[3]);
                    *(u32x4*)(rowp + bj * HALF) = w; } }
            asm volatile("" ::: "memory");
        }
    }
};
struct EpiResGate {
    static constexpr bool PERM = false, AFTER_DRAIN = false;
    const float* base; float* out; int ldc; const float* gate; int gate_stride;
    __device__ __forceinline__ void operator()(const f32x4 (&acc)[2][2][4][2], const Unit& u, int wr, int wc, int fr, int fq) const {
        const int row0 = u.pm * BM + wr * 64 + fr, col0 = u.pn * BM + wc * 32 + 4 * fq;
        const float* g = gate + (size_t)((u.pm * BM) >> 12) * gate_stride + col0;
        f32x4 gv[2][2];
#pragma unroll
        for (int bj = 0; bj < 2; ++bj)
#pragma unroll
            for (int n = 0; n < 2; ++n) gv[bj][n] = *(const f32x4*)(g + bj * HALF + n * 16);
#pragma unroll
        for (int ai = 0; ai < 2; ++ai)
#pragma unroll
            for (int m = 0; m < 4; ++m) { const size_t off = (size_t)(row0 + ai * HALF + m * 16) * ldc + col0;
#pragma unroll
                for (int bj = 0; bj < 2; ++bj)
#pragma unroll
                    for (int n = 0; n < 2; ++n) { const f32x4 bs = *(const f32x4*)(base + off + bj * HALF + n * 16); *(f32x4*)(out + off + bj * HALF + n * 16) = bs + gv[bj][n] * acc[ai][bj][m][n]; }
                asm volatile("" ::: "memory"); }
    }
};

template <class Epi, class Sched, bool ALIGN_EPI = false, bool SP2 = false, bool I8 = false>
__device__ __forceinline__ void gemm_phase(PG8_LAS unsigned char* lds, const Gemm g, const Sched& S, const Epi& E, const int wid) {
    const int lane = fresh_lane(), tid = wid * 64 + lane, wr = wid >> 2, wc = wid & 3, fr = lane & 15, fq = lane >> 4;
    const int K = g.K, nt = K / BK;
    unsigned voffA[2], voffB[2];
#pragma unroll
    for (int i = 0; i < 2; ++i) { int R, C; stage_rc(tid * 16 + i * 8192, R, C); const int Rb = Epi::PERM ? ((R & ~31) + perm32(R & 31)) : R;
        voffA[i] = (unsigned)(R * K + C) * 2u; voffB[i] = (unsigned)(Rb * K + C) * 2u; }
    const size_t kstep = (size_t)(BK * 2);
    const size_t hstep = (size_t)HALF * K * 2;
    const size_t tstep = 2 * hstep;
    const unsigned ldsw = (unsigned)wid * 1024u;
    const int aoff = lds_byte(wr * 64 + fr, fq * 8), boff = lds_byte(wc * 32 + fr, fq * 8);
#define PG8_SA(b, h) (((b) * 2 + (h)) * HTB)
#define PG8_SB(b, h) ((4 + (b) * 2 + (h)) * HTB)
#define PG8_STAGE(bufoff, gbase, voff) do { _Pragma("unroll") for (int _i = 0; _i < 2; ++_i) \
        __builtin_amdgcn_global_load_lds((const unsigned*)((const char*)(gbase) + (voff)[_i]), (PG8_LAS unsigned*)(lds + (bufoff) + ldsw + _i * 8192), 16, 0, 0); } while (0)
#define PG8_LDA(dst, b, h) do { _Pragma("unroll") for (int m = 0; m < 4; ++m) _Pragma("unroll") for (int k = 0; k < 2; ++k) dst[m][k] = *(const PG8_LAS bf16x8*)(lds + PG8_SA(b, h) + aoff + m * 2048 + k * 1024); } while (0)
#define PG8_LDB(dst, b, h) do { _Pragma("unroll") for (int n = 0; n < 2; ++n) _Pragma("unroll") for (int k = 0; k < 2; ++k) dst[n][k] = *(const PG8_LAS bf16x8*)(lds + PG8_SB(b, h) + boff + n * 2048 + k * 1024); } while (0)
#define PG8_MMA(ai, bj, At, Bt) do { __builtin_amdgcn_s_setprio(1); _Pragma("unroll") for (int m = 0; m < 4; ++m) _Pragma("unroll") for (int n = 0; n < 2; ++n) _Pragma("unroll") for (int k = 0; k < 2; ++k) { \
        if constexpr (I8) acc[ai][bj][m][n] = __builtin_bit_cast(f32x4, __builtin_amdgcn_mfma_i32_16x16x64_i8(__builtin_bit_cast(i32x4, Bt[n][k]), __builtin_bit_cast(i32x4, At[m][k]), __builtin_bit_cast(i32x4, acc[ai][bj][m][n]), 0, 0, 0)); \
        else acc[ai][bj][m][n] = __builtin_amdgcn_mfma_f32_16x16x32_bf16(Bt[n][k], At[m][k], acc[ai][bj][m][n], 0, 0, 0); } __builtin_amdgcn_s_setprio(0); } while (0)
#define PG8_WAIT_V(n) asm volatile("s_waitcnt vmcnt(" #n ")" ::: "memory")
#define PG8_WAIT_L(n) asm volatile("s_waitcnt lgkmcnt(" #n ")" ::: "memory")
#define PG8_BAR __builtin_amdgcn_s_barrier()
#define PG8_SCHED __builtin_amdgcn_sched_barrier(0)
    Unit cur, nxt; int ui = 0;
    if (!S.next(0, cur)) return;
    f32x4 acc[2][2][4][2];
#pragma unroll
    for (int a = 0; a < 2; ++a)
#pragma unroll
        for (int b = 0; b < 2; ++b)
#pragma unroll
            for (int m = 0; m < 4; ++m)
#pragma unroll
                for (int n = 0; n < 2; ++n) acc[a][b][m][n] = (f32x4){0.f, 0.f, 0.f, 0.f};
    bf16x8 At[4][2], B0[2][2], B1[2][2];
    const char* cA = (const char*)g.A + (size_t)cur.pm * tstep; const char* cB = (const char*)g.Bt + (size_t)cur.pn * tstep;
    S.a_ready(cur);
    if constexpr (SP2) {
        PG8_STAGE(PG8_SB(0, 0), cB, voffB); PG8_STAGE(PG8_SB(0, 1), cB + hstep, voffB); PG8_STAGE(PG8_SA(0, 0), cA, voffA); PG8_STAGE(PG8_SA(0, 1), cA + hstep, voffA);
        if (wr == 1) PG8_BAR;
        PG8_WAIT_V(2); PG8_BAR;
        PG8_STAGE(PG8_SB(1, 0), cB + kstep, voffB); PG8_STAGE(PG8_SA(1, 0), cA + kstep, voffA); PG8_STAGE(PG8_SB(1, 1), cB + hstep + kstep, voffB);
        PG8_WAIT_V(6); PG8_BAR;
    } else {
        PG8_STAGE(PG8_SB(0, 0), cB, voffB); PG8_STAGE(PG8_SA(0, 0), cA, voffA); PG8_STAGE(PG8_SB(0, 1), cB + hstep, voffB); PG8_STAGE(PG8_SA(0, 1), cA + hstep, voffA);
        if (wr == 1) PG8_BAR;
        PG8_WAIT_V(4); PG8_BAR;
        PG8_STAGE(PG8_SB(1, 0), cB + kstep, voffB); PG8_STAGE(PG8_SA(1, 0), cA + kstep, voffA); PG8_STAGE(PG8_SB(1, 1), cB + hstep + kstep, voffB);
        PG8_WAIT_V(6); PG8_BAR;
    }
    for (;;) {
        const bool has_next = S.next(ui + 1, nxt);
        const char* nA = has_next ? (const char*)g.A + (size_t)nxt.pm * tstep : cA; const char* nB = has_next ? (const char*)g.Bt + (size_t)nxt.pn * tstep : cB;
        for (int t = 0; t < nt; t += 2) {
            const bool last = (t == nt - 2);
            const char* a1 = cA + (size_t)(t + 1) * kstep;
            const char* a2 = last ? nA : cA + (size_t)(t + 2) * kstep; const char* b2 = last ? nB : cB + (size_t)(t + 2) * kstep;
            const char* a3 = a2 + kstep; const char* b3 = b2 + kstep;
            if (last && has_next) S.a_ready(nxt);
            if constexpr (SP2) {
            PG8_LDB(B0, 0, 0); PG8_LDB(B1, 0, 1); PG8_SCHED; PG8_LDA(At, 0, 0); PG8_STAGE(PG8_SA(1, 1), a1 + hstep, voffA);
            PG8_WAIT_V(8); PG8_WAIT_L(0); PG8_BAR; PG8_MMA(0, 0, At, B0); PG8_MMA(0, 1, At, B1); PG8_BAR; PG8_SCHED;
            PG8_LDA(At, 0, 1); PG8_STAGE(PG8_SB(0, 0), b2, voffB); PG8_STAGE(PG8_SB(0, 1), b2 + hstep, voffB); PG8_STAGE(PG8_SA(0, 0), a2, voffA);
            PG8_WAIT_V(8); PG8_WAIT_L(0); PG8_BAR; PG8_MMA(1, 0, At, B0); PG8_MMA(1, 1, At, B1); PG8_BAR; PG8_SCHED;
            PG8_LDB(B0, 1, 0); PG8_LDB(B1, 1, 1); PG8_SCHED; PG8_LDA(At, 1, 0); PG8_STAGE(PG8_SA(0, 1), a2 + hstep, voffA);
            PG8_WAIT_V(8); PG8_WAIT_L(0); PG8_BAR; PG8_MMA(0, 0, At, B0); PG8_MMA(0, 1, At, B1); PG8_BAR; PG8_SCHED;
            PG8_LDA(At, 1, 1); PG8_STAGE(PG8_SB(1, 0), b3, voffB); PG8_STAGE(PG8_SB(1, 1), b3 + hstep, voffB); PG8_STAGE(PG8_SA(1, 0), a3, voffA);
            PG8_WAIT_V(8); PG8_WAIT_L(0); PG8_BAR; PG8_MMA(1, 0, At, B0); PG8_MMA(1, 1, At, B1); PG8_BAR; PG8_SCHED;
            } else {
            PG8_LDB(B0, 0, 0); PG8_SCHED; PG8_LDA(At, 0, 0); PG8_STAGE(PG8_SA(1, 1), a1 + hstep, voffA);
            PG8_WAIT_L(8); PG8_BAR; PG8_WAIT_L(0); PG8_MMA(0, 0, At, B0); PG8_BAR; PG8_SCHED;
            PG8_LDB(B1, 0, 1); PG8_STAGE(PG8_SB(0, 0), b2, voffB);
            PG8_BAR; PG8_WAIT_L(0); PG8_MMA(0, 1, At, B1); PG8_BAR;
            PG8_LDA(At, 0, 1); PG8_STAGE(PG8_SA(0, 0), a2, voffA);
            PG8_BAR; PG8_WAIT_L(0); PG8_MMA(1, 0, At, B0); PG8_BAR; PG8_SCHED;
            PG8_STAGE(PG8_SB(0, 1), b2 + hstep, voffB);
            PG8_WAIT_V(6); PG8_BAR; PG8_MMA(1, 1, At, B1); PG8_BAR;
            PG8_LDB(B0, 1, 0); PG8_SCHED; PG8_LDA(At, 1, 0); PG8_STAGE(PG8_SA(0, 1), a2 + hstep, voffA);
            PG8_WAIT_L(8); PG8_BAR; PG8_WAIT_L(0); PG8_MMA(0, 0, At, B0); PG8_BAR; PG8_SCHED;
            PG8_LDB(B1, 1, 1); PG8_STAGE(PG8_SB(1, 0), b3, voffB);
            PG8_BAR; PG8_WAIT_L(0); PG8_MMA(0, 1, At, B1); PG8_BAR;
            PG8_LDA(At, 1, 1); PG8_STAGE(PG8_SA(1, 0), a3, voffA);
            PG8_BAR; PG8_WAIT_L(0); PG8_MMA(1, 0, At, B0); PG8_BAR; PG8_SCHED;
            PG8_STAGE(PG8_SB(1, 1), b3 + hstep, voffB);
            PG8_WAIT_V(6); PG8_BAR; PG8_MMA(1, 1, At, B1); PG8_BAR;
            }
        }
        if constexpr (ALIGN_EPI) { if (wr == 0) PG8_BAR; }
        if constexpr (!Epi::AFTER_DRAIN) { E(acc, cur, wr, wc, fr, fq); S.done(cur); }
        if (!has_next) break;
#pragma unroll
        for (int a = 0; a < 2; ++a)
#pragma unroll
            for (int b = 0; b < 2; ++b)
#pragma unroll
                for (int m = 0; m < 4; ++m)
#pragma unroll
                    for (int n = 0; n < 2; ++n) acc[a][b][m][n] = (f32x4){0.f, 0.f, 0.f, 0.f};
        cur = nxt; cA = nA; cB = nB; ++ui;
        if constexpr (ALIGN_EPI) { if (wr == 1) PG8_BAR; }
    }
    PG8_WAIT_V(0);
    if constexpr (!ALIGN_EPI) { if (wr == 0) PG8_BAR; }
    PG8_BAR;
#undef PG8_SA
#undef PG8_SB
#undef PG8_STAGE
#undef PG8_LDA
#undef PG8_LDB
#undef PG8_MMA
#undef PG8_WAIT_V
#undef PG8_WAIT_L
#undef PG8_BAR
#undef PG8_SCHED
}
}

#define XB_TMO      128
#define XB_XCNT(j)  (256  + 64 * (j))
#define XB_XSUB(j)  (1280 + 64 * (j))
#define XB_XGEN(j)  (2304 + 64 * (j))
#define XB_TOP      3328
#define XB_TOPGEN   3392
#define XCD_BAR_WORDS 3456
#define XB_SPIN_CAP (1u << 18)
__device__ __forceinline__ unsigned xb_ld(unsigned* p)              { return __hip_atomic_load(p, __ATOMIC_RELAXED, __HIP_MEMORY_SCOPE_AGENT); }
__device__ __forceinline__ unsigned xb_add(unsigned* p, unsigned v) { return __hip_atomic_fetch_add(p, v, __ATOMIC_RELAXED, __HIP_MEMORY_SCOPE_AGENT); }
__device__ __forceinline__ unsigned xb_xcc_id() { return (unsigned)__builtin_amdgcn_s_getreg((3 << 11) | 20) & 0xFu; }
#define XB_SPIN(cond, bar) do { unsigned _sp = 0; while (cond) { __builtin_amdgcn_s_sleep(1); \
    if ((++_sp & 255u) == 0u) { if (xb_ld(&(bar)[XB_TMO])) break; if (_sp > XB_SPIN_CAP) { atomicAdd(&(bar)[XB_TMO], 1u); break; } } } } while (0)
struct XcdBarrier { unsigned* bar; unsigned x; volatile LAS unsigned* st; int wave; };
__device__ __forceinline__ XcdBarrier xcd_barrier_post(unsigned* bar, volatile LAS unsigned* st, int wave) {
    XcdBarrier b; b.bar = bar; b.x = xb_xcc_id(); b.st = st; b.wave = wave;
    if (wave == 0 && fresh_lane() == 0) (void)xb_add(&bar[XB_XCNT(b.x)], 1u);
    return b;
}
__device__ __forceinline__ void xcd_barrier_complete(unsigned* bar, unsigned x, unsigned& nloc, unsigned& nx) {
    const unsigned G = gridDim.x * gridDim.y * gridDim.z;
    unsigned sum, cnt, mine, sp = 0u;
    for (;;) {
        sum = 0u; cnt = 0u; mine = 0u;
#pragma unroll
        for (unsigned j = 0; j < 16; ++j) { const unsigned c = xb_ld(&bar[XB_XCNT(j)]); sum += c; cnt += (c > 0u) ? 1u : 0u; mine = (j == x) ? c : mine; }
        if (sum == G) break;
        __builtin_amdgcn_s_sleep(1);
        if ((++sp & 255u) == 0u) { if (xb_ld(&bar[XB_TMO])) break; if (sp > XB_SPIN_CAP) { atomicAdd(&bar[XB_TMO], 1u); break; } }
    }
    nloc = mine > 0u ? mine : 1u; nx = cnt > 0u ? cnt : 1u;
}
__device__ __forceinline__ void xcd_barrier(const XcdBarrier& b) {
    asm volatile("s_waitcnt vmcnt(0)" ::: "memory");
    __syncthreads();
    if (b.wave == 0 && fresh_lane() == 0) {
        unsigned* bar = b.bar;
        __builtin_amdgcn_s_waitcnt(0);
        unsigned nloc = b.st[0], nx = b.st[1];
        if (nloc == 0u) { xcd_barrier_complete(bar, b.x, nloc, nx); b.st[0] = nloc; b.st[1] = nx; }
        const unsigned old = xb_add(&bar[XB_XSUB(b.x)], 1u);
        const unsigned gen = old / nloc, target = (gen + 1u) * nx;
        if (old + 1u == (gen + 1u) * nloc) {
            __builtin_amdgcn_fence(__ATOMIC_RELEASE, "agent");
            asm volatile("s_waitcnt vmcnt(0)" ::: "memory");
            const unsigned og = xb_add(&bar[XB_TOP], 1u);
            if (og + 1u != target) XB_SPIN(xb_ld(&bar[XB_TOP]) < target, bar);
        } else {
            XB_SPIN(xb_ld(&bar[XB_TOP]) < target, bar);
        }
        __builtin_amdgcn_fence(__ATOMIC_ACQUIRE, "agent");
        asm volatile("s_waitcnt vmcnt(0)" ::: "memory");
    }
    __syncthreads();
}

__device__ __forceinline__ void p0_ada_item(const float* cvec, const float* w_ada, const float* b_ada, float* mod, LAS unsigned char* lds, int item, int tid, int wave, int lane) {
    LAS float* sc = (LAS float*)(lds + wave * 8192);
    LAS float* red = (LAS float*)(lds + 65536);
    const int k0 = wave * 256;
    { float cv[32];
#pragma unroll
      for (int j = 0; j < 32; ++j) { const int i = lane + 64 * j; cv[j] = cvec[(i & 7) * DM + k0 + (i >> 3)]; }
#pragma unroll
      for (int j = 0; j < 32; ++j) { const int i = lane + 64 * j; const float v = cv[j]; sc[(i >> 3) * 8 + (i & 7)] = v * __builtin_amdgcn_rcpf(1.f + __builtin_amdgcn_exp2f(-v * LOG2E)); } }
    LDS_WAIT();
    const int rg = lane >> 4, cq = lane & 15;
    float acc[8][4];
#pragma unroll
    for (int b = 0; b < 8; ++b)
#pragma unroll
        for (int i = 0; i < 4; ++i) acc[b][i] = 0.f;
    const float* wp = w_ada + (size_t)(k0 + rg) * MODW + item * 64 + 4 * cq;
#pragma unroll 32
    for (int it = 0; it < 64; ++it) {
        const f32x4 w4 = __builtin_nontemporal_load((const f32x4*)(wp + (size_t)it * 4 * MODW));
        const int kk = it * 4 + rg;
        const f32x4 s0 = *(const LAS f32x4*)(sc + kk * 8), s1 = *(const LAS f32x4*)(sc + kk * 8 + 4);
#pragma unroll
        for (int i = 0; i < 4; ++i) {
            acc[0][i] += s0[0] * w4[i]; acc[1][i] += s0[1] * w4[i]; acc[2][i] += s0[2] * w4[i]; acc[3][i] += s0[3] * w4[i];
            acc[4][i] += s1[0] * w4[i]; acc[5][i] += s1[1] * w4[i]; acc[6][i] += s1[2] * w4[i]; acc[7][i] += s1[3] * w4[i];
        }
    }
#pragma unroll
    for (int b = 0; b < 8; ++b)
#pragma unroll
        for (int i = 0; i < 4; ++i) acc[b][i] = xrow_sum(acc[b][i]);
    if (rg == 0) {
#pragma unroll
        for (int b = 0; b < 8; ++b)
#pragma unroll
            for (int i = 0; i < 4; ++i) red[(wave * 8 + b) * 64 + 4 * cq + i] = acc[b][i];
    }
    LDS_WAIT();
    __syncthreads();
    { const int b = tid >> 6, col = tid & 63; float s = b_ada[item * 64 + col];
#pragma unroll
      for (int w = 0; w < 8; ++w) s += red[(w * 8 + b) * 64 + col];
      mod[b * MODW + item * 64 + col] = s; }
    LDS_WAIT();
    __syncthreads();
}
__device__ __forceinline__ void p0_transpose_item(const float* W, int K, int N, bf16_t* WT, LAS float* scr, int item, int lane) {
    const int nblk = N / 32, kb = item / nblk, nb = item % nblk, k0 = 64 * kb, n0 = 32 * nb;
#pragma unroll 8
    for (int i = 0; i < 32; ++i) { const int kk = 2 * i + (lane >> 5); scr[kk * 33 + (lane & 31)] = W[(size_t)(k0 + kk) * N + n0 + (lane & 31)]; }
    LDS_WAIT(); asm volatile("" ::: "memory");
    const int c = lane & 7;
#pragma unroll
    for (int j = 0; j < 4; ++j) { const int n = (lane >> 3) + 8 * j; const LAS float* s = scr + (8 * c) * 33 + n;
        u32x4 o; o.x = cvtpk(s[0 * 33], s[1 * 33]); o.y = cvtpk(s[2 * 33], s[3 * 33]); o.z = cvtpk(s[4 * 33], s[5 * 33]); o.w = cvtpk(s[6 * 33], s[7 * 33]);
        *(u32x4*)(WT + (size_t)(n0 + n) * K + k0 + 8 * c) = o; }
    LDS_WAIT(); asm volatile("" ::: "memory");
}
__device__ __forceinline__ void p0_colmax_item(const float* W, int N, unsigned* cmax, int item, int lane) {
    const int nblk = N / 32, kb = item / nblk, nb = item % nblk, k0 = 64 * kb, n0 = 32 * nb;
    float am = 0.f;
#pragma unroll
    for (int i = 0; i < 32; ++i) am = fmaxf(am, fabsf(W[(size_t)(k0 + 2 * i + (lane >> 5)) * N + n0 + (lane & 31)]));
    am = fmaxf(am, __shfl_xor(am, 32));
    if (lane < 32) atomicMax(cmax + n0 + lane, __float_as_uint(am));
}
template <bool INTERLEAVE>
__device__ __forceinline__ void p1_transpose_i8_item(const float* W, int K, int N, unsigned char* WT, const unsigned* cmax, LAS float* scr, int item, int lane) {
    const int nblk = N / 32, kb = item / nblk, nb = item % nblk, k0 = 64 * kb, nd0 = 32 * nb;
    int n0 = nd0;
    if (INTERLEAVE && nd0 >= 2560) { const int t = (nd0 - 2560) >> 8, j = (nd0 - 2560) & 255; n0 = j < 128 ? 2560 + 128 * t + j : 3584 + 128 * t + (j - 128); }
    float wv[32];
#pragma unroll
    for (int i = 0; i < 32; ++i) wv[i] = __builtin_nontemporal_load(W + (size_t)(k0 + 2 * i + (lane >> 5)) * N + n0 + (lane & 31));
#pragma unroll
    for (int i = 0; i < 32; ++i) { const int kk = 2 * i + (lane >> 5); scr[kk * 33 + (lane & 31)] = wv[i]; }
    LDS_WAIT(); asm volatile("" ::: "memory");
    const int c4 = lane & 3;
#pragma unroll
    for (int j = 0; j < 2; ++j) { const int n = (lane >> 2) + 16 * j; const LAS float* s = scr + (16 * c4) * 33 + n;
        const float am = __uint_as_float(cmax[n0 + n]); const float inv = am > 0.f ? 127.0f / am : 0.f;
        u32x4 o;
#pragma unroll
        for (int w = 0; w < 4; ++w) o[w] = pack_i8x4((f32x4){s[(4 * w) * 33], s[(4 * w + 1) * 33], s[(4 * w + 2) * 33], s[(4 * w + 3) * 33]}, inv);
        *(u32x4*)(WT + (size_t)(nd0 + n) * K + k0 + 16 * c4) = o; }
    LDS_WAIT(); asm volatile("" ::: "memory");
}
__device__ __forceinline__ void p0_w2_item(const float* w_pq, const float* subkeys, bf16_t* W2, unsigned* cmax, int item, int lane) {
    const int blk = item >> 5, kq = (item >> 4) & 1, dch = item & 15, c = lane & 15, quad = lane >> 4;
    bf16x8 kf[4][4];
    { f32x4 sv[4][4][2];
#pragma unroll
      for (int kt = 0; kt < 4; ++kt) { const float* sp = subkeys + ((size_t)blk * 128 + (kq * 4 + kt) * 16 + c) * 128 + 8 * quad;
#pragma unroll
          for (int ks = 0; ks < 4; ++ks) { sv[kt][ks][0] = *(const f32x4*)(sp + ks * 32); sv[kt][ks][1] = *(const f32x4*)(sp + ks * 32 + 4); } }
#pragma unroll
      for (int kt = 0; kt < 4; ++kt)
#pragma unroll
          for (int ks = 0; ks < 4; ++ks) { const f32x4 a = sv[kt][ks][0], b = sv[kt][ks][1];
              u32x4 w; w.x = cvtpk(a[0], a[1]); w.y = cvtpk(a[2], a[3]); w.z = cvtpk(b[0], b[1]); w.w = cvtpk(b[2], b[3]); kf[kt][ks] = __builtin_bit_cast(bf16x8, w); } }
    float am[4] = {0.f, 0.f, 0.f, 0.f};
#pragma nounroll
    for (int dq = 0; dq < 2; ++dq) {
        f32x4 wv[4][4][2];
#pragma unroll
        for (int j = 0; j < 4; ++j) { const float* wp = w_pq + (size_t)(dch * 128 + (dq * 4 + j) * 16 + c) * DM + blk * 128 + 8 * quad;
#pragma unroll
            for (int ks = 0; ks < 4; ++ks) { wv[j][ks][0] = *(const f32x4*)(wp + ks * 32); wv[j][ks][1] = *(const f32x4*)(wp + ks * 32 + 4); } }
#pragma unroll
        for (int j = 0; j < 4; ++j) { const int d0 = dch * 128 + (dq * 4 + j) * 16;
            bf16x8 wb[4];
#pragma unroll
            for (int ks = 0; ks < 4; ++ks) { const f32x4 a = wv[j][ks][0], b = wv[j][ks][1];
                u32x4 w; w.x = cvtpk(a[0], a[1]); w.y = cvtpk(a[2], a[3]); w.z = cvtpk(b[0], b[1]); w.w = cvtpk(b[2], b[3]); wb[ks] = __builtin_bit_cast(bf16x8, w); }
#pragma unroll
            for (int kt = 0; kt < 4; ++kt) {
                f32x4 acc = (f32x4){0.f, 0.f, 0.f, 0.f};
#pragma unroll
                for (int ks = 0; ks < 4; ++ks) acc = __builtin_amdgcn_mfma_f32_16x16x32_bf16(wb[ks], kf[kt][ks], acc, 0, 0, 0);
                am[kt] = fmaxf(fmaxf(am[kt], fmaxf(fabsf(acc[0]), fabsf(acc[1]))), fmaxf(fabsf(acc[2]), fabsf(acc[3])));
                u32x2 o; o.x = cvtpk(acc[0], acc[1]); o.y = cvtpk(acc[2], acc[3]);
                *(u32x2*)(W2 + (size_t)(blk * 128 + (kq * 4 + kt) * 16 + c) * DM + d0 + 4 * quad) = o; } }
    }
#pragma unroll
    for (int kt = 0; kt < 4; ++kt) { const float a = xrow_max(am[kt]); if (quad == 0) atomicMax(cmax + blk * 128 + (kq * 4 + kt) * 16 + c, __float_as_uint(a)); }
}
__device__ __forceinline__ void p1_w2_row(const bf16_t* W2, unsigned char* WT, const unsigned* cmax, int n, int lane) {
    const float am = __uint_as_float(cmax[n]); const float inv = am > 0.f ? 127.0f / am : 0.f;
#pragma unroll
    for (int j = 0; j < 8; ++j) { const u32x2 v = *(const u32x2*)(W2 + (size_t)n * DM + 256 * j + 4 * lane);
        *(unsigned*)(WT + (size_t)n * DM + 256 * j + 4 * lane) = pack_i8x4((f32x4){bf_lo(v.x), bf_hi(v.x), bf_lo(v.y), bf_hi(v.y)}, inv); }
}
__device__ __forceinline__ void p0_cvt_item(const float* src, bf16_t* dst, size_t base, int lane) {
#pragma unroll
    for (int j = 0; j < 4; ++j) { const size_t o = base + (size_t)j * 512 + lane * 8;
        const f32x4 a = *(const f32x4*)(src + o), b = *(const f32x4*)(src + o + 4);
        u32x4 w; w.x = cvtpk(a[0], a[1]); w.y = cvtpk(a[2], a[3]); w.z = cvtpk(b[0], b[1]); w.w = cvtpk(b[2], b[3]);
        *(u32x4*)(dst + o) = w; }
}
__device__ __forceinline__ size_t tab_off(int row, int col) { return ((size_t)(col >> 7) * PEER_N + row) * 128 + (col & 127); }
__device__ __forceinline__ void p0_fp8_item(const float* src, unsigned char* dst, size_t base, float scale, int lane) {
#pragma unroll
    for (int i = 0; i < 8; ++i) { const size_t o = base + (size_t)i * 256 + lane * 4; const f32x4 a = *(const f32x4*)(src + o);
        int p = 0; p = __builtin_amdgcn_cvt_pk_fp8_f32(a[0] * scale, a[1] * scale, p, false); p = __builtin_amdgcn_cvt_pk_fp8_f32(a[2] * scale, a[3] * scale, p, true);
        *(unsigned*)(dst + tab_off((int)(base >> 11), i * 256 + lane * 4)) = (unsigned)p; }
}
__device__ __forceinline__ void p0_i8_row(const float* src, unsigned char* dst, float* scale, int row, int lane) {
    const float* p = src + (size_t)row * DM + lane * 4;
    f32x4 v[8]; float am = 0.f;
#pragma unroll
    for (int i = 0; i < 8; ++i) { v[i] = *(const f32x4*)(p + i * 256); am = fmaxf(fmaxf(am, fmaxf(fabsf(v[i][0]), fabsf(v[i][1]))), fmaxf(fabsf(v[i][2]), fabsf(v[i][3]))); }
    am = wave_max(am);
    const float inv = am > 0.f ? 127.0f / am : 0.f;
#pragma unroll
    for (int i = 0; i < 8; ++i) *(unsigned*)(dst + tab_off(row, i * 256 + lane * 4)) = pack_i8x4(v[i], inv);
    if (lane == 0) scale[row] = am * (1.0f / 127.0f);
}
__device__ __forceinline__ void p0_tables8(const float* peer_u, const float* peer_v, unsigned char* UB, float* SU, unsigned char* VB, int gw, int ngw, int lane) {
#define P0_TAB_SRC(k) (((k) < 8 ? peer_u : peer_v) + (size_t)(gw + ((k) & 7) * ngw) * DM + lane * 4)
    f32x4 ra[8], rb[8], rc[8];
#pragma unroll
    for (int i = 0; i < 8; ++i) ra[i] = *(const f32x4*)(P0_TAB_SRC(0) + i * 256);
#pragma unroll
    for (int i = 0; i < 8; ++i) rb[i] = *(const f32x4*)(P0_TAB_SRC(1) + i * 256);
#pragma unroll
    for (int k = 0; k < 16; ++k) {
        const int row = gw + (k & 7) * ngw;
        f32x4 (&v)[8] = (k % 3 == 0) ? ra : (k % 3 == 1) ? rb : rc;
        f32x4 (&nn)[8] = (k % 3 == 0) ? rc : (k % 3 == 1) ? ra : rb;
        if (k < 14) {
#pragma unroll
            for (int i = 0; i < 8; ++i) nn[i] = *(const f32x4*)(P0_TAB_SRC(k + 2) + i * 256); }
        if (k < 8) {
            float am = 0.f;
#pragma unroll
            for (int i = 0; i < 8; ++i) am = fmaxf(fmaxf(am, fmaxf(fabsf(v[i][0]), fabsf(v[i][1]))), fmaxf(fabsf(v[i][2]), fabsf(v[i][3])));
            am = wave_max(am);
            const float inv = am > 0.f ? 127.0f / am : 0.f;
            unsigned char* q = UB + (size_t)(lane >> 5) * (PEER_N * 128) + (size_t)row * 128 + (lane & 31) * 4;
#pragma unroll
            for (int i = 0; i < 8; ++i) *(unsigned*)(q + (size_t)i * (2 * PEER_N * 128)) = pack_i8x4(v[i], inv);
            if (lane == 0) SU[row] = am * (1.0f / 127.0f);
        } else {
            unsigned char* q = VB + (size_t)(lane >> 5) * (PEER_N * 128) + (size_t)row * 128 + (lane & 31) * 4;
#pragma unroll
            for (int i = 0; i < 8; ++i) { int p = 0; p = __builtin_amdgcn_cvt_pk_fp8_f32(v[i][0] * V_SCALE, v[i][1] * V_SCALE, p, false); p = __builtin_amdgcn_cvt_pk_fp8_f32(v[i][2] * V_SCALE, v[i][3] * V_SCALE, p, true);
                *(unsigned*)(q + (size_t)i * (2 * PEER_N * 128)) = (unsigned)p; }
        }
    }
#undef P0_TAB_SRC
}
struct TabCtx { const float* src; unsigned char* dst; float* SU; int p; };
__device__ __forceinline__ void tab_row_load(const TabCtx& T, int k, f32x4 (&v)[8], int lane) {
    const float* np = T.src + (size_t)(T.p + 1024 * (k < 15 ? k : 15)) * DM + lane * 4;
#pragma unroll
    for (int i = 0; i < 8; ++i) v[i] = __builtin_nontemporal_load((const f32x4*)(np + i * 256));
}
template <bool ISV> __device__ __forceinline__ void tab_row_convert(const TabCtx& T, int k, const f32x4 (&v)[8], int lane) {
    const int row = T.p + 1024 * k;
    unsigned char* q = T.dst + (size_t)(lane >> 5) * (PEER_N * 128) + (size_t)row * 128 + (lane & 31) * 4;
    if (!ISV) {
        float am = 0.f;
#pragma unroll
        for (int i = 0; i < 8; ++i) am = fmaxf(fmaxf(am, fmaxf(fabsf(v[i][0]), fabsf(v[i][1]))), fmaxf(fabsf(v[i][2]), fabsf(v[i][3])));
        am = wave_max(am);
        const float inv = am > 0.f ? 127.0f / am : 0.f;
#pragma unroll
        for (int i = 0; i < 8; ++i) *(unsigned*)(q + (size_t)i * (2 * PEER_N * 128)) = pack_i8x4(v[i], inv);
        if (lane == 0) T.SU[row] = am * (1.0f / 127.0f);
    } else {
#pragma unroll
        for (int i = 0; i < 8; ++i) { int p = 0; p = __builtin_amdgcn_cvt_pk_fp8_f32(v[i][0] * V_SCALE, v[i][1] * V_SCALE, p, false); p = __builtin_amdgcn_cvt_pk_fp8_f32(v[i][2] * V_SCALE, v[i][3] * V_SCALE, p, true);
            *(unsigned*)(q + (size_t)i * (2 * PEER_N * 128)) = (unsigned)p; }
    }
}
__device__ __forceinline__ void p0_rope_item(float* rope, int item, int lane) {
    const int idx = item * 64 + lane, pos = idx >> 3, i = idx & 7;
    const double f = (i == 0) ? 0.15915494309189535 : (i == 1) ? 0.03086376340470123 : (i == 2) ? 0.005985185712713705 : (i == 3) ? 0.001160663641240061
                   : (i == 4) ? 0.00022507907903927653 : (i == 5) ? 4.364795279280289e-05 : (i == 6) ? 8.464330808241401e-06 : 1.6414262627950345e-06;
    const double rev = (double)pos * f; const double fr = rev - (double)(long long)rev;
    rope[idx] = __builtin_amdgcn_cosf((float)fr); rope[32768 + idx] = __builtin_amdgcn_sinf((float)fr);
}

__device__ __forceinline__ void norm_rows(const float* src, const float* gain, const float* mod, int off_shift, int off_scale, unsigned char* dst8, float* scale8, int gw, int ngw, int lane) {
    for (int grp = gw; grp < MTOK / 16; grp += ngw) {
        const int row0 = grp * 16; const float* mb = mod + (size_t)(row0 >> 12) * MODW;
        f32x4 A[8], B[8];
#pragma unroll
        for (int j = 0; j < 8; ++j) { const int c = 256 * j + 4 * lane; const f32x4 g = *(const f32x4*)(gain + c), sc = *(const f32x4*)(mb + off_scale + c); A[j] = g * (sc + 1.0f); B[j] = *(const f32x4*)(mb + off_shift + c); }
        f32x4 ra[8], rb[8], rc[8];
#pragma unroll
        for (int j = 0; j < 8; ++j) ra[j] = __builtin_nontemporal_load((const f32x4*)(src + (size_t)row0 * DM + 4 * lane + 256 * j));
#pragma unroll
        for (int j = 0; j < 8; ++j) rb[j] = __builtin_nontemporal_load((const f32x4*)(src + (size_t)(row0 + 1) * DM + 4 * lane + 256 * j));
#pragma unroll
        for (int r = 0; r < 16; ++r) {
            f32x4 (&cur)[8] = (r % 3 == 0) ? ra : (r % 3 == 1) ? rb : rc;
            f32x4 (&nn)[8] = (r % 3 == 0) ? rc : (r % 3 == 1) ? ra : rb;
            f32x4 v[8]; float ss = 0.f;
#pragma unroll
            for (int j = 0; j < 8; ++j) { v[j] = cur[j]; ss += (v[j][0] * v[j][0] + v[j][1] * v[j][1]) + (v[j][2] * v[j][2] + v[j][3] * v[j][3]); }
            if (r < 14) { const float* xn = src + (size_t)(row0 + r + 2) * DM + 4 * lane;
#pragma unroll
              for (int j = 0; j < 8; ++j) nn[j] = __builtin_nontemporal_load((const f32x4*)(xn + 256 * j)); }
            const float rstd = 1.0f / sqrtf(wave_sum(ss) * (1.0f / DM) + EPS);
            float am = 0.f;
#pragma unroll
            for (int j = 0; j < 8; ++j) { const f32x4 o = v[j] * rstd * A[j] + B[j]; v[j] = o; am = fmaxf(fmaxf(am, fmaxf(fabsf(o[0]), fabsf(o[1]))), fmaxf(fabsf(o[2]), fabsf(o[3]))); }
            am = wave_max(am); const float inv = am > 0.f ? 127.0f / am : 0.f;
            unsigned* q = (unsigned*)(dst8 + (size_t)(row0 + r) * DM + 4 * lane);
#pragma unroll
            for (int j = 0; j < 8; ++j) q[64 * j] = pack_i8x4(v[j], inv);
            if (lane == 0) scale8[row0 + r] = am * (1.0f / 127.0f);
        }
    }
}

__device__ __forceinline__ void norm_rows_bf16(const bf16_t* src, const float* gain, const float* mod, int off_shift, int off_scale, unsigned char* dst8, float* scale8, int gw, int ngw, int lane) {
    for (int grp = gw; grp < MTOK / 16; grp += ngw) {
        const int row0 = grp * 16; const float* mb = mod + (size_t)(row0 >> 12) * MODW;
        f32x4 A[8], B[8];
#pragma unroll
        for (int j = 0; j < 8; ++j) { const int c = 512 * (j >> 1) + 8 * lane + 4 * (j & 1); const f32x4 g = *(const f32x4*)(gain + c), sc = *(const f32x4*)(mb + off_scale + c); A[j] = g * (sc + 1.0f); B[j] = *(const f32x4*)(mb + off_shift + c); }
        u32x4 ra[4], rb[4], rc[4];
#pragma unroll
        for (int j = 0; j < 4; ++j) ra[j] = __builtin_nontemporal_load((const u32x4*)(src + (size_t)row0 * DM + 8 * lane + 512 * j));
#pragma unroll
        for (int j = 0; j < 4; ++j) rb[j] = __builtin_nontemporal_load((const u32x4*)(src + (size_t)(row0 + 1) * DM + 8 * lane + 512 * j));
#pragma unroll
        for (int r = 0; r < 16; ++r) {
            u32x4 (&cur)[4] = (r % 3 == 0) ? ra : (r % 3 == 1) ? rb : rc;
            u32x4 (&nn)[4] = (r % 3 == 0) ? rc : (r % 3 == 1) ? ra : rb;
            f32x4 v[8]; float ss = 0.f;
#pragma unroll
            for (int j = 0; j < 4; ++j) { const u32x4 t = cur[j]; v[2 * j] = (f32x4){bf_lo(t.x), bf_hi(t.x), bf_lo(t.y), bf_hi(t.y)}; v[2 * j + 1] = (f32x4){bf_lo(t.z), bf_hi(t.z), bf_lo(t.w), bf_hi(t.w)}; }
#pragma unroll
            for (int j = 0; j < 8; ++j) ss += (v[j][0] * v[j][0] + v[j][1] * v[j][1]) + (v[j][2] * v[j][2] + v[j][3] * v[j][3]);
            if (r < 14) { const bf16_t* xn = src + (size_t)(row0 + r + 2) * DM + 8 * lane;
#pragma unroll
              for (int j = 0; j < 4; ++j) nn[j] = __builtin_nontemporal_load((const u32x4*)(xn + 512 * j)); }
            const float rstd = __builtin_amdgcn_rsqf(wave_sum(ss) * (1.0f / DM) + EPS);
            float am = 0.f;
#pragma unroll
            for (int j = 0; j < 8; ++j) { const f32x4 o = v[j] * rstd * A[j] + B[j]; v[j] = o; am = fmaxf(fmaxf(am, fmaxf(fabsf(o[0]), fabsf(o[1]))), fmaxf(fabsf(o[2]), fabsf(o[3]))); }
            am = wave_max(am); const float inv = am > 0.f ? 127.0f / am : 0.f;
            unsigned char* q = dst8 + (size_t)(row0 + r) * DM + 8 * lane;
#pragma unroll
            for (int j = 0; j < 4; ++j) { u32x2 o; o.x = pack_i8x4(v[2 * j], inv); o.y = pack_i8x4(v[2 * j + 1], inv); *(u32x2*)(q + 512 * j) = o; }
            if (lane == 0) scale8[row0 + r] = am * (1.0f / 127.0f);
        }
    }
}

constexpr int KS_PITCH = 72;
constexpr int VT_PITCH = 264;
constexpr int LDS_KS = 0, LDS_VT = 256 * KS_PITCH * 2, LDS_RT = LDS_VT + 64 * VT_PITCH * 2;
constexpr int LDS_QS = LDS_RT + 8192, LDS_QS_HI = LDSCTL_OFF + 1024;
__device__ __forceinline__ int qstash_off(int wave) { return wave < 6 ? LDS_QS + wave * 8192 : LDS_QS_HI + (wave - 6) * 8192; }
static_assert(LDS_QS + 6 * 8192 <= LDSCTL_OFF && LDS_QS_HI + 2 * 8192 <= LDS_BYTES, "Q stash placement");
template <bool HOST, bool ISV>
__device__ __forceinline__ void attn_unit(int b, int hk, int n, const bf16_t* PROJ, const float* g_q, const float* g_k, const float* sinks, const float* g_oa, const float* rope, unsigned char* MIXED,
                                          LAS unsigned char* lds, int tid, int wave, int lane, const TabCtx& T, int tabk0, f32x4 (&tcur)[8], f32x4 (&tnx)[8]) {
    LAS bf16_t* Ks = (LAS bf16_t*)(lds + LDS_KS); LAS bf16_t* Vt = (LAS bf16_t*)(lds + LDS_VT); LAS float* RT = (LAS float*)(lds + LDS_RT);
    const size_t rowb = (size_t)b * SEQ;
    const int c = lane & 15, quad = lane >> 4, g = wave >> 1, hf = wave & 1, head = hk * 4 + g;
    const bf16_t* qsrc = PROJ + (rowb + n * 128 + hf * 64 + c) * INC + head * 64 + 8 * quad;
#pragma unroll
    for (int qt = 0; qt < 4; ++qt)
#pragma unroll
        for (int k = 0; k < 2; ++k)
            __builtin_amdgcn_global_load_lds((const unsigned*)(qsrc + (size_t)qt * 16 * INC + k * 32), (LAS unsigned*)(lds + qstash_off(wave) + (qt * 2 + k) * 1024), 16, 0, 2);
    u32x4 kr[2][2]; f32x4 kcs[2][4]; u32x4 vr[4];
    const int part = tid & 3;
#pragma unroll
    for (int it = 0; it < 2; ++it) {
        const int row = (tid + 512 * it) >> 2, pos = (n - 1) * 128 + row, posc = pos >= 0 ? pos : 0;
        const bf16_t* src = PROJ + (rowb + posc) * INC + COL_K + hk * 64 + 16 * part;
        kr[it][0] = *(const u32x4*)src; kr[it][1] = *(const u32x4*)(src + 8);
        const float* rp = rope + posc * 8;
        kcs[it][0] = *(const f32x4*)rp; kcs[it][1] = *(const f32x4*)(rp + 4); kcs[it][2] = *(const f32x4*)(rp + 32768); kcs[it][3] = *(const f32x4*)(rp + 32768 + 4);
    }
#pragma unroll
    for (int it = 0; it < 4; ++it) {
        const int task = tid + 512 * it, row = task & 255, ch = task >> 8, pos = (n - 1) * 128 + row, posc = pos >= 0 ? pos : 0;
        vr[it] = *(const u32x4*)(PROJ + (rowb + posc) * INC + COL_V + hk * 64 + 8 * ch);
    }
    const f32x4 rv = *(const f32x4*)(rope + ((tid & 3) >> 1) * 32768 + (size_t)(n * 128 + (tid >> 2)) * 8 + (tid & 1) * 4);
    f32x4 gk[4], gq[4], goa[4];
#pragma unroll
    for (int i = 0; i < 4; ++i) gk[i] = *(const f32x4*)(g_k + 16 * part + 4 * i);
    gq[0] = *(const f32x4*)(g_q + 8 * quad); gq[1] = *(const f32x4*)(g_q + 8 * quad + 4); gq[2] = *(const f32x4*)(g_q + 32 + 8 * quad); gq[3] = *(const f32x4*)(g_q + 32 + 8 * quad + 4);
#pragma unroll
    for (int dt = 0; dt < 4; ++dt) goa[dt] = *(const f32x4*)(g_oa + head * 64 + dt * 16 + 4 * quad);
    const float sinkv = sinks[head] * LOG2E;
    *(LAS f32x4*)(RT + (tid >> 2) * 16 + (tid & 3) * 4) = rv;
#pragma unroll
    for (int it = 0; it < 2; ++it) {
        const int row = (tid + 512 * it) >> 2; const bool valid = (n - 1) * 128 + row >= 0;
        const u32x4 r0 = kr[it][0], r1 = kr[it][1];
        float x[16];
#pragma unroll
        for (int i = 0; i < 4; ++i) { x[2 * i] = bf_lo(r0[i]); x[2 * i + 1] = bf_hi(r0[i]); x[8 + 2 * i] = bf_lo(r1[i]); x[8 + 2 * i + 1] = bf_hi(r1[i]); }
        float ss = 0.f;
#pragma unroll
        for (int i = 0; i < 16; ++i) ss += x[i] * x[i];
        ss = dpp_add<0xB1>(ss); ss = dpp_add<0x4E>(ss);
        const float rstd = 1.0f / sqrtf(ss * (1.0f / 64.0f) + EPS);
#pragma unroll
        for (int i = 0; i < 16; ++i) x[i] = x[i] * rstd * gk[i >> 2][i & 3];
#pragma unroll
        for (int i = 0; i < 8; ++i) { const float cs = kcs[it][i >> 2][i & 3], sn = kcs[it][2 + (i >> 2)][i & 3]; const float t1 = x[i], t2 = x[8 + i];
            x[i] = part == 0 ? t1 * cs - t2 * sn : t1; x[8 + i] = part == 0 ? t2 * cs + t1 * sn : t2; }
        u32x4 w0, w1;
#pragma unroll
        for (int i = 0; i < 4; ++i) { w0[i] = valid ? cvtpk(x[2 * i], x[2 * i + 1]) : 0u; w1[i] = valid ? cvtpk(x[8 + 2 * i], x[8 + 2 * i + 1]) : 0u; }
        LAS bf16_t* d = Ks + row * KS_PITCH + 16 * part;
        *(LAS u32x4*)d = w0; *(LAS u32x4*)(d + 8) = w1;
    }
#pragma unroll
    for (int it = 0; it < 4; ++it) {
        const int task = tid + 512 * it, row = task & 255, ch = task >> 8; const bool valid = (n - 1) * 128 + row >= 0;
        u32x4 r = vr[it];
        if (!valid) r = (u32x4){0u, 0u, 0u, 0u};
#pragma unroll
        for (int i = 0; i < 4; ++i) { Vt[(8 * ch + 2 * i) * VT_PITCH + row] = (bf16_t)(r[i] & 0xffffu); Vt[(8 * ch + 2 * i + 1) * VT_PITCH + row] = (bf16_t)(r[i] >> 16); }
    }
    VM_WAIT();
    LDS_WAIT();
    __syncthreads();
#pragma unroll
    for (int i = 0; i < 4; ++i) { gq[i] = gq[i] * (0.125f * LOG2E); asm volatile("" : "+v"(gq[i])); asm volatile("" : "+v"(goa[i])); }
    const int lq = 4 * quad - c;
    const LAS unsigned char* qstash = lds + qstash_off(wave) + lane * 16;
    for (int qt = 0; qt < 4; ++qt) {
        const int qi0 = hf * 64 + qt * 16, kt0 = (qi0 >> 4) & ~1, qi = qi0 + c, pos = n * 128 + qi;
        const size_t tq = rowb + pos;
        bf16x8 qf[2];
        {
            const u32x4 r0 = *(const LAS u32x4*)(qstash + qt * 2048), r1 = *(const LAS u32x4*)(qstash + qt * 2048 + 1024);
            float x0[8], x1[8];
#pragma unroll
            for (int i = 0; i < 4; ++i) { x0[2 * i] = bf_lo(r0[i]); x0[2 * i + 1] = bf_hi(r0[i]); x1[2 * i] = bf_lo(r1[i]); x1[2 * i + 1] = bf_hi(r1[i]); }
            float ss = 0.f;
#pragma unroll
            for (int i = 0; i < 8; ++i) ss += x0[i] * x0[i] + x1[i] * x1[i];
            ss = xrow_sum(ss);
            const float rstd = __builtin_amdgcn_rsqf(ss * (1.0f / 64.0f) + EPS);
#pragma unroll
            for (int i = 0; i < 8; ++i) { x0[i] = x0[i] * rstd * gq[i >> 2][i & 3]; x1[i] = x1[i] * rstd * gq[2 + (i >> 2)][i & 3]; }
            const LAS float* rt = RT + qi * 16;
            const f32x4 rc0 = *(const LAS f32x4*)rt, rc1 = *(const LAS f32x4*)(rt + 4), rs0 = *(const LAS f32x4*)(rt + 8), rs1 = *(const LAS f32x4*)(rt + 12);
#pragma unroll
            for (int i = 0; i < 8; ++i) {
                const float other = xrow16_other(x0[i], (quad & 1) != 0);
                const float cs = i < 4 ? rc0[i & 3] : rc1[i & 3], sn = i < 4 ? rs0[i & 3] : rs1[i & 3];
                const float rot = (quad == 0) ? (x0[i] * cs - other * sn) : (x0[i] * cs + other * sn);
                x0[i] = (quad < 2) ? rot : x0[i];
            }
            u32x4 w0, w1;
#pragma unroll
            for (int i = 0; i < 4; ++i) { w0[i] = cvtpk(x0[2 * i], x0[2 * i + 1]); w1[i] = cvtpk(x1[2 * i], x1[2 * i + 1]); }
            qf[0] = __builtin_bit_cast(bf16x8, w0); qf[1] = __builtin_bit_cast(bf16x8, w1);
        }
        f32x4 s[10];
#pragma unroll
        for (int t = 0; t < 10; ++t) {
            s[t] = (f32x4){0.f, 0.f, 0.f, 0.f};
            const LAS bf16_t* kp = Ks + ((kt0 + t) * 16 + c) * KS_PITCH + 8 * quad;
#pragma unroll
            for (int ks = 0; ks < 2; ++ks) { const bf16x8 kf = *(const LAS bf16x8*)(kp + ks * 32); s[t] = __builtin_amdgcn_mfma_f32_16x16x32_bf16(kf, qf[ks], s[t], 0, 0, 0); }
        }
        if (n == 0) {
#pragma unroll
            for (int t = 0; t < 10; ++t)
#pragma unroll
                for (int r = 0; r < 4; ++r) { const int kj = (kt0 + t) * 16 + 4 * quad + r; const bool ok = (kj >= qi + 1) && (kj <= qi + 128) && kj >= 128; s[t][r] = ok ? s[t][r] : -1e30f; }
        } else {
            const int L = kt0 * 16 - qi0 + lq;
#pragma unroll
            for (int t = 0; t < 2; ++t)
#pragma unroll
                for (int r = 0; r < 4; ++r) { s[t][r] = (L >= 1 - (16 * t + r)) ? s[t][r] : -1e30f; s[8 + t][r] = (L <= 128 - (16 * (8 + t) + r)) ? s[8 + t][r] : -1e30f; }
        }
        float m = sinkv;
#pragma unroll
        for (int t = 0; t < 10; ++t)
#pragma unroll
            for (int r = 0; r < 4; ++r) m = __builtin_amdgcn_fmed3f(m, s[t][r], __builtin_inff());
        m = xrow_max(m);
#pragma unroll
        for (int t = 0; t < 10; ++t)
#pragma unroll
            for (int r = 0; r < 4; ++r) s[t][r] = __builtin_amdgcn_exp2f(s[t][r] - m);
        bf16x8 pf[5];
#pragma unroll
        for (int i = 0; i < 5; ++i) { u32x4 w; w.x = cvtpk(s[2 * i][0], s[2 * i][1]); w.y = cvtpk(s[2 * i][2], s[2 * i][3]);
            w.z = cvtpk(s[2 * i + 1][0], s[2 * i + 1][1]); w.w = cvtpk(s[2 * i + 1][2], s[2 * i + 1][3]); pf[i] = __builtin_bit_cast(bf16x8, w); }
        f32x4 osum = (f32x4){0.f, 0.f, 0.f, 0.f};
        { const unsigned ow = (c & 3) == 0 ? 0x3F803F80u : 0u; const bf16x8 onesA = __builtin_bit_cast(bf16x8, (u32x4){ow, ow, ow, ow});
#pragma unroll
          for (int i = 0; i < 5; ++i) osum = __builtin_amdgcn_mfma_f32_16x16x32_bf16(onesA, pf[i], osum, 0, 0, 0); }
        const float inv = __builtin_amdgcn_rcpf(osum[0] + __builtin_amdgcn_exp2f(sinkv - m));
        f32x4 o[4]; float ss = 0.f;
#pragma unroll
        for (int dt = 0; dt < 4; ++dt) {
            o[dt] = (f32x4){0.f, 0.f, 0.f, 0.f};
            const LAS bf16_t* vp = Vt + (dt * 16 + c) * VT_PITCH + kt0 * 16 + 4 * quad;
#pragma unroll
            for (int i = 0; i < 5; ++i) { const u32x2 lo = *(const LAS u32x2*)(vp + i * 32), hi = *(const LAS u32x2*)(vp + i * 32 + 16);
                u32x4 w; w.x = lo.x; w.y = lo.y; w.z = hi.x; w.w = hi.y;
                o[dt] = __builtin_amdgcn_mfma_f32_16x16x32_bf16(__builtin_bit_cast(bf16x8, w), pf[i], o[dt], 0, 0, 0); }
            ss += (o[dt][0] * o[dt][0] + o[dt][1] * o[dt][1]) + (o[dt][2] * o[dt][2] + o[dt][3] * o[dt][3]);
        }
        ss = xrow_sum(ss);
        const float fac = inv * __builtin_amdgcn_rsqf(inv * inv * ss * (1.0f / 64.0f) + EPS) * MIX_SCALE;
        if (HOST) {
            tab_row_convert<ISV>(T, tabk0 + qt, tnx, lane);
            tab_row_load(T, tabk0 + qt + 1, tnx, lane);
        }
        unsigned char* orow = MIXED + tq * DM + head * 64 + 4 * quad;
#pragma unroll
        for (int dt = 0; dt < 4; ++dt) *(unsigned*)(orow + dt * 16) = pack_i8x4_sat(o[dt] * goa[dt], fac);
    }
    __syncthreads();
}
__device__ __forceinline__ void conv_item(int item, const bf16_t* PROJ, const float* conv_w, const float* g_oc, unsigned char* MIXED, int lane) {
    const int t0 = item * 16, ch = 16 * lane;
    float w0[16], w1[16], w2[16], gg[16], up2[16], up1[16];
#pragma unroll
    for (int i = 0; i < 16; ++i) { w0[i] = conv_w[ch + i]; w1[i] = conv_w[1024 + ch + i]; w2[i] = conv_w[2048 + ch + i]; gg[i] = g_oc[ch + i]; up2[i] = 0.f; up1[i] = 0.f; }
    if ((t0 & (SEQ - 1)) != 0) {
#pragma unroll
        for (int h = 0; h < 2; ++h) {
            const bf16_t* pr = PROJ + (size_t)(t0 - 2 + h) * INC + ch;
            const u32x4 c0 = __builtin_nontemporal_load((const u32x4*)(pr + COL_C)), c1 = __builtin_nontemporal_load((const u32x4*)(pr + COL_C + 8));
#pragma unroll
            for (int i = 0; i < 4; ++i) {
                const float u0 = bf_lo(c0[i]), u1 = bf_hi(c0[i]), u2 = bf_lo(c1[i]), u3 = bf_hi(c1[i]);
                if (h == 0) { up2[2 * i] = u0; up2[2 * i + 1] = u1; up2[8 + 2 * i] = u2; up2[8 + 2 * i + 1] = u3; }
                else        { up1[2 * i] = u0; up1[2 * i + 1] = u1; up1[8 + 2 * i] = u2; up1[8 + 2 * i + 1] = u3; }
            }
        }
    }
    u32x4 nb0, nb1, nc0, nc1;
    { const bf16_t* pr = PROJ + (size_t)t0 * INC + ch; nb0 = __builtin_nontemporal_load((const u32x4*)(pr + COL_B)); nb1 = __builtin_nontemporal_load((const u32x4*)(pr + COL_B + 8)); nc0 = __builtin_nontemporal_load((const u32x4*)(pr + COL_C)); nc1 = __builtin_nontemporal_load((const u32x4*)(pr + COL_C + 8)); }
#pragma unroll
    for (int r = 0; r < 16; ++r) {
        const u32x4 b0 = nb0, b1 = nb1, c0 = nc0, c1 = nc1;
        { const bf16_t* pr = PROJ + (size_t)(t0 + (r < 15 ? r + 1 : r)) * INC + ch; nb0 = __builtin_nontemporal_load((const u32x4*)(pr + COL_B)); nb1 = __builtin_nontemporal_load((const u32x4*)(pr + COL_B + 8)); nc0 = __builtin_nontemporal_load((const u32x4*)(pr + COL_C)); nc1 = __builtin_nontemporal_load((const u32x4*)(pr + COL_C + 8)); }
        float u[16], bg[16], y[16];
#pragma unroll
        for (int i = 0; i < 4; ++i) {
            u[2 * i] = bf_lo(c0[i]); u[2 * i + 1] = bf_hi(c0[i]); u[8 + 2 * i] = bf_lo(c1[i]); u[8 + 2 * i + 1] = bf_hi(c1[i]);
            bg[2 * i] = bf_lo(b0[i]); bg[2 * i + 1] = bf_hi(b0[i]); bg[8 + 2 * i] = bf_lo(b1[i]); bg[8 + 2 * i + 1] = bf_hi(b1[i]);
        }
        float ss = 0.f;
#pragma unroll
        for (int i = 0; i < 16; ++i) { y[i] = bg[i] * (w0[i] * up2[i] + w1[i] * up1[i] + w2[i] * u[i]); ss += y[i] * y[i]; up2[i] = up1[i]; up1[i] = u[i]; }
        ss += __shfl_xor(ss, 1); ss += __shfl_xor(ss, 2);
        const float rstd = 1.0f / sqrtf(ss * (1.0f / 64.0f) + EPS);
        u32x4 o0;
#pragma unroll
        for (int i = 0; i < 4; ++i) o0[i] = pack_i8x4_sat((f32x4){y[4 * i] * rstd * gg[4 * i], y[4 * i + 1] * rstd * gg[4 * i + 1], y[4 * i + 2] * rstd * gg[4 * i + 2], y[4 * i + 3] * rstd * gg[4 * i + 3]}, MIX_SCALE);
        *(u32x4*)(MIXED + (size_t)(t0 + r) * DM + 1024 + ch) = o0;
    }
}

__device__ __forceinline__ void ins16(float (&L)[16], float x) {
#pragma unroll
    for (int j = 0; j < 16; ++j) { const float hi = fmaxf(L[j], x); x = fminf(L[j], x); L[j] = hi; }
}
template <int C> __device__ __forceinline__ float pack7(float s, unsigned q32) { unsigned t; asm("v_and_b32 %0, 0xffffff80, %1\n\tv_or3_b32 %0, %0, %2, %3" : "=&v"(t) : "v"(s), "v"(q32), "n"(C)); return __uint_as_float(t); }
template <int C> __device__ __forceinline__ float pack8(float s) { unsigned t; asm("v_and_b32 %0, 0xffffff00, %1\n\tv_or_b32 %0, %2, %0" : "=&v"(t) : "v"(s), "n"(C)); return __uint_as_float(t); }
template <int KEY> __device__ __forceinline__ float pack_lo(unsigned u) { unsigned t; asm("v_lshlrev_b32 %0, 16, %1\n\tv_or_b32 %0, %2, %0" : "=&v"(t) : "v"(u), "n"(KEY)); return __uint_as_float(t); }
template <int KEY> __device__ __forceinline__ float pack_hi(unsigned u) { unsigned t; asm("v_and_b32 %0, 0xffff0000, %1\n\tv_or_b32 %0, %2, %0" : "=&v"(t) : "v"(u), "n"(KEY)); return __uint_as_float(t); }
__device__ __forceinline__ unsigned key_of(unsigned x) { return ((x >> 2) & 7u) * 16u + (x >> 5) * 4u + (x & 3u); }
#define CE_DESC(a, b) do { const float hi_ = fmaxf(a, b), lo_ = fminf(a, b); a = hi_; b = lo_; } while (0)
__device__ __forceinline__ void bitonic_tail16(float (&L)[16]) {
#pragma unroll
    for (int d = 8; d >= 1; d >>= 1)
#pragma unroll
        for (int i = 0; i < 16; ++i) if ((i & d) == 0) CE_DESC(L[i], L[i + d]);
}
__device__ __forceinline__ void sort16_desc(float (&L)[16]) {
#define SN(i, j) CE_DESC(L[i], L[j]);
    SN(0,13) SN(1,12) SN(2,15) SN(3,14) SN(4,8) SN(5,6) SN(7,11) SN(9,10)
    SN(0,5) SN(1,7) SN(2,9) SN(3,4) SN(6,13) SN(8,14) SN(10,15) SN(11,12)
    SN(0,1) SN(2,3) SN(4,5) SN(6,8) SN(7,9) SN(10,11) SN(12,13) SN(14,15)
    SN(0,2) SN(1,3) SN(4,10) SN(5,11) SN(6,7) SN(8,9) SN(12,14) SN(13,15)
    SN(1,2) SN(3,12) SN(4,6) SN(5,7) SN(8,10) SN(9,11) SN(13,14)
    SN(1,4) SN(2,6) SN(5,8) SN(7,10) SN(9,13) SN(11,14)
    SN(2,4) SN(3,6) SN(9,12) SN(11,13)
    SN(3,5) SN(6,8) SN(7,9) SN(10,12)
    SN(3,4) SN(5,6) SN(7,8) SN(9,10) SN(11,12)
    SN(6,7) SN(8,9)
#undef SN
}
__device__ __forceinline__ void top16_of_two(float (&A)[16], const float (&B)[16]) {
#pragma unroll
    for (int j = 0; j < 16; ++j) A[j] = fmaxf(A[j], B[15 - j]);
    bitonic_tail16(A);
}
__device__ __forceinline__ void merge16(float (&L)[16], int mask) {
    float P[16];
#pragma unroll
    for (int j = 0; j < 16; ++j) P[j] = __shfl_xor(L[j], mask);
    top16_of_two(L, P);
}
constexpr int SKT_OFF = 8192 + 512, SKT_PITCH = 272;
__device__ __forceinline__ void peer_chunk(int tokb, const bf16_t* QP, const bf16_t* SK, const unsigned char* H8, const float* SH, const unsigned char* UB, const float* SU, const unsigned char* VB, const float* mod, const bf16_t* X1B, float* out,
                                           LAS unsigned char* lds, int tid, int wave, int lane) {
    LAS unsigned char* wl = lds + wave * 16384;
    int tok0 = tokb + wave * 16;
    LAS bf16_t* eidx = (LAS bf16_t*)wl; LAS bf16_t* gate = (LAS bf16_t*)(wl + 4096); LAS float* accL = (LAS float*)(wl + 8192); LAS unsigned char* ids = wl + 8192;
#pragma nounroll
    for (int rep7a_ = 0; rep7a_ < REP7A; ++rep7a_) {
#pragma nounroll
    for (int i2 = 0; i2 < 2; ++i2) {
        const int p = tid + 512 * i2, tkn = p & 127, h = p >> 7;
        const u32x4* srow = (const u32x4*)QP + (size_t)(h * 32) * MTOK + tokb + tkn;
        float T0[16], T1[16];
#pragma unroll
        for (int hf = 0; hf < 2; ++hf) {
            float L[16], Bv[16];
#define PKC(ch, DST) { const u32x4 a_ = __builtin_nontemporal_load(srow + (size_t)(hf * 16 + 2 * (ch)) * MTOK), b_ = __builtin_nontemporal_load(srow + (size_t)(hf * 16 + 2 * (ch) + 1) * MTOK); \
                DST[0] = pack_lo<(ch) * 16 + 0>(a_.x); DST[1] = pack_hi<(ch) * 16 + 1>(a_.x); DST[2] = pack_lo<(ch) * 16 + 2>(a_.y); DST[3] = pack_hi<(ch) * 16 + 3>(a_.y); \
                DST[4] = pack_lo<(ch) * 16 + 4>(a_.z); DST[5] = pack_hi<(ch) * 16 + 5>(a_.z); DST[6] = pack_lo<(ch) * 16 + 6>(a_.w); DST[7] = pack_hi<(ch) * 16 + 7>(a_.w); \
                DST[8] = pack_lo<(ch) * 16 + 8>(b_.x); DST[9] = pack_hi<(ch) * 16 + 9>(b_.x); DST[10] = pack_lo<(ch) * 16 + 10>(b_.y); DST[11] = pack_hi<(ch) * 16 + 11>(b_.y); \
                DST[12] = pack_lo<(ch) * 16 + 12>(b_.z); DST[13] = pack_hi<(ch) * 16 + 13>(b_.z); DST[14] = pack_lo<(ch) * 16 + 14>(b_.w); DST[15] = pack_hi<(ch) * 16 + 15>(b_.w); }
            PKC(0, L) sort16_desc(L);
            PKC(1, Bv) sort16_desc(Bv); top16_of_two(L, Bv);
            PKC(2, Bv) sort16_desc(Bv); top16_of_two(L, Bv);
            PKC(3, Bv) sort16_desc(Bv); top16_of_two(L, Bv);
            PKC(4, Bv) sort16_desc(Bv); top16_of_two(L, Bv);
            PKC(5, Bv) sort16_desc(Bv); top16_of_two(L, Bv);
            PKC(6, Bv) sort16_desc(Bv); top16_of_two(L, Bv);
            PKC(7, Bv) sort16_desc(Bv); top16_of_two(L, Bv);
#undef PKC
#pragma unroll
            for (int j = 0; j < 16; ++j) { if (hf == 0) T0[j] = L[j]; else T1[j] = L[j]; }
        }
        float R[16], Bc[16], Cc[16];
#define CAND(i, j) pack8<(i) * 16 + (j)>(T0[i] + T1[j])
#pragma unroll
        for (int j = 0; j < 16; ++j) R[j] = __uint_as_float((__float_as_uint(T0[0] + T1[j]) & 0xFFFFFF00u) | (unsigned)j);
        Bc[0] = CAND(1, 0); Bc[1] = CAND(1, 1); Bc[2] = CAND(1, 2); Bc[3] = CAND(1, 3); Bc[4] = CAND(1, 4); Bc[5] = CAND(1, 5); Bc[6] = CAND(1, 6); Bc[7] = CAND(1, 7);
        Bc[8] = CAND(2, 0); Bc[9] = CAND(2, 1); Bc[10] = CAND(2, 2); Bc[11] = CAND(2, 3); Bc[12] = CAND(2, 4); Bc[13] = CAND(3, 0); Bc[14] = CAND(3, 1); Bc[15] = CAND(3, 2);
        Cc[0] = CAND(3, 3); Cc[1] = CAND(4, 0); Cc[2] = CAND(4, 1); Cc[3] = CAND(4, 2); Cc[4] = CAND(5, 0); Cc[5] = CAND(5, 1); Cc[6] = CAND(6, 0); Cc[7] = CAND(6, 1);
        Cc[8] = CAND(7, 0); Cc[9] = CAND(7, 1); Cc[10] = CAND(8, 0); Cc[11] = CAND(9, 0); Cc[12] = CAND(10, 0); Cc[13] = CAND(11, 0); Cc[14] = CAND(12, 0); Cc[15] = CAND(13, 0);
        sort16_desc(Bc); sort16_desc(Cc); top16_of_two(R, Bc); top16_of_two(R, Cc);
        ins16(R, CAND(14, 0)); ins16(R, CAND(15, 0));
#undef CAND
        {
            LAS unsigned char* idb = lds + wave * 16384 + 8192 + lane * 32;
            u32x4 i0, i1;
#pragma unroll
            for (int w = 0; w < 4; ++w) {
                i0[w] = (__float_as_uint(T0[4 * w]) & 0x7Fu) | ((__float_as_uint(T0[4 * w + 1]) & 0x7Fu) << 8) | ((__float_as_uint(T0[4 * w + 2]) & 0x7Fu) << 16) | ((__float_as_uint(T0[4 * w + 3]) & 0x7Fu) << 24);
                i1[w] = (__float_as_uint(T1[4 * w]) & 0x7Fu) | ((__float_as_uint(T1[4 * w + 1]) & 0x7Fu) << 8) | ((__float_as_uint(T1[4 * w + 2]) & 0x7Fu) << 16) | ((__float_as_uint(T1[4 * w + 3]) & 0x7Fu) << 24); }
            *(LAS u32x4*)idb = i0; *(LAS u32x4*)(idb + 16) = i1;
            float e[16], sum = 0.f;
#pragma unroll
            for (int k = 0; k < 16; ++k) { e[k] = __builtin_amdgcn_exp2f((R[k] - R[0]) * LOG2E); sum += e[k]; }
            const float inv = 1.0f / sum;
            LDS_WAIT(); asm volatile("" ::: "memory");
            unsigned ex[16];
#pragma unroll
            for (int k = 0; k < 16; ++k) { const unsigned code = __float_as_uint(R[k]) & 0xFFu; ex[k] = (unsigned)idb[code >> 4] * 128u + (unsigned)idb[16 + (code & 15u)]; }
            LAS unsigned char* tb = lds + (tkn >> 4) * 16384 + ((tkn & 15) * 128 + h * 16) * 2;
            u32x4 ea, eb, ga, gb;
#pragma unroll
            for (int w = 0; w < 4; ++w) { ea[w] = ex[2 * w] | (ex[2 * w + 1] << 16); eb[w] = ex[8 + 2 * w] | (ex[8 + 2 * w + 1] << 16);
                ga[w] = cvtpk(e[2 * w] * inv, e[2 * w + 1] * inv); gb[w] = cvtpk(e[8 + 2 * w] * inv, e[8 + 2 * w + 1] * inv); }
            *(LAS u32x4*)tb = ea; *(LAS u32x4*)(tb + 16) = eb; *(LAS u32x4*)(tb + 4096) = ga; *(LAS u32x4*)(tb + 4096 + 16) = gb;
        }
    }
    LDS_WAIT();
    __syncthreads();
    }
    LDS_WAIT(); asm volatile("" ::: "memory");
    int lane_b = lane; asm volatile("" : "+v"(lane_b));
    const int g = lane_b >> 3, k = lane_b & 7; const unsigned k16 = (unsigned)k * 16u;
    LAS int* accI = (LAS int*)accL;
#pragma nounroll
    for (int rep7u_ = 0; rep7u_ < REP7U; ++rep7u_) {
    LDS_WAIT(); asm volatile("" ::: "memory");
    for (int i = lane; i < 2048; i += 64) accI[i] = 0;
    LDS_WAIT(); asm volatile("" ::: "memory");
    asm volatile("" : "+s"(tok0));
    const unsigned char* hbase = H8 + (size_t)(tok0 + g) * DM + k * 16;
    u32x4 hn = __builtin_nontemporal_load((const u32x4*)hbase);
    for (int s = 0; s < 16; ++s) {
        const unsigned char* Us = UB + (size_t)s * (PEER_N * 128);
#pragma unroll
        for (int r = 0; r < 2; ++r) {
            const int tl = r * 8 + g;
            const u32x4 hq = hn;
            { const int sn = r ? s + 1 : s, rn = r ^ 1; if (sn < 16) hn = __builtin_nontemporal_load((const u32x4*)(hbase + (size_t)rn * 8 * DM + sn * 128)); }
            const LAS bf16_t* ei = eidx + tl * 128;
            LAS int* ap = accI + tl * 128 + k;
#pragma nounroll
            for (int ib2 = 0; ib2 < 8; ++ib2) {
                u32x4 uv[16];
#pragma unroll
                for (int q = 0; q < 16; ++q) { const unsigned e = ei[ib2 * 16 + q]; uv[q] = *(const u32x4*)(Us + (size_t)(unsigned)((e << 7) + k16)); }
#pragma unroll
                for (int hb = 0; hb < 2; ++hb) {
                    int p[8];
#pragma unroll
                    for (int ii = 0; ii < 8; ++ii) { const u32x4 v = uv[hb * 8 + ii];
                        p[ii] = __builtin_amdgcn_sdot4((int)v.x, (int)hq.x, __builtin_amdgcn_sdot4((int)v.y, (int)hq.y, __builtin_amdgcn_sdot4((int)v.z, (int)hq.z, __builtin_amdgcn_sdot4((int)v.w, (int)hq.w, 0, false), false), false), false); }
                    int a4[4], a2[2];
#pragma unroll
                    for (int j = 0; j < 4; ++j) { const int send = (k & 4) ? p[j] : p[j + 4], keep = (k & 4) ? p[j + 4] : p[j]; a4[j] = keep + dpp_movi<0x141>(send); }
#pragma unroll
                    for (int j = 0; j < 2; ++j) { const int send = (k & 2) ? a4[j] : a4[j + 2], keep = (k & 2) ? a4[j + 2] : a4[j]; a2[j] = keep + dpp_movi<0x1B>(send); }
                    const int send = (k & 1) ? a2[0] : a2[1], keep = (k & 1) ? a2[1] : a2[0];
                    const int tot = keep + dpp_movi<0xB1>(send);
                    __hip_atomic_fetch_add(ap + ib2 * 16 + hb * 8, tot, __ATOMIC_RELAXED, __HIP_MEMORY_SCOPE_WORKGROUP);
                }
            }
        }
    }
    }
    LDS_WAIT(); asm volatile("" ::: "memory");
    LAS bf16_t* wgt = gate;
    for (int i = lane; i < 2048; i += 64) {
        const float a = (float)accI[i] * SU[eidx[i]] * SH[tok0 + (i >> 7)];
        const float ge = 0.5f * a * (1.0f + erff(a * 0.70710678118654752f));
        wgt[i] = (bf16_t)(cvtpk(bf_lo((unsigned)gate[i]) * ge * (1.0f / V_SCALE), 0.f) & 0xffffu);
    }
    LDS_WAIT(); asm volatile("" ::: "memory");
    const float* g2 = mod + (size_t)(tok0 >> 12) * MODW + 5 * DM;
#pragma nounroll
    for (int rep7v_ = 0; rep7v_ < REP7V; ++rep7v_)
    for (int s = 0; s < 16; ++s) {
        const unsigned char* Vs = VB + (size_t)s * (PEER_N * 128);
        f32x4 gvv[4];
#pragma unroll
        for (int q = 0; q < 4; ++q) gvv[q] = *(const f32x4*)(g2 + s * 128 + k * 16 + 4 * q);
#pragma unroll
        for (int r = 0; r < 2; ++r) {
            const int tl = r * 8 + g;
            float* orow = out + (size_t)(tok0 + tl) * DM + s * 128 + k * 16;
            const bf16_t* xrow = X1B + (size_t)(tok0 + tl) * DM + s * 128 + k * 16;
            const u32x4 xb0 = __builtin_nontemporal_load((const u32x4*)xrow), xb1 = __builtin_nontemporal_load((const u32x4*)(xrow + 8));
            const LAS bf16_t* ei = eidx + tl * 128; const LAS bf16_t* wi = wgt + tl * 128;
            float y[16];
#pragma unroll
            for (int i = 0; i < 16; ++i) y[i] = 0.f;
#pragma nounroll
            for (int b = 0; b < 8; ++b) {
                u32x4 vq[16];
#pragma unroll
                for (int q = 0; q < 16; ++q) { const unsigned e = ei[b * 16 + q]; vq[q] = *(const u32x4*)(Vs + (size_t)(unsigned)((e << 7) + k16)); }
#pragma unroll
                for (int q = 0; q < 16; ++q) {
                    const float wf = bf_lo((unsigned)wi[b * 16 + q]); const u32x4 vv = vq[q];
#pragma unroll
                    for (int w = 0; w < 4; ++w) { const f32x2 f01 = __builtin_amdgcn_cvt_pk_f32_fp8(vv[w], false), f23 = __builtin_amdgcn_cvt_pk_f32_fp8(vv[w], true);
                        y[4 * w] = fmaf(wf, f01.x, y[4 * w]); y[4 * w + 1] = fmaf(wf, f01.y, y[4 * w + 1]); y[4 * w + 2] = fmaf(wf, f23.x, y[4 * w + 2]); y[4 * w + 3] = fmaf(wf, f23.y, y[4 * w + 3]); }
                }
            }
#pragma unroll
            for (int q = 0; q < 4; ++q) { f32x4 o; const f32x4 gv = gvv[q];
                const u32x4 xb = q < 2 ? xb0 : xb1; const unsigned xlo = (q & 1) ? xb.z : xb.x, xhi = (q & 1) ? xb.w : xb.y;
                const float x1v[4] = {bf_lo(xlo), bf_hi(xlo), bf_lo(xhi), bf_hi(xhi)};
#pragma unroll
                for (int i = 0; i < 4; ++i) o[i] = x1v[i] + gv[i] * y[4 * q + i];
                if (rep7v_ == REP7V - 1) *(f32x4*)(orow + 4 * q) = o; else asm volatile("" :: "v"(o)); }
        }
    }
}

constexpr int N_PHASES = 8;
struct Args { const float* in[18]; float* out; unsigned char* ws; int ph_lo, ph_hi; };
__global__ void __launch_bounds__(NWAVES * 64, 2) hymba_fwd(Args args) {
    extern __shared__ __attribute__((aligned(16))) unsigned char lds_raw[];
    LAS unsigned char* lds = (LAS unsigned char*)lds_raw;
    volatile LAS unsigned* MISC = (volatile LAS unsigned*)(lds + MISC_OFF);
    const int wave = __builtin_amdgcn_readfirstlane((int)threadIdx.x >> 6);
    const int G = gridDim.x, bx = blockIdx.x;
    const int gw = bx * NWAVES + wave, NGW = G * NWAVES;
#define FRESH_IDS() const int lane = fresh_lane(); const int tid = wave * 64 + lane; (void)tid
    unsigned char* ws = args.ws;
    const float* x = args.in[0]; const float* cvec = args.in[1]; const float* w_ada = args.in[2]; const float* b_ada = args.in[3]; const float* g_norm1 = args.in[4];
    const float* w_in = args.in[5]; const float* g_q = args.in[6]; const float* g_k = args.in[7]; const float* sinks = args.in[8]; const float* conv_w = args.in[9];
    const float* g_oa = args.in[10]; const float* g_oc = args.in[11]; const float* w_out = args.in[12]; const float* g_norm2 = args.in[13]; const float* w_pq = args.in[14];
    const float* subkeys = args.in[15]; const float* peer_u = args.in[16]; const float* peer_v = args.in[17];
    float* out = args.out;
    float* mod = (float*)(ws + WS_MOD); float* rope = (float*)(ws + WS_ROPE);
    bf16_t* SK = (bf16_t*)(ws + WS_SK); bf16_t* WIN = (bf16_t*)(ws + WS_WIN); bf16_t* WOUT = (bf16_t*)(ws + WS_WOUT); bf16_t* WPQ = (bf16_t*)(ws + WS_WPQ);
    unsigned char* UB = ws + WS_UB; unsigned char* VB = ws + WS_VB; unsigned char* H8 = ws + WS_H8; float* SU = (float*)(ws + WS_SU); float* SH = (float*)(ws + WS_SH); bf16_t* XN = (bf16_t*)(ws + WS_XN); bf16_t* PROJ = (bf16_t*)(ws + WS_PROJ);
    bf16_t* QP = (bf16_t*)(ws + WS_QP); bf16_t* X1B = (bf16_t*)(ws + WS_X1B); unsigned char* MIXED = ws + WS_MIXED; unsigned char* XN8 = ws + WS_XN; float* SX1 = (float*)(ws + WS_SX1); bf16_t* W2 = (bf16_t*)(ws + WS_XN + 64 * MiB);
    unsigned* ctl = (unsigned*)(ws + WS_CTL);

    { FRESH_IDS(); for (int u = tid; u < (LDS_BYTES - LDSCTL_OFF) / 4; u += NWAVES * 64) ((LAS unsigned*)(lds + LDSCTL_OFF))[u] = 0u; }
    __syncthreads();
    XcdBarrier bar; bar.bar = ctl + CW_BAR; bar.x = 0; bar.st = nullptr; bar.wave = wave;
    if (MK_N_LAUNCHES == 1) bar = xcd_barrier_post(ctl + CW_BAR, MISC + 8, wave);
    const int lo = args.ph_lo, hi = args.ph_hi;
#define IN(k) (lo <= (k) && (k) < hi)
#define SEAM(k) do { if (IN(k) && IN((k) + 1)) xcd_barrier(bar); } while (0)

#pragma nounroll
    for (int rep_ = 0; rep_ < REP0; ++rep_) { if (rep_) xcd_barrier(bar);
    if (IN(0)) { FRESH_IDS();
#pragma nounroll
        for (int ra_ = 0; ra_ < REP0A; ++ra_)
        for (int it = bx; it < MODW / 64; it += G) p0_ada_item(cvec, w_ada, b_ada, mod, lds, it, tid, wave, lane);
        LAS float* scr = (LAS float*)(lds + wave * 16384);
        constexpr int I_IN = (DM / 64) * (INC / 32), I_SQ = (DM / 64) * (DM / 32), I_TAB = PEER_N * DM / 2048, I_W2 = 512, I_ROPE = 512;
        (void)scr;
        { const int nfree = G > MODW / 64 ? (G - MODW / 64) * NWAVES : 0;
          if (nfree > 0) { if (bx >= MODW / 64) for (int r = (bx - MODW / 64) * NWAVES + wave; r < I_W2; r += nfree) p0_w2_item(w_pq, subkeys, W2, ctl + CW_CMX_PQ, r, lane); }
          else for (int r = gw; r < I_W2; r += NGW) p0_w2_item(w_pq, subkeys, W2, ctl + CW_CMX_PQ, r, lane); }
#pragma nounroll
        for (int rc_ = 0; rc_ < REP0C; ++rc_)
        for (int r = gw; r < I_IN + I_SQ; r += NGW) { if (r < I_IN) p0_colmax_item(w_in, INC, ctl + CW_CMX_IN, r, lane); else p0_colmax_item(w_out, DM, ctl + CW_CMX_OUT, r - I_IN, lane); }
        for (int r = gw; r < I_ROPE; r += NGW) p0_rope_item(rope, r, lane);
        if (G == 256) {   }
        else if (NGW * 8 == I_TAB) p0_tables8(peer_u, peer_v, UB, SU, VB, gw, NGW, lane);
        else for (int r = gw; r < 2 * I_TAB; r += NGW) { if (r < I_TAB) p0_i8_row(peer_u, UB, SU, r, lane); else p0_fp8_item(peer_v, VB, (size_t)(r - I_TAB) * 2048, V_SCALE, lane); }
    }
    }
    SEAM(0);
#pragma nounroll
    for (int rep_ = 0; rep_ < REP1; ++rep_) { if (rep_) xcd_barrier(bar);
    if (IN(1)) { FRESH_IDS(); norm_rows(x, g_norm1, mod, 0 * DM, 1 * DM, XN8, SX1, gw, NGW, lane);
        LAS float* scr = (LAS float*)(lds + wave * 16384);
        constexpr int I_IN = (DM / 64) * (INC / 32), I_SQ = (DM / 64) * (DM / 32);
        for (int it = gw; it < I_IN + I_SQ + DM; it += NGW) {
            int r = it;
            if (r < I_IN) { p1_transpose_i8_item<true>(w_in, DM, INC, (unsigned char*)WIN, ctl + CW_CMX_IN, scr, r, lane); continue; } r -= I_IN;
            if (r < I_SQ) { p1_transpose_i8_item<false>(w_out, DM, DM, (unsigned char*)WOUT, ctl + CW_CMX_OUT, scr, r, lane); continue; } r -= I_SQ;
            p1_w2_row(W2, (unsigned char*)WPQ, ctl + CW_CMX_PQ, r, lane);
        }
    }
    }
    SEAM(1);
#if REP2 > 1
    if (IN(2)) {
        pg8::Gemm g{(const bf16_t*)XN8, (const bf16_t*)WIN, MTOK, INC, DM / 2}; pg8::StaticOrder S; S.init(MTOK, INC, G, bx);
        pg8::EpiProjI8 E{PROJ, INC, SX1, ctl + CW_CMX_IN};
        pg8::gemm_phase<pg8::EpiProjI8, pg8::StaticOrder, true, true, true>(lds, g, S, E, wave);
    }
    xcd_barrier(bar);
#endif
    if (IN(2)) {
        pg8::Gemm g{(const bf16_t*)XN8, (const bf16_t*)WIN, MTOK, INC, DM / 2}; pg8::StaticOrder S; S.init(MTOK, INC, G, bx);
        pg8::EpiProjI8 E{PROJ, INC, SX1, ctl + CW_CMX_IN};
        pg8::gemm_phase<pg8::EpiProjI8, pg8::StaticOrder, true, true, true>(lds, g, S, E, wave);
    }
    SEAM(2);
#pragma nounroll
    for (int rep_ = 0; rep_ < REP3; ++rep_) { if (rep_) xcd_barrier(bar);
    if (IN(3)) { FRESH_IDS();
#ifndef REP3A
#define REP3A 1
#endif
#pragma nounroll
        for (int ra_ = 0; ra_ < REP3A; ++ra_)
        { f32x4 tcur[8], tnx[8];
          if (G != 256) {
              const TabCtx T{peer_u, UB, SU, 0};
              for (int u = bx; u < BATCH * 4 * 32; u += G) attn_unit<false, false>(u >> 7, (u >> 5) & 3, u & 31, PROJ, g_q, g_k, sinks, g_oa, rope, MIXED, lds, tid, wave, lane, T, 0, tcur, tnx);
          } else if (wave & 1) {
              const TabCtx T{peer_v, VB, SU, gw >> 1};
              tab_row_load(T, 0, tnx, lane);
              int ui = 0;
              for (int u = bx; u < BATCH * 4 * 32; u += G, ++ui) attn_unit<true, true>(u >> 7, (u >> 5) & 3, u & 31, PROJ, g_q, g_k, sinks, g_oa, rope, MIXED, lds, tid, wave, lane, T, ui * 4, tcur, tnx);
          } else {
              const TabCtx T{peer_u, UB, SU, gw >> 1};
              tab_row_load(T, 0, tnx, lane);
              int ui = 0;
              for (int u = bx; u < BATCH * 4 * 32; u += G, ++ui) attn_unit<true, false>(u >> 7, (u >> 5) & 3, u & 31, PROJ, g_q, g_k, sinks, g_oa, rope, MIXED, lds, tid, wave, lane, T, ui * 4, tcur, tnx);
          } }
        for (int it = gw; it < MTOK / 16; it += NGW) conv_item(it, PROJ, conv_w, g_oc, MIXED, lane);
    }
    }
    SEAM(3);
#if REP4 > 1
    if (IN(4)) {
        pg8::Gemm g{(const bf16_t*)MIXED, (const bf16_t*)WOUT, MTOK, DM, DM / 2}; pg8::StaticOrder S; S.init(MTOK, DM, G, bx);
        pg8::EpiResGateBf16I8 E{x, X1B, DM, mod + 2 * DM, MODW, 1.0f / MIX_SCALE, ctl + CW_CMX_OUT};
        pg8::gemm_phase<pg8::EpiResGateBf16I8, pg8::StaticOrder, true, true, true>(lds, g, S, E, wave);
    }
    xcd_barrier(bar);
#endif
    if (IN(4)) {
        pg8::Gemm g{(const bf16_t*)MIXED, (const bf16_t*)WOUT, MTOK, DM, DM / 2}; pg8::StaticOrder S; S.init(MTOK, DM, G, bx);
        pg8::EpiResGateBf16I8 E{x, X1B, DM, mod + 2 * DM, MODW, 1.0f / MIX_SCALE, ctl + CW_CMX_OUT};
        pg8::gemm_phase<pg8::EpiResGateBf16I8, pg8::StaticOrder, true, true, true>(lds, g, S, E, wave);
    }
    SEAM(4);
#pragma nounroll
    for (int rep_ = 0; rep_ < REP5; ++rep_) { if (rep_) xcd_barrier(bar);
    if (IN(5)) { FRESH_IDS(); norm_rows_bf16(X1B, g_norm2, mod, 3 * DM, 4 * DM, H8, SH, gw, NGW, lane); }
    }
    SEAM(5);
#if REP6 > 1
    if (IN(6)) {
        pg8::Gemm g{(const bf16_t*)H8, (const bf16_t*)WPQ, MTOK, DM, DM / 2}; pg8::StaticOrder S; S.init(MTOK, DM, G, bx);
        pg8::EpiScoresI8 E{QP, MTOK, SH, ctl + CW_CMX_PQ};
        pg8::gemm_phase<pg8::EpiScoresI8, pg8::StaticOrder, true, true, true>(lds, g, S, E, wave);
    }
    xcd_barrier(bar);
#endif
    if (IN(6)) {
        pg8::Gemm g{(const bf16_t*)H8, (const bf16_t*)WPQ, MTOK, DM, DM / 2}; pg8::StaticOrder S; S.init(MTOK, DM, G, bx);
        pg8::EpiScoresI8 E{QP, MTOK, SH, ctl + CW_CMX_PQ};
        pg8::gemm_phase<pg8::EpiScoresI8, pg8::StaticOrder, true, true, true>(lds, g, S, E, wave);
    }
    SEAM(6);
    if (IN(7)) { FRESH_IDS();
        for (int chunk = bx; chunk < MTOK / 128; chunk += G) peer_chunk(chunk * 128, QP, SK, H8, SH, UB, SU, VB, mod, X1B, out, lds, tid, wave, lane);
    }
#undef IN
#undef SEAM
}

extern "C" void kernel_launch(void* const* d_in, const int* in_sizes, int n_in, void* d_out, int out_size, void* d_ws, size_t ws_size, hipStream_t stream) {
    static int grid = 0;
    if (grid == 0) {
        if (n_in != 18 || in_sizes[0] != MTOK * DM || out_size != MTOK * DM || ws_size < WS_END) { fprintf(stderr, "kernel_launch: unexpected shapes (n_in %d, in0 %d, out %d, ws %zu)\n", n_in, n_in > 0 ? in_sizes[0] : -1, out_size, ws_size); grid = -1; return; }
        int dev = 0, cus = 0, per_cu = 0;
        if (hipGetDevice(&dev) != hipSuccess || hipDeviceGetAttribute(&cus, hipDeviceAttributeMultiprocessorCount, dev) != hipSuccess) { grid = -1; return; }
        if (hipFuncSetAttribute((const void*)hymba_fwd, hipFuncAttributeMaxDynamicSharedMemorySize, LDS_BYTES) != hipSuccess) { fprintf(stderr, "kernel_launch: hipFuncSetAttribute failed\n"); grid = -1; return; }
        if (hipOccupancyMaxActiveBlocksPerMultiprocessor(&per_cu, (const void*)hymba_fwd, NWAVES * 64, LDS_BYTES) != hipSuccess || per_cu < 1) { fprintf(stderr, "kernel_launch: occupancy query says %d blocks per CU\n", per_cu); per_cu = 1; }
        (void)hipGetLastError();
        grid = cus;
    }
    if (grid < 0) return;
    (void)hipMemsetAsync((char*)d_ws + WS_CTL, 0, CTL_ZERO_BYTES, stream);
    Args a{};
    for (int i = 0; i < 18; ++i) a.in[i] = (const float*)d_in[i];
    a.out = (float*)d_out; a.ws = (unsigned char*)d_ws;
    if (MK_N_LAUNCHES == 1) {
        a.ph_lo = 0; a.ph_hi = N_PHASES;
        hipLaunchKernelGGL(hymba_fwd, dim3(grid), dim3(NWAVES * 64), LDS_BYTES, stream, a);
    } else {
        for (int p = 0; p < N_PHASES; ++p) { a.ph_lo = p; a.ph_hi = p + 1; hipLaunchKernelGGL(hymba_fwd, dim3(grid), dim3(NWAVES * 64), LDS_BYTES, stream, a); }
    }
}
```

```cpp
#include <hip/hip_runtime.h>
#include <cstdio>
#include <cstdint>

#ifndef MK_N_LAUNCHES
#define MK_N_LAUNCHES 1
#endif

#ifndef REP0
#define REP0 1
#endif
#ifndef REP0A
#define REP0A 1
#endif
#ifndef REP0C
#define REP0C 1
#endif
#ifndef REP1
#define REP1 1
#endif
#ifndef REP2
#define REP2 1
#endif
#ifndef REP3
#define REP3 1
#endif
#ifndef REP4
#define REP4 1
#endif
#ifndef REP5
#define REP5 1
#endif
#ifndef REP6
#define REP6 1
#endif
#ifndef REP7A
#define REP7A 1
#endif
#ifndef REP7U
#define REP7U 1
#endif
#ifndef REPSEL
#define REPSEL 1
#endif
#ifndef REP7V
#define REP7V 1
#endif
#ifndef REPSC
#define REPSC 1
#endif

#define LAS __attribute__((address_space(3)))
#define GAS __attribute__((address_space(1)))
typedef unsigned short bf16_t;
typedef short bf16x8 __attribute__((ext_vector_type(8)));
typedef short s16x4 __attribute__((ext_vector_type(4)));
typedef float f32x4 __attribute__((ext_vector_type(4)));
typedef float f32x2 __attribute__((ext_vector_type(2)));
typedef unsigned u32x4 __attribute__((ext_vector_type(4)));
typedef unsigned u32x2 __attribute__((ext_vector_type(2)));
typedef int i32x4 __attribute__((ext_vector_type(4)));
typedef __bf16 bf16x2_t __attribute__((ext_vector_type(2)));

constexpr int DM = 2048, BATCH = 8, SEQ = 4096, MTOK = BATCH * SEQ;
constexpr int INC = 4608;
constexpr int COL_K = 1024, COL_V = 1280, COL_B = 1536, COL_C = 2560, COL_H = 3584;
constexpr int MODW = 6 * DM;
constexpr int PEER_N = 16384;
constexpr float EPS = 1e-6f;
constexpr float LOG2E = 1.4426950408889634f;
constexpr float MIX_SCALE = 127.0f / 6.0f;
constexpr float V_SCALE = 16.0f;

constexpr size_t MiB = 1u << 20;
constexpr size_t WS_CTL = 0, CTL_ZERO_BYTES = 1 * MiB;
constexpr size_t WS_MOD = 1 * MiB;
constexpr size_t WS_ROPE = 1 * MiB + 512 * 1024;
constexpr size_t WS_SK = 2 * MiB;
constexpr size_t WS_WIN = 4 * MiB;
constexpr size_t WS_WOUT = 22 * MiB;
constexpr size_t WS_WPQ = 30 * MiB;
constexpr size_t WS_SU = 3 * MiB;
constexpr size_t WS_SH = 3 * MiB + 256 * 1024;
constexpr size_t WS_SX1 = 3 * MiB + 512 * 1024;
constexpr size_t WS_UB = 40 * MiB;
constexpr size_t WS_VB = 104 * MiB;
constexpr size_t WS_XN = 168 * MiB;
constexpr size_t WS_PROJ = 296 * MiB;
constexpr size_t WS_QP = WS_PROJ;
constexpr size_t WS_X1B = WS_PROJ + 128 * MiB;
constexpr size_t WS_MIXED = 584 * MiB;
constexpr size_t WS_H8 = 712 * MiB;
constexpr size_t WS_END = 776 * MiB;
constexpr int CW_BAR = 4096;
constexpr int CW_CMX_IN = 32768, CW_CMX_OUT = CW_CMX_IN + 4608, CW_CMX_PQ = CW_CMX_OUT + 2048;

constexpr int RING_BYTES = 131072;
constexpr int LDSCTL_OFF = RING_BYTES, MISC_OFF = LDSCTL_OFF + 320;
constexpr int LDS_BYTES = 148480;
constexpr int NWAVES = 8;

#define LDS_WAIT() asm volatile("s_waitcnt lgkmcnt(0)" ::: "memory")
#define VM_WAIT() asm volatile("s_waitcnt vmcnt(0)" ::: "memory")

__device__ __forceinline__ unsigned cvtpk(float lo, float hi) { f32x2 v = {lo, hi}; bf16x2_t b = __builtin_convertvector(v, bf16x2_t); return __builtin_bit_cast(unsigned, b); }
__device__ __forceinline__ float bf_lo(unsigned u) { return __uint_as_float(u << 16); }
__device__ __forceinline__ float bf_hi(unsigned u) { return __uint_as_float(u & 0xffff0000u); }
__device__ __forceinline__ float dot2bf(unsigned a, unsigned b, float c) { return __builtin_amdgcn_fdot2_f32_bf16(__builtin_bit_cast(bf16x2_t, a), __builtin_bit_cast(bf16x2_t, b), c, false); }
__device__ __forceinline__ int fresh_lane() { int l = (int)__builtin_amdgcn_mbcnt_hi(~0u, __builtin_amdgcn_mbcnt_lo(~0u, 0u)); asm volatile("" : "+v"(l)); return l; }
__device__ __forceinline__ float xrow_sum(float v) {
    const u32x2 a = __builtin_amdgcn_permlane16_swap(__float_as_uint(v), __float_as_uint(v), false, false); v = __uint_as_float(a.x) + __uint_as_float(a.y);
    const u32x2 b = __builtin_amdgcn_permlane32_swap(__float_as_uint(v), __float_as_uint(v), false, false); return __uint_as_float(b.x) + __uint_as_float(b.y);
}
__device__ __forceinline__ float xrow_max(float v) {
    const u32x2 a = __builtin_amdgcn_permlane16_swap(__float_as_uint(v), __float_as_uint(v), false, false); v = fmaxf(__uint_as_float(a.x), __uint_as_float(a.y));
    const u32x2 b = __builtin_amdgcn_permlane32_swap(__float_as_uint(v), __float_as_uint(v), false, false); return fmaxf(__uint_as_float(b.x), __uint_as_float(b.y));
}
__device__ __forceinline__ float xrow16_other(float v, bool odd_row) {
    const u32x2 a = __builtin_amdgcn_permlane16_swap(__float_as_uint(v), __float_as_uint(v), false, false); return __uint_as_float(odd_row ? a.x : a.y);
}

template <int CTRL> __device__ __forceinline__ float dpp_add(float v) { return v + __int_as_float(__builtin_amdgcn_update_dpp(0, __float_as_int(v), CTRL, 0xF, 0xF, false)); }
template <int CTRL> __device__ __forceinline__ float dpp_mov(float v) { return __int_as_float(__builtin_amdgcn_update_dpp(0, __float_as_int(v), CTRL, 0xF, 0xF, true)); }
__device__ __forceinline__ float allred8(float v) { v = dpp_add<0x141>(v); v = dpp_add<0x1B>(v); v = dpp_add<0xB1>(v); return v; }

template <int CTRL> __device__ __forceinline__ float dpp_max(float v) { return fmaxf(v, __int_as_float(__builtin_amdgcn_update_dpp(0, __float_as_int(v), CTRL, 0xF, 0xF, false))); }
__device__ __forceinline__ float wave_sum(float v) { v = dpp_add<0xB1>(v); v = dpp_add<0x4E>(v); v = dpp_add<0x141>(v); v = dpp_add<0x140>(v); return xrow_sum(v); }
__device__ __forceinline__ float wave_max(float v) { v = dpp_max<0xB1>(v); v = dpp_max<0x4E>(v); v = dpp_max<0x141>(v); v = dpp_max<0x140>(v); return xrow_max(v); }
__device__ __forceinline__ unsigned pack_i8x4_sat(f32x4 x, float inv) {
    const int a = (int)rintf(fminf(fmaxf(x[0] * inv, -127.f), 127.f)), b = (int)rintf(fminf(fmaxf(x[1] * inv, -127.f), 127.f)), c = (int)rintf(fminf(fmaxf(x[2] * inv, -127.f), 127.f)), d = (int)rintf(fminf(fmaxf(x[3] * inv, -127.f), 127.f));
    return ((unsigned)a & 0xffu) | (((unsigned)b & 0xffu) << 8) | (((unsigned)c & 0xffu) << 16) | ((unsigned)d << 24);
}
__device__ __forceinline__ unsigned pack_i8x4(f32x4 x, float inv) {
    const int a = (int)rintf(x[0] * inv), b = (int)rintf(x[1] * inv), c = (int)rintf(x[2] * inv), d = (int)rintf(x[3] * inv);
    return ((unsigned)a & 0xffu) | (((unsigned)b & 0xffu) << 8) | (((unsigned)c & 0xffu) << 16) | ((unsigned)d << 24);
}
template <int CTRL> __device__ __forceinline__ int dpp_movi(int v) { return __builtin_amdgcn_update_dpp(0, v, CTRL, 0xF, 0xF, true); }

namespace pg8 {
#define PG8_LAS __attribute__((address_space(3)))
constexpr int BM = 256, BK = 64, HALF = 128, HTB = HALF * BK * 2, STAGE_BYTES = 8 * HTB, NXCD = 8, WGM = 4;
__host__ __device__ __forceinline__ int lds_byte(int r, int c) { const int st = (r >> 4) * 2 + (c >> 5), rr = r & 15, cc = c & 31, ob = rr * 64 + cc * 2; return st * 1024 + (ob ^ (((ob >> 9) & 1) << 5)); }
__host__ __device__ __forceinline__ void stage_rc(int b, int& R, int& C) { const int st = b / 1024, sb = b % 1024, swz = sb ^ (((sb >> 9) & 1) << 5); R = (st >> 1) * 16 + swz / 64; C = (st & 1) * 32 + (swz % 64) / 2; }
__host__ __device__ __forceinline__ int perm32(int rho) { const int n = rho >> 4, i = rho & 15; return 8 * (i >> 2) + 4 * n + (i & 3); }
struct Unit { int pm, pn; };
struct Gemm { const bf16_t* A; const bf16_t* Bt; int M, N, K; };
struct StaticOrder {
    int nM, nN, nwg, G, c;
    __host__ __device__ void init(int M, int N, int G_, int c_) { nM = M / BM; nN = N / BM; nwg = nM * nN; G = G_; c = c_; }
    __host__ __device__ bool next(int i, Unit& u) const {
        const long L = (long)i * G + c; if (L >= nwg) return false;
        int wgid = (int)L; { const int q = nwg / NXCD, r = nwg % NXCD, xcd = wgid % NXCD, off = wgid / NXCD; wgid = (xcd < r ? xcd * (q + 1) : r * (q + 1) + (xcd - r) * q) + off; }
        const int nig = WGM * nN, gid = wgid / nig, fm = gid * WGM, gsz = (nM - fm) < WGM ? (nM - fm) : WGM;
        u.pm = fm + ((wgid % nig) % gsz); u.pn = (wgid % nig) / gsz; return true;
    }
    __device__ __forceinline__ void a_ready(const Unit&) const {}
    __device__ __forceinline__ void done(const Unit&) const {}
};
__device__ __forceinline__ unsigned cvt_pk_bf16(float lo, float hi) { unsigned r; asm volatile("v_cvt_pk_bf16_f32 %0, %1, %2" : "=v"(r) : "v"(lo), "v"(hi)); return r; }

struct EpiBf16 {
    static constexpr bool PERM = true, AFTER_DRAIN = false;
    bf16_t* O; int ldc;
    __device__ __forceinline__ void operator()(const f32x4 (&acc)[2][2][4][2], const Unit& u, int wr, int wc, int fr, int fq) const {
        const int row0 = u.pm * BM + wr * 64 + fr, col0 = u.pn * BM + wc * 32 + 8 * fq;
#pragma unroll
        for (int ai = 0; ai < 2; ++ai)
#pragma unroll
            for (int m = 0; m < 4; ++m) { bf16_t* rowp = O + (size_t)(row0 + ai * HALF + m * 16) * ldc + col0;
#pragma unroll
                for (int bj = 0; bj < 2; ++bj) { const f32x4 v0 = acc[ai][bj][m][0], v1 = acc[ai][bj][m][1];
                    u32x4 w; w.x = cvt_pk_bf16(v0[0], v0[1]); w.y = cvt_pk_bf16(v0[2], v0[3]); w.z = cvt_pk_bf16(v1[0], v1[1]); w.w = cvt_pk_bf16(v1[2], v1[3]);
                    *(u32x4*)(rowp + bj * HALF) = w; } }
    }
};
struct EpiBf16I8 {
    static constexpr bool PERM = true, AFTER_DRAIN = false;
    bf16_t* O; int ldc; const float* srow; const unsigned* cmax;
    __device__ __forceinline__ void operator()(const f32x4 (&acc)[2][2][4][2], const Unit& u, int wr, int wc, int fr, int fq) const {
        const int row0 = u.pm * BM + wr * 64 + fr, col0 = u.pn * BM + wc * 32 + 8 * fq;
        f32x4 sc[2][2];
#pragma unroll
        for (int bj = 0; bj < 2; ++bj)
#pragma unroll
            for (int n = 0; n < 2; ++n) { const u32x4 b = *(const u32x4*)(cmax + col0 + bj * HALF + 4 * n);
#pragma unroll
                for (int i = 0; i < 4; ++i) sc[bj][n][i] = __uint_as_float(b[i]) * (1.0f / 127.0f); }
        float srv[2][4];
#pragma unroll
        for (int ai = 0; ai < 2; ++ai)
#pragma unroll
            for (int m = 0; m < 4; ++m) srv[ai][m] = srow[row0 + ai * HALF + m * 16];
#pragma unroll
        for (int ai = 0; ai < 2; ++ai)
#pragma unroll
            for (int m = 0; m < 4; ++m) { const int row = row0 + ai * HALF + m * 16; const float sr = srv[ai][m]; bf16_t* rowp = O + (size_t)row * ldc + col0;
#pragma unroll
                for (int bj = 0; bj < 2; ++bj) { const i32x4 a0 = __builtin_bit_cast(i32x4, acc[ai][bj][m][0]), a1 = __builtin_bit_cast(i32x4, acc[ai][bj][m][1]);
                    f32x4 v0, v1;
#pragma unroll
                    for (int i = 0; i < 4; ++i) { v0[i] = (float)a0[i] * sr * sc[bj][0][i]; v1[i] = (float)a1[i] * sr * sc[bj][1][i]; }
                    u32x4 w; w.x = cvt_pk_bf16(v0[0], v0[1]); w.y = cvt_pk_bf16(v0[2], v0[3]); w.z = cvt_pk_bf16(v1[0], v1[1]); w.w = cvt_pk_bf16(v1[2], v1[3]);
                    *(u32x4*)(rowp + bj * HALF) = w; } }
    }
};
struct EpiScoresI8 {
    static constexpr bool PERM = true, AFTER_DRAIN = false;
    bf16_t* O; int M; const float* srow; const unsigned* cmax;
    __device__ __forceinline__ void operator()(const f32x4 (&acc)[2][2][4][2], const Unit& u, int wr, int wc, int fr, int fq) const {
        const int row0 = u.pm * BM + wr * 64 + fr, col0 = u.pn * BM + wc * 32 + 8 * fq;
        f32x4 sc[2][2];
#pragma unroll
        for (int bj = 0; bj < 2; ++bj)
#pragma unroll
            for (int n = 0; n < 2; ++n) { const u32x4 b = *(const u32x4*)(cmax + col0 + bj * HALF + 4 * n);
#pragma unroll
                for (int i = 0; i < 4; ++i) sc[bj][n][i] = __uint_as_float(b[i]) * (1.0f / 127.0f); }
        float srv[2][4];
#pragma unroll
        for (int ai = 0; ai < 2; ++ai)
#pragma unroll
            for (int m = 0; m < 4; ++m) srv[ai][m] = srow[row0 + ai * HALF + m * 16];
#pragma unroll
        for (int ai = 0; ai < 2; ++ai)
#pragma unroll
            for (int m = 0; m < 4; ++m) { const int row = row0 + ai * HALF + m * 16; const float sr = srv[ai][m];
#pragma unroll
                for (int bj = 0; bj < 2; ++bj) { const i32x4 a0 = __builtin_bit_cast(i32x4, acc[ai][bj][m][0]), a1 = __builtin_bit_cast(i32x4, acc[ai][bj][m][1]);
                    f32x4 v0, v1;
#pragma unroll
                    for (int i = 0; i < 4; ++i) { v0[i] = (float)a0[i] * sr * sc[bj][0][i]; v1[i] = (float)a1[i] * sr * sc[bj][1][i]; }
                    u32x4 w; w.x = cvt_pk_bf16(v0[0], v0[1]); w.y = cvt_pk_bf16(v0[2], v0[3]); w.z = cvt_pk_bf16(v1[0], v1[1]); w.w = cvt_pk_bf16(v1[2], v1[3]);
                    *(u32x4*)(O + ((size_t)(u.pn * 32 + bj * 16 + wc * 4 + fq) * M + row) * 8) = w; } }
    }
};
struct EpiProjI8 {
    static constexpr bool PERM = true, AFTER_DRAIN = false;
    bf16_t* O; int ldc; const float* srow; const unsigned* cmax;
    __device__ __forceinline__ void operator()(const f32x4 (&acc)[2][2][4][2], const Unit& u, int wr, int wc, int fr, int fq) const {
        const int row0 = u.pm * BM + wr * 64 + fr;
        const bool prod = u.pn >= 10;
        const int col0 = prod ? 2560 + (u.pn - 10) * 128 + wc * 32 + 8 * fq : u.pn * BM + wc * 32 + 8 * fq;
        const int sc0 = col0, sc1 = prod ? col0 + 1024 : col0 + HALF;
        f32x4 sc[2][2];
#pragma unroll
        for (int n = 0; n < 2; ++n) { const u32x4 b0 = *(const u32x4*)(cmax + sc0 + 4 * n), b1 = *(const u32x4*)(cmax + sc1 + 4 * n);
#pragma unroll
            for (int i = 0; i < 4; ++i) { sc[0][n][i] = __uint_as_float(b0[i]) * (1.0f / 127.0f); sc[1][n][i] = __uint_as_float(b1[i]) * (1.0f / 127.0f); } }
        float srv[2][4];
#pragma unroll
        for (int ai = 0; ai < 2; ++ai)
#pragma unroll
            for (int m = 0; m < 4; ++m) srv[ai][m] = srow[row0 + ai * HALF + m * 16];
#pragma unroll
        for (int ai = 0; ai < 2; ++ai)
#pragma unroll
            for (int m = 0; m < 4; ++m) { const float sr = srv[ai][m]; bf16_t* rowp = O + (size_t)(row0 + ai * HALF + m * 16) * ldc + col0;
                f32x4 v[2][2];
#pragma unroll
                for (int bj = 0; bj < 2; ++bj) { const i32x4 a0 = __builtin_bit_cast(i32x4, acc[ai][bj][m][0]), a1 = __builtin_bit_cast(i32x4, acc[ai][bj][m][1]);
#pragma unroll
                    for (int i = 0; i < 4; ++i) { v[bj][0][i] = (float)a0[i] * sr * sc[bj][0][i]; v[bj][1][i] = (float)a1[i] * sr * sc[bj][1][i]; } }
                if (prod) { const f32x4 p0 = v[0][0] * v[1][0], p1 = v[0][1] * v[1][1];
                    u32x4 w; w.x = cvt_pk_bf16(p0[0], p0[1]); w.y = cvt_pk_bf16(p0[2], p0[3]); w.z = cvt_pk_bf16(p1[0], p1[1]); w.w = cvt_pk_bf16(p1[2], p1[3]);
                    *(u32x4*)rowp = w;
                } else {
#pragma unroll
                    for (int bj = 0; bj < 2; ++bj) { u32x4 w; w.x = cvt_pk_bf16(v[bj][0][0], v[bj][0][1]); w.y = cvt_pk_bf16(v[bj][0][2], v[bj][0][3]); w.z = cvt_pk_bf16(v[bj][1][0], v[bj][1][1]); w.w = cvt_pk_bf16(v[bj][1][2], v[bj][1][3]);
                        *(u32x4*)(rowp + bj * HALF) = w; } }
            }
    }
};
struct EpiResGateI8 {
    static constexpr bool PERM = false, AFTER_DRAIN = false;
    const float* base; float* out; int ldc; const float* gate; int gate_stride; float srow_const; const unsigned* cmax;
    __device__ __forceinline__ void operator()(const f32x4 (&acc)[2][2][4][2], const Unit& u, int wr, int wc, int fr, int fq) const {
        const int row0 = u.pm * BM + wr * 64 + fr, col0 = u.pn * BM + wc * 32 + 4 * fq;
        const float* g = gate + (size_t)((u.pm * BM) >> 12) * gate_stride + col0;
        f32x4 gv[2][2];
#pragma unroll
        for (int bj = 0; bj < 2; ++bj)
#pragma unroll
            for (int n = 0; n < 2; ++n) { const f32x4 gg = *(const f32x4*)(g + bj * HALF + n * 16); const u32x4 b = *(const u32x4*)(cmax + col0 + bj * HALF + n * 16);
#pragma unroll
                for (int i = 0; i < 4; ++i) gv[bj][n][i] = gg[i] * __uint_as_float(b[i]) * (srow_const * (1.0f / 127.0f)); }
#pragma unroll
        for (int g2 = 0; g2 < 4; ++g2) {
            const int ai = g2 >> 1, m0 = (g2 & 1) * 2;
            f32x4 bs[2][2][2];
#pragma unroll
            for (int mm = 0; mm < 2; ++mm)
#pragma unroll
                for (int bj = 0; bj < 2; ++bj)
#pragma unroll
                    for (int n = 0; n < 2; ++n) bs[mm][bj][n] = *(const f32x4*)(base + (size_t)(row0 + ai * HALF + (m0 + mm) * 16) * ldc + col0 + bj * HALF + n * 16);
            asm volatile("" ::: "memory");
#pragma unroll
            for (int mm = 0; mm < 2; ++mm) { const size_t off = (size_t)(row0 + ai * HALF + (m0 + mm) * 16) * ldc + col0;
#pragma unroll
                for (int bj = 0; bj < 2; ++bj)
#pragma unroll
                    for (int n = 0; n < 2; ++n) { const i32x4 a = __builtin_bit_cast(i32x4, acc[ai][bj][m0 + mm][n]);
                        f32x4 o;
#pragma unroll
                        for (int i = 0; i < 4; ++i) o[i] = bs[mm][bj][n][i] + gv[bj][n][i] * (float)a[i];
                        *(f32x4*)(out + off + bj * HALF + n * 16) = o; } }
            asm volatile("" ::: "memory");
        }
    }
};
struct EpiResGateBf16I8 {
    static constexpr bool PERM = true, AFTER_DRAIN = false;
    const float* base; bf16_t* O; int ldc; const float* gate; int gate_stride; float srow_const; const unsigned* cmax;
    __device__ __forceinline__ void operator()(const f32x4 (&acc)[2][2][4][2], const Unit& u, int wr, int wc, int fr, int fq) const {
        const int row0 = u.pm * BM + wr * 64 + fr, col0 = u.pn * BM + wc * 32 + 8 * fq;
        const float* g = gate + (size_t)((u.pm * BM) >> 12) * gate_stride + col0;
        f32x4 gv[2][2];
#pragma unroll
        for (int bj = 0; bj < 2; ++bj)
#pragma unroll
            for (int n = 0; n < 2; ++n) { const f32x4 gg = *(const f32x4*)(g + bj * HALF + 4 * n); const u32x4 b = *(const u32x4*)(cmax + col0 + bj * HALF + 4 * n);
#pragma unroll
                for (int i = 0; i < 4; ++i) gv[bj][n][i] = gg[i] * __uint_as_float(b[i]) * (srow_const * (1.0f / 127.0f)); }
#pragma unroll
        for (int g2 = 0; g2 < 2; ++g2) {
            const int ai = g2, m0 = 0;
            f32x4 bs[4][2][2];
#pragma unroll
            for (int mm = 0; mm < 4; ++mm)
#pragma unroll
                for (int bj = 0; bj < 2; ++bj)
#pragma unroll
                    for (int n = 0; n < 2; ++n) bs[mm][bj][n] = __builtin_nontemporal_load((const f32x4*)(base + (size_t)(row0 + ai * HALF + (m0 + mm) * 16) * ldc + col0 + bj * HALF + 4 * n));
            asm volatile("" ::: "memory");
#pragma unroll
            for (int mm = 0; mm < 4; ++mm) { bf16_t* rowp = O + (size_t)(row0 + ai * HALF + (m0 + mm) * 16) * ldc + col0;
#pragma unroll
                for (int bj = 0; bj < 2; ++bj) { const i32x4 a0 = __builtin_bit_cast(i32x4, acc[ai][bj][m0 + mm][0]), a1 = __builtin_bit_cast(i32x4, acc[ai][bj][m0 + mm][1]);
                    f32x4 v0, v1;
#pragma unroll
                    for (int i = 0; i < 4; ++i) { v0[i] = bs[mm][bj][0][i] + gv[bj][0][i] * (float)a0[i]; v1[i] = bs[mm][bj][1][i] + gv[bj][1][i] * (float)a1[i]; }
                    u32x4 w; w.x = cvt_pk_bf16(v0[0], v0[1]); w.y = cvt_pk_bf16(v0[2], v0[3]); w.z = cvt_pk_bf16(v1[0], v1[1]); w.w = cvt_pk_bf16(v1[2], v1[3]);
                    *(u32x4*)(rowp + bj * HALF) = w; } }
            asm volatile("" ::: "memory");
        }
    }
};
struct EpiResGate {
    static constexpr bool PERM = false, AFTER_DRAIN = false;
    const float* base; float* out; int ldc; const float* gate; int gate_stride;
    __device__ __forceinline__ void operator()(const f32x4 (&acc)[2][2][4][2], const Unit& u, int wr, int wc, int fr, int fq) const {
        const int row0 = u.pm * BM + wr * 64 + fr, col0 = u.pn * BM + wc * 32 + 4 * fq;
        const float* g = gate + (size_t)((u.pm * BM) >> 12) * gate_stride + col0;
        f32x4 gv[2][2];
#pragma unroll
        for (int bj = 0; bj < 2; ++bj)
#pragma unroll
            for (int n = 0; n < 2; ++n) gv[bj][n] = *(const f32x4*)(g + bj * HALF + n * 16);
#pragma unroll
        for (int ai = 0; ai < 2; ++ai)
#pragma unroll
            for (int m = 0; m < 4; ++m) { const size_t off = (size_t)(row0 + ai * HALF + m * 16) * ldc + col0;
#pragma unroll
                for (int bj = 0; bj < 2; ++bj)
#pragma unroll
                    for (int n = 0; n < 2; ++n) { const f32x4 bs = *(const f32x4*)(base + off + bj * HALF + n * 16); *(f32x4*)(out + off + bj * HALF + n * 16) = bs + gv[bj][n] * acc[ai][bj][m][n]; }
                asm volatile("" ::: "memory"); }
    }
};

template <class Epi, class Sched, bool ALIGN_EPI = false, bool SP2 = false, bool I8 = false>
__device__ __forceinline__ void gemm_phase(PG8_LAS unsigned char* lds, const Gemm g, const Sched& S, const Epi& E, const int wid) {
    const int lane = fresh_lane(), tid = wid * 64 + lane, wr = wid >> 2, wc = wid & 3, fr = lane & 15, fq = lane >> 4;
    const int K = g.K, nt = K / BK;
    unsigned voffA[2], voffB[2];
#pragma unroll
    for (int i = 0; i < 2; ++i) { int R, C; stage_rc(tid * 16 + i * 8192, R, C); const int Rb = Epi::PERM ? ((R & ~31) + perm32(R & 31)) : R;
        voffA[i] = (unsigned)(R * K + C) * 2u; voffB[i] = (unsigned)(Rb * K + C) * 2u; }
    const size_t kstep = (size_t)(BK * 2);
    const size_t hstep = (size_t)HALF * K * 2;
    const size_t tstep = 2 * hstep;
    const unsigned ldsw = (unsigned)wid * 1024u;
    const int aoff = lds_byte(wr * 64 + fr, fq * 8), boff = lds_byte(wc * 32 + fr, fq * 8);
#define PG8_SA(b, h) (((b) * 2 + (h)) * HTB)
#define PG8_SB(b, h) ((4 + (b) * 2 + (h)) * HTB)
#define PG8_STAGE(bufoff, gbase, voff) do { _Pragma("unroll") for (int _i = 0; _i < 2; ++_i) \
        __builtin_amdgcn_global_load_lds((const unsigned*)((const char*)(gbase) + (voff)[_i]), (PG8_LAS unsigned*)(lds + (bufoff) + ldsw + _i * 8192), 16, 0, 0); } while (0)
#define PG8_LDA(dst, b, h) do { _Pragma("unroll") for (int m = 0; m < 4; ++m) _Pragma("unroll") for (int k = 0; k < 2; ++k) dst[m][k] = *(const PG8_LAS bf16x8*)(lds + PG8_SA(b, h) + aoff + m * 2048 + k * 1024); } while (0)
#define PG8_LDB(dst, b, h) do { _Pragma("unroll") for (int n = 0; n < 2; ++n) _Pragma("unroll") for (int k = 0; k < 2; ++k) dst[n][k] = *(const PG8_LAS bf16x8*)(lds + PG8_SB(b, h) + boff + n * 2048 + k * 1024); } while (0)
#define PG8_MMA(ai, bj, At, Bt) do { __builtin_amdgcn_s_setprio(1); _Pragma("unroll") for (int m = 0; m < 4; ++m) _Pragma("unroll") for (int n = 0; n < 2; ++n) _Pragma("unroll") for (int k = 0; k < 2; ++k) { \
        if constexpr (I8) acc[ai][bj][m][n] = __builtin_bit_cast(f32x4, __builtin_amdgcn_mfma_i32_16x16x64_i8(__builtin_bit_cast(i32x4, Bt[n][k]), __builtin_bit_cast(i32x4, At[m][k]), __builtin_bit_cast(i32x4, acc[ai][bj][m][n]), 0, 0, 0)); \
        else acc[ai][bj][m][n] = __builtin_amdgcn_mfma_f32_16x16x32_bf16(Bt[n][k], At[m][k], acc[ai][bj][m][n], 0, 0, 0); } __builtin_amdgcn_s_setprio(0); } while (0)
#define PG8_WAIT_V(n) asm volatile("s_waitcnt vmcnt(" #n ")" ::: "memory")
#define PG8_WAIT_L(n) asm volatile("s_waitcnt lgkmcnt(" #n ")" ::: "memory")
#define PG8_BAR __builtin_amdgcn_s_barrier()
#define PG8_SCHED __builtin_amdgcn_sched_barrier(0)
    Unit cur, nxt; int ui = 0;
    if (!S.next(0, cur)) return;
    f32x4 acc[2][2][4][2];
#pragma unroll
    for (int a = 0; a < 2; ++a)
#pragma unroll
        for (int b = 0; b < 2; ++b)
#pragma unroll
            for (int m = 0; m < 4; ++m)
#pragma unroll
                for (int n = 0; n < 2; ++n) acc[a][b][m][n] = (f32x4){0.f, 0.f, 0.f, 0.f};
    bf16x8 At[4][2], B0[2][2], B1[2][2];
    const char* cA = (const char*)g.A + (size_t)cur.pm * tstep; const char* cB = (const char*)g.Bt + (size_t)cur.pn * tstep;
    S.a_ready(cur);
    if constexpr (SP2) {
        PG8_STAGE(PG8_SB(0, 0), cB, voffB); PG8_STAGE(PG8_SB(0, 1), cB + hstep, voffB); PG8_STAGE(PG8_SA(0, 0), cA, voffA); PG8_STAGE(PG8_SA(0, 1), cA + hstep, voffA);
        if (wr == 1) PG8_BAR;
        PG8_WAIT_V(2); PG8_BAR;
        PG8_STAGE(PG8_SB(1, 0), cB + kstep, voffB); PG8_STAGE(PG8_SA(1, 0), cA + kstep, voffA); PG8_STAGE(PG8_SB(1, 1), cB + hstep + kstep, voffB);
        PG8_WAIT_V(6); PG8_BAR;
    } else {
        PG8_STAGE(PG8_SB(0, 0), cB, voffB); PG8_STAGE(PG8_SA(0, 0), cA, voffA); PG8_STAGE(PG8_SB(0, 1), cB + hstep, voffB); PG8_STAGE(PG8_SA(0, 1), cA + hstep, voffA);
        if (wr == 1) PG8_BAR;
        PG8_WAIT_V(4); PG8_BAR;
        PG8_STAGE(PG8_SB(1, 0), cB + kstep, voffB); PG8_STAGE(PG8_SA(1, 0), cA + kstep, voffA); PG8_STAGE(PG8_SB(1, 1), cB + hstep + kstep, voffB);
        PG8_WAIT_V(6); PG8_BAR;
    }
    for (;;) {
        const bool has_next = S.next(ui + 1, nxt);
        const char* nA = has_next ? (const char*)g.A + (size_t)nxt.pm * tstep : cA; const char* nB = has_next ? (const char*)g.Bt + (size_t)nxt.pn * tstep : cB;
        for (int t = 0; t < nt; t += 2) {
            const bool last = (t == nt - 2);
            const char* a1 = cA + (size_t)(t + 1) * kstep;
            const char* a2 = last ? nA : cA + (size_t)(t + 2) * kstep; const char* b2 = last ? nB : cB + (size_t)(t + 2) * kstep;
            const char* a3 = a2 + kstep; const char* b3 = b2 + kstep;
            if (last && has_next) S.a_ready(nxt);
            if constexpr (SP2) {
            PG8_LDB(B0, 0, 0); PG8_LDB(B1, 0, 1); PG8_SCHED; PG8_LDA(At, 0, 0); PG8_STAGE(PG8_SA(1, 1), a1 + hstep, voffA);
            PG8_WAIT_V(8); PG8_WAIT_L(0); PG8_BAR; PG8_MMA(0, 0, At, B0); PG8_MMA(0, 1, At, B1); PG8_BAR; PG8_SCHED;
            PG8_LDA(At, 0, 1); PG8_STAGE(PG8_SB(0, 0), b2, voffB); PG8_STAGE(PG8_SB(0, 1), b2 + hstep, voffB); PG8_STAGE(PG8_SA(0, 0), a2, voffA);
            PG8_WAIT_V(8); PG8_WAIT_L(0); PG8_BAR; PG8_MMA(1, 0, At, B0); PG8_MMA(1, 1, At, B1); PG8_BAR; PG8_SCHED;
            PG8_LDB(B0, 1, 0); PG8_LDB(B1, 1, 1); PG8_SCHED; PG8_LDA(At, 1, 0); PG8_STAGE(PG8_SA(0, 1), a2 + hstep, voffA);
            PG8_WAIT_V(8); PG8_WAIT_L(0); PG8_BAR; PG8_MMA(0, 0, At, B0); PG8_MMA(0, 1, At, B1); PG8_BAR; PG8_SCHED;
            PG8_LDA(At, 1, 1); PG8_STAGE(PG8_SB(1, 0), b3, voffB); PG8_STAGE(PG8_SB(1, 1), b3 + hstep, voffB); PG8_STAGE(PG8_SA(1, 0), a3, voffA);
            PG8_WAIT_V(8); PG8_WAIT_L(0); PG8_BAR; PG8_MMA(1, 0, At, B0); PG8_MMA(1, 1, At, B1); PG8_BAR; PG8_SCHED;
            } else {
            PG8_LDB(B0, 0, 0); PG8_SCHED; PG8_LDA(At, 0, 0); PG8_STAGE(PG8_SA(1, 1), a1 + hstep, voffA);
            PG8_WAIT_L(8); PG8_BAR; PG8_WAIT_L(0); PG8_MMA(0, 0, At, B0); PG8_BAR; PG8_SCHED;
            PG8_LDB(B1, 0, 1); PG8_STAGE(PG8_SB(0, 0), b2, voffB);
            PG8_BAR; PG8_WAIT_L(0); PG8_MMA(0, 1, At, B1); PG8_BAR;
            PG8_LDA(At, 0, 1); PG8_STAGE(PG8_SA(0, 0), a2, voffA);
            PG8_BAR; PG8_WAIT_L(0); PG8_MMA(1, 0, At, B0); PG8_BAR; PG8_SCHED;
            PG8_STAGE(PG8_SB(0, 1), b2 + hstep, voffB);
            PG8_WAIT_V(6); PG8_BAR; PG8_MMA(1, 1, At, B1); PG8_BAR;
            PG8_LDB(B0, 1, 0); PG8_SCHED; PG8_LDA(At, 1, 0); PG8_STAGE(PG8_SA(0, 1), a2 + hstep, voffA);
            PG8_WAIT_L(8); PG8_BAR; PG8_WAIT_L(0); PG8_MMA(0, 0, At, B0); PG8_BAR; PG8_SCHED;
            PG8_LDB(B1, 1, 1); PG8_STAGE(PG8_SB(1, 0), b3, voffB);
            PG8_BAR; PG8_WAIT_L(0); PG8_MMA(0, 1, At, B1); PG8_BAR;
            PG8_LDA(At, 1, 1); PG8_STAGE(PG8_SA(1, 0), a3, voffA);
            PG8_BAR; PG8_WAIT_L(0); PG8_MMA(1, 0, At, B0); PG8_BAR; PG8_SCHED;
            PG8_STAGE(PG8_SB(1, 1), b3 + hstep, voffB);
            PG8_WAIT_V(6); PG8_BAR; PG8_MMA(1, 1, At, B1); PG8_BAR;
            }
        }
        if constexpr (ALIGN_EPI) { if (wr == 0) PG8_BAR; }
        if constexpr (!Epi::AFTER_DRAIN) { E(acc, cur, wr, wc, fr, fq); S.done(cur); }
        if (!has_next) break;
#pragma unroll
        for (int a = 0; a < 2; ++a)
#pragma unroll
            for (int b = 0; b < 2; ++b)
#pragma unroll
                for (int m = 0; m < 4; ++m)
#pragma unroll
                    for (int n = 0; n < 2; ++n) acc[a][b][m][n] = (f32x4){0.f, 0.f, 0.f, 0.f};
        cur = nxt; cA = nA; cB = nB; ++ui;
        if constexpr (ALIGN_EPI) { if (wr == 1) PG8_BAR; }
    }
    PG8_WAIT_V(0);
    if constexpr (!ALIGN_EPI) { if (wr == 0) PG8_BAR; }
    PG8_BAR;
#undef PG8_SA
#undef PG8_SB
#undef PG8_STAGE
#undef PG8_LDA
#undef PG8_LDB
#undef PG8_MMA
#undef PG8_WAIT_V
#undef PG8_WAIT_L
#undef PG8_BAR
#undef PG8_SCHED
}
}

#define XB_TMO      128
#define XB_XCNT(j)  (256  + 64 * (j))
#define XB_XSUB(j)  (1280 + 64 * (j))
#define XB_XGEN(j)  (2304 + 64 * (j))
#define XB_TOP      3328
#define XB_TOPGEN   3392
#define XCD_BAR_WORDS 3456
#define XB_SPIN_CAP (1u << 18)
__device__ __forceinline__ unsigned xb_ld(unsigned* p)              { return __hip_atomic_load(p, __ATOMIC_RELAXED, __HIP_MEMORY_SCOPE_AGENT); }
__device__ __forceinline__ unsigned xb_add(unsigned* p, unsigned v) { return __hip_atomic_fetch_add(p, v, __ATOMIC_RELAXED, __HIP_MEMORY_SCOPE_AGENT); }
__device__ __forceinline__ unsigned xb_xcc_id() { return (unsigned)__builtin_amdgcn_s_getreg((3 << 11) | 20) & 0xFu; }
#define XB_SPIN(cond, bar) do { unsigned _sp = 0; while (cond) { __builtin_amdgcn_s_sleep(1); \
    if ((++_sp & 255u) == 0u) { if (xb_ld(&(bar)[XB_TMO])) break; if (_sp > XB_SPIN_CAP) { atomicAdd(&(bar)[XB_TMO], 1u); break; } } } } while (0)
struct XcdBarrier { unsigned* bar; unsigned x; volatile LAS unsigned* st; int wave; };
__device__ __forceinline__ XcdBarrier xcd_barrier_post(unsigned* bar, volatile LAS unsigned* st, int wave) {
    XcdBarrier b; b.bar = bar; b.x = xb_xcc_id(); b.st = st; b.wave = wave;
    if (wave == 0 && fresh_lane() == 0) (void)xb_add(&bar[XB_XCNT(b.x)], 1u);
    return b;
}
__device__ __forceinline__ void xcd_barrier_complete(unsigned* bar, unsigned x, unsigned& nloc, unsigned& nx) {
    const unsigned G = gridDim.x * gridDim.y * gridDim.z;
    unsigned sum, cnt, mine, sp = 0u;
    for (;;) {
        sum = 0u; cnt = 0u; mine = 0u;
#pragma unroll
        for (unsigned j = 0; j < 16; ++j) { const unsigned c = xb_ld(&bar[XB_XCNT(j)]); sum += c; cnt += (c > 0u) ? 1u : 0u; mine = (j == x) ? c : mine; }
        if (sum == G) break;
        __builtin_amdgcn_s_sleep(1);
        if ((++sp & 255u) == 0u) { if (xb_ld(&bar[XB_TMO])) break; if (sp > XB_SPIN_CAP) { atomicAdd(&bar[XB_TMO], 1u); break; } }
    }
    nloc = mine > 0u ? mine : 1u; nx = cnt > 0u ? cnt : 1u;
}
__device__ __forceinline__ void xcd_barrier(const XcdBarrier& b) {
    asm volatile("s_waitcnt vmcnt(0)" ::: "memory");
    __syncthreads();
    if (b.wave == 0 && fresh_lane() == 0) {
        unsigned* bar = b.bar;
        __builtin_amdgcn_s_waitcnt(0);
        unsigned nloc = b.st[0], nx = b.st[1];
        if (nloc == 0u) { xcd_barrier_complete(bar, b.x, nloc, nx); b.st[0] = nloc; b.st[1] = nx; }
        const unsigned old = xb_add(&bar[XB_XSUB(b.x)], 1u);
        const unsigned gen = old / nloc, target = (gen + 1u) * nx;
        if (old + 1u == (gen + 1u) * nloc) {
            __builtin_amdgcn_fence(__ATOMIC_RELEASE, "agent");
            asm volatile("s_waitcnt vmcnt(0)" ::: "memory");
            const unsigned og = xb_add(&bar[XB_TOP], 1u);
            if (og + 1u != target) XB_SPIN(xb_ld(&bar[XB_TOP]) < target, bar);
        } else {
            XB_SPIN(xb_ld(&bar[XB_TOP]) < target, bar);
        }
        __builtin_amdgcn_fence(__ATOMIC_ACQUIRE, "agent");
        asm volatile("s_waitcnt vmcnt(0)" ::: "memory");
    }
    __syncthreads();
}

__device__ __forceinline__ void p0_ada_item(const float* cvec, const float* w_ada, const float* b_ada, float* mod, LAS unsigned char* lds, int item, int tid, int wave, int lane) {
    LAS float* sc = (LAS float*)(lds + wave * 8192);
    LAS float* red = (LAS float*)(lds + 65536);
    const int k0 = wave * 256;
    { float cv[32];
#pragma unroll
      for (int j = 0; j < 32; ++j) { const int i = lane + 64 * j; cv[j] = cvec[(i & 7) * DM + k0 + (i >> 3)]; }
#pragma unroll
      for (int j = 0; j < 32; ++j) { const int i = lane + 64 * j; const float v = cv[j]; sc[(i >> 3) * 8 + (i & 7)] = v * __builtin_amdgcn_rcpf(1.f + __builtin_amdgcn_exp2f(-v * LOG2E)); } }
    LDS_WAIT();
    const int rg = lane >> 4, cq = lane & 15;
    float acc[8][4];
#pragma unroll
    for (int b = 0; b < 8; ++b)
#pragma unroll
        for (int i = 0; i < 4; ++i) acc[b][i] = 0.f;
    const float* wp = w_ada + (size_t)(k0 + rg) * MODW + item * 64 + 4 * cq;
#pragma unroll 32
    for (int it = 0; it < 64; ++it) {
        const f32x4 w4 = __builtin_nontemporal_load((const f32x4*)(wp + (size_t)it * 4 * MODW));
        const int kk = it * 4 + rg;
        const f32x4 s0 = *(const LAS f32x4*)(sc + kk * 8), s1 = *(const LAS f32x4*)(sc + kk * 8 + 4);
#pragma unroll
        for (int i = 0; i < 4; ++i) {
            acc[0][i] += s0[0] * w4[i]; acc[1][i] += s0[1] * w4[i]; acc[2][i] += s0[2] * w4[i]; acc[3][i] += s0[3] * w4[i];
            acc[4][i] += s1[0] * w4[i]; acc[5][i] += s1[1] * w4[i]; acc[6][i] += s1[2] * w4[i]; acc[7][i] += s1[3] * w4[i];
        }
    }
#pragma unroll
    for (int b = 0; b < 8; ++b)
#pragma unroll
        for (int i = 0; i < 4; ++i) acc[b][i] = xrow_sum(acc[b][i]);
    if (rg == 0) {
#pragma unroll
        for (int b = 0; b < 8; ++b)
#pragma unroll
            for (int i = 0; i < 4; ++i) red[(wave * 8 + b) * 64 + 4 * cq + i] = acc[b][i];
    }
    LDS_WAIT();
    __syncthreads();
    { const int b = tid >> 6, col = tid & 63; float s = b_ada[item * 64 + col];
#pragma unroll
      for (int w = 0; w < 8; ++w) s += red[(w * 8 + b) * 64 + col];
      mod[b * MODW + item * 64 + col] = s; }
    LDS_WAIT();
    __syncthreads();
}
__device__ __forceinline__ void p0_transpose_item(const float* W, int K, int N, bf16_t* WT, LAS float* scr, int item, int lane) {
    const int nblk = N / 32, kb = item / nblk, nb = item % nblk, k0 = 64 * kb, n0 = 32 * nb;
#pragma unroll 8
    for (int i = 0; i < 32; ++i) { const int kk = 2 * i + (lane >> 5); scr[kk * 33 + (lane & 31)] = W[(size_t)(k0 + kk) * N + n0 + (lane & 31)]; }
    LDS_WAIT(); asm volatile("" ::: "memory");
    const int c = lane & 7;
#pragma unroll
    for (int j = 0; j < 4; ++j) { const int n = (lane >> 3) + 8 * j; const LAS float* s = scr + (8 * c) * 33 + n;
        u32x4 o; o.x = cvtpk(s[0 * 33], s[1 * 33]); o.y = cvtpk(s[2 * 33], s[3 * 33]); o.z = cvtpk(s[4 * 33], s[5 * 33]); o.w = cvtpk(s[6 * 33], s[7 * 33]);
        *(u32x4*)(WT + (size_t)(n0 + n) * K + k0 + 8 * c) = o; }
    LDS_WAIT(); asm volatile("" ::: "memory");
}
__device__ __forceinline__ void p0_colmax_item(const float* W, int N, unsigned* cmax, int item, int lane) {
    const int nblk = N / 32, kb = item / nblk, nb = item % nblk, k0 = 64 * kb, n0 = 32 * nb;
    float am = 0.f;
#pragma unroll
    for (int i = 0; i < 32; ++i) am = fmaxf(am, fabsf(W[(size_t)(k0 + 2 * i + (lane >> 5)) * N + n0 + (lane & 31)]));
    am = fmaxf(am, __shfl_xor(am, 32));
    if (lane < 32) atomicMax(cmax + n0 + lane, __float_as_uint(am));
}
template <bool INTERLEAVE>
__device__ __forceinline__ void p1_transpose_i8_item(const float* W, int K, int N, unsigned char* WT, const unsigned* cmax, LAS float* scr, int item, int lane) {
    const int nblk = N / 32, kb = item / nblk, nb = item % nblk, k0 = 64 * kb, nd0 = 32 * nb;
    int n0 = nd0;
    if (INTERLEAVE && nd0 >= 2560) { const int t = (nd0 - 2560) >> 8, j = (nd0 - 2560) & 255; n0 = j < 128 ? 2560 + 128 * t + j : 3584 + 128 * t + (j - 128); }
    float wv[32];
#pragma unroll
    for (int i = 0; i < 32; ++i) wv[i] = __builtin_nontemporal_load(W + (size_t)(k0 + 2 * i + (lane >> 5)) * N + n0 + (lane & 31));
#pragma unroll
    for (int i = 0; i < 32; ++i) { const int kk = 2 * i + (lane >> 5); scr[kk * 33 + (lane & 31)] = wv[i]; }
    LDS_WAIT(); asm volatile("" ::: "memory");
    const int c4 = lane & 3;
#pragma unroll
    for (int j = 0; j < 2; ++j) { const int n = (lane >> 2) + 16 * j; const LAS float* s = scr + (16 * c4) * 33 + n;
        const float am = __uint_as_float(cmax[n0 + n]); const float inv = am > 0.f ? 127.0f / am : 0.f;
        u32x4 o;
#pragma unroll
        for (int w = 0; w < 4; ++w) o[w] = pack_i8x4((f32x4){s[(4 * w) * 33], s[(4 * w + 1) * 33], s[(4 * w + 2) * 33], s[(4 * w + 3) * 33]}, inv);
        *(u32x4*)(WT + (size_t)(nd0 + n) * K + k0 + 16 * c4) = o; }
    LDS_WAIT(); asm volatile("" ::: "memory");
}
__device__ __forceinline__ void p0_w2_item(const float* w_pq, const float* subkeys, bf16_t* W2, unsigned* cmax, int item, int lane) {
    const int blk = item >> 5, kq = (item >> 4) & 1, dch = item & 15, c = lane & 15, quad = lane >> 4;
    bf16x8 kf[4][4];
    { f32x4 sv[4][4][2];
#pragma unroll
      for (int kt = 0; kt < 4; ++kt) { const float* sp = subkeys + ((size_t)blk * 128 + (kq * 4 + kt) * 16 + c) * 128 + 8 * quad;
#pragma unroll
          for (int ks = 0; ks < 4; ++ks) { sv[kt][ks][0] = *(const f32x4*)(sp + ks * 32); sv[kt][ks][1] = *(const f32x4*)(sp + ks * 32 + 4); } }
#pragma unroll
      for (int kt = 0; kt < 4; ++kt)
#pragma unroll
          for (int ks = 0; ks < 4; ++ks) { const f32x4 a = sv[kt][ks][0], b = sv[kt][ks][1];
              u32x4 w; w.x = cvtpk(a[0], a[1]); w.y = cvtpk(a[2], a[3]); w.z = cvtpk(b[0], b[1]); w.w = cvtpk(b[2], b[3]); kf[kt][ks] = __builtin_bit_cast(bf16x8, w); } }
    float am[4] = {0.f, 0.f, 0.f, 0.f};
#pragma nounroll
    for (int dq = 0; dq < 2; ++dq) {
        f32x4 wv[4][4][2];
#pragma unroll
        for (int j = 0; j < 4; ++j) { const float* wp = w_pq + (size_t)(dch * 128 + (dq * 4 + j) * 16 + c) * DM + blk * 128 + 8 * quad;
#pragma unroll
            for (int ks = 0; ks < 4; ++ks) { wv[j][ks][0] = *(const f32x4*)(wp + ks * 32); wv[j][ks][1] = *(const f32x4*)(wp + ks * 32 + 4); } }
#pragma unroll
        for (int j = 0; j < 4; ++j) { const int d0 = dch * 128 + (dq * 4 + j) * 16;
            bf16x8 wb[4];
#pragma unroll
            for (int ks = 0; ks < 4; ++ks) { const f32x4 a = wv[j][ks][0], b = wv[j][ks][1];
                u32x4 w; w.x = cvtpk(a[0], a[1]); w.y = cvtpk(a[2], a[3]); w.z = cvtpk(b[0], b[1]); w.w = cvtpk(b[2], b[3]); wb[ks] = __builtin_bit_cast(bf16x8, w); }
#pragma unroll
            for (int kt = 0; kt < 4; ++kt) {
                f32x4 acc = (f32x4){0.f, 0.f, 0.f, 0.f};
#pragma unroll
                for (int ks = 0; ks < 4; ++ks) acc = __builtin_amdgcn_mfma_f32_16x16x32_bf16(wb[ks], kf[kt][ks], acc, 0, 0, 0);
                am[kt] = fmaxf(fmaxf(am[kt], fmaxf(fabsf(acc[0]), fabsf(acc[1]))), fmaxf(fabsf(acc[2]), fabsf(acc[3])));
                u32x2 o; o.x = cvtpk(acc[0], acc[1]); o.y = cvtpk(acc[2], acc[3]);
                *(u32x2*)(W2 + (size_t)(blk * 128 + (kq * 4 + kt) * 16 + c) * DM + d0 + 4 * quad) = o; } }
    }
#pragma unroll
    for (int kt = 0; kt < 4; ++kt) { const float a = xrow_max(am[kt]); if (quad == 0) atomicMax(cmax + blk * 128 + (kq * 4 + kt) * 16 + c, __float_as_uint(a)); }
}
__device__ __forceinline__ void p1_w2_row(const bf16_t* W2, unsigned char* WT, const unsigned* cmax, int n, int lane) {
    const float am = __uint_as_float(cmax[n]); const float inv = am > 0.f ? 127.0f / am : 0.f;
#pragma unroll
    for (int j = 0; j < 8; ++j) { const u32x2 v = *(const u32x2*)(W2 + (size_t)n * DM + 256 * j + 4 * lane);
        *(unsigned*)(WT + (size_t)n * DM + 256 * j + 4 * lane) = pack_i8x4((f32x4){bf_lo(v.x), bf_hi(v.x), bf_lo(v.y), bf_hi(v.y)}, inv); }
}
__device__ __forceinline__ void p0_cvt_item(const float* src, bf16_t* dst, size_t base, int lane) {
#pragma unroll
    for (int j = 0; j < 4; ++j) { const size_t o = base + (size_t)j * 512 + lane * 8;
        const f32x4 a = *(const f32x4*)(src + o), b = *(const f32x4*)(src + o + 4);
        u32x4 w; w.x = cvtpk(a[0], a[1]); w.y = cvtpk(a[2], a[3]); w.z = cvtpk(b[0], b[1]); w.w = cvtpk(b[2], b[3]);
        *(u32x4*)(dst + o) = w; }
}
__device__ __forceinline__ int vperm4(int grp) { return (grp & 7) * 16 + (grp >> 3) * 4; }
__device__ __forceinline__ size_t tab_off(int row, int col) { return ((size_t)(col >> 7) * PEER_N + row) * 128 + (col & 127); }
__device__ __forceinline__ void p0_fp8_item(const float* src, unsigned char* dst, size_t base, float scale, int lane) {
#pragma unroll
    for (int i = 0; i < 8; ++i) { const size_t o = base + (size_t)i * 256 + lane * 4; const f32x4 a = *(const f32x4*)(src + o);
        int p = 0; p = __builtin_amdgcn_cvt_pk_fp8_f32(a[0] * scale, a[1] * scale, p, false); p = __builtin_amdgcn_cvt_pk_fp8_f32(a[2] * scale, a[3] * scale, p, true);
        *(unsigned*)(dst + ((size_t)(2 * i + (lane >> 5)) * PEER_N + (base >> 11)) * 128 + vperm4(lane & 31)) = (unsigned)p; }
}
__device__ __forceinline__ void p0_i8_row(const float* src, unsigned char* dst, float* scale, int row, int lane) {
    const float* p = src + (size_t)row * DM + lane * 4;
    f32x4 v[8]; float am = 0.f;
#pragma unroll
    for (int i = 0; i < 8; ++i) { v[i] = *(const f32x4*)(p + i * 256); am = fmaxf(fmaxf(am, fmaxf(fabsf(v[i][0]), fabsf(v[i][1]))), fmaxf(fabsf(v[i][2]), fabsf(v[i][3]))); }
    am = wave_max(am);
    const float inv = am > 0.f ? 127.0f / am : 0.f;
#pragma unroll
    for (int i = 0; i < 8; ++i) *(unsigned*)(dst + tab_off(row, i * 256 + lane * 4)) = pack_i8x4(v[i], inv);
    if (lane == 0) scale[row] = am * (1.0f / 127.0f);
}
__device__ __forceinline__ void p0_tables8(const float* peer_u, const float* peer_v, unsigned char* UB, float* SU, unsigned char* VB, int gw, int ngw, int lane) {
#define P0_TAB_SRC(k) (((k) < 8 ? peer_u : peer_v) + (size_t)(gw + ((k) & 7) * ngw) * DM + lane * 4)
    f32x4 ra[8], rb[8], rc[8];
#pragma unroll
    for (int i = 0; i < 8; ++i) ra[i] = *(const f32x4*)(P0_TAB_SRC(0) + i * 256);
#pragma unroll
    for (int i = 0; i < 8; ++i) rb[i] = *(const f32x4*)(P0_TAB_SRC(1) + i * 256);
#pragma unroll
    for (int k = 0; k < 16; ++k) {
        const int row = gw + (k & 7) * ngw;
        f32x4 (&v)[8] = (k % 3 == 0) ? ra : (k % 3 == 1) ? rb : rc;
        f32x4 (&nn)[8] = (k % 3 == 0) ? rc : (k % 3 == 1) ? ra : rb;
        if (k < 14) {
#pragma unroll
            for (int i = 0; i < 8; ++i) nn[i] = *(const f32x4*)(P0_TAB_SRC(k + 2) + i * 256); }
        if (k < 8) {
            float am = 0.f;
#pragma unroll
            for (int i = 0; i < 8; ++i) am = fmaxf(fmaxf(am, fmaxf(fabsf(v[i][0]), fabsf(v[i][1]))), fmaxf(fabsf(v[i][2]), fabsf(v[i][3])));
            am = wave_max(am);
            const float inv = am > 0.f ? 127.0f / am : 0.f;
            unsigned char* q = UB + (size_t)(lane >> 5) * (PEER_N * 128) + (size_t)row * 128 + (lane & 31) * 4;
#pragma unroll
            for (int i = 0; i < 8; ++i) *(unsigned*)(q + (size_t)i * (2 * PEER_N * 128)) = pack_i8x4(v[i], inv);
            if (lane == 0) SU[row] = am * (1.0f / 127.0f);
        } else {
            unsigned char* q = VB + (size_t)(lane >> 5) * (PEER_N * 128) + (size_t)row * 128 + vperm4(lane & 31);
#pragma unroll
            for (int i = 0; i < 8; ++i) { int p = 0; p = __builtin_amdgcn_cvt_pk_fp8_f32(v[i][0] * V_SCALE, v[i][1] * V_SCALE, p, false); p = __builtin_amdgcn_cvt_pk_fp8_f32(v[i][2] * V_SCALE, v[i][3] * V_SCALE, p, true);
                *(unsigned*)(q + (size_t)i * (2 * PEER_N * 128)) = (unsigned)p; }
        }
    }
#undef P0_TAB_SRC
}
struct TabCtx { const float* src; unsigned char* dst; float* SU; int p; };
__device__ __forceinline__ void tab_row_load(const TabCtx& T, int k, f32x4 (&v)[8], int lane) {
    const float* np = T.src + (size_t)(T.p + 1024 * (k < 15 ? k : 15)) * DM + lane * 4;
#pragma unroll
    for (int i = 0; i < 8; ++i) v[i] = __builtin_nontemporal_load((const f32x4*)(np + i * 256));
}
template <bool ISV> __device__ __forceinline__ void tab_row_convert(const TabCtx& T, int k, const f32x4 (&v)[8], int lane) {
    const int row = T.p + 1024 * k;
    unsigned char* q = T.dst + (size_t)(lane >> 5) * (PEER_N * 128) + (size_t)row * 128 + (ISV ? vperm4(lane & 31) : (lane & 31) * 4);
    if (!ISV) {
        float am = 0.f;
#pragma unroll
        for (int i = 0; i < 8; ++i) am = fmaxf(fmaxf(am, fmaxf(fabsf(v[i][0]), fabsf(v[i][1]))), fmaxf(fabsf(v[i][2]), fabsf(v[i][3])));
        am = wave_max(am);
        const float inv = am > 0.f ? 127.0f / am : 0.f;
#pragma unroll
        for (int i = 0; i < 8; ++i) *(unsigned*)(q + (size_t)i * (2 * PEER_N * 128)) = pack_i8x4(v[i], inv);
        if (lane == 0) T.SU[row] = am * (1.0f / 127.0f);
    } else {
#pragma unroll
        for (int i = 0; i < 8; ++i) { int p = 0; p = __builtin_amdgcn_cvt_pk_fp8_f32(v[i][0] * V_SCALE, v[i][1] * V_SCALE, p, false); p = __builtin_amdgcn_cvt_pk_fp8_f32(v[i][2] * V_SCALE, v[i][3] * V_SCALE, p, true);
            *(unsigned*)(q + (size_t)i * (2 * PEER_N * 128)) = (unsigned)p; }
    }
}
__device__ __forceinline__ void p0_rope_item(float* rope, int item, int lane) {
    const int idx = item * 64 + lane, pos = idx >> 3, i = idx & 7;
    const double f = (i == 0) ? 0.15915494309189535 : (i == 1) ? 0.03086376340470123 : (i == 2) ? 0.005985185712713705 : (i == 3) ? 0.001160663641240061
                   : (i == 4) ? 0.00022507907903927653 : (i == 5) ? 4.364795279280289e-05 : (i == 6) ? 8.464330808241401e-06 : 1.6414262627950345e-06;
    const double rev = (double)pos * f; const double fr = rev - (double)(long long)rev;
    rope[idx] = __builtin_amdgcn_cosf((float)fr); rope[32768 + idx] = __builtin_amdgcn_sinf((float)fr);
}

__device__ __forceinline__ void norm_rows(const float* src, const float* gain, const float* mod, int off_shift, int off_scale, unsigned char* dst8, float* scale8, int gw, int ngw, int lane) {
    for (int grp = gw; grp < MTOK / 16; grp += ngw) {
        const int row0 = grp * 16; const float* mb = mod + (size_t)(row0 >> 12) * MODW;
        f32x4 A[8], B[8];
#pragma unroll
        for (int j = 0; j < 8; ++j) { const int c = 256 * j + 4 * lane; const f32x4 g = *(const f32x4*)(gain + c), sc = *(const f32x4*)(mb + off_scale + c); A[j] = g * (sc + 1.0f); B[j] = *(const f32x4*)(mb + off_shift + c); }
        f32x4 ra[8], rb[8], rc[8];
#pragma unroll
        for (int j = 0; j < 8; ++j) ra[j] = __builtin_nontemporal_load((const f32x4*)(src + (size_t)row0 * DM + 4 * lane + 256 * j));
#pragma unroll
        for (int j = 0; j < 8; ++j) rb[j] = __builtin_nontemporal_load((const f32x4*)(src + (size_t)(row0 + 1) * DM + 4 * lane + 256 * j));
#pragma unroll
        for (int r = 0; r < 16; ++r) {
            f32x4 (&cur)[8] = (r % 3 == 0) ? ra : (r % 3 == 1) ? rb : rc;
            f32x4 (&nn)[8] = (r % 3 == 0) ? rc : (r % 3 == 1) ? ra : rb;
            f32x4 v[8]; float ss = 0.f;
#pragma unroll
            for (int j = 0; j < 8; ++j) { v[j] = cur[j]; ss += (v[j][0] * v[j][0] + v[j][1] * v[j][1]) + (v[j][2] * v[j][2] + v[j][3] * v[j][3]); }
            if (r < 14) { const float* xn = src + (size_t)(row0 + r + 2) * DM + 4 * lane;
#pragma unroll
              for (int j = 0; j < 8; ++j) nn[j] = __builtin_nontemporal_load((const f32x4*)(xn + 256 * j)); }
            const float rstd = 1.0f / sqrtf(wave_sum(ss) * (1.0f / DM) + EPS);
            float am = 0.f;
#pragma unroll
            for (int j = 0; j < 8; ++j) { const f32x4 o = v[j] * rstd * A[j] + B[j]; v[j] = o; am = fmaxf(fmaxf(am, fmaxf(fabsf(o[0]), fabsf(o[1]))), fmaxf(fabsf(o[2]), fabsf(o[3]))); }
            am = wave_max(am); const float inv = am > 0.f ? 127.0f / am : 0.f;
            unsigned* q = (unsigned*)(dst8 + (size_t)(row0 + r) * DM + 4 * lane);
#pragma unroll
            for (int j = 0; j < 8; ++j) q[64 * j] = pack_i8x4(v[j], inv);
            if (lane == 0) scale8[row0 + r] = am * (1.0f / 127.0f);
        }
    }
}

__device__ __forceinline__ void norm_rows_bf16(const bf16_t* src, const float* gain, const float* mod, int off_shift, int off_scale, unsigned char* dst8, float* scale8, int gw, int ngw, int lane) {
    for (int grp = gw; grp < MTOK / 16; grp += ngw) {
        const int row0 = grp * 16; const float* mb = mod + (size_t)(row0 >> 12) * MODW;
        f32x4 A[8], B[8];
#pragma unroll
        for (int j = 0; j < 8; ++j) { const int c = 512 * (j >> 1) + 8 * lane + 4 * (j & 1); const f32x4 g = *(const f32x4*)(gain + c), sc = *(const f32x4*)(mb + off_scale + c); A[j] = g * (sc + 1.0f); B[j] = *(const f32x4*)(mb + off_shift + c); }
        u32x4 ra[4], rb[4], rc[4];
#pragma unroll
        for (int j = 0; j < 4; ++j) ra[j] = __builtin_nontemporal_load((const u32x4*)(src + (size_t)row0 * DM + 8 * lane + 512 * j));
#pragma unroll
        for (int j = 0; j < 4; ++j) rb[j] = __builtin_nontemporal_load((const u32x4*)(src + (size_t)(row0 + 1) * DM + 8 * lane + 512 * j));
#pragma unroll
        for (int r = 0; r < 16; ++r) {
            u32x4 (&cur)[4] = (r % 3 == 0) ? ra : (r % 3 == 1) ? rb : rc;
            u32x4 (&nn)[4] = (r % 3 == 0) ? rc : (r % 3 == 1) ? ra : rb;
            f32x4 v[8]; float ss = 0.f;
#pragma unroll
            for (int j = 0; j < 4; ++j) { const u32x4 t = cur[j]; v[2 * j] = (f32x4){bf_lo(t.x), bf_hi(t.x), bf_lo(t.y), bf_hi(t.y)}; v[2 * j + 1] = (f32x4){bf_lo(t.z), bf_hi(t.z), bf_lo(t.w), bf_hi(t.w)}; }
#pragma unroll
            for (int j = 0; j < 8; ++j) ss += (v[j][0] * v[j][0] + v[j][1] * v[j][1]) + (v[j][2] * v[j][2] + v[j][3] * v[j][3]);
            if (r < 14) { const bf16_t* xn = src + (size_t)(row0 + r + 2) * DM + 8 * lane;
#pragma unroll
              for (int j = 0; j < 4; ++j) nn[j] = __builtin_nontemporal_load((const u32x4*)(xn + 512 * j)); }
            const float rstd = __builtin_amdgcn_rsqf(wave_sum(ss) * (1.0f / DM) + EPS);
            float am = 0.f;
#pragma unroll
            for (int j = 0; j < 8; ++j) { const f32x4 o = v[j] * rstd * A[j] + B[j]; v[j] = o; am = fmaxf(fmaxf(am, fmaxf(fabsf(o[0]), fabsf(o[1]))), fmaxf(fabsf(o[2]), fabsf(o[3]))); }
            am = wave_max(am); const float inv = am > 0.f ? 127.0f / am : 0.f;
            unsigned char* q = dst8 + (size_t)(row0 + r) * DM + 8 * lane;
#pragma unroll
            for (int j = 0; j < 4; ++j) { u32x2 o; o.x = pack_i8x4(v[2 * j], inv); o.y = pack_i8x4(v[2 * j + 1], inv); *(u32x2*)(q + 512 * j) = o; }
            if (lane == 0) scale8[row0 + r] = am * (1.0f / 127.0f);
        }
    }
}

constexpr int KS_PITCH = 72;
constexpr int VT_PITCH = 264;
constexpr int LDS_KS = 0, LDS_VT = 256 * KS_PITCH * 2, LDS_RT = LDS_VT + 64 * VT_PITCH * 2;
constexpr int LDS_QS = LDS_RT + 8192, LDS_QS_HI = LDSCTL_OFF + 1024;
__device__ __forceinline__ int qstash_off(int wave) { return wave < 6 ? LDS_QS + wave * 8192 : LDS_QS_HI + (wave - 6) * 8192; }
static_assert(LDS_QS + 6 * 8192 <= LDSCTL_OFF && LDS_QS_HI + 2 * 8192 <= LDS_BYTES, "Q stash placement");
template <bool HOST, bool ISV>
__device__ __forceinline__ void attn_unit(int b, int hk, int n, const bf16_t* PROJ, const float* g_q, const float* g_k, const float* sinks, const float* g_oa, const float* rope, unsigned char* MIXED,
                                          LAS unsigned char* lds, int tid, int wave, int lane, const TabCtx& T, int tabk0, f32x4 (&tcur)[8], f32x4 (&tnx)[8]) {
    LAS bf16_t* Ks = (LAS bf16_t*)(lds + LDS_KS); LAS bf16_t* Vt = (LAS bf16_t*)(lds + LDS_VT); LAS float* RT = (LAS float*)(lds + LDS_RT);
    const size_t rowb = (size_t)b * SEQ;
    const int c = lane & 15, quad = lane >> 4, g = wave >> 1, hf = wave & 1, head = hk * 4 + g;
    const bf16_t* qsrc = PROJ + (rowb + n * 128 + hf * 64 + c) * INC + head * 64 + 8 * quad;
#pragma unroll
    for (int qt = 0; qt < 4; ++qt)
#pragma unroll
        for (int k = 0; k < 2; ++k)
            __builtin_amdgcn_global_load_lds((const unsigned*)(qsrc + (size_t)qt * 16 * INC + k * 32), (LAS unsigned*)(lds + qstash_off(wave) + (qt * 2 + k) * 1024), 16, 0, 2);
    u32x4 kr[2][2]; f32x4 kcs[2][4]; u32x4 vr[4];
    const int part = tid & 3;
#pragma unroll
    for (int it = 0; it < 2; ++it) {
        const int row = (tid + 512 * it) >> 2, pos = (n - 1) * 128 + row, posc = pos >= 0 ? pos : 0;
        const bf16_t* src = PROJ + (rowb + posc) * INC + COL_K + hk * 64 + 16 * part;
        kr[it][0] = *(const u32x4*)src; kr[it][1] = *(const u32x4*)(src + 8);
        const float* rp = rope + posc * 8;
        kcs[it][0] = *(const f32x4*)rp; kcs[it][1] = *(const f32x4*)(rp + 4); kcs[it][2] = *(const f32x4*)(rp + 32768); kcs[it][3] = *(const f32x4*)(rp + 32768 + 4);
    }
#pragma unroll
    for (int it = 0; it < 4; ++it) {
        const int task = tid + 512 * it, row = task & 255, ch = task >> 8, pos = (n - 1) * 128 + row, posc = pos >= 0 ? pos : 0;
        vr[it] = *(const u32x4*)(PROJ + (rowb + posc) * INC + COL_V + hk * 64 + 8 * ch);
    }
    const f32x4 rv = *(const f32x4*)(rope + ((tid & 3) >> 1) * 32768 + (size_t)(n * 128 + (tid >> 2)) * 8 + (tid & 1) * 4);
    f32x4 gk[4], gq[4], goa[4];
#pragma unroll
    for (int i = 0; i < 4; ++i) gk[i] = *(const f32x4*)(g_k + 16 * part + 4 * i);
    gq[0] = *(const f32x4*)(g_q + 8 * quad); gq[1] = *(const f32x4*)(g_q + 8 * quad + 4); gq[2] = *(const f32x4*)(g_q + 32 + 8 * quad); gq[3] = *(const f32x4*)(g_q + 32 + 8 * quad + 4);
#pragma unroll
    for (int dt = 0; dt < 4; ++dt) goa[dt] = *(const f32x4*)(g_oa + head * 64 + dt * 16 + 4 * quad);
    const float sinkv = sinks[head] * LOG2E;
    *(LAS f32x4*)(RT + (tid >> 2) * 16 + (tid & 3) * 4) = rv;
#pragma unroll
    for (int it = 0; it < 2; ++it) {
        const int row = (tid + 512 * it) >> 2; const bool valid = (n - 1) * 128 + row >= 0;
        const u32x4 r0 = kr[it][0], r1 = kr[it][1];
        float x[16];
#pragma unroll
        for (int i = 0; i < 4; ++i) { x[2 * i] = bf_lo(r0[i]); x[2 * i + 1] = bf_hi(r0[i]); x[8 + 2 * i] = bf_lo(r1[i]); x[8 + 2 * i + 1] = bf_hi(r1[i]); }
        float ss = 0.f;
#pragma unroll
        for (int i = 0; i < 16; ++i) ss += x[i] * x[i];
        ss = dpp_add<0xB1>(ss); ss = dpp_add<0x4E>(ss);
        const float rstd = 1.0f / sqrtf(ss * (1.0f / 64.0f) + EPS);
#pragma unroll
        for (int i = 0; i < 16; ++i) x[i] = x[i] * rstd * gk[i >> 2][i & 3];
#pragma unroll
        for (int i = 0; i < 8; ++i) { const float cs = kcs[it][i >> 2][i & 3], sn = kcs[it][2 + (i >> 2)][i & 3]; const float t1 = x[i], t2 = x[8 + i];
            x[i] = part == 0 ? t1 * cs - t2 * sn : t1; x[8 + i] = part == 0 ? t2 * cs + t1 * sn : t2; }
        u32x4 w0, w1;
#pragma unroll
        for (int i = 0; i < 4; ++i) { w0[i] = valid ? cvtpk(x[2 * i], x[2 * i + 1]) : 0u; w1[i] = valid ? cvtpk(x[8 + 2 * i], x[8 + 2 * i + 1]) : 0u; }
        LAS bf16_t* d = Ks + row * KS_PITCH + 16 * part;
        *(LAS u32x4*)d = w0; *(LAS u32x4*)(d + 8) = w1;
    }
#pragma unroll
    for (int it = 0; it < 4; ++it) {
        const int task = tid + 512 * it, row = task & 255, ch = task >> 8; const bool valid = (n - 1) * 128 + row >= 0;
        u32x4 r = vr[it];
        if (!valid) r = (u32x4){0u, 0u, 0u, 0u};
#pragma unroll
        for (int i = 0; i < 4; ++i) { Vt[(8 * ch + 2 * i) * VT_PITCH + row] = (bf16_t)(r[i] & 0xffffu); Vt[(8 * ch + 2 * i + 1) * VT_PITCH + row] = (bf16_t)(r[i] >> 16); }
    }
    VM_WAIT();
    LDS_WAIT();
    __syncthreads();
#pragma unroll
    for (int i = 0; i < 4; ++i) { gq[i] = gq[i] * (0.125f * LOG2E); asm volatile("" : "+v"(gq[i])); asm volatile("" : "+v"(goa[i])); }
    const int lq = 4 * quad - c;
    const LAS unsigned char* qstash = lds + qstash_off(wave) + lane * 16;
    for (int qt = 0; qt < 4; ++qt) {
        const int qi0 = hf * 64 + qt * 16, kt0 = (qi0 >> 4) & ~1, qi = qi0 + c, pos = n * 128 + qi;
        const size_t tq = rowb + pos;
        bf16x8 qf[2];
        {
            const u32x4 r0 = *(const LAS u32x4*)(qstash + qt * 2048), r1 = *(const LAS u32x4*)(qstash + qt * 2048 + 1024);
            float x0[8], x1[8];
#pragma unroll
            for (int i = 0; i < 4; ++i) { x0[2 * i] = bf_lo(r0[i]); x0[2 * i + 1] = bf_hi(r0[i]); x1[2 * i] = bf_lo(r1[i]); x1[2 * i + 1] = bf_hi(r1[i]); }
            float ss = 0.f;
#pragma unroll
            for (int i = 0; i < 8; ++i) ss += x0[i] * x0[i] + x1[i] * x1[i];
            ss = xrow_sum(ss);
            const float rstd = __builtin_amdgcn_rsqf(ss * (1.0f / 64.0f) + EPS);
#pragma unroll
            for (int i = 0; i < 8; ++i) { x0[i] = x0[i] * rstd * gq[i >> 2][i & 3]; x1[i] = x1[i] * rstd * gq[2 + (i >> 2)][i & 3]; }
            const LAS float* rt = RT + qi * 16;
            const f32x4 rc0 = *(const LAS f32x4*)rt, rc1 = *(const LAS f32x4*)(rt + 4), rs0 = *(const LAS f32x4*)(rt + 8), rs1 = *(const LAS f32x4*)(rt + 12);
#pragma unroll
            for (int i = 0; i < 8; ++i) {
                const float other = xrow16_other(x0[i], (quad & 1) != 0);
                const float cs = i < 4 ? rc0[i & 3] : rc1[i & 3], sn = i < 4 ? rs0[i & 3] : rs1[i & 3];
                const float rot = (quad == 0) ? (x0[i] * cs - other * sn) : (x0[i] * cs + other * sn);
                x0[i] = (quad < 2) ? rot : x0[i];
            }
            u32x4 w0, w1;
#pragma unroll
            for (int i = 0; i < 4; ++i) { w0[i] = cvtpk(x0[2 * i], x0[2 * i + 1]); w1[i] = cvtpk(x1[2 * i], x1[2 * i + 1]); }
            qf[0] = __builtin_bit_cast(bf16x8, w0); qf[1] = __builtin_bit_cast(bf16x8, w1);
        }
        f32x4 s[10];
#pragma unroll
        for (int t = 0; t < 10; ++t) {
            s[t] = (f32x4){0.f, 0.f, 0.f, 0.f};
            const LAS bf16_t* kp = Ks + ((kt0 + t) * 16 + c) * KS_PITCH + 8 * quad;
#pragma unroll
            for (int ks = 0; ks < 2; ++ks) { const bf16x8 kf = *(const LAS bf16x8*)(kp + ks * 32); s[t] = __builtin_amdgcn_mfma_f32_16x16x32_bf16(kf, qf[ks], s[t], 0, 0, 0); }
        }
        if (n == 0) {
#pragma unroll
            for (int t = 0; t < 10; ++t)
#pragma unroll
                for (int r = 0; r < 4; ++r) { const int kj = (kt0 + t) * 16 + 4 * quad + r; const bool ok = (kj >= qi + 1) && (kj <= qi + 128) && kj >= 128; s[t][r] = ok ? s[t][r] : -1e30f; }
        } else {
            const int L = kt0 * 16 - qi0 + lq;
#pragma unroll
            for (int t = 0; t < 2; ++t)
#pragma unroll
                for (int r = 0; r < 4; ++r) { s[t][r] = (L >= 1 - (16 * t + r)) ? s[t][r] : -1e30f; s[8 + t][r] = (L <= 128 - (16 * (8 + t) + r)) ? s[8 + t][r] : -1e30f; }
        }
        float m = sinkv;
#pragma unroll
        for (int t = 0; t < 10; ++t)
#pragma unroll
            for (int r = 0; r < 4; ++r) m = __builtin_amdgcn_fmed3f(m, s[t][r], __builtin_inff());
        m = xrow_max(m);
#pragma unroll
        for (int t = 0; t < 10; ++t)
#pragma unroll
            for (int r = 0; r < 4; ++r) s[t][r] = __builtin_amdgcn_exp2f(s[t][r] - m);
        bf16x8 pf[5];
#pragma unroll
        for (int i = 0; i < 5; ++i) { u32x4 w; w.x = cvtpk(s[2 * i][0], s[2 * i][1]); w.y = cvtpk(s[2 * i][2], s[2 * i][3]);
            w.z = cvtpk(s[2 * i + 1][0], s[2 * i + 1][1]); w.w = cvtpk(s[2 * i + 1][2], s[2 * i + 1][3]); pf[i] = __builtin_bit_cast(bf16x8, w); }
        f32x4 osum = (f32x4){0.f, 0.f, 0.f, 0.f};
        { const unsigned ow = (c & 3) == 0 ? 0x3F803F80u : 0u; const bf16x8 onesA = __builtin_bit_cast(bf16x8, (u32x4){ow, ow, ow, ow});
#pragma unroll
          for (int i = 0; i < 5; ++i) osum = __builtin_amdgcn_mfma_f32_16x16x32_bf16(onesA, pf[i], osum, 0, 0, 0); }
        const float inv = __builtin_amdgcn_rcpf(osum[0] + __builtin_amdgcn_exp2f(sinkv - m));
        f32x4 o[4]; float ss = 0.f;
#pragma unroll
        for (int dt = 0; dt < 4; ++dt) {
            o[dt] = (f32x4){0.f, 0.f, 0.f, 0.f};
            const LAS bf16_t* vp = Vt + (dt * 16 + c) * VT_PITCH + kt0 * 16 + 4 * quad;
#pragma unroll
            for (int i = 0; i < 5; ++i) { const u32x2 lo = *(const LAS u32x2*)(vp + i * 32), hi = *(const LAS u32x2*)(vp + i * 32 + 16);
                u32x4 w; w.x = lo.x; w.y = lo.y; w.z = hi.x; w.w = hi.y;
                o[dt] = __builtin_amdgcn_mfma_f32_16x16x32_bf16(__builtin_bit_cast(bf16x8, w), pf[i], o[dt], 0, 0, 0); }
            ss += (o[dt][0] * o[dt][0] + o[dt][1] * o[dt][1]) + (o[dt][2] * o[dt][2] + o[dt][3] * o[dt][3]);
        }
        ss = xrow_sum(ss);
        const float fac = inv * __builtin_amdgcn_rsqf(inv * inv * ss * (1.0f / 64.0f) + EPS) * MIX_SCALE;
        if (HOST) {
            tab_row_convert<ISV>(T, tabk0 + qt, tnx, lane);
            tab_row_load(T, tabk0 + qt + 1, tnx, lane);
        }
        unsigned char* orow = MIXED + tq * DM + head * 64 + 4 * quad;
#pragma unroll
        for (int dt = 0; dt < 4; ++dt) *(unsigned*)(orow + dt * 16) = pack_i8x4_sat(o[dt] * goa[dt], fac);
    }
    __syncthreads();
}
__device__ __forceinline__ void conv_item(int item, const bf16_t* PROJ, const float* conv_w, const float* g_oc, unsigned char* MIXED, int lane) {
    const int t0 = item * 16, ch = 16 * lane;
    float w0[16], w1[16], w2[16], gg[16], up2[16], up1[16];
#pragma unroll
    for (int i = 0; i < 16; ++i) { w0[i] = conv_w[ch + i]; w1[i] = conv_w[1024 + ch + i]; w2[i] = conv_w[2048 + ch + i]; gg[i] = g_oc[ch + i]; up2[i] = 0.f; up1[i] = 0.f; }
    if ((t0 & (SEQ - 1)) != 0) {
#pragma unroll
        for (int h = 0; h < 2; ++h) {
            const bf16_t* pr = PROJ + (size_t)(t0 - 2 + h) * INC + ch;
            const u32x4 c0 = __builtin_nontemporal_load((const u32x4*)(pr + COL_C)), c1 = __builtin_nontemporal_load((const u32x4*)(pr + COL_C + 8));
#pragma unroll
            for (int i = 0; i < 4; ++i) {
                const float u0 = bf_lo(c0[i]), u1 = bf_hi(c0[i]), u2 = bf_lo(c1[i]), u3 = bf_hi(c1[i]);
                if (h == 0) { up2[2 * i] = u0; up2[2 * i + 1] = u1; up2[8 + 2 * i] = u2; up2[8 + 2 * i + 1] = u3; }
                else        { up1[2 * i] = u0; up1[2 * i + 1] = u1; up1[8 + 2 * i] = u2; up1[8 + 2 * i + 1] = u3; }
            }
        }
    }
    u32x4 nb0, nb1, nc0, nc1;
    { const bf16_t* pr = PROJ + (size_t)t0 * INC + ch; nb0 = __builtin_nontemporal_load((const u32x4*)(pr + COL_B)); nb1 = __builtin_nontemporal_load((const u32x4*)(pr + COL_B + 8)); nc0 = __builtin_nontemporal_load((const u32x4*)(pr + COL_C)); nc1 = __builtin_nontemporal_load((const u32x4*)(pr + COL_C + 8)); }
#pragma unroll
    for (int r = 0; r < 16; ++r) {
        const u32x4 b0 = nb0, b1 = nb1, c0 = nc0, c1 = nc1;
        { const bf16_t* pr = PROJ + (size_t)(t0 + (r < 15 ? r + 1 : r)) * INC + ch; nb0 = __builtin_nontemporal_load((const u32x4*)(pr + COL_B)); nb1 = __builtin_nontemporal_load((const u32x4*)(pr + COL_B + 8)); nc0 = __builtin_nontemporal_load((const u32x4*)(pr + COL_C)); nc1 = __builtin_nontemporal_load((const u32x4*)(pr + COL_C + 8)); }
        float u[16], bg[16], y[16];
#pragma unroll
        for (int i = 0; i < 4; ++i) {
            u[2 * i] = bf_lo(c0[i]); u[2 * i + 1] = bf_hi(c0[i]); u[8 + 2 * i] = bf_lo(c1[i]); u[8 + 2 * i + 1] = bf_hi(c1[i]);
            bg[2 * i] = bf_lo(b0[i]); bg[2 * i + 1] = bf_hi(b0[i]); bg[8 + 2 * i] = bf_lo(b1[i]); bg[8 + 2 * i + 1] = bf_hi(b1[i]);
        }
        float ss = 0.f;
#pragma unroll
        for (int i = 0; i < 16; ++i) { y[i] = bg[i] * (w0[i] * up2[i] + w1[i] * up1[i] + w2[i] * u[i]); ss += y[i] * y[i]; up2[i] = up1[i]; up1[i] = u[i]; }
        ss += __shfl_xor(ss, 1); ss += __shfl_xor(ss, 2);
        const float rstd = 1.0f / sqrtf(ss * (1.0f / 64.0f) + EPS);
        u32x4 o0;
#pragma unroll
        for (int i = 0; i < 4; ++i) o0[i] = pack_i8x4_sat((f32x4){y[4 * i] * rstd * gg[4 * i], y[4 * i + 1] * rstd * gg[4 * i + 1], y[4 * i + 2] * rstd * gg[4 * i + 2], y[4 * i + 3] * rstd * gg[4 * i + 3]}, MIX_SCALE);
        *(u32x4*)(MIXED + (size_t)(t0 + r) * DM + 1024 + ch) = o0;
    }
}

__device__ __forceinline__ void ins16(float (&L)[16], float x) {
#pragma unroll
    for (int j = 0; j < 16; ++j) { const float hi = fmaxf(L[j], x); x = fminf(L[j], x); L[j] = hi; }
}
template <int C> __device__ __forceinline__ float pack7(float s, unsigned q32) { unsigned t; asm("v_and_b32 %0, 0xffffff80, %1\n\tv_or3_b32 %0, %0, %2, %3" : "=&v"(t) : "v"(s), "v"(q32), "n"(C)); return __uint_as_float(t); }
template <int C> __device__ __forceinline__ float pack8(float s) { unsigned t; asm("v_and_b32 %0, 0xffffff00, %1\n\tv_or_b32 %0, %2, %0" : "=&v"(t) : "v"(s), "n"(C)); return __uint_as_float(t); }
template <int KEY> __device__ __forceinline__ float pack_lo(unsigned u) { unsigned t; asm("v_lshlrev_b32 %0, 16, %1\n\tv_or_b32 %0, %2, %0" : "=&v"(t) : "v"(u), "n"(KEY)); return __uint_as_float(t); }
template <int KEY> __device__ __forceinline__ float pack_hi(unsigned u) { unsigned t; asm("v_and_b32 %0, 0xffff0000, %1\n\tv_or_b32 %0, %2, %0" : "=&v"(t) : "v"(u), "n"(KEY)); return __uint_as_float(t); }
__device__ __forceinline__ unsigned key_of(unsigned x) { return ((x >> 2) & 7u) * 16u + (x >> 5) * 4u + (x & 3u); }
#define CE_DESC(a, b) do { const float hi_ = fmaxf(a, b), lo_ = fminf(a, b); a = hi_; b = lo_; } while (0)
__device__ __forceinline__ void bitonic_tail16(float (&L)[16]) {
#pragma unroll
    for (int d = 8; d >= 1; d >>= 1)
#pragma unroll
        for (int i = 0; i < 16; ++i) if ((i & d) == 0) CE_DESC(L[i], L[i + d]);
}
__device__ __forceinline__ void sort16_desc(float (&L)[16]) {
#define SN(i, j) CE_DESC(L[i], L[j]);
    SN(0,13) SN(1,12) SN(2,15) SN(3,14) SN(4,8) SN(5,6) SN(7,11) SN(9,10)
    SN(0,5) SN(1,7) SN(2,9) SN(3,4) SN(6,13) SN(8,14) SN(10,15) SN(11,12)
    SN(0,1) SN(2,3) SN(4,5) SN(6,8) SN(7,9) SN(10,11) SN(12,13) SN(14,15)
    SN(0,2) SN(1,3) SN(4,10) SN(5,11) SN(6,7) SN(8,9) SN(12,14) SN(13,15)
    SN(1,2) SN(3,12) SN(4,6) SN(5,7) SN(8,10) SN(9,11) SN(13,14)
    SN(1,4) SN(2,6) SN(5,8) SN(7,10) SN(9,13) SN(11,14)
    SN(2,4) SN(3,6) SN(9,12) SN(11,13)
    SN(3,5) SN(6,8) SN(7,9) SN(10,12)
    SN(3,4) SN(5,6) SN(7,8) SN(9,10) SN(11,12)
    SN(6,7) SN(8,9)
#undef SN
}
__device__ __forceinline__ void top16_of_two(float (&A)[16], const float (&B)[16]) {
#pragma unroll
    for (int j = 0; j < 16; ++j) A[j] = fmaxf(A[j], B[15 - j]);
    bitonic_tail16(A);
}
__device__ __forceinline__ void merge16(float (&L)[16], int mask) {
    float P[16];
#pragma unroll
    for (int j = 0; j < 16; ++j) P[j] = __shfl_xor(L[j], mask);
    top16_of_two(L, P);
}
constexpr int SKT_OFF = 8192 + 512, SKT_PITCH = 272;
__device__ __forceinline__ void peer_chunk(int tokb, const bf16_t* QP, const bf16_t* SK, const unsigned char* H8, const float* SH, const unsigned char* UB, const float* SU, const unsigned char* VB, const float* mod, const bf16_t* X1B, float* out,
                                           LAS unsigned char* lds, int tid, int wave, int lane) {
    LAS unsigned char* wl = lds + wave * 16384;
    int tok0 = tokb + wave * 16;
    LAS bf16_t* eidx = (LAS bf16_t*)wl; LAS bf16_t* gate = (LAS bf16_t*)(wl + 4096); LAS float* accL = (LAS float*)(wl + 8192); LAS unsigned char* ids = wl + 8192;
#pragma nounroll
    for (int rep7a_ = 0; rep7a_ < REP7A; ++rep7a_) {
#pragma nounroll
    for (int i2 = 0; i2 < 2; ++i2) {
        const int p = tid + 512 * i2, tkn = p & 127, h = p >> 7;
        const u32x4* srow = (const u32x4*)QP + (size_t)(h * 32) * MTOK + tokb + tkn;
        float T0[16], T1[16];
#pragma unroll
        for (int hf = 0; hf < 2; ++hf) {
            float L[16], Bv[16];
#define PKC(ch, DST) { const u32x4 a_ = __builtin_nontemporal_load(srow + (size_t)(hf * 16 + 2 * (ch)) * MTOK), b_ = __builtin_nontemporal_load(srow + (size_t)(hf * 16 + 2 * (ch) + 1) * MTOK); \
                DST[0] = pack_lo<(ch) * 16 + 0>(a_.x); DST[1] = pack_hi<(ch) * 16 + 1>(a_.x); DST[2] = pack_lo<(ch) * 16 + 2>(a_.y); DST[3] = pack_hi<(ch) * 16 + 3>(a_.y); \
                DST[4] = pack_lo<(ch) * 16 + 4>(a_.z); DST[5] = pack_hi<(ch) * 16 + 5>(a_.z); DST[6] = pack_lo<(ch) * 16 + 6>(a_.w); DST[7] = pack_hi<(ch) * 16 + 7>(a_.w); \
                DST[8] = pack_lo<(ch) * 16 + 8>(b_.x); DST[9] = pack_hi<(ch) * 16 + 9>(b_.x); DST[10] = pack_lo<(ch) * 16 + 10>(b_.y); DST[11] = pack_hi<(ch) * 16 + 11>(b_.y); \
                DST[12] = pack_lo<(ch) * 16 + 12>(b_.z); DST[13] = pack_hi<(ch) * 16 + 13>(b_.z); DST[14] = pack_lo<(ch) * 16 + 14>(b_.w); DST[15] = pack_hi<(ch) * 16 + 15>(b_.w); }
            PKC(0, L) sort16_desc(L);
            PKC(1, Bv) sort16_desc(Bv); top16_of_two(L, Bv);
            PKC(2, Bv) sort16_desc(Bv); top16_of_two(L, Bv);
            PKC(3, Bv) sort16_desc(Bv); top16_of_two(L, Bv);
            PKC(4, Bv) sort16_desc(Bv); top16_of_two(L, Bv);
            PKC(5, Bv) sort16_desc(Bv); top16_of_two(L, Bv);
            PKC(6, Bv) sort16_desc(Bv); top16_of_two(L, Bv);
            PKC(7, Bv) sort16_desc(Bv); top16_of_two(L, Bv);
#undef PKC
#pragma unroll
            for (int j = 0; j < 16; ++j) { if (hf == 0) T0[j] = L[j]; else T1[j] = L[j]; }
        }
        float R[16], Bc[16], Cc[16];
#define CAND(i, j) pack8<(i) * 16 + (j)>(T0[i] + T1[j])
#pragma unroll
        for (int j = 0; j < 16; ++j) R[j] = __uint_as_float((__float_as_uint(T0[0] + T1[j]) & 0xFFFFFF00u) | (unsigned)j);
        Bc[0] = CAND(1, 0); Bc[1] = CAND(1, 1); Bc[2] = CAND(1, 2); Bc[3] = CAND(1, 3); Bc[4] = CAND(1, 4); Bc[5] = CAND(1, 5); Bc[6] = CAND(1, 6); Bc[7] = CAND(1, 7);
        Bc[8] = CAND(2, 0); Bc[9] = CAND(2, 1); Bc[10] = CAND(2, 2); Bc[11] = CAND(2, 3); Bc[12] = CAND(2, 4); Bc[13] = CAND(3, 0); Bc[14] = CAND(3, 1); Bc[15] = CAND(3, 2);
        Cc[0] = CAND(3, 3); Cc[1] = CAND(4, 0); Cc[2] = CAND(4, 1); Cc[3] = CAND(4, 2); Cc[4] = CAND(5, 0); Cc[5] = CAND(5, 1); Cc[6] = CAND(6, 0); Cc[7] = CAND(6, 1);
        Cc[8] = CAND(7, 0); Cc[9] = CAND(7, 1); Cc[10] = CAND(8, 0); Cc[11] = CAND(9, 0); Cc[12] = CAND(10, 0); Cc[13] = CAND(11, 0); Cc[14] = CAND(12, 0); Cc[15] = CAND(13, 0);
        sort16_desc(Bc); sort16_desc(Cc); top16_of_two(R, Bc); top16_of_two(R, Cc);
        ins16(R, CAND(14, 0)); ins16(R, CAND(15, 0));
#undef CAND
        {
            LAS unsigned char* idb = lds + wave * 16384 + 8192 + lane * 32;
            u32x4 i0, i1;
#pragma unroll
            for (int w = 0; w < 4; ++w) {
                i0[w] = (__float_as_uint(T0[4 * w]) & 0x7Fu) | ((__float_as_uint(T0[4 * w + 1]) & 0x7Fu) << 8) | ((__float_as_uint(T0[4 * w + 2]) & 0x7Fu) << 16) | ((__float_as_uint(T0[4 * w + 3]) & 0x7Fu) << 24);
                i1[w] = (__float_as_uint(T1[4 * w]) & 0x7Fu) | ((__float_as_uint(T1[4 * w + 1]) & 0x7Fu) << 8) | ((__float_as_uint(T1[4 * w + 2]) & 0x7Fu) << 16) | ((__float_as_uint(T1[4 * w + 3]) & 0x7Fu) << 24); }
            *(LAS u32x4*)idb = i0; *(LAS u32x4*)(idb + 16) = i1;
            float e[16], sum = 0.f;
#pragma unroll
            for (int k = 0; k < 16; ++k) { e[k] = __builtin_amdgcn_exp2f((R[k] - R[0]) * LOG2E); sum += e[k]; }
            const float inv = 1.0f / sum;
            LDS_WAIT(); asm volatile("" ::: "memory");
            unsigned ex[16];
#pragma unroll
            for (int k = 0; k < 16; ++k) { const unsigned code = __float_as_uint(R[k]) & 0xFFu; ex[k] = (unsigned)idb[code >> 4] * 128u + (unsigned)idb[16 + (code & 15u)]; }
            LAS unsigned char* tb = lds + (tkn >> 4) * 16384 + ((tkn & 15) * 128 + h * 16) * 2;
            u32x4 ea, eb, ga, gb;
#pragma unroll
            for (int w = 0; w < 4; ++w) { ea[w] = ex[2 * w] | (ex[2 * w + 1] << 16); eb[w] = ex[8 + 2 * w] | (ex[8 + 2 * w + 1] << 16);
                ga[w] = cvtpk(e[2 * w] * inv, e[2 * w + 1] * inv); gb[w] = cvtpk(e[8 + 2 * w] * inv, e[8 + 2 * w + 1] * inv); }
            *(LAS u32x4*)tb = ea; *(LAS u32x4*)(tb + 16) = eb; *(LAS u32x4*)(tb + 4096) = ga; *(LAS u32x4*)(tb + 4096 + 16) = gb;
        }
    }
    LDS_WAIT();
    __syncthreads();
    }
    LDS_WAIT(); asm volatile("" ::: "memory");
    int lane_b = lane; asm volatile("" : "+v"(lane_b));
    const int g = lane_b >> 3, k = lane_b & 7; const unsigned k16 = (unsigned)k * 16u;
    LAS int* accI = (LAS int*)accL;
#pragma nounroll
    for (int rep7u_ = 0; rep7u_ < REP7U; ++rep7u_) {
    LDS_WAIT(); asm volatile("" ::: "memory");
    for (int i = lane; i < 2048; i += 64) accI[i] = 0;
    LDS_WAIT(); asm volatile("" ::: "memory");
    asm volatile("" : "+s"(tok0));
    const unsigned char* hbase = H8 + (size_t)(tok0 + g) * DM + k * 16;
    u32x4 hn = __builtin_nontemporal_load((const u32x4*)hbase);
    for (int s = 0; s < 16; ++s) {
        const unsigned char* Us = UB + (size_t)s * (PEER_N * 128);
#pragma unroll
        for (int r = 0; r < 2; ++r) {
            const int tl = r * 8 + g;
            const u32x4 hq = hn;
            { const int sn = r ? s + 1 : s, rn = r ^ 1; if (sn < 16) hn = __builtin_nontemporal_load((const u32x4*)(hbase + (size_t)rn * 8 * DM + sn * 128)); }
            const LAS bf16_t* ei = eidx + tl * 128;
            LAS int* ap = accI + tl * 128 + k;
#pragma nounroll
            for (int ib2 = 0; ib2 < 8; ++ib2) {
                u32x4 uv[16];
#pragma unroll
                for (int q = 0; q < 16; ++q) { const unsigned e = ei[ib2 * 16 + q]; uv[q] = *(const u32x4*)(Us + (size_t)(unsigned)((e << 7) + k16)); }
#pragma unroll
                for (int hb = 0; hb < 2; ++hb) {
                    int p[8];
#pragma unroll
                    for (int ii = 0; ii < 8; ++ii) { const u32x4 v = uv[hb * 8 + ii];
                        p[ii] = __builtin_amdgcn_sdot4((int)v.x, (int)hq.x, __builtin_amdgcn_sdot4((int)v.y, (int)hq.y, __builtin_amdgcn_sdot4((int)v.z, (int)hq.z, __builtin_amdgcn_sdot4((int)v.w, (int)hq.w, 0, false), false), false), false); }
                    int a4[4], a2[2];
#pragma unroll
                    for (int j = 0; j < 4; ++j) { const int send = (k & 4) ? p[j] : p[j + 4], keep = (k & 4) ? p[j + 4] : p[j]; a4[j] = keep + dpp_movi<0x141>(send); }
#pragma unroll
                    for (int j = 0; j < 2; ++j) { const int send = (k & 2) ? a4[j] : a4[j + 2], keep = (k & 2) ? a4[j + 2] : a4[j]; a2[j] = keep + dpp_movi<0x1B>(send); }
                    const int send = (k & 1) ? a2[0] : a2[1], keep = (k & 1) ? a2[1] : a2[0];
                    const int tot = keep + dpp_movi<0xB1>(send);
                    __hip_atomic_fetch_add(ap + ib2 * 16 + hb * 8, tot, __ATOMIC_RELAXED, __HIP_MEMORY_SCOPE_WORKGROUP);
                }
            }
        }
    }
    }
    LDS_WAIT(); asm volatile("" ::: "memory");
    LAS bf16_t* wgt = gate;
    for (int i = lane; i < 2048; i += 64) {
        const float a = (float)accI[i] * SU[eidx[i]] * SH[tok0 + (i >> 7)];
        const float ge = 0.5f * a * (1.0f + erff(a * 0.70710678118654752f));
        wgt[i] = (bf16_t)(cvtpk(bf_lo((unsigned)gate[i]) * ge * (1.0f / V_SCALE), 0.f) & 0xffffu);
    }
    LDS_WAIT(); asm volatile("" ::: "memory");
    const float* g2 = mod + (size_t)(tok0 >> 12) * MODW + 5 * DM;
#pragma nounroll
    for (int rep7v_ = 0; rep7v_ < REP7V; ++rep7v_)
    for (int s = 0; s < 16; ++s) {
        const unsigned char* Vs = VB + (size_t)s * (PEER_N * 128);
        f32x4 gvv[4];
#pragma unroll
        for (int q = 0; q < 4; ++q) gvv[q] = *(const f32x4*)(g2 + s * 128 + 32 * q + 4 * k);
#pragma unroll
        for (int r = 0; r < 2; ++r) {
            const int tl = r * 8 + g;
            float* orow = out + (size_t)(tok0 + tl) * DM + s * 128 + 4 * k;
            const bf16_t* xrow = X1B + (size_t)(tok0 + tl) * DM + s * 128 + 4 * k;
            u32x2 xq[4];
#pragma unroll
            for (int q = 0; q < 4; ++q) xq[q] = __builtin_nontemporal_load((const u32x2*)(xrow + 32 * q));
            const LAS bf16_t* ei = eidx + tl * 128; const LAS bf16_t* wi = wgt + tl * 128;
            float y[16];
#pragma unroll
            for (int i = 0; i < 16; ++i) y[i] = 0.f;
#pragma nounroll
            for (int b = 0; b < 8; ++b) {
                u32x4 vq[16];
#pragma unroll
                for (int q = 0; q < 16; ++q) { const unsigned e = ei[b * 16 + q]; vq[q] = *(const u32x4*)(Vs + (size_t)(unsigned)((e << 7) + k16)); }
#pragma unroll
                for (int q = 0; q < 16; ++q) {
                    const float wf = bf_lo((unsigned)wi[b * 16 + q]); const u32x4 vv = vq[q];
#pragma unroll
                    for (int w = 0; w < 4; ++w) { const f32x2 f01 = __builtin_amdgcn_cvt_pk_f32_fp8(vv[w], false), f23 = __builtin_amdgcn_cvt_pk_f32_fp8(vv[w], true);
                        y[4 * w] = fmaf(wf, f01.x, y[4 * w]); y[4 * w + 1] = fmaf(wf, f01.y, y[4 * w + 1]); y[4 * w + 2] = fmaf(wf, f23.x, y[4 * w + 2]); y[4 * w + 3] = fmaf(wf, f23.y, y[4 * w + 3]); }
                }
            }
#pragma unroll
            for (int q = 0; q < 4; ++q) { f32x4 o; const f32x4 gv = gvv[q];
                const unsigned xlo = xq[q].x, xhi = xq[q].y;
                const float x1v[4] = {bf_lo(xlo), bf_hi(xlo), bf_lo(xhi), bf_hi(xhi)};
#pragma unroll
                for (int i = 0; i < 4; ++i) o[i] = x1v[i] + gv[i] * y[4 * q + i];
                if (rep7v_ == REP7V - 1) __builtin_nontemporal_store(o, (f32x4*)(orow + 32 * q)); else asm volatile("" :: "v"(o)); }
        }
    }
}

constexpr int N_PHASES = 8;
struct Args { const float* in[18]; float* out; unsigned char* ws; int ph_lo, ph_hi; };
__global__ void __launch_bounds__(NWAVES * 64, 2) hymba_fwd(Args args) {
    extern __shared__ __attribute__((aligned(16))) unsigned char lds_raw[];
    LAS unsigned char* lds = (LAS unsigned char*)lds_raw;
    volatile LAS unsigned* MISC = (volatile LAS unsigned*)(lds + MISC_OFF);
    const int wave = __builtin_amdgcn_readfirstlane((int)threadIdx.x >> 6);
    const int G = gridDim.x, bx = blockIdx.x;
    const int gw = bx * NWAVES + wave, NGW = G * NWAVES;
#define FRESH_IDS() const int lane = fresh_lane(); const int tid = wave * 64 + lane; (void)tid
    unsigned char* ws = args.ws;
    const float* x = args.in[0]; const float* cvec = args.in[1]; const float* w_ada = args.in[2]; const float* b_ada = args.in[3]; const float* g_norm1 = args.in[4];
    const float* w_in = args.in[5]; const float* g_q = args.in[6]; const float* g_k = args.in[7]; const float* sinks = args.in[8]; const float* conv_w = args.in[9];
    const float* g_oa = args.in[10]; const float* g_oc = args.in[11]; const float* w_out = args.in[12]; const float* g_norm2 = args.in[13]; const float* w_pq = args.in[14];
    const float* subkeys = args.in[15]; const float* peer_u = args.in[16]; const float* peer_v = args.in[17];
    float* out = args.out;
    float* mod = (float*)(ws + WS_MOD); float* rope = (float*)(ws + WS_ROPE);
    bf16_t* SK = (bf16_t*)(ws + WS_SK); bf16_t* WIN = (bf16_t*)(ws + WS_WIN); bf16_t* WOUT = (bf16_t*)(ws + WS_WOUT); bf16_t* WPQ = (bf16_t*)(ws + WS_WPQ);
    unsigned char* UB = ws + WS_UB; unsigned char* VB = ws + WS_VB; unsigned char* H8 = ws + WS_H8; float* SU = (float*)(ws + WS_SU); float* SH = (float*)(ws + WS_SH); bf16_t* XN = (bf16_t*)(ws + WS_XN); bf16_t* PROJ = (bf16_t*)(ws + WS_PROJ);
    bf16_t* QP = (bf16_t*)(ws + WS_QP); bf16_t* X1B = (bf16_t*)(ws + WS_X1B); unsigned char* MIXED = ws + WS_MIXED; unsigned char* XN8 = ws + WS_XN; float* SX1 = (float*)(ws + WS_SX1); bf16_t* W2 = (bf16_t*)(ws + WS_XN + 64 * MiB);
    unsigned* ctl = (unsigned*)(ws + WS_CTL);

    { FRESH_IDS(); for (int u = tid; u < (LDS_BYTES - LDSCTL_OFF) / 4; u += NWAVES * 64) ((LAS unsigned*)(lds + LDSCTL_OFF))[u] = 0u; }
    __syncthreads();
    XcdBarrier bar; bar.bar = ctl + CW_BAR; bar.x = 0; bar.st = nullptr; bar.wave = wave;
    if (MK_N_LAUNCHES == 1) bar = xcd_barrier_post(ctl + CW_BAR, MISC + 8, wave);
    const int lo = args.ph_lo, hi = args.ph_hi;
#define IN(k) (lo <= (k) && (k) < hi)
#define SEAM(k) do { if (IN(k) && IN((k) + 1)) xcd_barrier(bar); } while (0)

#pragma nounroll
    for (int rep_ = 0; rep_ < REP0; ++rep_) { if (rep_) xcd_barrier(bar);
    if (IN(0)) { FRESH_IDS();
#pragma nounroll
        for (int ra_ = 0; ra_ < REP0A; ++ra_)
        for (int it = bx; it < MODW / 64; it += G) p0_ada_item(cvec, w_ada, b_ada, mod, lds, it, tid, wave, lane);
        LAS float* scr = (LAS float*)(lds + wave * 16384);
        constexpr int I_IN = (DM / 64) * (INC / 32), I_SQ = (DM / 64) * (DM / 32), I_TAB = PEER_N * DM / 2048, I_W2 = 512, I_ROPE = 512;
        (void)scr;
        { const int nfree = G > MODW / 64 ? (G - MODW / 64) * NWAVES : 0;
          if (nfree > 0) { if (bx >= MODW / 64) for (int r = (bx - MODW / 64) * NWAVES + wave; r < I_W2; r += nfree) p0_w2_item(w_pq, subkeys, W2, ctl + CW_CMX_PQ, r, lane); }
          else for (int r = gw; r < I_W2; r += NGW) p0_w2_item(w_pq, subkeys, W2, ctl + CW_CMX_PQ, r, lane); }
#pragma nounroll
        for (int rc_ = 0; rc_ < REP0C; ++rc_)
        for (int r = gw; r < I_IN + I_SQ; r += NGW) { if (r < I_IN) p0_colmax_item(w_in, INC, ctl + CW_CMX_IN, r, lane); else p0_colmax_item(w_out, DM, ctl + CW_CMX_OUT, r - I_IN, lane); }
        for (int r = gw; r < I_ROPE; r += NGW) p0_rope_item(rope, r, lane);
        if (G == 256) {   }
        else if (NGW * 8 == I_TAB) p0_tables8(peer_u, peer_v, UB, SU, VB, gw, NGW, lane);
        else for (int r = gw; r < 2 * I_TAB; r += NGW) { if (r < I_TAB) p0_i8_row(peer_u, UB, SU, r, lane); else p0_fp8_item(peer_v, VB, (size_t)(r - I_TAB) * 2048, V_SCALE, lane); }
    }
    }
    SEAM(0);
#pragma nounroll
    for (int rep_ = 0; rep_ < REP1; ++rep_) { if (rep_) xcd_barrier(bar);
    if (IN(1)) { FRESH_IDS(); norm_rows(x, g_norm1, mod, 0 * DM, 1 * DM, XN8, SX1, gw, NGW, lane);
        LAS float* scr = (LAS float*)(lds + wave * 16384);
        constexpr int I_IN = (DM / 64) * (INC / 32), I_SQ = (DM / 64) * (DM / 32);
        for (int it = gw; it < I_IN + I_SQ + DM; it += NGW) {
            int r = it;
            if (r < I_IN) { p1_transpose_i8_item<true>(w_in, DM, INC, (unsigned char*)WIN, ctl + CW_CMX_IN, scr, r, lane); continue; } r -= I_IN;
            if (r < I_SQ) { p1_transpose_i8_item<false>(w_out, DM, DM, (unsigned char*)WOUT, ctl + CW_CMX_OUT, scr, r, lane); continue; } r -= I_SQ;
            p1_w2_row(W2, (unsigned char*)WPQ, ctl + CW_CMX_PQ, r, lane);
        }
    }
    }
    SEAM(1);
#if REP2 > 1
    if (IN(2)) {
        pg8::Gemm g{(const bf16_t*)XN8, (const bf16_t*)WIN, MTOK, INC, DM / 2}; pg8::StaticOrder S; S.init(MTOK, INC, G, bx);
        pg8::EpiProjI8 E{PROJ, INC, SX1, ctl + CW_CMX_IN};
        pg8::gemm_phase<pg8::EpiProjI8, pg8::StaticOrder, true, true, true>(lds, g, S, E, wave);
    }
    xcd_barrier(bar);
#endif
    if (IN(2)) {
        pg8::Gemm g{(const bf16_t*)XN8, (const bf16_t*)WIN, MTOK, INC, DM / 2}; pg8::StaticOrder S; S.init(MTOK, INC, G, bx);
        pg8::EpiProjI8 E{PROJ, INC, SX1, ctl + CW_CMX_IN};
        pg8::gemm_phase<pg8::EpiProjI8, pg8::StaticOrder, true, true, true>(lds, g, S, E, wave);
    }
    SEAM(2);
#pragma nounroll
    for (int rep_ = 0; rep_ < REP3; ++rep_) { if (rep_) xcd_barrier(bar);
    if (IN(3)) { FRESH_IDS();
#ifndef REP3A
#define REP3A 1
#endif
#pragma nounroll
        for (int ra_ = 0; ra_ < REP3A; ++ra_)
        { f32x4 tcur[8], tnx[8];
          if (G != 256) {
              const TabCtx T{peer_u, UB, SU, 0};
              for (int u = bx; u < BATCH * 4 * 32; u += G) attn_unit<false, false>(u >> 7, (u >> 5) & 3, u & 31, PROJ, g_q, g_k, sinks, g_oa, rope, MIXED, lds, tid, wave, lane, T, 0, tcur, tnx);
          } else if (wave & 1) {
              const TabCtx T{peer_v, VB, SU, gw >> 1};
              tab_row_load(T, 0, tnx, lane);
              int ui = 0;
              for (int u = bx; u < BATCH * 4 * 32; u += G, ++ui) attn_unit<true, true>(u >> 7, (u >> 5) & 3, u & 31, PROJ, g_q, g_k, sinks, g_oa, rope, MIXED, lds, tid, wave, lane, T, ui * 4, tcur, tnx);
          } else {
              const TabCtx T{peer_u, UB, SU, gw >> 1};
              tab_row_load(T, 0, tnx, lane);
              int ui = 0;
              for (int u = bx; u < BATCH * 4 * 32; u += G, ++ui) attn_unit<true, false>(u >> 7, (u >> 5) & 3, u & 31, PROJ, g_q, g_k, sinks, g_oa, rope, MIXED, lds, tid, wave, lane, T, ui * 4, tcur, tnx);
          } }
        for (int it = gw; it < MTOK / 16; it += NGW) conv_item(it, PROJ, conv_w, g_oc, MIXED, lane);
    }
    }
    SEAM(3);
#if REP4 > 1
    if (IN(4)) {
        pg8::Gemm g{(const bf16_t*)MIXED, (const bf16_t*)WOUT, MTOK, DM, DM / 2}; pg8::StaticOrder S; S.init(MTOK, DM, G, bx);
        pg8::EpiResGateBf16I8 E{x, X1B, DM, mod + 2 * DM, MODW, 1.0f / MIX_SCALE, ctl + CW_CMX_OUT};
        pg8::gemm_phase<pg8::EpiResGateBf16I8, pg8::StaticOrder, true, true, true>(lds, g, S, E, wave);
    }
    xcd_barrier(bar);
#endif
    if (IN(4)) {
        pg8::Gemm g{(const bf16_t*)MIXED, (const bf16_t*)WOUT, MTOK, DM, DM / 2}; pg8::StaticOrder S; S.init(MTOK, DM, G, bx);
        pg8::EpiResGateBf16I8 E{x, X1B, DM, mod + 2 * DM, MODW, 1.0f / MIX_SCALE, ctl + CW_CMX_OUT};
        pg8::gemm_phase<pg8::EpiResGateBf16I8, pg8::StaticOrder, true, true, true>(lds, g, S, E, wave);
    }
    SEAM(4);
#pragma nounroll
    for (int rep_ = 0; rep_ < REP5; ++rep_) { if (rep_) xcd_barrier(bar);
    if (IN(5)) { FRESH_IDS(); norm_rows_bf16(X1B, g_norm2, mod, 3 * DM, 4 * DM, H8, SH, gw, NGW, lane); }
    }
    SEAM(5);
#if REP6 > 1
    if (IN(6)) {
        pg8::Gemm g{(const bf16_t*)H8, (const bf16_t*)WPQ, MTOK, DM, DM / 2}; pg8::StaticOrder S; S.init(MTOK, DM, G, bx);
        pg8::EpiScoresI8 E{QP, MTOK, SH, ctl + CW_CMX_PQ};
        pg8::gemm_phase<pg8::EpiScoresI8, pg8::StaticOrder, true, true, true>(lds, g, S, E, wave);
    }
    xcd_barrier(bar);
#endif
    if (IN(6)) {
        pg8::Gemm g{(const bf16_t*)H8, (const bf16_t*)WPQ, MTOK, DM, DM / 2}; pg8::StaticOrder S; S.init(MTOK, DM, G, bx);
        pg8::EpiScoresI8 E{QP, MTOK, SH, ctl + CW_CMX_PQ};
        pg8::gemm_phase<pg8::EpiScoresI8, pg8::StaticOrder, true, true, true>(lds, g, S, E, wave);
    }
    SEAM(6);
    if (IN(7)) { FRESH_IDS();
        for (int chunk = bx; chunk < MTOK / 128; chunk += G) peer_chunk(chunk * 128, QP, SK, H8, SH, UB, SU, VB, mod, X1B, out, lds, tid, wave, lane);
    }
#undef IN
#undef SEAM
}

extern "C" void kernel_launch(void* const* d_in, const int* in_sizes, int n_in, void* d_out, int out_size, void* d_ws, size_t ws_size, hipStream_t stream) {
    static int grid = 0;
    if (grid == 0) {
        if (n_in != 18 || in_sizes[0] != MTOK * DM || out_size != MTOK * DM || ws_size < WS_END) { fprintf(stderr, "kernel_launch: unexpected shapes (n_in %d, in0 %d, out %d, ws %zu)\n", n_in, n_in > 0 ? in_sizes[0] : -1, out_size, ws_size); grid = -1; return; }
        int dev = 0, cus = 0, per_cu = 0;
        if (hipGetDevice(&dev) != hipSuccess || hipDeviceGetAttribute(&cus, hipDeviceAttributeMultiprocessorCount, dev) != hipSuccess) { grid = -1; return; }
        if (hipFuncSetAttribute((const void*)hymba_fwd, hipFuncAttributeMaxDynamicSharedMemorySize, LDS_BYTES) != hipSuccess) { fprintf(stderr, "kernel_launch: hipFuncSetAttribute failed\n"); grid = -1; return; }
        if (hipOccupancyMaxActiveBlocksPerMultiprocessor(&per_cu, (const void*)hymba_fwd, NWAVES * 64, LDS_BYTES) != hipSuccess || per_cu < 1) { fprintf(stderr, "kernel_launch: occupancy query says %d blocks per CU\n", per_cu); per_cu = 1; }
        (void)hipGetLastError();
        grid = cus;
    }
    if (grid < 0) return;
    (void)hipMemsetAsync((char*)d_ws + WS_CTL, 0, CTL_ZERO_BYTES, stream);
    Args a{};
    for (int i = 0; i < 18; ++i) a.in[i] = (const float*)d_in[i];
    a.out = (float*)d_out; a.ws = (unsigned char*)d_ws;
    if (MK_N_LAUNCHES == 1) {
        a.ph_lo = 0; a.ph_hi = N_PHASES;
        hipLaunchKernelGGL(hymba_fwd, dim3(grid), dim3(NWAVES * 64), LDS_BYTES, stream, a);
    } else {
        for (int p = 0; p < N_PHASES; ++p) { a.ph_lo = p; a.ph_hi = p + 1; hipLaunchKernelGGL(hymba_fwd, dim3(grid), dim3(NWAVES * 64), LDS_BYTES, stream, a); }
    }
}
```

```cpp
#include <hip/hip_runtime.h>
#include <cstdio>
#include <cstdint>

#ifndef MK_N_LAUNCHES
#define MK_N_LAUNCHES 1
#endif

#ifndef REP0
#define REP0 1
#endif
#ifndef REP0A
#define REP0A 1
#endif
#ifndef REP0C
#define REP0C 1
#endif
#ifndef REP1
#define REP1 1
#endif
#ifndef REP2
#define REP2 1
#endif
#ifndef REP3
#define REP3 1
#endif
#ifndef REP4
#define REP4 1
#endif
#ifndef REP5
#define REP5 1
#endif
#ifndef REP6
#define REP6 1
#endif
#ifndef REP7A
#define REP7A 1
#endif
#ifndef REP7U
#define REP7U 1
#endif
#ifndef REPSEL
#define REPSEL 1
#endif
#ifndef REP7V
#define REP7V 1
#endif
#ifndef REPSC
#define REPSC 1
#endif

#define LAS __attribute__((address_space(3)))
#define GAS __attribute__((address_space(1)))
typedef unsigned short bf16_t;
typedef short bf16x8 __attribute__((ext_vector_type(8)));
typedef short s16x4 __attribute__((ext_vector_type(4)));
typedef float f32x4 __attribute__((ext_vector_type(4)));
typedef float f32x2 __attribute__((ext_vector_type(2)));
typedef unsigned u32x4 __attribute__((ext_vector_type(4)));
typedef unsigned u32x2 __attribute__((ext_vector_type(2)));
typedef int i32x4 __attribute__((ext_vector_type(4)));
typedef __bf16 bf16x2_t __attribute__((ext_vector_type(2)));

constexpr int DM = 2048, BATCH = 8, SEQ = 4096, MTOK = BATCH * SEQ;
constexpr int INC = 4608;
constexpr int COL_K = 1024, COL_V = 1280, COL_B = 1536, COL_C = 2560, COL_H = 3584;
constexpr int MODW = 6 * DM;
constexpr int PEER_N = 16384;
constexpr float EPS = 1e-6f;
constexpr float LOG2E = 1.4426950408889634f;
constexpr float MIX_SCALE = 127.0f / 6.0f;
constexpr float V_SCALE = 16.0f;

constexpr size_t MiB = 1u << 20;
constexpr size_t WS_CTL = 0, CTL_ZERO_BYTES = 1 * MiB;
constexpr size_t WS_MOD = 1 * MiB;
constexpr size_t WS_ROPE = 1 * MiB + 512 * 1024;
constexpr size_t WS_SK = 2 * MiB;
constexpr size_t WS_WIN = 4 * MiB;
constexpr size_t WS_WOUT = 22 * MiB;
constexpr size_t WS_WPQ = 30 * MiB;
constexpr size_t WS_SU = 3 * MiB;
constexpr size_t WS_SH = 3 * MiB + 256 * 1024;
constexpr size_t WS_SX1 = 3 * MiB + 512 * 1024;
constexpr size_t WS_UB = 40 * MiB;
constexpr size_t WS_VB = 104 * MiB;
constexpr size_t WS_XN = 168 * MiB;
constexpr size_t WS_PROJ = 296 * MiB;
constexpr size_t WS_QP = WS_PROJ;
constexpr size_t WS_X1B = WS_PROJ + 128 * MiB;
constexpr size_t WS_MIXED = 584 * MiB;
constexpr size_t WS_H8 = 712 * MiB;
constexpr size_t WS_END = 776 * MiB;
constexpr int CW_BAR = 4096;
constexpr int CW_CMX_IN = 32768, CW_CMX_OUT = CW_CMX_IN + 4608, CW_CMX_PQ = CW_CMX_OUT + 2048;

constexpr int RING_BYTES = 131072;
constexpr int LDSCTL_OFF = RING_BYTES, MISC_OFF = LDSCTL_OFF + 320;
constexpr int LDS_BYTES = 148480;
constexpr int NWAVES = 8;

#define LDS_WAIT() asm volatile("s_waitcnt lgkmcnt(0)" ::: "memory")
#define VM_WAIT() asm volatile("s_waitcnt vmcnt(0)" ::: "memory")

__device__ __forceinline__ unsigned cvtpk(float lo, float hi) { f32x2 v = {lo, hi}; bf16x2_t b = __builtin_convertvector(v, bf16x2_t); return __builtin_bit_cast(unsigned, b); }
__device__ __forceinline__ float bf_lo(unsigned u) { return __uint_as_float(u << 16); }
__device__ __forceinline__ float bf_hi(unsigned u) { return __uint_as_float(u & 0xffff0000u); }
__device__ __forceinline__ float dot2bf(unsigned a, unsigned b, float c) { return __builtin_amdgcn_fdot2_f32_bf16(__builtin_bit_cast(bf16x2_t, a), __builtin_bit_cast(bf16x2_t, b), c, false); }
__device__ __forceinline__ int fresh_lane() { int l = (int)__builtin_amdgcn_mbcnt_hi(~0u, __builtin_amdgcn_mbcnt_lo(~0u, 0u)); asm volatile("" : "+v"(l)); return l; }
__device__ __forceinline__ float xrow_sum(float v) {
    const u32x2 a = __builtin_amdgcn_permlane16_swap(__float_as_uint(v), __float_as_uint(v), false, false); v = __uint_as_float(a.x) + __uint_as_float(a.y);
    const u32x2 b = __builtin_amdgcn_permlane32_swap(__float_as_uint(v), __float_as_uint(v), false, false); return __uint_as_float(b.x) + __uint_as_float(b.y);
}
__device__ __forceinline__ float xrow_max(float v) {
    const u32x2 a = __builtin_amdgcn_permlane16_swap(__float_as_uint(v), __float_as_uint(v), false, false); v = fmaxf(__uint_as_float(a.x), __uint_as_float(a.y));
    const u32x2 b = __builtin_amdgcn_permlane32_swap(__float_as_uint(v), __float_as_uint(v), false, false); return fmaxf(__uint_as_float(b.x), __uint_as_float(b.y));
}
__device__ __forceinline__ float xrow16_other(float v, bool odd_row) {
    const u32x2 a = __builtin_amdgcn_permlane16_swap(__float_as_uint(v), __float_as_uint(v), false, false); return __uint_as_float(odd_row ? a.x : a.y);
}

template <int CTRL> __device__ __forceinline__ float dpp_add(float v) { return v + __int_as_float(__builtin_amdgcn_update_dpp(0, __float_as_int(v), CTRL, 0xF, 0xF, false)); }
template <int CTRL> __device__ __forceinline__ float dpp_mov(float v) { return __int_as_float(__builtin_amdgcn_update_dpp(0, __float_as_int(v), CTRL, 0xF, 0xF, true)); }
__device__ __forceinline__ float allred8(float v) { v = dpp_add<0x141>(v); v = dpp_add<0x1B>(v); v = dpp_add<0xB1>(v); return v; }

template <int CTRL> __device__ __forceinline__ float dpp_max(float v) { return fmaxf(v, __int_as_float(__builtin_amdgcn_update_dpp(0, __float_as_int(v), CTRL, 0xF, 0xF, false))); }
__device__ __forceinline__ float wave_sum(float v) { v = dpp_add<0xB1>(v); v = dpp_add<0x4E>(v); v = dpp_add<0x141>(v); v = dpp_add<0x140>(v); return xrow_sum(v); }
__device__ __forceinline__ float wave_max(float v) { v = dpp_max<0xB1>(v); v = dpp_max<0x4E>(v); v = dpp_max<0x141>(v); v = dpp_max<0x140>(v); return xrow_max(v); }
__device__ __forceinline__ unsigned pack_i8x4_sat(f32x4 x, float inv) {
    const int a = (int)rintf(fminf(fmaxf(x[0] * inv, -127.f), 127.f)), b = (int)rintf(fminf(fmaxf(x[1] * inv, -127.f), 127.f)), c = (int)rintf(fminf(fmaxf(x[2] * inv, -127.f), 127.f)), d = (int)rintf(fminf(fmaxf(x[3] * inv, -127.f), 127.f));
    return ((unsigned)a & 0xffu) | (((unsigned)b & 0xffu) << 8) | (((unsigned)c & 0xffu) << 16) | ((unsigned)d << 24);
}
__device__ __forceinline__ unsigned pack_i8x4(f32x4 x, float inv) {
    const int a = (int)rintf(x[0] * inv), b = (int)rintf(x[1] * inv), c = (int)rintf(x[2] * inv), d = (int)rintf(x[3] * inv);
    return ((unsigned)a & 0xffu) | (((unsigned)b & 0xffu) << 8) | (((unsigned)c & 0xffu) << 16) | ((unsigned)d << 24);
}
template <int CTRL> __device__ __forceinline__ int dpp_movi(int v) { return __builtin_amdgcn_update_dpp(0, v, CTRL, 0xF, 0xF, true); }

namespace pg8 {
#define PG8_LAS __attribute__((address_space(3)))
constexpr int BM = 256, BK = 64, HALF = 128, HTB = HALF * BK * 2, STAGE_BYTES = 8 * HTB, NXCD = 8, WGM = 4;
__host__ __device__ __forceinline__ int lds_byte(int r, int c) { const int st = (r >> 4) * 2 + (c >> 5), rr = r & 15, cc = c & 31, ob = rr * 64 + cc * 2; return st * 1024 + (ob ^ (((ob >> 9) & 1) << 5)); }
__host__ __device__ __forceinline__ void stage_rc(int b, int& R, int& C) { const int st = b / 1024, sb = b % 1024, swz = sb ^ (((sb >> 9) & 1) << 5); R = (st >> 1) * 16 + swz / 64; C = (st & 1) * 32 + (swz % 64) / 2; }
__host__ __device__ __forceinline__ int perm32(int rho) { const int n = rho >> 4, i = rho & 15; return 8 * (i >> 2) + 4 * n + (i & 3); }
struct Unit { int pm, pn; };
struct Gemm { const bf16_t* A; const bf16_t* Bt; int M, N, K; };
struct StaticOrder {
    int nM, nN, nwg, G, c;
    __host__ __device__ void init(int M, int N, int G_, int c_) { nM = M / BM; nN = N / BM; nwg = nM * nN; G = G_; c = c_; }
    __host__ __device__ bool next(int i, Unit& u) const {
        const long L = (long)i * G + c; if (L >= nwg) return false;
        int wgid = (int)L; { const int q = nwg / NXCD, r = nwg % NXCD, xcd = wgid % NXCD, off = wgid / NXCD; wgid = (xcd < r ? xcd * (q + 1) : r * (q + 1) + (xcd - r) * q) + off; }
        const int nig = WGM * nN, gid = wgid / nig, fm = gid * WGM, gsz = (nM - fm) < WGM ? (nM - fm) : WGM;
        u.pm = fm + ((wgid % nig) % gsz); u.pn = (wgid % nig) / gsz; return true;
    }
    __device__ __forceinline__ void a_ready(const Unit&) const {}
    __device__ __forceinline__ void done(const Unit&) const {}
};
__device__ __forceinline__ unsigned cvt_pk_bf16(float lo, float hi) { unsigned r; asm volatile("v_cvt_pk_bf16_f32 %0, %1, %2" : "=v"(r) : "v"(lo), "v"(hi)); return r; }

struct EpiBf16 {
    static constexpr bool PERM = true, AFTER_DRAIN = false;
    bf16_t* O; int ldc;
    __device__ __forceinline__ void operator()(const f32x4 (&acc)[2][2][4][2], const Unit& u, int wr, int wc, int fr, int fq) const {
        const int row0 = u.pm * BM + wr * 64 + fr, col0 = u.pn * BM + wc * 32 + 8 * fq;
#pragma unroll
        for (int ai = 0; ai < 2; ++ai)
#pragma unroll
            for (int m = 0; m < 4; ++m) { bf16_t* rowp = O + (size_t)(row0 + ai * HALF + m * 16) * ldc + col0;
#pragma unroll
                for (int bj = 0; bj < 2; ++bj) { const f32x4 v0 = acc[ai][bj][m][0], v1 = acc[ai][bj][m][1];
                    u32x4 w; w.x = cvt_pk_bf16(v0[0], v0[1]); w.y = cvt_pk_bf16(v0[2], v0[3]); w.z = cvt_pk_bf16(v1[0], v1[1]); w.w = cvt_pk_bf16(v1[2], v1[3]);
                    *(u32x4*)(rowp + bj * HALF) = w; } }
    }
};
struct EpiBf16I8 {
    static constexpr bool PERM = true, AFTER_DRAIN = false;
    bf16_t* O; int ldc; const float* srow; const unsigned* cmax;
    __device__ __forceinline__ void operator()(const f32x4 (&acc)[2][2][4][2], const Unit& u, int wr, int wc, int fr, int fq) const {
        const int row0 = u.pm * BM + wr * 64 + fr, col0 = u.pn * BM + wc * 32 + 8 * fq;
        f32x4 sc[2][2];
#pragma unroll
        for (int bj = 0; bj < 2; ++bj)
#pragma unroll
            for (int n = 0; n < 2; ++n) { const u32x4 b = *(const u32x4*)(cmax + col0 + bj * HALF + 4 * n);
#pragma unroll
                for (int i = 0; i < 4; ++i) sc[bj][n][i] = __uint_as_float(b[i]) * (1.0f / 127.0f); }
        float srv[2][4];
#pragma unroll
        for (int ai = 0; ai < 2; ++ai)
#pragma unroll
            for (int m = 0; m < 4; ++m) srv[ai][m] = srow[row0 + ai * HALF + m * 16];
#pragma unroll
        for (int ai = 0; ai < 2; ++ai)
#pragma unroll
            for (int m = 0; m < 4; ++m) { const int row = row0 + ai * HALF + m * 16; const float sr = srv[ai][m]; bf16_t* rowp = O + (size_t)row * ldc + col0;
#pragma unroll
                for (int bj = 0; bj < 2; ++bj) { const i32x4 a0 = __builtin_bit_cast(i32x4, acc[ai][bj][m][0]), a1 = __builtin_bit_cast(i32x4, acc[ai][bj][m][1]);
                    f32x4 v0, v1;
#pragma unroll
                    for (int i = 0; i < 4; ++i) { v0[i] = (float)a0[i] * sr * sc[bj][0][i]; v1[i] = (float)a1[i] * sr * sc[bj][1][i]; }
                    u32x4 w; w.x = cvt_pk_bf16(v0[0], v0[1]); w.y = cvt_pk_bf16(v0[2], v0[3]); w.z = cvt_pk_bf16(v1[0], v1[1]); w.w = cvt_pk_bf16(v1[2], v1[3]);
                    *(u32x4*)(rowp + bj * HALF) = w; } }
    }
};
struct EpiScoresI8 {
    static constexpr bool PERM = true, AFTER_DRAIN = false;
    bf16_t* O; int M; const float* srow; const unsigned* cmax;
    __device__ __forceinline__ void operator()(const f32x4 (&acc)[2][2][4][2], const Unit& u, int wr, int wc, int fr, int fq) const {
        const int row0 = u.pm * BM + wr * 64 + fr, col0 = u.pn * BM + wc * 32 + 8 * fq;
        f32x4 sc[2][2];
#pragma unroll
        for (int bj = 0; bj < 2; ++bj)
#pragma unroll
            for (int n = 0; n < 2; ++n) { const u32x4 b = *(const u32x4*)(cmax + col0 + bj * HALF + 4 * n);
#pragma unroll
                for (int i = 0; i < 4; ++i) sc[bj][n][i] = __uint_as_float(b[i]) * (1.0f / 127.0f); }
        float srv[2][4];
#pragma unroll
        for (int ai = 0; ai < 2; ++ai)
#pragma unroll
            for (int m = 0; m < 4; ++m) srv[ai][m] = srow[row0 + ai * HALF + m * 16];
#pragma unroll
        for (int ai = 0; ai < 2; ++ai)
#pragma unroll
            for (int m = 0; m < 4; ++m) { const int row = row0 + ai * HALF + m * 16; const float sr = srv[ai][m];
#pragma unroll
                for (int bj = 0; bj < 2; ++bj) { const i32x4 a0 = __builtin_bit_cast(i32x4, acc[ai][bj][m][0]), a1 = __builtin_bit_cast(i32x4, acc[ai][bj][m][1]);
                    f32x4 v0, v1;
#pragma unroll
                    for (int i = 0; i < 4; ++i) { v0[i] = (float)a0[i] * sr * sc[bj][0][i]; v1[i] = (float)a1[i] * sr * sc[bj][1][i]; }
                    u32x4 w; w.x = cvt_pk_bf16(v0[0], v0[1]); w.y = cvt_pk_bf16(v0[2], v0[3]); w.z = cvt_pk_bf16(v1[0], v1[1]); w.w = cvt_pk_bf16(v1[2], v1[3]);
                    *(u32x4*)(O + ((size_t)(u.pn * 32 + bj * 16 + wc * 4 + fq) * M + row) * 8) = w; } }
    }
};
struct EpiProjI8 {
    static constexpr bool PERM = true, AFTER_DRAIN = false;
    bf16_t* O; int ldc; const float* srow; const unsigned* cmax;
    __device__ __forceinline__ void operator()(const f32x4 (&acc)[2][2][4][2], const Unit& u, int wr, int wc, int fr, int fq) const {
        const int row0 = u.pm * BM + wr * 64 + fr;
        const bool prod = u.pn >= 10;
        const int col0 = prod ? 2560 + (u.pn - 10) * 128 + wc * 32 + 8 * fq : u.pn * BM + wc * 32 + 8 * fq;
        const int sc0 = col0, sc1 = prod ? col0 + 1024 : col0 + HALF;
        f32x4 sc[2][2];
#pragma unroll
        for (int n = 0; n < 2; ++n) { const u32x4 b0 = *(const u32x4*)(cmax + sc0 + 4 * n), b1 = *(const u32x4*)(cmax + sc1 + 4 * n);
#pragma unroll
            for (int i = 0; i < 4; ++i) { sc[0][n][i] = __uint_as_float(b0[i]) * (1.0f / 127.0f); sc[1][n][i] = __uint_as_float(b1[i]) * (1.0f / 127.0f); } }
        float srv[2][4];
#pragma unroll
        for (int ai = 0; ai < 2; ++ai)
#pragma unroll
            for (int m = 0; m < 4; ++m) srv[ai][m] = srow[row0 + ai * HALF + m * 16];
#pragma unroll
        for (int ai = 0; ai < 2; ++ai)
#pragma unroll
            for (int m = 0; m < 4; ++m) { const float sr = srv[ai][m]; bf16_t* rowp = O + (size_t)(row0 + ai * HALF + m * 16) * ldc + col0;
                f32x4 v[2][2];
#pragma unroll
                for (int bj = 0; bj < 2; ++bj) { const i32x4 a0 = __builtin_bit_cast(i32x4, acc[ai][bj][m][0]), a1 = __builtin_bit_cast(i32x4, acc[ai][bj][m][1]);
#pragma unroll
                    for (int i = 0; i < 4; ++i) { v[bj][0][i] = (float)a0[i] * sr * sc[bj][0][i]; v[bj][1][i] = (float)a1[i] * sr * sc[bj][1][i]; } }
                if (prod) { const f32x4 p0 = v[0][0] * v[1][0], p1 = v[0][1] * v[1][1];
                    u32x4 w; w.x = cvt_pk_bf16(p0[0], p0[1]); w.y = cvt_pk_bf16(p0[2], p0[3]); w.z = cvt_pk_bf16(p1[0], p1[1]); w.w = cvt_pk_bf16(p1[2], p1[3]);
                    *(u32x4*)rowp = w;
                } else {
#pragma unroll
                    for (int bj = 0; bj < 2; ++bj) { u32x4 w; w.x = cvt_pk_bf16(v[bj][0][0], v[bj][0][1]); w.y = cvt_pk_bf16(v[bj][0][2], v[bj][0][3]); w.z = cvt_pk_bf16(v[bj][1][0], v[bj][1][1]); w.w = cvt_pk_bf16(v[bj][1][2], v[bj][1][3]);
                        *(u32x4*)(rowp + bj * HALF) = w; } }
            }
    }
};
struct EpiResGateI8 {
    static constexpr bool PERM = false, AFTER_DRAIN = false;
    const float* base; float* out; int ldc; const float* gate; int gate_stride; float srow_const; const unsigned* cmax;
    __device__ __forceinline__ void operator()(const f32x4 (&acc)[2][2][4][2], const Unit& u, int wr, int wc, int fr, int fq) const {
        const int row0 = u.pm * BM + wr * 64 + fr, col0 = u.pn * BM + wc * 32 + 4 * fq;
        const float* g = gate + (size_t)((u.pm * BM) >> 12) * gate_stride + col0;
        f32x4 gv[2][2];
#pragma unroll
        for (int bj = 0; bj < 2; ++bj)
#pragma unroll
            for (int n = 0; n < 2; ++n) { const f32x4 gg = *(const f32x4*)(g + bj * HALF + n * 16); const u32x4 b = *(const u32x4*)(cmax + col0 + bj * HALF + n * 16);
#pragma unroll
                for (int i = 0; i < 4; ++i) gv[bj][n][i] = gg[i] * __uint_as_float(b[i]) * (srow_const * (1.0f / 127.0f)); }
#pragma unroll
        for (int g2 = 0; g2 < 4; ++g2) {
            const int ai = g2 >> 1, m0 = (g2 & 1) * 2;
            f32x4 bs[2][2][2];
#pragma unroll
            for (int mm = 0; mm < 2; ++mm)
#pragma unroll
                for (int bj = 0; bj < 2; ++bj)
#pragma unroll
                    for (int n = 0; n < 2; ++n) bs[mm][bj][n] = *(const f32x4*)(base + (size_t)(row0 + ai * HALF + (m0 + mm) * 16) * ldc + col0 + bj * HALF + n * 16);
            asm volatile("" ::: "memory");
#pragma unroll
            for (int mm = 0; mm < 2; ++mm) { const size_t off = (size_t)(row0 + ai * HALF + (m0 + mm) * 16) * ldc + col0;
#pragma unroll
                for (int bj = 0; bj < 2; ++bj)
#pragma unroll
                    for (int n = 0; n < 2; ++n) { const i32x4 a = __builtin_bit_cast(i32x4, acc[ai][bj][m0 + mm][n]);
                        f32x4 o;
#pragma unroll
                        for (int i = 0; i < 4; ++i) o[i] = bs[mm][bj][n][i] + gv[bj][n][i] * (float)a[i];
                        *(f32x4*)(out + off + bj * HALF + n * 16) = o; } }
            asm volatile("" ::: "memory");
        }
    }
};
struct EpiResGateBf16I8 {
    static constexpr bool PERM = true, AFTER_DRAIN = false;
    const float* base; bf16_t* O; int ldc; const float* gate; int gate_stride; float srow_const; const unsigned* cmax;
    __device__ __forceinline__ void operator()(const f32x4 (&acc)[2][2][4][2], const Unit& u, int wr, int wc, int fr, int fq) const {
        const int row0 = u.pm * BM + wr * 64 + fr, col0 = u.pn * BM + wc * 32 + 8 * fq;
        const float* g = gate + (size_t)((u.pm * BM) >> 12) * gate_stride + col0;
        f32x4 gv[2][2];
#pragma unroll
        for (int bj = 0; bj < 2; ++bj)
#pragma unroll
            for (int n = 0; n < 2; ++n) { const f32x4 gg = *(const f32x4*)(g + bj * HALF + 4 * n); const u32x4 b = *(const u32x4*)(cmax + col0 + bj * HALF + 4 * n);
#pragma unroll
                for (int i = 0; i < 4; ++i) gv[bj][n][i] = gg[i] * __uint_as_float(b[i]) * (srow_const * (1.0f / 127.0f)); }
#pragma unroll
        for (int g2 = 0; g2 < 2; ++g2) {
            const int ai = g2, m0 = 0;
            f32x4 bs[4][2][2];
#pragma unroll
            for (int mm = 0; mm < 4; ++mm)
#pragma unroll
                for (int bj = 0; bj < 2; ++bj)
#pragma unroll
                    for (int n = 0; n < 2; ++n) bs[mm][bj][n] = __builtin_nontemporal_load((const f32x4*)(base + (size_t)(row0 + ai * HALF + (m0 + mm) * 16) * ldc + col0 + bj * HALF + 4 * n));
            asm volatile("" ::: "memory");
#pragma unroll
            for (int mm = 0; mm < 4; ++mm) { bf16_t* rowp = O + (size_t)(row0 + ai * HALF + (m0 + mm) * 16) * ldc + col0;
#pragma unroll
                for (int bj = 0; bj < 2; ++bj) { const i32x4 a0 = __builtin_bit_cast(i32x4, acc[ai][bj][m0 + mm][0]), a1 = __builtin_bit_cast(i32x4, acc[ai][bj][m0 + mm][1]);
                    f32x4 v0, v1;
#pragma unroll
                    for (int i = 0; i < 4; ++i) { v0[i] = bs[mm][bj][0][i] + gv[bj][0][i] * (float)a0[i]; v1[i] = bs[mm][bj][1][i] + gv[bj][1][i] * (float)a1[i]; }
                    u32x4 w; w.x = cvt_pk_bf16(v0[0], v0[1]); w.y = cvt_pk_bf16(v0[2], v0[3]); w.z = cvt_pk_bf16(v1[0], v1[1]); w.w = cvt_pk_bf16(v1[2], v1[3]);
                    *(u32x4*)(rowp + bj * HALF) = w; } }
            asm volatile("" ::: "memory");
        }
    }
};
struct EpiResGate {
    static constexpr bool PERM = false, AFTER_DRAIN = false;
    const float* base; float* out; int ldc; const float* gate; int gate_stride;
    __device__ __forceinline__ void operator()(const f32x4 (&acc)[2][2][4][2], const Unit& u, int wr, int wc, int fr, int fq) const {
        const int row0 = u.pm * BM + wr * 64 + fr, col0 = u.pn * BM + wc * 32 + 4 * fq;
        const float* g = gate + (size_t)((u.pm * BM) >> 12) * gate_stride + col0;
        f32x4 gv[2][2];
#pragma unroll
        for (int bj = 0; bj < 2; ++bj)
#pragma unroll
            for (int n = 0; n < 2; ++n) gv[bj][n] = *(const f32x4*)(g + bj * HALF + n * 16);
#pragma unroll
        for (int ai = 0; ai < 2; ++ai)
#pragma unroll
            for (int m = 0; m < 4; ++m) { const size_t off = (size_t)(row0 + ai * HALF + m * 16) * ldc + col0;
#pragma unroll
                for (int bj = 0; bj < 2; ++bj)
#pragma unroll
                    for (int n = 0; n < 2; ++n) { const f32x4 bs = *(const f32x4*)(base + off + bj * HALF + n * 16); *(f32x4*)(out + off + bj * HALF + n * 16) = bs + gv[bj][n] * acc[ai][bj][m][n]; }
                asm volatile("" ::: "memory"); }
    }
};

template <class Epi, class Sched, bool ALIGN_EPI = false, bool SP2 = false, bool I8 = false>
__device__ __forceinline__ void gemm_phase(PG8_LAS unsigned char* lds, const Gemm g, const Sched& S, const Epi& E, const int wid) {
    const int lane = fresh_lane(), tid = wid * 64 + lane, wr = wid >> 2, wc = wid & 3, fr = lane & 15, fq = lane >> 4;
    const int K = g.K, nt = K / BK;
    unsigned voffA[2], voffB[2];
#pragma unroll
    for (int i = 0; i < 2; ++i) { int R, C; stage_rc(tid * 16 + i * 8192, R, C); const int Rb = Epi::PERM ? ((R & ~31) + perm32(R & 31)) : R;
        voffA[i] = (unsigned)(R * K + C) * 2u; voffB[i] = (unsigned)(Rb * K + C) * 2u; }
    const size_t kstep = (size_t)(BK * 2);
    const size_t hstep = (size_t)HALF * K * 2;
    const size_t tstep = 2 * hstep;
    const unsigned ldsw = (unsigned)wid * 1024u;
    const int aoff = lds_byte(wr * 64 + fr, fq * 8), boff = lds_byte(wc * 32 + fr, fq * 8);
#define PG8_SA(b, h) (((b) * 2 + (h)) * HTB)
#define PG8_SB(b, h) ((4 + (b) * 2 + (h)) * HTB)
#define PG8_STAGE(bufoff, gbase, voff) do { _Pragma("unroll") for (int _i = 0; _i < 2; ++_i) \
        __builtin_amdgcn_global_load_lds((const unsigned*)((const char*)(gbase) + (voff)[_i]), (PG8_LAS unsigned*)(lds + (bufoff) + ldsw + _i * 8192), 16, 0, 0); } while (0)
#define PG8_LDA(dst, b, h) do { _Pragma("unroll") for (int m = 0; m < 4; ++m) _Pragma("unroll") for (int k = 0; k < 2; ++k) dst[m][k] = *(const PG8_LAS bf16x8*)(lds + PG8_SA(b, h) + aoff + m * 2048 + k * 1024); } while (0)
#define PG8_LDB(dst, b, h) do { _Pragma("unroll") for (int n = 0; n < 2; ++n) _Pragma("unroll") for (int k = 0; k < 2; ++k) dst[n][k] = *(const PG8_LAS bf16x8*)(lds + PG8_SB(b, h) + boff + n * 2048 + k * 1024); } while (0)
#define PG8_MMA(ai, bj, At, Bt) do { __builtin_amdgcn_s_setprio(1); _Pragma("unroll") for (int m = 0; m < 4; ++m) _Pragma("unroll") for (int n = 0; n < 2; ++n) _Pragma("unroll") for (int k = 0; k < 2; ++k) { \
        if constexpr (I8) acc[ai][bj][m][n] = __builtin_bit_cast(f32x4, __builtin_amdgcn_mfma_i32_16x16x64_i8(__builtin_bit_cast(i32x4, Bt[n][k]), __builtin_bit_cast(i32x4, At[m][k]), __builtin_bit_cast(i32x4, acc[ai][bj][m][n]), 0, 0, 0)); \
        else acc[ai][bj][m][n] = __builtin_amdgcn_mfma_f32_16x16x32_bf16(Bt[n][k], At[m][k], acc[ai][bj][m][n], 0, 0, 0); } __builtin_amdgcn_s_setprio(0); } while (0)
#define PG8_WAIT_V(n) asm volatile("s_waitcnt vmcnt(" #n ")" ::: "memory")
#define PG8_WAIT_L(n) asm volatile("s_waitcnt lgkmcnt(" #n ")" ::: "memory")
#define PG8_BAR __builtin_amdgcn_s_barrier()
#define PG8_SCHED __builtin_amdgcn_sched_barrier(0)
    Unit cur, nxt; int ui = 0;
    if (!S.next(0, cur)) return;
    f32x4 acc[2][2][4][2];
#pragma unroll
    for (int a = 0; a < 2; ++a)
#pragma unroll
        for (int b = 0; b < 2; ++b)
#pragma unroll
            for (int m = 0; m < 4; ++m)
#pragma unroll
                for (int n = 0; n < 2; ++n) acc[a][b][m][n] = (f32x4){0.f, 0.f, 0.f, 0.f};
    bf16x8 At[4][2], B0[2][2], B1[2][2];
    const char* cA = (const char*)g.A + (size_t)cur.pm * tstep; const char* cB = (const char*)g.Bt + (size_t)cur.pn * tstep;
    S.a_ready(cur);
    if constexpr (SP2) {
        PG8_STAGE(PG8_SB(0, 0), cB, voffB); PG8_STAGE(PG8_SB(0, 1), cB + hstep, voffB); PG8_STAGE(PG8_SA(0, 0), cA, voffA); PG8_STAGE(PG8_SA(0, 1), cA + hstep, voffA);
        if (wr == 1) PG8_BAR;
        PG8_WAIT_V(2); PG8_BAR;
        PG8_STAGE(PG8_SB(1, 0), cB + kstep, voffB); PG8_STAGE(PG8_SA(1, 0), cA + kstep, voffA); PG8_STAGE(PG8_SB(1, 1), cB + hstep + kstep, voffB);
        PG8_WAIT_V(6); PG8_BAR;
    } else {
        PG8_STAGE(PG8_SB(0, 0), cB, voffB); PG8_STAGE(PG8_SA(0, 0), cA, voffA); PG8_STAGE(PG8_SB(0, 1), cB + hstep, voffB); PG8_STAGE(PG8_SA(0, 1), cA + hstep, voffA);
        if (wr == 1) PG8_BAR;
        PG8_WAIT_V(4); PG8_BAR;
        PG8_STAGE(PG8_SB(1, 0), cB + kstep, voffB); PG8_STAGE(PG8_SA(1, 0), cA + kstep, voffA); PG8_STAGE(PG8_SB(1, 1), cB + hstep + kstep, voffB);
        PG8_WAIT_V(6); PG8_BAR;
    }
    for (;;) {
        const bool has_next = S.next(ui + 1, nxt);
        const char* nA = has_next ? (const char*)g.A + (size_t)nxt.pm * tstep : cA; const char* nB = has_next ? (const char*)g.Bt + (size_t)nxt.pn * tstep : cB;
        for (int t = 0; t < nt; t += 2) {
            const bool last = (t == nt - 2);
            const char* a1 = cA + (size_t)(t + 1) * kstep;
            const char* a2 = last ? nA : cA + (size_t)(t + 2) * kstep; const char* b2 = last ? nB : cB + (size_t)(t + 2) * kstep;
            const char* a3 = a2 + kstep; const char* b3 = b2 + kstep;
            if (last && has_next) S.a_ready(nxt);
            if constexpr (SP2) {
            PG8_LDB(B0, 0, 0); PG8_LDB(B1, 0, 1); PG8_SCHED; PG8_LDA(At, 0, 0); PG8_STAGE(PG8_SA(1, 1), a1 + hstep, voffA);
            PG8_WAIT_V(8); PG8_WAIT_L(0); PG8_BAR; PG8_MMA(0, 0, At, B0); PG8_MMA(0, 1, At, B1); PG8_BAR; PG8_SCHED;
            PG8_LDA(At, 0, 1); PG8_STAGE(PG8_SB(0, 0), b2, voffB); PG8_STAGE(PG8_SB(0, 1), b2 + hstep, voffB); PG8_STAGE(PG8_SA(0, 0), a2, voffA);
            PG8_WAIT_V(8); PG8_WAIT_L(0); PG8_BAR; PG8_MMA(1, 0, At, B0); PG8_MMA(1, 1, At, B1); PG8_BAR; PG8_SCHED;
            PG8_LDB(B0, 1, 0); PG8_LDB(B1, 1, 1); PG8_SCHED; PG8_LDA(At, 1, 0); PG8_STAGE(PG8_SA(0, 1), a2 + hstep, voffA);
            PG8_WAIT_V(8); PG8_WAIT_L(0); PG8_BAR; PG8_MMA(0, 0, At, B0); PG8_MMA(0, 1, At, B1); PG8_BAR; PG8_SCHED;
            PG8_LDA(At, 1, 1); PG8_STAGE(PG8_SB(1, 0), b3, voffB); PG8_STAGE(PG8_SB(1, 1), b3 + hstep, voffB); PG8_STAGE(PG8_SA(1, 0), a3, voffA);
            PG8_WAIT_V(8); PG8_WAIT_L(0); PG8_BAR; PG8_MMA(1, 0, At, B0); PG8_MMA(1, 1, At, B1); PG8_BAR; PG8_SCHED;
            } else {
            PG8_LDB(B0, 0, 0); PG8_SCHED; PG8_LDA(At, 0, 0); PG8_STAGE(PG8_SA(1, 1), a1 + hstep, voffA);
            PG8_WAIT_L(8); PG8_BAR; PG8_WAIT_L(0); PG8_MMA(0, 0, At, B0); PG8_BAR; PG8_SCHED;
            PG8_LDB(B1, 0, 1); PG8_STAGE(PG8_SB(0, 0), b2, voffB);
            PG8_BAR; PG8_WAIT_L(0); PG8_MMA(0, 1, At, B1); PG8_BAR;
            PG8_LDA(At, 0, 1); PG8_STAGE(PG8_SA(0, 0), a2, voffA);
            PG8_BAR; PG8_WAIT_L(0); PG8_MMA(1, 0, At, B0); PG8_BAR; PG8_SCHED;
            PG8_STAGE(PG8_SB(0, 1), b2 + hstep, voffB);
            PG8_WAIT_V(6); PG8_BAR; PG8_MMA(1, 1, At, B1); PG8_BAR;
            PG8_LDB(B0, 1, 0); PG8_SCHED; PG8_LDA(At, 1, 0); PG8_STAGE(PG8_SA(0, 1), a2 + hstep, voffA);
            PG8_WAIT_L(8); PG8_BAR; PG8_WAIT_L(0); PG8_MMA(0, 0, At, B0); PG8_BAR; PG8_SCHED;
            PG8_LDB(B1, 1, 1); PG8_STAGE(PG8_SB(1, 0), b3, voffB);
            PG8_BAR; PG8_WAIT_L(0); PG8_MMA(0, 1, At, B1); PG8_BAR;
            PG8_LDA(At, 1, 1); PG8_STAGE(PG8_SA(1, 0), a3, voffA);
            PG8_BAR; PG8_WAIT_L(0); PG8_MMA(1, 0, At, B0); PG8_BAR; PG8_SCHED;
            PG8_STAGE(PG8_SB(1, 1), b3 + hstep, voffB);
            PG8_WAIT_V(6); PG8_BAR; PG8_MMA(1, 1, At, B1); PG8_BAR;
            }
        }
        if constexpr (ALIGN_EPI) { if (wr == 0) PG8_BAR; }
        if constexpr (!Epi::AFTER_DRAIN) { E(acc, cur, wr, wc, fr, fq); S.done(cur); }
        if (!has_next) break;
#pragma unroll
        for (int a = 0; a < 2; ++a)
#pragma unroll
            for (int b = 0; b < 2; ++b)
#pragma unroll
                for (int m = 0; m < 4; ++m)
#pragma unroll
                    for (int n = 0; n < 2; ++n) acc[a][b][m][n] = (f32x4){0.f, 0.f, 0.f, 0.f};
        cur = nxt; cA = nA; cB = nB; ++ui;
        if constexpr (ALIGN_EPI) { if (wr == 1) PG8_BAR; }
    }
    PG8_WAIT_V(0);
    if constexpr (!ALIGN_EPI) { if (wr == 0) PG8_BAR; }
    PG8_BAR;
#undef PG8_SA
#undef PG8_SB
#undef PG8_STAGE
#undef PG8_LDA
#undef PG8_LDB
#undef PG8_MMA
#undef PG8_WAIT_V
#undef PG8_WAIT_L
#undef PG8_BAR
#undef PG8_SCHED
}
}

#define XB_TMO      128
#define XB_XCNT(j)  (256  + 64 * (j))
#define XB_XSUB(j)  (1280 + 64 * (j))
#define XB_XGEN(j)  (2304 + 64 * (j))
#define XB_TOP      3328
#define XB_TOPGEN   3392
#define XCD_BAR_WORDS 3456
#define XB_SPIN_CAP (1u << 18)
__device__ __forceinline__ unsigned xb_ld(unsigned* p)              { return __hip_atomic_load(p, __ATOMIC_RELAXED, __HIP_MEMORY_SCOPE_AGENT); }
__device__ __forceinline__ unsigned xb_add(unsigned* p, unsigned v) { return __hip_atomic_fetch_add(p, v, __ATOMIC_RELAXED, __HIP_MEMORY_SCOPE_AGENT); }
__device__ __forceinline__ unsigned xb_xcc_id() { return (unsigned)__builtin_amdgcn_s_getreg((3 << 11) | 20) & 0xFu; }
#define XB_SPIN(cond, bar) do { unsigned _sp = 0; while (cond) { __builtin_amdgcn_s_sleep(1); \
    if ((++_sp & 255u) == 0u) { if (xb_ld(&(bar)[XB_TMO])) break; if (_sp > XB_SPIN_CAP) { atomicAdd(&(bar)[XB_TMO], 1u); break; } } } } while (0)
struct XcdBarrier { unsigned* bar; unsigned x; volatile LAS unsigned* st; int wave; };
__device__ __forceinline__ XcdBarrier xcd_barrier_post(unsigned* bar, volatile LAS unsigned* st, int wave) {
    XcdBarrier b; b.bar = bar; b.x = xb_xcc_id(); b.st = st; b.wave = wave;
    if (wave == 0 && fresh_lane() == 0) (void)xb_add(&bar[XB_XCNT(b.x)], 1u);
    return b;
}
__device__ __forceinline__ void xcd_barrier_complete(unsigned* bar, unsigned x, unsigned& nloc, unsigned& nx) {
    const unsigned G = gridDim.x * gridDim.y * gridDim.z;
    unsigned sum, cnt, mine, sp = 0u;
    for (;;) {
        sum = 0u; cnt = 0u; mine = 0u;
#pragma unroll
        for (unsigned j = 0; j < 16; ++j) { const unsigned c = xb_ld(&bar[XB_XCNT(j)]); sum += c; cnt += (c > 0u) ? 1u : 0u; mine = (j == x) ? c : mine; }
        if (sum == G) break;
        __builtin_amdgcn_s_sleep(1);
        if ((++sp & 255u) == 0u) { if (xb_ld(&bar[XB_TMO])) break; if (sp > XB_SPIN_CAP) { atomicAdd(&bar[XB_TMO], 1u); break; } }
    }
    nloc = mine > 0u ? mine : 1u; nx = cnt > 0u ? cnt : 1u;
}
__device__ __forceinline__ void xcd_barrier(const XcdBarrier& b) {
    asm volatile("s_waitcnt vmcnt(0)" ::: "memory");
    __syncthreads();
    if (b.wave == 0 && fresh_lane() == 0) {
        unsigned* bar = b.bar;
        __builtin_amdgcn_s_waitcnt(0);
        unsigned nloc = b.st[0], nx = b.st[1];
        if (nloc == 0u) { xcd_barrier_complete(bar, b.x, nloc, nx); b.st[0] = nloc; b.st[1] = nx; }
        const unsigned old = xb_add(&bar[XB_XSUB(b.x)], 1u);
        const unsigned gen = old / nloc, target = (gen + 1u) * nx;
        if (old + 1u == (gen + 1u) * nloc) {
            __builtin_amdgcn_fence(__ATOMIC_RELEASE, "agent");
            asm volatile("s_waitcnt vmcnt(0)" ::: "memory");
            const unsigned og = xb_add(&bar[XB_TOP], 1u);
            if (og + 1u != target) XB_SPIN(xb_ld(&bar[XB_TOP]) < target, bar);
        } else {
            XB_SPIN(xb_ld(&bar[XB_TOP]) < target, bar);
        }
        __builtin_amdgcn_fence(__ATOMIC_ACQUIRE, "agent");
        asm volatile("s_waitcnt vmcnt(0)" ::: "memory");
    }
    __syncthreads();
}

__device__ __forceinline__ void p0_ada_item(const float* cvec, const float* w_ada, const float* b_ada, float* mod, LAS unsigned char* lds, int item, int tid, int wave, int lane) {
    LAS float* sc = (LAS float*)(lds + wave * 8192);
    LAS float* red = (LAS float*)(lds + 65536);
    const int k0 = wave * 256;
    { float cv[32];
#pragma unroll
      for (int j = 0; j < 32; ++j) { const int i = lane + 64 * j; cv[j] = cvec[(i & 7) * DM + k0 + (i >> 3)]; }
#pragma unroll
      for (int j = 0; j < 32; ++j) { const int i = lane + 64 * j; const float v = cv[j]; sc[(i >> 3) * 8 + (i & 7)] = v * __builtin_amdgcn_rcpf(1.f + __builtin_amdgcn_exp2f(-v * LOG2E)); } }
    LDS_WAIT();
    const int rg = lane >> 4, cq = lane & 15;
    float acc[8][4];
#pragma unroll
    for (int b = 0; b < 8; ++b)
#pragma unroll
        for (int i = 0; i < 4; ++i) acc[b][i] = 0.f;
    const float* wp = w_ada + (size_t)(k0 + rg) * MODW + item * 64 + 4 * cq;
#pragma unroll 32
    for (int it = 0; it < 64; ++it) {
        const f32x4 w4 = __builtin_nontemporal_load((const f32x4*)(wp + (size_t)it * 4 * MODW));
        const int kk = it * 4 + rg;
        const f32x4 s0 = *(const LAS f32x4*)(sc + kk * 8), s1 = *(const LAS f32x4*)(sc + kk * 8 + 4);
#pragma unroll
        for (int i = 0; i < 4; ++i) {
            acc[0][i] += s0[0] * w4[i]; acc[1][i] += s0[1] * w4[i]; acc[2][i] += s0[2] * w4[i]; acc[3][i] += s0[3] * w4[i];
            acc[4][i] += s1[0] * w4[i]; acc[5][i] += s1[1] * w4[i]; acc[6][i] += s1[2] * w4[i]; acc[7][i] += s1[3] * w4[i];
        }
    }
#pragma unroll
    for (int b = 0; b < 8; ++b)
#pragma unroll
        for (int i = 0; i < 4; ++i) acc[b][i] = xrow_sum(acc[b][i]);
    if (rg == 0) {
#pragma unroll
        for (int b = 0; b < 8; ++b)
#pragma unroll
            for (int i = 0; i < 4; ++i) red[(wave * 8 + b) * 64 + 4 * cq + i] = acc[b][i];
    }
    LDS_WAIT();
    __syncthreads();
    { const int b = tid >> 6, col = tid & 63; float s = b_ada[item * 64 + col];
#pragma unroll
      for (int w = 0; w < 8; ++w) s += red[(w * 8 + b) * 64 + col];
      mod[b * MODW + item * 64 + col] = s; }
    LDS_WAIT();
    __syncthreads();
}
__device__ __forceinline__ void p0_transpose_item(const float* W, int K, int N, bf16_t* WT, LAS float* scr, int item, int lane) {
    const int nblk = N / 32, kb = item / nblk, nb = item % nblk, k0 = 64 * kb, n0 = 32 * nb;
#pragma unroll 8
    for (int i = 0; i < 32; ++i) { const int kk = 2 * i + (lane >> 5); scr[kk * 33 + (lane & 31)] = W[(size_t)(k0 + kk) * N + n0 + (lane & 31)]; }
    LDS_WAIT(); asm volatile("" ::: "memory");
    const int c = lane & 7;
#pragma unroll
    for (int j = 0; j < 4; ++j) { const int n = (lane >> 3) + 8 * j; const LAS float* s = scr + (8 * c) * 33 + n;
        u32x4 o; o.x = cvtpk(s[0 * 33], s[1 * 33]); o.y = cvtpk(s[2 * 33], s[3 * 33]); o.z = cvtpk(s[4 * 33], s[5 * 33]); o.w = cvtpk(s[6 * 33], s[7 * 33]);
        *(u32x4*)(WT + (size_t)(n0 + n) * K + k0 + 8 * c) = o; }
    LDS_WAIT(); asm volatile("" ::: "memory");
}
__device__ __forceinline__ void p0_colmax_item(const float* W, int N, unsigned* cmax, int item, int lane) {
    const int nblk = N / 32, kb = item / nblk, nb = item % nblk, k0 = 64 * kb, n0 = 32 * nb;
    float am = 0.f;
#pragma unroll
    for (int i = 0; i < 32; ++i) am = fmaxf(am, fabsf(W[(size_t)(k0 + 2 * i + (lane >> 5)) * N + n0 + (lane & 31)]));
    am = fmaxf(am, __shfl_xor(am, 32));
    if (lane < 32) atomicMax(cmax + n0 + lane, __float_as_uint(am));
}
template <bool INTERLEAVE>
__device__ __forceinline__ void p1_transpose_i8_item(const float* W, int K, int N, unsigned char* WT, const unsigned* cmax, LAS float* scr, int item, int lane) {
    const int nblk = N / 32, kb = item / nblk, nb = item % nblk, k0 = 64 * kb, nd0 = 32 * nb;
    int n0 = nd0;
    if (INTERLEAVE && nd0 >= 2560) { const int t = (nd0 - 2560) >> 8, j = (nd0 - 2560) & 255; n0 = j < 128 ? 2560 + 128 * t + j : 3584 + 128 * t + (j - 128); }
    float wv[32];
#pragma unroll
    for (int i = 0; i < 32; ++i) wv[i] = __builtin_nontemporal_load(W + (size_t)(k0 + 2 * i + (lane >> 5)) * N + n0 + (lane & 31));
#pragma unroll
    for (int i = 0; i < 32; ++i) { const int kk = 2 * i + (lane >> 5); scr[kk * 33 + (lane & 31)] = wv[i]; }
    LDS_WAIT(); asm volatile("" ::: "memory");
    const int c4 = lane & 3;
#pragma unroll
    for (int j = 0; j < 2; ++j) { const int n = (lane >> 2) + 16 * j; const LAS float* s = scr + (16 * c4) * 33 + n;
        const float am = __uint_as_float(cmax[n0 + n]); const float inv = am > 0.f ? 127.0f / am : 0.f;
        u32x4 o;
#pragma unroll
        for (int w = 0; w < 4; ++w) o[w] = pack_i8x4((f32x4){s[(4 * w) * 33], s[(4 * w + 1) * 33], s[(4 * w + 2) * 33], s[(4 * w + 3) * 33]}, inv);
        *(u32x4*)(WT + (size_t)(nd0 + n) * K + k0 + 16 * c4) = o; }
    LDS_WAIT(); asm volatile("" ::: "memory");
}
__device__ __forceinline__ void p0_w2_item(const float* w_pq, const float* subkeys, bf16_t* W2, unsigned* cmax, int item, int lane) {
    const int blk = item >> 5, kq = (item >> 4) & 1, dch = item & 15, c = lane & 15, quad = lane >> 4;
    bf16x8 kf[4][4];
    { f32x4 sv[4][4][2];
#pragma unroll
      for (int kt = 0; kt < 4; ++kt) { const float* sp = subkeys + ((size_t)blk * 128 + (kq * 4 + kt) * 16 + c) * 128 + 8 * quad;
#pragma unroll
          for (int ks = 0; ks < 4; ++ks) { sv[kt][ks][0] = *(const f32x4*)(sp + ks * 32); sv[kt][ks][1] = *(const f32x4*)(sp + ks * 32 + 4); } }
#pragma unroll
      for (int kt = 0; kt < 4; ++kt)
#pragma unroll
          for (int ks = 0; ks < 4; ++ks) { const f32x4 a = sv[kt][ks][0], b = sv[kt][ks][1];
              u32x4 w; w.x = cvtpk(a[0], a[1]); w.y = cvtpk(a[2], a[3]); w.z = cvtpk(b[0], b[1]); w.w = cvtpk(b[2], b[3]); kf[kt][ks] = __builtin_bit_cast(bf16x8, w); } }
    float am[4] = {0.f, 0.f, 0.f, 0.f};
#pragma nounroll
    for (int dq = 0; dq < 2; ++dq) {
        f32x4 wv[4][4][2];
#pragma unroll
        for (int j = 0; j < 4; ++j) { const float* wp = w_pq + (size_t)(dch * 128 + (dq * 4 + j) * 16 + c) * DM + blk * 128 + 8 * quad;
#pragma unroll
            for (int ks = 0; ks < 4; ++ks) { wv[j][ks][0] = *(const f32x4*)(wp + ks * 32); wv[j][ks][1] = *(const f32x4*)(wp + ks * 32 + 4); } }
#pragma unroll
        for (int j = 0; j < 4; ++j) { const int d0 = dch * 128 + (dq * 4 + j) * 16;
            bf16x8 wb[4];
#pragma unroll
            for (int ks = 0; ks < 4; ++ks) { const f32x4 a = wv[j][ks][0], b = wv[j][ks][1];
                u32x4 w; w.x = cvtpk(a[0], a[1]); w.y = cvtpk(a[2], a[3]); w.z = cvtpk(b[0], b[1]); w.w = cvtpk(b[2], b[3]); wb[ks] = __builtin_bit_cast(bf16x8, w); }
#pragma unroll
            for (int kt = 0; kt < 4; ++kt) {
                f32x4 acc = (f32x4){0.f, 0.f, 0.f, 0.f};
#pragma unroll
                for (int ks = 0; ks < 4; ++ks) acc = __builtin_amdgcn_mfma_f32_16x16x32_bf16(wb[ks], kf[kt][ks], acc, 0, 0, 0);
                am[kt] = fmaxf(fmaxf(am[kt], fmaxf(fabsf(acc[0]), fabsf(acc[1]))), fmaxf(fabsf(acc[2]), fabsf(acc[3])));
                u32x2 o; o.x = cvtpk(acc[0], acc[1]); o.y = cvtpk(acc[2], acc[3]);
                *(u32x2*)(W2 + (size_t)(blk * 128 + (kq * 4 + kt) * 16 + c) * DM + d0 + 4 * quad) = o; } }
    }
#pragma unroll
    for (int kt = 0; kt < 4; ++kt) { const float a = xrow_max(am[kt]); if (quad == 0) atomicMax(cmax + blk * 128 + (kq * 4 + kt) * 16 + c, __float_as_uint(a)); }
}
__device__ __forceinline__ void p1_w2_row(const bf16_t* W2, unsigned char* WT, const unsigned* cmax, int n, int lane) {
    const float am = __uint_as_float(cmax[n]); const float inv = am > 0.f ? 127.0f / am : 0.f;
#pragma unroll
    for (int j = 0; j < 8; ++j) { const u32x2 v = *(const u32x2*)(W2 + (size_t)n * DM + 256 * j + 4 * lane);
        *(unsigned*)(WT + (size_t)n * DM + 256 * j + 4 * lane) = pack_i8x4((f32x4){bf_lo(v.x), bf_hi(v.x), bf_lo(v.y), bf_hi(v.y)}, inv); }
}
__device__ __forceinline__ void p0_cvt_item(const float* src, bf16_t* dst, size_t base, int lane) {
#pragma unroll
    for (int j = 0; j < 4; ++j) { const size_t o = base + (size_t)j * 512 + lane * 8;
        const f32x4 a = *(const f32x4*)(src + o), b = *(const f32x4*)(src + o + 4);
        u32x4 w; w.x = cvtpk(a[0], a[1]); w.y = cvtpk(a[2], a[3]); w.z = cvtpk(b[0], b[1]); w.w = cvtpk(b[2], b[3]);
        *(u32x4*)(dst + o) = w; }
}
__device__ __forceinline__ int vperm4(int grp) { return (grp & 7) * 16 + (grp >> 3) * 4; }
__device__ __forceinline__ size_t tab_off(int row, int col) { return ((size_t)(col >> 7) * PEER_N + row) * 128 + (col & 127); }
__device__ __forceinline__ void p0_fp8_item(const float* src, unsigned char* dst, size_t base, float scale, int lane) {
#pragma unroll
    for (int i = 0; i < 8; ++i) { const size_t o = base + (size_t)i * 256 + lane * 4; const f32x4 a = *(const f32x4*)(src + o);
        int p = 0; p = __builtin_amdgcn_cvt_pk_fp8_f32(a[0] * scale, a[1] * scale, p, false); p = __builtin_amdgcn_cvt_pk_fp8_f32(a[2] * scale, a[3] * scale, p, true);
        *(unsigned*)(dst + ((size_t)(2 * i + (lane >> 5)) * PEER_N + (base >> 11)) * 128 + vperm4(lane & 31)) = (unsigned)p; }
}
__device__ __forceinline__ void p0_i8_row(const float* src, unsigned char* dst, float* scale, int row, int lane) {
    const float* p = src + (size_t)row * DM + lane * 4;
    f32x4 v[8]; float am = 0.f;
#pragma unroll
    for (int i = 0; i < 8; ++i) { v[i] = *(const f32x4*)(p + i * 256); am = fmaxf(fmaxf(am, fmaxf(fabsf(v[i][0]), fabsf(v[i][1]))), fmaxf(fabsf(v[i][2]), fabsf(v[i][3]))); }
    am = wave_max(am);
    const float inv = am > 0.f ? 127.0f / am : 0.f;
#pragma unroll
    for (int i = 0; i < 8; ++i) *(unsigned*)(dst + tab_off(row, i * 256 + lane * 4)) = pack_i8x4(v[i], inv);
    if (lane == 0) scale[row] = am * (1.0f / 127.0f);
}
__device__ __forceinline__ void p0_tables8(const float* peer_u, const float* peer_v, unsigned char* UB, float* SU, unsigned char* VB, int gw, int ngw, int lane) {
#define P0_TAB_SRC(k) (((k) < 8 ? peer_u : peer_v) + (size_t)(gw + ((k) & 7) * ngw) * DM + lane * 4)
    f32x4 ra[8], rb[8], rc[8];
#pragma unroll
    for (int i = 0; i < 8; ++i) ra[i] = *(const f32x4*)(P0_TAB_SRC(0) + i * 256);
#pragma unroll
    for (int i = 0; i < 8; ++i) rb[i] = *(const f32x4*)(P0_TAB_SRC(1) + i * 256);
#pragma unroll
    for (int k = 0; k < 16; ++k) {
        const int row = gw + (k & 7) * ngw;
        f32x4 (&v)[8] = (k % 3 == 0) ? ra : (k % 3 == 1) ? rb : rc;
        f32x4 (&nn)[8] = (k % 3 == 0) ? rc : (k % 3 == 1) ? ra : rb;
        if (k < 14) {
#pragma unroll
            for (int i = 0; i < 8; ++i) nn[i] = *(const f32x4*)(P0_TAB_SRC(k + 2) + i * 256); }
        if (k < 8) {
            float am = 0.f;
#pragma unroll
            for (int i = 0; i < 8; ++i) am = fmaxf(fmaxf(am, fmaxf(fabsf(v[i][0]), fabsf(v[i][1]))), fmaxf(fabsf(v[i][2]), fabsf(v[i][3])));
            am = wave_max(am);
            const float inv = am > 0.f ? 127.0f / am : 0.f;
            unsigned char* q = UB + (size_t)(lane >> 5) * (PEER_N * 128) + (size_t)row * 128 + (lane & 31) * 4;
#pragma unroll
            for (int i = 0; i < 8; ++i) *(unsigned*)(q + (size_t)i * (2 * PEER_N * 128)) = pack_i8x4(v[i], inv);
            if (lane == 0) SU[row] = am * (1.0f / 127.0f);
        } else {
            unsigned char* q = VB + (size_t)(lane >> 5) * (PEER_N * 128) + (size_t)row * 128 + vperm4(lane & 31);
#pragma unroll
            for (int i = 0; i < 8; ++i) { int p = 0; p = __builtin_amdgcn_cvt_pk_fp8_f32(v[i][0] * V_SCALE, v[i][1] * V_SCALE, p, false); p = __builtin_amdgcn_cvt_pk_fp8_f32(v[i][2] * V_SCALE, v[i][3] * V_SCALE, p, true);
                *(unsigned*)(q + (size_t)i * (2 * PEER_N * 128)) = (unsigned)p; }
        }
    }
#undef P0_TAB_SRC
}
struct TabCtx { const float* src; unsigned char* dst; float* SU; int p; };
__device__ __forceinline__ void tab_row_load(const TabCtx& T, int k, f32x4 (&v)[8], int lane) {
    const float* np = T.src + (size_t)(T.p + 1024 * (k < 15 ? k : 15)) * DM + lane * 4;
#pragma unroll
    for (int i = 0; i < 8; ++i) v[i] = __builtin_nontemporal_load((const f32x4*)(np + i * 256));
}
template <bool ISV> __device__ __forceinline__ void tab_row_convert(const TabCtx& T, int k, const f32x4 (&v)[8], int lane) {
    const int row = T.p + 1024 * k;
    unsigned char* q = T.dst + (size_t)(lane >> 5) * (PEER_N * 128) + (size_t)row * 128 + (ISV ? vperm4(lane & 31) : (lane & 31) * 4);
    if (!ISV) {
        float am = 0.f;
#pragma unroll
        for (int i = 0; i < 8; ++i) am = fmaxf(fmaxf(am, fmaxf(fabsf(v[i][0]), fabsf(v[i][1]))), fmaxf(fabsf(v[i][2]), fabsf(v[i][3])));
        am = wave_max(am);
        const float inv = am > 0.f ? 127.0f / am : 0.f;
#pragma unroll
        for (int i = 0; i < 8; ++i) *(unsigned*)(q + (size_t)i * (2 * PEER_N * 128)) = pack_i8x4(v[i], inv);
        if (lane == 0) T.SU[row] = am * (1.0f / 127.0f);
    } else {
#pragma unroll
        for (int i = 0; i < 8; ++i) { int p = 0; p = __builtin_amdgcn_cvt_pk_fp8_f32(v[i][0] * V_SCALE, v[i][1] * V_SCALE, p, false); p = __builtin_amdgcn_cvt_pk_fp8_f32(v[i][2] * V_SCALE, v[i][3] * V_SCALE, p, true);
            *(unsigned*)(q + (size_t)i * (2 * PEER_N * 128)) = (unsigned)p; }
    }
}
__device__ __forceinline__ void p0_rope_item(float* rope, int item, int lane) {
    const int idx = item * 64 + lane, pos = idx >> 3, i = idx & 7;
    const double f = (i == 0) ? 0.15915494309189535 : (i == 1) ? 0.03086376340470123 : (i == 2) ? 0.005985185712713705 : (i == 3) ? 0.001160663641240061
                   : (i == 4) ? 0.00022507907903927653 : (i == 5) ? 4.364795279280289e-05 : (i == 6) ? 8.464330808241401e-06 : 1.6414262627950345e-06;
    const double rev = (double)pos * f; const double fr = rev - (double)(long long)rev;
    rope[idx] = __builtin_amdgcn_cosf((float)fr); rope[32768 + idx] = __builtin_amdgcn_sinf((float)fr);
}

__device__ __forceinline__ void norm_rows(const float* src, const float* gain, const float* mod, int off_shift, int off_scale, unsigned char* dst8, float* scale8, int gw, int ngw, int lane) {
    for (int grp = gw; grp < MTOK / 16; grp += ngw) {
        const int row0 = grp * 16; const float* mb = mod + (size_t)(row0 >> 12) * MODW;
        f32x4 A[8], B[8];
#pragma unroll
        for (int j = 0; j < 8; ++j) { const int c = 256 * j + 4 * lane; const f32x4 g = *(const f32x4*)(gain + c), sc = *(const f32x4*)(mb + off_scale + c); A[j] = g * (sc + 1.0f); B[j] = *(const f32x4*)(mb + off_shift + c); }
        f32x4 ra[8], rb[8], rc[8];
#pragma unroll
        for (int j = 0; j < 8; ++j) ra[j] = __builtin_nontemporal_load((const f32x4*)(src + (size_t)row0 * DM + 4 * lane + 256 * j));
#pragma unroll
        for (int j = 0; j < 8; ++j) rb[j] = __builtin_nontemporal_load((const f32x4*)(src + (size_t)(row0 + 1) * DM + 4 * lane + 256 * j));
#pragma unroll
        for (int r = 0; r < 16; ++r) {
            f32x4 (&cur)[8] = (r % 3 == 0) ? ra : (r % 3 == 1) ? rb : rc;
            f32x4 (&nn)[8] = (r % 3 == 0) ? rc : (r % 3 == 1) ? ra : rb;
            f32x4 v[8]; float ss = 0.f;
#pragma unroll
            for (int j = 0; j < 8; ++j) { v[j] = cur[j]; ss += (v[j][0] * v[j][0] + v[j][1] * v[j][1]) + (v[j][2] * v[j][2] + v[j][3] * v[j][3]); }
            if (r < 14) { const float* xn = src + (size_t)(row0 + r + 2) * DM + 4 * lane;
#pragma unroll
              for (int j = 0; j < 8; ++j) nn[j] = __builtin_nontemporal_load((const f32x4*)(xn + 256 * j)); }
            const float rstd = 1.0f / sqrtf(wave_sum(ss) * (1.0f / DM) + EPS);
            float am = 0.f;
#pragma unroll
            for (int j = 0; j < 8; ++j) { const f32x4 o = v[j] * rstd * A[j] + B[j]; v[j] = o; am = fmaxf(fmaxf(am, fmaxf(fabsf(o[0]), fabsf(o[1]))), fmaxf(fabsf(o[2]), fabsf(o[3]))); }
            am = wave_max(am); const float inv = am > 0.f ? 127.0f / am : 0.f;
            unsigned* q = (unsigned*)(dst8 + (size_t)(row0 + r) * DM + 4 * lane);
#pragma unroll
            for (int j = 0; j < 8; ++j) q[64 * j] = pack_i8x4(v[j], inv);
            if (lane == 0) scale8[row0 + r] = am * (1.0f / 127.0f);
        }
    }
}

__device__ __forceinline__ void norm_rows_bf16(const bf16_t* src, const float* gain, const float* mod, int off_shift, int off_scale, unsigned char* dst8, float* scale8, int gw, int ngw, int lane) {
    for (int grp = gw; grp < MTOK / 16; grp += ngw) {
        const int row0 = grp * 16; const float* mb = mod + (size_t)(row0 >> 12) * MODW;
        f32x4 A[8], B[8];
#pragma unroll
        for (int j = 0; j < 8; ++j) { const int c = 512 * (j >> 1) + 8 * lane + 4 * (j & 1); const f32x4 g = *(const f32x4*)(gain + c), sc = *(const f32x4*)(mb + off_scale + c); A[j] = g * (sc + 1.0f); B[j] = *(const f32x4*)(mb + off_shift + c); }
        u32x4 ra[4], rb[4], rc[4];
#pragma unroll
        for (int j = 0; j < 4; ++j) ra[j] = __builtin_nontemporal_load((const u32x4*)(src + (size_t)row0 * DM + 8 * lane + 512 * j));
#pragma unroll
        for (int j = 0; j < 4; ++j) rb[j] = __builtin_nontemporal_load((const u32x4*)(src + (size_t)(row0 + 1) * DM + 8 * lane + 512 * j));
#pragma unroll
        for (int r = 0; r < 16; ++r) {
            u32x4 (&cur)[4] = (r % 3 == 0) ? ra : (r % 3 == 1) ? rb : rc;
            u32x4 (&nn)[4] = (r % 3 == 0) ? rc : (r % 3 == 1) ? ra : rb;
            f32x4 v[8]; float ss = 0.f;
#pragma unroll
            for (int j = 0; j < 4; ++j) { const u32x4 t = cur[j]; v[2 * j] = (f32x4){bf_lo(t.x), bf_hi(t.x), bf_lo(t.y), bf_hi(t.y)}; v[2 * j + 1] = (f32x4){bf_lo(t.z), bf_hi(t.z), bf_lo(t.w), bf_hi(t.w)}; }
#pragma unroll
            for (int j = 0; j < 8; ++j) ss += (v[j][0] * v[j][0] + v[j][1] * v[j][1]) + (v[j][2] * v[j][2] + v[j][3] * v[j][3]);
            if (r < 14) { const bf16_t* xn = src + (size_t)(row0 + r + 2) * DM + 8 * lane;
#pragma unroll
              for (int j = 0; j < 4; ++j) nn[j] = __builtin_nontemporal_load((const u32x4*)(xn + 512 * j)); }
            const float rstd = __builtin_amdgcn_rsqf(wave_sum(ss) * (1.0f / DM) + EPS);
            float am = 0.f;
#pragma unroll
            for (int j = 0; j < 8; ++j) { const f32x4 o = v[j] * rstd * A[j] + B[j]; v[j] = o; am = fmaxf(fmaxf(am, fmaxf(fabsf(o[0]), fabsf(o[1]))), fmaxf(fabsf(o[2]), fabsf(o[3]))); }
            am = wave_max(am); const float inv = am > 0.f ? 127.0f / am : 0.f;
            unsigned char* q = dst8 + (size_t)(row0 + r) * DM + 8 * lane;
#pragma unroll
            for (int j = 0; j < 4; ++j) { u32x2 o; o.x = pack_i8x4(v[2 * j], inv); o.y = pack_i8x4(v[2 * j + 1], inv); *(u32x2*)(q + 512 * j) = o; }
            if (lane == 0) scale8[row0 + r] = am * (1.0f / 127.0f);
        }
    }
}

constexpr int KS_PITCH = 72;
constexpr int VT_PITCH = 264;
constexpr int LDS_KS = 0, LDS_VT = 256 * KS_PITCH * 2, LDS_RT = LDS_VT + 64 * VT_PITCH * 2;
constexpr int LDS_QS = LDS_RT + 8192, LDS_QS_HI = LDSCTL_OFF + 1024;
__device__ __forceinline__ int qstash_off(int wave) { return wave < 6 ? LDS_QS + wave * 8192 : LDS_QS_HI + (wave - 6) * 8192; }
static_assert(LDS_QS + 6 * 8192 <= LDSCTL_OFF && LDS_QS_HI + 2 * 8192 <= LDS_BYTES, "Q stash placement");
template <bool HOST, bool ISV>
__device__ __forceinline__ void attn_unit(int b, int hk, int n, const bf16_t* PROJ, const float* g_q, const float* g_k, const float* sinks, const float* g_oa, const float* rope, unsigned char* MIXED,
                                          LAS unsigned char* lds, int tid, int wave, int lane, const TabCtx& T, int tabk0, f32x4 (&tcur)[8], f32x4 (&tnx)[8]) {
    LAS bf16_t* Ks = (LAS bf16_t*)(lds + LDS_KS); LAS bf16_t* Vt = (LAS bf16_t*)(lds + LDS_VT); LAS float* RT = (LAS float*)(lds + LDS_RT);
    const size_t rowb = (size_t)b * SEQ;
    const int c = lane & 15, quad = lane >> 4, g = wave >> 1, hf = wave & 1, head = hk * 4 + g;
    const bf16_t* qsrc = PROJ + (rowb + n * 128 + hf * 64 + c) * INC + head * 64 + 8 * quad;
#pragma unroll
    for (int qt = 0; qt < 4; ++qt)
#pragma unroll
        for (int k = 0; k < 2; ++k)
            __builtin_amdgcn_global_load_lds((const unsigned*)(qsrc + (size_t)qt * 16 * INC + k * 32), (LAS unsigned*)(lds + qstash_off(wave) + (qt * 2 + k) * 1024), 16, 0, 2);
    u32x4 kr[2][2]; f32x4 kcs[2][4]; u32x4 vr[4];
    const int part = tid & 3;
#pragma unroll
    for (int it = 0; it < 2; ++it) {
        const int row = (tid + 512 * it) >> 2, pos = (n - 1) * 128 + row, posc = pos >= 0 ? pos : 0;
        const bf16_t* src = PROJ + (rowb + posc) * INC + COL_K + hk * 64 + 16 * part;
        kr[it][0] = *(const u32x4*)src; kr[it][1] = *(const u32x4*)(src + 8);
        const float* rp = rope + posc * 8;
        kcs[it][0] = *(const f32x4*)rp; kcs[it][1] = *(const f32x4*)(rp + 4); kcs[it][2] = *(const f32x4*)(rp + 32768); kcs[it][3] = *(const f32x4*)(rp + 32768 + 4);
    }
#pragma unroll
    for (int it = 0; it < 4; ++it) {
        const int task = tid + 512 * it, row = task & 255, ch = task >> 8, pos = (n - 1) * 128 + row, posc = pos >= 0 ? pos : 0;
        vr[it] = *(const u32x4*)(PROJ + (rowb + posc) * INC + COL_V + hk * 64 + 8 * ch);
    }
    const f32x4 rv = *(const f32x4*)(rope + ((tid & 3) >> 1) * 32768 + (size_t)(n * 128 + (tid >> 2)) * 8 + (tid & 1) * 4);
    f32x4 gk[4], gq[4], goa[4];
#pragma unroll
    for (int i = 0; i < 4; ++i) gk[i] = *(const f32x4*)(g_k + 16 * part + 4 * i);
    gq[0] = *(const f32x4*)(g_q + 8 * quad); gq[1] = *(const f32x4*)(g_q + 8 * quad + 4); gq[2] = *(const f32x4*)(g_q + 32 + 8 * quad); gq[3] = *(const f32x4*)(g_q + 32 + 8 * quad + 4);
#pragma unroll
    for (int dt = 0; dt < 4; ++dt) goa[dt] = *(const f32x4*)(g_oa + head * 64 + dt * 16 + 4 * quad);
    const float sinkv = sinks[head] * LOG2E;
    *(LAS f32x4*)(RT + (tid >> 2) * 16 + (tid & 3) * 4) = rv;
#pragma unroll
    for (int it = 0; it < 2; ++it) {
        const int row = (tid + 512 * it) >> 2; const bool valid = (n - 1) * 128 + row >= 0;
        const u32x4 r0 = kr[it][0], r1 = kr[it][1];
        float x[16];
#pragma unroll
        for (int i = 0; i < 4; ++i) { x[2 * i] = bf_lo(r0[i]); x[2 * i + 1] = bf_hi(r0[i]); x[8 + 2 * i] = bf_lo(r1[i]); x[8 + 2 * i + 1] = bf_hi(r1[i]); }
        float ss = 0.f;
#pragma unroll
        for (int i = 0; i < 16; ++i) ss += x[i] * x[i];
        ss = dpp_add<0xB1>(ss); ss = dpp_add<0x4E>(ss);
        const float rstd = 1.0f / sqrtf(ss * (1.0f / 64.0f) + EPS);
#pragma unroll
        for (int i = 0; i < 16; ++i) x[i] = x[i] * rstd * gk[i >> 2][i & 3];
#pragma unroll
        for (int i = 0; i < 8; ++i) { const float cs = kcs[it][i >> 2][i & 3], sn = kcs[it][2 + (i >> 2)][i & 3]; const float t1 = x[i], t2 = x[8 + i];
            x[i] = part == 0 ? t1 * cs - t2 * sn : t1; x[8 + i] = part == 0 ? t2 * cs + t1 * sn : t2; }
        u32x4 w0, w1;
#pragma unroll
        for (int i = 0; i < 4; ++i) { w0[i] = valid ? cvtpk(x[2 * i], x[2 * i + 1]) : 0u; w1[i] = valid ? cvtpk(x[8 + 2 * i], x[8 + 2 * i + 1]) : 0u; }
        LAS bf16_t* d = Ks + row * KS_PITCH + 16 * part;
        *(LAS u32x4*)d = w0; *(LAS u32x4*)(d + 8) = w1;
    }
#pragma unroll
    for (int it = 0; it < 4; ++it) {
        const int task = tid + 512 * it, row = task & 255, ch = task >> 8; const bool valid = (n - 1) * 128 + row >= 0;
        u32x4 r = vr[it];
        if (!valid) r = (u32x4){0u, 0u, 0u, 0u};
#pragma unroll
        for (int i = 0; i < 4; ++i) { Vt[(8 * ch + 2 * i) * VT_PITCH + row] = (bf16_t)(r[i] & 0xffffu); Vt[(8 * ch + 2 * i + 1) * VT_PITCH + row] = (bf16_t)(r[i] >> 16); }
    }
    VM_WAIT();
    LDS_WAIT();
    __syncthreads();
#pragma unroll
    for (int i = 0; i < 4; ++i) { gq[i] = gq[i] * (0.125f * LOG2E); asm volatile("" : "+v"(gq[i])); asm volatile("" : "+v"(goa[i])); }
    const int lq = 4 * quad - c;
    const LAS unsigned char* qstash = lds + qstash_off(wave) + lane * 16;
    for (int qt = 0; qt < 4; ++qt) {
        const int qi0 = hf * 64 + qt * 16, kt0 = (qi0 >> 4) & ~1, qi = qi0 + c, pos = n * 128 + qi;
        const size_t tq = rowb + pos;
        bf16x8 qf[2];
        {
            const u32x4 r0 = *(const LAS u32x4*)(qstash + qt * 2048), r1 = *(const LAS u32x4*)(qstash + qt * 2048 + 1024);
            float x0[8], x1[8];
#pragma unroll
            for (int i = 0; i < 4; ++i) { x0[2 * i] = bf_lo(r0[i]); x0[2 * i + 1] = bf_hi(r0[i]); x1[2 * i] = bf_lo(r1[i]); x1[2 * i + 1] = bf_hi(r1[i]); }
            float ss = 0.f;
#pragma unroll
            for (int i = 0; i < 8; ++i) ss += x0[i] * x0[i] + x1[i] * x1[i];
            ss = xrow_sum(ss);
            const float rstd = __builtin_amdgcn_rsqf(ss * (1.0f / 64.0f) + EPS);
#pragma unroll
            for (int i = 0; i < 8; ++i) { x0[i] = x0[i] * rstd * gq[i >> 2][i & 3]; x1[i] = x1[i] * rstd * gq[2 + (i >> 2)][i & 3]; }
            const LAS float* rt = RT + qi * 16;
            const f32x4 rc0 = *(const LAS f32x4*)rt, rc1 = *(const LAS f32x4*)(rt + 4), rs0 = *(const LAS f32x4*)(rt + 8), rs1 = *(const LAS f32x4*)(rt + 12);
#pragma unroll
            for (int i = 0; i < 8; ++i) {
                const float other = xrow16_other(x0[i], (quad & 1) != 0);
                const float cs = i < 4 ? rc0[i & 3] : rc1[i & 3], sn = i < 4 ? rs0[i & 3] : rs1[i & 3];
                const float rot = (quad == 0) ? (x0[i] * cs - other * sn) : (x0[i] * cs + other * sn);
                x0[i] = (quad < 2) ? rot : x0[i];
            }
            u32x4 w0, w1;
#pragma unroll
            for (int i = 0; i < 4; ++i) { w0[i] = cvtpk(x0[2 * i], x0[2 * i + 1]); w1[i] = cvtpk(x1[2 * i], x1[2 * i + 1]); }
            qf[0] = __builtin_bit_cast(bf16x8, w0); qf[1] = __builtin_bit_cast(bf16x8, w1);
        }
        f32x4 s[10];
#pragma unroll
        for (int t = 0; t < 10; ++t) {
            s[t] = (f32x4){0.f, 0.f, 0.f, 0.f};
            const LAS bf16_t* kp = Ks + ((kt0 + t) * 16 + c) * KS_PITCH + 8 * quad;
#pragma unroll
            for (int ks = 0; ks < 2; ++ks) { const bf16x8 kf = *(const LAS bf16x8*)(kp + ks * 32); s[t] = __builtin_amdgcn_mfma_f32_16x16x32_bf16(kf, qf[ks], s[t], 0, 0, 0); }
        }
        if (n == 0) {
#pragma unroll
            for (int t = 0; t < 10; ++t)
#pragma unroll
                for (int r = 0; r < 4; ++r) { const int kj = (kt0 + t) * 16 + 4 * quad + r; const bool ok = (kj >= qi + 1) && (kj <= qi + 128) && kj >= 128; s[t][r] = ok ? s[t][r] : -1e30f; }
        } else {
            const int L = kt0 * 16 - qi0 + lq;
#pragma unroll
            for (int t = 0; t < 2; ++t)
#pragma unroll
                for (int r = 0; r < 4; ++r) { s[t][r] = (L >= 1 - (16 * t + r)) ? s[t][r] : -1e30f; s[8 + t][r] = (L <= 128 - (16 * (8 + t) + r)) ? s[8 + t][r] : -1e30f; }
        }
        float m = sinkv;
#pragma unroll
        for (int t = 0; t < 10; ++t)
#pragma unroll
            for (int r = 0; r < 4; ++r) m = __builtin_amdgcn_fmed3f(m, s[t][r], __builtin_inff());
        m = xrow_max(m);
#pragma unroll
        for (int t = 0; t < 10; ++t)
#pragma unroll
            for (int r = 0; r < 4; ++r) s[t][r] = __builtin_amdgcn_exp2f(s[t][r] - m);
        bf16x8 pf[5];
#pragma unroll
        for (int i = 0; i < 5; ++i) { u32x4 w; w.x = cvtpk(s[2 * i][0], s[2 * i][1]); w.y = cvtpk(s[2 * i][2], s[2 * i][3]);
            w.z = cvtpk(s[2 * i + 1][0], s[2 * i + 1][1]); w.w = cvtpk(s[2 * i + 1][2], s[2 * i + 1][3]); pf[i] = __builtin_bit_cast(bf16x8, w); }
        f32x4 osum = (f32x4){0.f, 0.f, 0.f, 0.f};
        { const unsigned ow = (c & 3) == 0 ? 0x3F803F80u : 0u; const bf16x8 onesA = __builtin_bit_cast(bf16x8, (u32x4){ow, ow, ow, ow});
#pragma unroll
          for (int i = 0; i < 5; ++i) osum = __builtin_amdgcn_mfma_f32_16x16x32_bf16(onesA, pf[i], osum, 0, 0, 0); }
        const float inv = __builtin_amdgcn_rcpf(osum[0] + __builtin_amdgcn_exp2f(sinkv - m));
        f32x4 o[4]; float ss = 0.f;
#pragma unroll
        for (int dt = 0; dt < 4; ++dt) {
            o[dt] = (f32x4){0.f, 0.f, 0.f, 0.f};
            const LAS bf16_t* vp = Vt + (dt * 16 + c) * VT_PITCH + kt0 * 16 + 4 * quad;
#pragma unroll
            for (int i = 0; i < 5; ++i) { const u32x2 lo = *(const LAS u32x2*)(vp + i * 32), hi = *(const LAS u32x2*)(vp + i * 32 + 16);
                u32x4 w; w.x = lo.x; w.y = lo.y; w.z = hi.x; w.w = hi.y;
                o[dt] = __builtin_amdgcn_mfma_f32_16x16x32_bf16(__builtin_bit_cast(bf16x8, w), pf[i], o[dt], 0, 0, 0); }
            ss += (o[dt][0] * o[dt][0] + o[dt][1] * o[dt][1]) + (o[dt][2] * o[dt][2] + o[dt][3] * o[dt][3]);
        }
        ss = xrow_sum(ss);
        const float fac = inv * __builtin_amdgcn_rsqf(inv * inv * ss * (1.0f / 64.0f) + EPS) * MIX_SCALE;
        if (HOST) {
            tab_row_convert<ISV>(T, tabk0 + qt, tnx, lane);
            tab_row_load(T, tabk0 + qt + 1, tnx, lane);
        }
        unsigned char* orow = MIXED + tq * DM + head * 64 + 4 * quad;
#pragma unroll
        for (int dt = 0; dt < 4; ++dt) *(unsigned*)(orow + dt * 16) = pack_i8x4_sat(o[dt] * goa[dt], fac);
    }
    __syncthreads();
}
__device__ __forceinline__ void conv_item(int item, const bf16_t* PROJ, const float* conv_w, const float* g_oc, unsigned char* MIXED, int lane) {
    const int t0 = item * 16, ch = 16 * lane;
    float w0[16], w1[16], w2[16], gg[16], up2[16], up1[16];
#pragma unroll
    for (int i = 0; i < 16; ++i) { w0[i] = conv_w[ch + i]; w1[i] = conv_w[1024 + ch + i]; w2[i] = conv_w[2048 + ch + i]; gg[i] = g_oc[ch + i]; up2[i] = 0.f; up1[i] = 0.f; }
    if ((t0 & (SEQ - 1)) != 0) {
#pragma unroll
        for (int h = 0; h < 2; ++h) {
            const bf16_t* pr = PROJ + (size_t)(t0 - 2 + h) * INC + ch;
            const u32x4 c0 = __builtin_nontemporal_load((const u32x4*)(pr + COL_C)), c1 = __builtin_nontemporal_load((const u32x4*)(pr + COL_C + 8));
#pragma unroll
            for (int i = 0; i < 4; ++i) {
                const float u0 = bf_lo(c0[i]), u1 = bf_hi(c0[i]), u2 = bf_lo(c1[i]), u3 = bf_hi(c1[i]);
                if (h == 0) { up2[2 * i] = u0; up2[2 * i + 1] = u1; up2[8 + 2 * i] = u2; up2[8 + 2 * i + 1] = u3; }
                else        { up1[2 * i] = u0; up1[2 * i + 1] = u1; up1[8 + 2 * i] = u2; up1[8 + 2 * i + 1] = u3; }
            }
        }
    }
    u32x4 nb0, nb1, nc0, nc1;
    { const bf16_t* pr = PROJ + (size_t)t0 * INC + ch; nb0 = __builtin_nontemporal_load((const u32x4*)(pr + COL_B)); nb1 = __builtin_nontemporal_load((const u32x4*)(pr + COL_B + 8)); nc0 = __builtin_nontemporal_load((const u32x4*)(pr + COL_C)); nc1 = __builtin_nontemporal_load((const u32x4*)(pr + COL_C + 8)); }
#pragma unroll
    for (int r = 0; r < 16; ++r) {
        const u32x4 b0 = nb0, b1 = nb1, c0 = nc0, c1 = nc1;
        { const bf16_t* pr = PROJ + (size_t)(t0 + (r < 15 ? r + 1 : r)) * INC + ch; nb0 = __builtin_nontemporal_load((const u32x4*)(pr + COL_B)); nb1 = __builtin_nontemporal_load((const u32x4*)(pr + COL_B + 8)); nc0 = __builtin_nontemporal_load((const u32x4*)(pr + COL_C)); nc1 = __builtin_nontemporal_load((const u32x4*)(pr + COL_C + 8)); }
        float u[16], bg[16], y[16];
#pragma unroll
        for (int i = 0; i < 4; ++i) {
            u[2 * i] = bf_lo(c0[i]); u[2 * i + 1] = bf_hi(c0[i]); u[8 + 2 * i] = bf_lo(c1[i]); u[8 + 2 * i + 1] = bf_hi(c1[i]);
            bg[2 * i] = bf_lo(b0[i]); bg[2 * i + 1] = bf_hi(b0[i]); bg[8 + 2 * i] = bf_lo(b1[i]); bg[8 + 2 * i + 1] = bf_hi(b1[i]);
        }
        float ss = 0.f;
#pragma unroll
        for (int i = 0; i < 16; ++i) { y[i] = bg[i] * (w0[i] * up2[i] + w1[i] * up1[i] + w2[i] * u[i]); ss += y[i] * y[i]; up2[i] = up1[i]; up1[i] = u[i]; }
        ss += __shfl_xor(ss, 1); ss += __shfl_xor(ss, 2);
        const float rstd = 1.0f / sqrtf(ss * (1.0f / 64.0f) + EPS);
        u32x4 o0;
#pragma unroll
        for (int i = 0; i < 4; ++i) o0[i] = pack_i8x4_sat((f32x4){y[4 * i] * rstd * gg[4 * i], y[4 * i + 1] * rstd * gg[4 * i + 1], y[4 * i + 2] * rstd * gg[4 * i + 2], y[4 * i + 3] * rstd * gg[4 * i + 3]}, MIX_SCALE);
        *(u32x4*)(MIXED + (size_t)(t0 + r) * DM + 1024 + ch) = o0;
    }
}

__device__ __forceinline__ void ins16(float (&L)[16], float x) {
#pragma unroll
    for (int j = 0; j < 16; ++j) { const float hi = fmaxf(L[j], x); x = fminf(L[j], x); L[j] = hi; }
}
template <int C> __device__ __forceinline__ float pack7(float s, unsigned q32) { unsigned t; asm("v_and_b32 %0, 0xffffff80, %1\n\tv_or3_b32 %0, %0, %2, %3" : "=&v"(t) : "v"(s), "v"(q32), "n"(C)); return __uint_as_float(t); }
template <int C> __device__ __forceinline__ float pack8(float s) { unsigned t; asm("v_and_b32 %0, 0xffffff00, %1\n\tv_or_b32 %0, %2, %0" : "=&v"(t) : "v"(s), "n"(C)); return __uint_as_float(t); }
template <int KEY> __device__ __forceinline__ float pack_lo(unsigned u) { unsigned t; asm("v_lshlrev_b32 %0, 16, %1\n\tv_or_b32 %0, %2, %0" : "=&v"(t) : "v"(u), "n"(KEY)); return __uint_as_float(t); }
template <int KEY> __device__ __forceinline__ float pack_hi(unsigned u) { unsigned t; asm("v_and_b32 %0, 0xffff0000, %1\n\tv_or_b32 %0, %2, %0" : "=&v"(t) : "v"(u), "n"(KEY)); return __uint_as_float(t); }
__device__ __forceinline__ unsigned key_of(unsigned x) { return ((x >> 2) & 7u) * 16u + (x >> 5) * 4u + (x & 3u); }
#define CE_DESC(a, b) do { const float hi_ = fmaxf(a, b), lo_ = fminf(a, b); a = hi_; b = lo_; } while (0)
__device__ __forceinline__ void bitonic_tail16(float (&L)[16]) {
#pragma unroll
    for (int d = 8; d >= 1; d >>= 1)
#pragma unroll
        for (int i = 0; i < 16; ++i) if ((i & d) == 0) CE_DESC(L[i], L[i + d]);
}
__device__ __forceinline__ void sort16_desc(float (&L)[16]) {
#define SN(i, j) CE_DESC(L[i], L[j]);
    SN(0,13) SN(1,12) SN(2,15) SN(3,14) SN(4,8) SN(5,6) SN(7,11) SN(9,10)
    SN(0,5) SN(1,7) SN(2,9) SN(3,4) SN(6,13) SN(8,14) SN(10,15) SN(11,12)
    SN(0,1) SN(2,3) SN(4,5) SN(6,8) SN(7,9) SN(10,11) SN(12,13) SN(14,15)
    SN(0,2) SN(1,3) SN(4,10) SN(5,11) SN(6,7) SN(8,9) SN(12,14) SN(13,15)
    SN(1,2) SN(3,12) SN(4,6) SN(5,7) SN(8,10) SN(9,11) SN(13,14)
    SN(1,4) SN(2,6) SN(5,8) SN(7,10) SN(9,13) SN(11,14)
    SN(2,4) SN(3,6) SN(9,12) SN(11,13)
    SN(3,5) SN(6,8) SN(7,9) SN(10,12)
    SN(3,4) SN(5,6) SN(7,8) SN(9,10) SN(11,12)
    SN(6,7) SN(8,9)
#undef SN
}
__device__ __forceinline__ void top16_of_two(float (&A)[16], const float (&B)[16]) {
#pragma unroll
    for (int j = 0; j < 16; ++j) A[j] = fmaxf(A[j], B[15 - j]);
    bitonic_tail16(A);
}
__device__ __forceinline__ void merge16(float (&L)[16], int mask) {
    float P[16];
#pragma unroll
    for (int j = 0; j < 16; ++j) P[j] = __shfl_xor(L[j], mask);
    top16_of_two(L, P);
}
constexpr int SKT_OFF = 8192 + 512, SKT_PITCH = 272;
__device__ __forceinline__ void peer_chunk(int tokb, const bf16_t* QP, const bf16_t* SK, const unsigned char* H8, const float* SH, const unsigned char* UB, const float* SU, const unsigned char* VB, const float* mod, const bf16_t* X1B, float* out,
                                           LAS unsigned char* lds, int tid, int wave, int lane) {
    LAS unsigned char* wl = lds + wave * 16384;
    int tok0 = tokb + wave * 16;
    LAS bf16_t* eidx = (LAS bf16_t*)wl; LAS bf16_t* gate = (LAS bf16_t*)(wl + 4096); LAS float* accL = (LAS float*)(wl + 8192); LAS unsigned char* ids = wl + 8192;
#pragma nounroll
    for (int rep7a_ = 0; rep7a_ < REP7A; ++rep7a_) {
#pragma nounroll
    for (int i2 = 0; i2 < 2; ++i2) {
        const int p = tid + 512 * i2, tkn = p & 127, h = p >> 7;
        const u32x4* srow = (const u32x4*)QP + (size_t)(h * 32) * MTOK + tokb + tkn;
        float T0[16], T1[16];
#pragma unroll
        for (int hf = 0; hf < 2; ++hf) {
            float L[16], Bv[16];
#define PKC(ch, DST) { const u32x4 a_ = __builtin_nontemporal_load(srow + (size_t)(hf * 16 + 2 * (ch)) * MTOK), b_ = __builtin_nontemporal_load(srow + (size_t)(hf * 16 + 2 * (ch) + 1) * MTOK); \
                DST[0] = pack_lo<(ch) * 16 + 0>(a_.x); DST[1] = pack_hi<(ch) * 16 + 1>(a_.x); DST[2] = pack_lo<(ch) * 16 + 2>(a_.y); DST[3] = pack_hi<(ch) * 16 + 3>(a_.y); \
                DST[4] = pack_lo<(ch) * 16 + 4>(a_.z); DST[5] = pack_hi<(ch) * 16 + 5>(a_.z); DST[6] = pack_lo<(ch) * 16 + 6>(a_.w); DST[7] = pack_hi<(ch) * 16 + 7>(a_.w); \
                DST[8] = pack_lo<(ch) * 16 + 8>(b_.x); DST[9] = pack_hi<(ch) * 16 + 9>(b_.x); DST[10] = pack_lo<(ch) * 16 + 10>(b_.y); DST[11] = pack_hi<(ch) * 16 + 11>(b_.y); \
                DST[12] = pack_lo<(ch) * 16 + 12>(b_.z); DST[13] = pack_hi<(ch) * 16 + 13>(b_.z); DST[14] = pack_lo<(ch) * 16 + 14>(b_.w); DST[15] = pack_hi<(ch) * 16 + 15>(b_.w); }
            PKC(0, L) sort16_desc(L);
            PKC(1, Bv) sort16_desc(Bv); top16_of_two(L, Bv);
            PKC(2, Bv) sort16_desc(Bv); top16_of_two(L, Bv);
            PKC(3, Bv) sort16_desc(Bv); top16_of_two(L, Bv);
            PKC(4, Bv) sort16_desc(Bv); top16_of_two(L, Bv);
            PKC(5, Bv) sort16_desc(Bv); top16_of_two(L, Bv);
            PKC(6, Bv) sort16_desc(Bv); top16_of_two(L, Bv);
            PKC(7, Bv) sort16_desc(Bv); top16_of_two(L, Bv);
#undef PKC
#pragma unroll
            for (int j = 0; j < 16; ++j) { if (hf == 0) T0[j] = L[j]; else T1[j] = L[j]; }
        }
        float R[16], Bc[16], Cc[16];
#define CAND(i, j) pack8<(i) * 16 + (j)>(T0[i] + T1[j])
#pragma unroll
        for (int j = 0; j < 16; ++j) R[j] = __uint_as_float((__float_as_uint(T0[0] + T1[j]) & 0xFFFFFF00u) | (unsigned)j);
        Bc[0] = CAND(1, 0); Bc[1] = CAND(1, 1); Bc[2] = CAND(1, 2); Bc[3] = CAND(1, 3); Bc[4] = CAND(1, 4); Bc[5] = CAND(1, 5); Bc[6] = CAND(1, 6); Bc[7] = CAND(1, 7);
        Bc[8] = CAND(2, 0); Bc[9] = CAND(2, 1); Bc[10] = CAND(2, 2); Bc[11] = CAND(2, 3); Bc[12] = CAND(2, 4); Bc[13] = CAND(3, 0); Bc[14] = CAND(3, 1); Bc[15] = CAND(3, 2);
        Cc[0] = CAND(3, 3); Cc[1] = CAND(4, 0); Cc[2] = CAND(4, 1); Cc[3] = CAND(4, 2); Cc[4] = CAND(5, 0); Cc[5] = CAND(5, 1); Cc[6] = CAND(6, 0); Cc[7] = CAND(6, 1);
        Cc[8] = CAND(7, 0); Cc[9] = CAND(7, 1); Cc[10] = CAND(8, 0); Cc[11] = CAND(9, 0); Cc[12] = CAND(10, 0); Cc[13] = CAND(11, 0); Cc[14] = CAND(12, 0); Cc[15] = CAND(13, 0);
        sort16_desc(Bc); sort16_desc(Cc); top16_of_two(R, Bc); top16_of_two(R, Cc);
        ins16(R, CAND(14, 0)); ins16(R, CAND(15, 0));
#undef CAND
        {
            LAS unsigned char* idb = lds + wave * 16384 + 8192 + lane * 32;
            u32x4 i0, i1;
#pragma unroll
            for (int w = 0; w < 4; ++w) {
                i0[w] = (__float_as_uint(T0[4 * w]) & 0x7Fu) | ((__float_as_uint(T0[4 * w + 1]) & 0x7Fu) << 8) | ((__float_as_uint(T0[4 * w + 2]) & 0x7Fu) << 16) | ((__float_as_uint(T0[4 * w + 3]) & 0x7Fu) << 24);
                i1[w] = (__float_as_uint(T1[4 * w]) & 0x7Fu) | ((__float_as_uint(T1[4 * w + 1]) & 0x7Fu) << 8) | ((__float_as_uint(T1[4 * w + 2]) & 0x7Fu) << 16) | ((__float_as_uint(T1[4 * w + 3]) & 0x7Fu) << 24); }
            *(LAS u32x4*)idb = i0; *(LAS u32x4*)(idb + 16) = i1;
            float e[16], sum = 0.f;
#pragma unroll
            for (int k = 0; k < 16; ++k) { e[k] = __builtin_amdgcn_exp2f((R[k] - R[0]) * LOG2E); sum += e[k]; }
            const float inv = 1.0f / sum;
            LDS_WAIT(); asm volatile("" ::: "memory");
            unsigned ex[16];
#pragma unroll
            for (int k = 0; k < 16; ++k) { const unsigned code = __float_as_uint(R[k]) & 0xFFu; ex[k] = (unsigned)idb[code >> 4] * 128u + (unsigned)idb[16 + (code & 15u)]; }
            LAS unsigned char* tb = lds + (tkn >> 4) * 16384 + ((tkn & 15) * 128 + h * 16) * 2;
            u32x4 ea, eb, ga, gb;
#pragma unroll
            for (int w = 0; w < 4; ++w) { ea[w] = ex[2 * w] | (ex[2 * w + 1] << 16); eb[w] = ex[8 + 2 * w] | (ex[8 + 2 * w + 1] << 16);
                ga[w] = cvtpk(e[2 * w] * inv, e[2 * w + 1] * inv); gb[w] = cvtpk(e[8 + 2 * w] * inv, e[8 + 2 * w + 1] * inv); }
            *(LAS u32x4*)tb = ea; *(LAS u32x4*)(tb + 16) = eb; *(LAS u32x4*)(tb + 4096) = ga; *(LAS u32x4*)(tb + 4096 + 16) = gb;
        }
    }
    LDS_WAIT();
    __syncthreads();
    }
    LDS_WAIT(); asm volatile("" ::: "memory");
    int lane_b = lane; asm volatile("" : "+v"(lane_b));
    const int g = lane_b >> 3, k = lane_b & 7; const unsigned k16 = (unsigned)k * 16u;
    LAS int* accI = (LAS int*)accL;
#pragma nounroll
    for (int rep7u_ = 0; rep7u_ < REP7U; ++rep7u_) {
    LDS_WAIT(); asm volatile("" ::: "memory");
    for (int i = lane; i < 2048; i += 64) accI[i] = 0;
    LDS_WAIT(); asm volatile("" ::: "memory");
    asm volatile("" : "+s"(tok0));
    const unsigned char* hbase = H8 + (size_t)(tok0 + g) * DM + k * 16;
    u32x4 hn = __builtin_nontemporal_load((const u32x4*)hbase);
    for (int s = 0; s < 16; ++s) {
        const unsigned char* Us = UB + (size_t)s * (PEER_N * 128);
#pragma unroll
        for (int r = 0; r < 2; ++r) {
            const int tl = r * 8 + g;
            const u32x4 hq = hn;
            { const int sn = r ? s + 1 : s, rn = r ^ 1; if (sn < 16) hn = __builtin_nontemporal_load((const u32x4*)(hbase + (size_t)rn * 8 * DM + sn * 128)); }
            const LAS bf16_t* ei = eidx + tl * 128;
            LAS int* ap = accI + tl * 128 + k;
#pragma nounroll
            for (int ib2 = 0; ib2 < 16; ++ib2) {
                u32x4 uv[8];
#pragma unroll
                for (int q = 0; q < 8; ++q) { const unsigned e = ei[ib2 * 8 + q]; uv[q] = *(const u32x4*)(Us + (size_t)(unsigned)((e << 7) + k16)); }
                {
                    int p[8];
#pragma unroll
                    for (int ii = 0; ii < 8; ++ii) { const u32x4 v = uv[ii];
                        p[ii] = __builtin_amdgcn_sdot4((int)v.x, (int)hq.x, __builtin_amdgcn_sdot4((int)v.y, (int)hq.y, __builtin_amdgcn_sdot4((int)v.z, (int)hq.z, __builtin_amdgcn_sdot4((int)v.w, (int)hq.w, 0, false), false), false), false); }
                    int a4[4], a2[2];
#pragma unroll
                    for (int j = 0; j < 4; ++j) { const int send = (k & 4) ? p[j] : p[j + 4], keep = (k & 4) ? p[j + 4] : p[j]; a4[j] = keep + dpp_movi<0x141>(send); }
#pragma unroll
                    for (int j = 0; j < 2; ++j) { const int send = (k & 2) ? a4[j] : a4[j + 2], keep = (k & 2) ? a4[j + 2] : a4[j]; a2[j] = keep + dpp_movi<0x1B>(send); }
                    const int send = (k & 1) ? a2[0] : a2[1], keep = (k & 1) ? a2[1] : a2[0];
                    const int tot = keep + dpp_movi<0xB1>(send);
                    __hip_atomic_fetch_add(ap + ib2 * 8, tot, __ATOMIC_RELAXED, __HIP_MEMORY_SCOPE_WORKGROUP);
                }
            }
        }
    }
    }
    LDS_WAIT(); asm volatile("" ::: "memory");
    LAS bf16_t* wgt = gate;
    for (int i = lane; i < 2048; i += 64) {
        const float a = (float)accI[i] * SU[eidx[i]] * SH[tok0 + (i >> 7)];
        const float ge = 0.5f * a * (1.0f + erff(a * 0.70710678118654752f));
        wgt[i] = (bf16_t)(cvtpk(bf_lo((unsigned)gate[i]) * ge * (1.0f / V_SCALE), 0.f) & 0xffffu);
    }
    LDS_WAIT(); asm volatile("" ::: "memory");
    const float* g2 = mod + (size_t)(tok0 >> 12) * MODW + 5 * DM;
#pragma nounroll
    for (int rep7v_ = 0; rep7v_ < REP7V; ++rep7v_)
    for (int s = 0; s < 16; ++s) {
        const unsigned char* Vs = VB + (size_t)s * (PEER_N * 128);
        f32x4 gvv[4];
#pragma unroll
        for (int q = 0; q < 4; ++q) gvv[q] = *(const f32x4*)(g2 + s * 128 + 32 * q + 4 * k);
#pragma unroll
        for (int r = 0; r < 2; ++r) {
            const int tl = r * 8 + g;
            float* orow = out + (size_t)(tok0 + tl) * DM + s * 128 + 4 * k;
            const bf16_t* xrow = X1B + (size_t)(tok0 + tl) * DM + s * 128 + 4 * k;
            u32x2 xq[4];
#pragma unroll
            for (int q = 0; q < 4; ++q) xq[q] = __builtin_nontemporal_load((const u32x2*)(xrow + 32 * q));
            const LAS bf16_t* ei = eidx + tl * 128; const LAS bf16_t* wi = wgt + tl * 128;
            float y[16];
#pragma unroll
            for (int i = 0; i < 16; ++i) y[i] = 0.f;
#pragma nounroll
            for (int b = 0; b < 8; ++b) {
                u32x4 vq[16];
#pragma unroll
                for (int q = 0; q < 16; ++q) { const unsigned e = ei[b * 16 + q]; vq[q] = *(const u32x4*)(Vs + (size_t)(unsigned)((e << 7) + k16)); }
#pragma unroll
                for (int q = 0; q < 16; ++q) {
                    const float wf = bf_lo((unsigned)wi[b * 16 + q]); const u32x4 vv = vq[q];
#pragma unroll
                    for (int w = 0; w < 4; ++w) { const f32x2 f01 = __builtin_amdgcn_cvt_pk_f32_fp8(vv[w], false), f23 = __builtin_amdgcn_cvt_pk_f32_fp8(vv[w], true);
                        y[4 * w] = fmaf(wf, f01.x, y[4 * w]); y[4 * w + 1] = fmaf(wf, f01.y, y[4 * w + 1]); y[4 * w + 2] = fmaf(wf, f23.x, y[4 * w + 2]); y[4 * w + 3] = fmaf(wf, f23.y, y[4 * w + 3]); }
                }
            }
#pragma unroll
            for (int q = 0; q < 4; ++q) { f32x4 o; const f32x4 gv = gvv[q];
                const unsigned xlo = xq[q].x, xhi = xq[q].y;
                const float x1v[4] = {bf_lo(xlo), bf_hi(xlo), bf_lo(xhi), bf_hi(xhi)};
#pragma unroll
                for (int i = 0; i < 4; ++i) o[i] = x1v[i] + gv[i] * y[4 * q + i];
                if (rep7v_ == REP7V - 1) __builtin_nontemporal_store(o, (f32x4*)(orow + 32 * q)); else asm volatile("" :: "v"(o)); }
        }
    }
}

constexpr int N_PHASES = 8;
struct Args { const float* in[18]; float* out; unsigned char* ws; int ph_lo, ph_hi; };
__global__ void __launch_bounds__(NWAVES * 64, 2) hymba_fwd(Args args) {
    extern __shared__ __attribute__((aligned(16))) unsigned char lds_raw[];
    LAS unsigned char* lds = (LAS unsigned char*)lds_raw;
    volatile LAS unsigned* MISC = (volatile LAS unsigned*)(lds + MISC_OFF);
    const int wave = __builtin_amdgcn_readfirstlane((int)threadIdx.x >> 6);
    const int G = gridDim.x, bx = blockIdx.x;
    const int gw = bx * NWAVES + wave, NGW = G * NWAVES;
#define FRESH_IDS() const int lane = fresh_lane(); const int tid = wave * 64 + lane; (void)tid
    unsigned char* ws = args.ws;
    const float* x = args.in[0]; const float* cvec = args.in[1]; const float* w_ada = args.in[2]; const float* b_ada = args.in[3]; const float* g_norm1 = args.in[4];
    const float* w_in = args.in[5]; const float* g_q = args.in[6]; const float* g_k = args.in[7]; const float* sinks = args.in[8]; const float* conv_w = args.in[9];
    const float* g_oa = args.in[10]; const float* g_oc = args.in[11]; const float* w_out = args.in[12]; const float* g_norm2 = args.in[13]; const float* w_pq = args.in[14];
    const float* subkeys = args.in[15]; const float* peer_u = args.in[16]; const float* peer_v = args.in[17];
    float* out = args.out;
    float* mod = (float*)(ws + WS_MOD); float* rope = (float*)(ws + WS_ROPE);
    bf16_t* SK = (bf16_t*)(ws + WS_SK); bf16_t* WIN = (bf16_t*)(ws + WS_WIN); bf16_t* WOUT = (bf16_t*)(ws + WS_WOUT); bf16_t* WPQ = (bf16_t*)(ws + WS_WPQ);
    unsigned char* UB = ws + WS_UB; unsigned char* VB = ws + WS_VB; unsigned char* H8 = ws + WS_H8; float* SU = (float*)(ws + WS_SU); float* SH = (float*)(ws + WS_SH); bf16_t* XN = (bf16_t*)(ws + WS_XN); bf16_t* PROJ = (bf16_t*)(ws + WS_PROJ);
    bf16_t* QP = (bf16_t*)(ws + WS_QP); bf16_t* X1B = (bf16_t*)(ws + WS_X1B); unsigned char* MIXED = ws + WS_MIXED; unsigned char* XN8 = ws + WS_XN; float* SX1 = (float*)(ws + WS_SX1); bf16_t* W2 = (bf16_t*)(ws + WS_XN + 64 * MiB);
    unsigned* ctl = (unsigned*)(ws + WS_CTL);

    { FRESH_IDS(); for (int u = tid; u < (LDS_BYTES - LDSCTL_OFF) / 4; u += NWAVES * 64) ((LAS unsigned*)(lds + LDSCTL_OFF))[u] = 0u; }
    __syncthreads();
    XcdBarrier bar; bar.bar = ctl + CW_BAR; bar.x = 0; bar.st = nullptr; bar.wave = wave;
    if (MK_N_LAUNCHES == 1) bar = xcd_barrier_post(ctl + CW_BAR, MISC + 8, wave);
    const int lo = args.ph_lo, hi = args.ph_hi;
#define IN(k) (lo <= (k) && (k) < hi)
#define SEAM(k) do { if (IN(k) && IN((k) + 1)) xcd_barrier(bar); } while (0)

#pragma nounroll
    for (int rep_ = 0; rep_ < REP0; ++rep_) { if (rep_) xcd_barrier(bar);
    if (IN(0)) { FRESH_IDS();
#pragma nounroll
        for (int ra_ = 0; ra_ < REP0A; ++ra_)
        for (int it = bx; it < MODW / 64; it += G) p0_ada_item(cvec, w_ada, b_ada, mod, lds, it, tid, wave, lane);
        LAS float* scr = (LAS float*)(lds + wave * 16384);
        constexpr int I_IN = (DM / 64) * (INC / 32), I_SQ = (DM / 64) * (DM / 32), I_TAB = PEER_N * DM / 2048, I_W2 = 512, I_ROPE = 512;
        (void)scr;
        { const int nfree = G > MODW / 64 ? (G - MODW / 64) * NWAVES : 0;
          if (nfree > 0) { if (bx >= MODW / 64) for (int r = (bx - MODW / 64) * NWAVES + wave; r < I_W2; r += nfree) p0_w2_item(w_pq, subkeys, W2, ctl + CW_CMX_PQ, r, lane); }
          else for (int r = gw; r < I_W2; r += NGW) p0_w2_item(w_pq, subkeys, W2, ctl + CW_CMX_PQ, r, lane); }
#pragma nounroll
        for (int rc_ = 0; rc_ < REP0C; ++rc_)
        for (int r = gw; r < I_IN + I_SQ; r += NGW) { if (r < I_IN) p0_colmax_item(w_in, INC, ctl + CW_CMX_IN, r, lane); else p0_colmax_item(w_out, DM, ctl + CW_CMX_OUT, r - I_IN, lane); }
        for (int r = gw; r < I_ROPE; r += NGW) p0_rope_item(rope, r, lane);
        if (G == 256) {   }
        else if (NGW * 8 == I_TAB) p0_tables8(peer_u, peer_v, UB, SU, VB, gw, NGW, lane);
        else for (int r = gw; r < 2 * I_TAB; r += NGW) { if (r < I_TAB) p0_i8_row(peer_u, UB, SU, r, lane); else p0_fp8_item(peer_v, VB, (size_t)(r - I_TAB) * 2048, V_SCALE, lane); }
    }
    }
    SEAM(0);
#pragma nounroll
    for (int rep_ = 0; rep_ < REP1; ++rep_) { if (rep_) xcd_barrier(bar);
    if (IN(1)) { FRESH_IDS(); norm_rows(x, g_norm1, mod, 0 * DM, 1 * DM, XN8, SX1, gw, NGW, lane);
        LAS float* scr = (LAS float*)(lds + wave * 16384);
        constexpr int I_IN = (DM / 64) * (INC / 32), I_SQ = (DM / 64) * (DM / 32);
        for (int it = gw; it < I_IN + I_SQ + DM; it += NGW) {
            int r = it;
            if (r < I_IN) { p1_transpose_i8_item<true>(w_in, DM, INC, (unsigned char*)WIN, ctl + CW_CMX_IN, scr, r, lane); continue; } r -= I_IN;
            if (r < I_SQ) { p1_transpose_i8_item<false>(w_out, DM, DM, (unsigned char*)WOUT, ctl + CW_CMX_OUT, scr, r, lane); continue; } r -= I_SQ;
            p1_w2_row(W2, (unsigned char*)WPQ, ctl + CW_CMX_PQ, r, lane);
        }
    }
    }
    SEAM(1);
#if REP2 > 1
    if (IN(2)) {
        pg8::Gemm g{(const bf16_t*)XN8, (const bf16_t*)WIN, MTOK, INC, DM / 2}; pg8::StaticOrder S; S.init(MTOK, INC, G, bx);
        pg8::EpiProjI8 E{PROJ, INC, SX1, ctl + CW_CMX_IN};
        pg8::gemm_phase<pg8::EpiProjI8, pg8::StaticOrder, true, true, true>(lds, g, S, E, wave);
    }
    xcd_barrier(bar);
#endif
    if (IN(2)) {
        pg8::Gemm g{(const bf16_t*)XN8, (const bf16_t*)WIN, MTOK, INC, DM / 2}; pg8::StaticOrder S; S.init(MTOK, INC, G, bx);
        pg8::EpiProjI8 E{PROJ, INC, SX1, ctl + CW_CMX_IN};
        pg8::gemm_phase<pg8::EpiProjI8, pg8::StaticOrder, true, true, true>(lds, g, S, E, wave);
    }
    SEAM(2);
#pragma nounroll
    for (int rep_ = 0; rep_ < REP3; ++rep_) { if (rep_) xcd_barrier(bar);
    if (IN(3)) { FRESH_IDS();
#ifndef REP3A
#define REP3A 1
#endif
#pragma nounroll
        for (int ra_ = 0; ra_ < REP3A; ++ra_)
        { f32x4 tcur[8], tnx[8];
          if (G != 256) {
              const TabCtx T{peer_u, UB, SU, 0};
              for (int u = bx; u < BATCH * 4 * 32; u += G) attn_unit<false, false>(u >> 7, (u >> 5) & 3, u & 31, PROJ, g_q, g_k, sinks, g_oa, rope, MIXED, lds, tid, wave, lane, T, 0, tcur, tnx);
          } else if (wave & 1) {
              const TabCtx T{peer_v, VB, SU, gw >> 1};
              tab_row_load(T, 0, tnx, lane);
              int ui = 0;
              for (int u = bx; u < BATCH * 4 * 32; u += G, ++ui) attn_unit<true, true>(u >> 7, (u >> 5) & 3, u & 31, PROJ, g_q, g_k, sinks, g_oa, rope, MIXED, lds, tid, wave, lane, T, ui * 4, tcur, tnx);
          } else {
              const TabCtx T{peer_u, UB, SU, gw >> 1};
              tab_row_load(T, 0, tnx, lane);
              int ui = 0;
              for (int u = bx; u < BATCH * 4 * 32; u += G, ++ui) attn_unit<true, false>(u >> 7, (u >> 5) & 3, u & 31, PROJ, g_q, g_k, sinks, g_oa, rope, MIXED, lds, tid, wave, lane, T, ui * 4, tcur, tnx);
          } }
        for (int it = gw; it < MTOK / 16; it += NGW) conv_item(it, PROJ, conv_w, g_oc, MIXED, lane);
    }
    }
    SEAM(3);
#if REP4 > 1
    if (IN(4)) {
        pg8::Gemm g{(const bf16_t*)MIXED, (const bf16_t*)WOUT, MTOK, DM, DM / 2}; pg8::StaticOrder S; S.init(MTOK, DM, G, bx);
        pg8::EpiResGateBf16I8 E{x, X1B, DM, mod + 2 * DM, MODW, 1.0f / MIX_SCALE, ctl + CW_CMX_OUT};
        pg8::gemm_phase<pg8::EpiResGateBf16I8, pg8::StaticOrder, true, true, true>(lds, g, S, E, wave);
    }
    xcd_barrier(bar);
#endif
    if (IN(4)) {
        pg8::Gemm g{(const bf16_t*)MIXED, (const bf16_t*)WOUT, MTOK, DM, DM / 2}; pg8::StaticOrder S; S.init(MTOK, DM, G, bx);
        pg8::EpiResGateBf16I8 E{x, X1B, DM, mod + 2 * DM, MODW, 1.0f / MIX_SCALE, ctl + CW_CMX_OUT};
        pg8::gemm_phase<pg8::EpiResGateBf16I8, pg8::StaticOrder, true, true, true>(lds, g, S, E, wave);
    }
    SEAM(4);
#pragma nounroll
    for (int rep_ = 0; rep_ < REP5; ++rep_) { if (rep_) xcd_barrier(bar);
    if (IN(5)) { FRESH_IDS(); norm_rows_bf16(X1B, g_norm2, mod, 3 * DM, 4 * DM, H8, SH, gw, NGW, lane); }
    }
    SEAM(5);
#if REP6 > 1
    if (IN(6)) {
        pg8::Gemm g{(const bf16_t*)H8, (const bf16_t*)WPQ, MTOK, DM, DM / 2}; pg8::StaticOrder S; S.init(MTOK, DM, G, bx);
        pg8::EpiScoresI8 E{QP, MTOK, SH, ctl + CW_CMX_PQ};
        pg8::gemm_phase<pg8::EpiScoresI8, pg8::StaticOrder, true, true, true>(lds, g, S, E, wave);
    }
    xcd_barrier(bar);
#endif
    if (IN(6)) {
        pg8::Gemm g{(const bf16_t*)H8, (const bf16_t*)WPQ, MTOK, DM, DM / 2}; pg8::StaticOrder S; S.init(MTOK, DM, G, bx);
        pg8::EpiScoresI8 E{QP, MTOK, SH, ctl + CW_CMX_PQ};
        pg8::gemm_phase<pg8::EpiScoresI8, pg8::StaticOrder, true, true, true>(lds, g, S, E, wave);
    }
    SEAM(6);
    if (IN(7)) { FRESH_IDS();
        for (int chunk = bx; chunk < MTOK / 128; chunk += G) peer_chunk(chunk * 128, QP, SK, H8, SH, UB, SU, VB, mod, X1B, out, lds, tid, wave, lane);
    }
#undef IN
#undef SEAM
}

extern "C" void kernel_launch(void* const* d_in, const int* in_sizes, int n_in, void* d_out, int out_size, void* d_ws, size_t ws_size, hipStream_t stream) {
    static int grid = 0;
    if (grid == 0) {
        if (n_in != 18 || in_sizes[0] != MTOK * DM || out_size != MTOK * DM || ws_size < WS_END) { fprintf(stderr, "kernel_launch: unexpected shapes (n_in %d, in0 %d, out %d, ws %zu)\n", n_in, n_in > 0 ? in_sizes[0] : -1, out_size, ws_size); grid = -1; return; }
        int dev = 0, cus = 0, per_cu = 0;
        if (hipGetDevice(&dev) != hipSuccess || hipDeviceGetAttribute(&cus, hipDeviceAttributeMultiprocessorCount, dev) != hipSuccess) { grid = -1; return; }
        if (hipFuncSetAttribute((const void*)hymba_fwd, hipFuncAttributeMaxDynamicSharedMemorySize, LDS_BYTES) != hipSuccess) { fprintf(stderr, "kernel_launch: hipFuncSetAttribute failed\n"); grid = -1; return; }
        if (hipOccupancyMaxActiveBlocksPerMultiprocessor(&per_cu, (const void*)hymba_fwd, NWAVES * 64, LDS_BYTES) != hipSuccess || per_cu < 1) { fprintf(stderr, "kernel_launch: occupancy query says %d blocks per CU\n", per_cu); per_cu = 1; }
        (void)hipGetLastError();
        grid = cus;
    }
    if (grid < 0) return;
    (void)hipMemsetAsync((char*)d_ws + WS_CTL, 0, CTL_ZERO_BYTES, stream);
    Args a{};
    for (int i = 0; i < 18; ++i) a.in[i] = (const float*)d_in[i];
    a.out = (float*)d_out; a.ws = (unsigned char*)d_ws;
    if (MK_N_LAUNCHES == 1) {
        a.ph_lo = 0; a.ph_hi = N_PHASES;
        hipLaunchKernelGGL(hymba_fwd, dim3(grid), dim3(NWAVES * 64), LDS_BYTES, stream, a);
    } else {
        for (int p = 0; p < N_PHASES; ++p) { a.ph_lo = p; a.ph_hi = p + 1; hipLaunchKernelGGL(hymba_fwd, dim3(grid), dim3(NWAVES * 64), LDS_BYTES, stream, a); }
    }
}
```

```cpp
#include <hip/hip_runtime.h>
#include <cstdio>
#include <cstdint>

#ifndef MK_N_LAUNCHES
#define MK_N_LAUNCHES 1
#endif

#ifndef REP0
#define REP0 1
#endif
#ifndef REP0A
#define REP0A 1
#endif
#ifndef REP0C
#define REP0C 1
#endif
#ifndef REP1
#define REP1 1
#endif
#ifndef REP2
#define REP2 1
#endif
#ifndef REP3
#define REP3 1
#endif
#ifndef REP4
#define REP4 1
#endif
#ifndef REP5
#define REP5 1
#endif
#ifndef REP6
#define REP6 1
#endif
#ifndef REP7A
#define REP7A 1
#endif
#ifndef REP7U
#define REP7U 1
#endif
#ifndef REPSEL
#define REPSEL 1
#endif
#ifndef REP7V
#define REP7V 1
#endif
#ifndef REPSC
#define REPSC 1
#endif

#define LAS __attribute__((address_space(3)))
#define GAS __attribute__((address_space(1)))
typedef unsigned short bf16_t;
typedef short bf16x8 __attribute__((ext_vector_type(8)));
typedef short s16x4 __attribute__((ext_vector_type(4)));
typedef float f32x4 __attribute__((ext_vector_type(4)));
typedef float f32x2 __attribute__((ext_vector_type(2)));
typedef unsigned u32x4 __attribute__((ext_vector_type(4)));
typedef unsigned u32x2 __attribute__((ext_vector_type(2)));
typedef int i32x4 __attribute__((ext_vector_type(4)));
typedef __bf16 bf16x2_t __attribute__((ext_vector_type(2)));

constexpr int DM = 2048, BATCH = 8, SEQ = 4096, MTOK = BATCH * SEQ;
constexpr int INC = 4608;
constexpr int COL_K = 1024, COL_V = 1280, COL_B = 1536, COL_C = 2560, COL_H = 3584;
constexpr int MODW = 6 * DM;
constexpr int PEER_N = 16384;
constexpr float EPS = 1e-6f;
constexpr float LOG2E = 1.4426950408889634f;
constexpr float MIX_SCALE = 127.0f / 6.0f;
constexpr float V_SCALE = 16.0f;

constexpr size_t MiB = 1u << 20;
constexpr size_t WS_CTL = 0, CTL_ZERO_BYTES = 1 * MiB;
constexpr size_t WS_MOD = 1 * MiB;
constexpr size_t WS_ROPE = 1 * MiB + 512 * 1024;
constexpr size_t WS_SK = 2 * MiB;
constexpr size_t WS_WIN = 4 * MiB;
constexpr size_t WS_WOUT = 22 * MiB;
constexpr size_t WS_WPQ = 30 * MiB;
constexpr size_t WS_SU = 3 * MiB;
constexpr size_t WS_SH = 3 * MiB + 256 * 1024;
constexpr size_t WS_SX1 = 3 * MiB + 512 * 1024;
constexpr size_t WS_UB = 40 * MiB;
constexpr size_t WS_VB = 104 * MiB;
constexpr size_t WS_XN = 168 * MiB;
constexpr size_t WS_PROJ = 296 * MiB;
constexpr size_t WS_QP = WS_PROJ;
constexpr size_t WS_X1B = WS_PROJ + 128 * MiB;
constexpr size_t WS_MIXED = 584 * MiB;
constexpr size_t WS_H8 = 712 * MiB;
constexpr size_t WS_END = 776 * MiB;
constexpr int CW_BAR = 4096;
constexpr int CW_CMX_IN = 32768, CW_CMX_OUT = CW_CMX_IN + 4608, CW_CMX_PQ = CW_CMX_OUT + 2048;

constexpr int RING_BYTES = 131072;
constexpr int LDSCTL_OFF = RING_BYTES, MISC_OFF = LDSCTL_OFF + 320;
constexpr int LDS_BYTES = 148480;
constexpr int NWAVES = 8;

#define LDS_WAIT() asm volatile("s_waitcnt lgkmcnt(0)" ::: "memory")
#define VM_WAIT() asm volatile("s_waitcnt vmcnt(0)" ::: "memory")

__device__ __forceinline__ unsigned cvtpk(float lo, float hi) { f32x2 v = {lo, hi}; bf16x2_t b = __builtin_convertvector(v, bf16x2_t); return __builtin_bit_cast(unsigned, b); }
__device__ __forceinline__ float bf_lo(unsigned u) { return __uint_as_float(u << 16); }
__device__ __forceinline__ float bf_hi(unsigned u) { return __uint_as_float(u & 0xffff0000u); }
__device__ __forceinline__ float dot2bf(unsigned a, unsigned b, float c) { return __builtin_amdgcn_fdot2_f32_bf16(__builtin_bit_cast(bf16x2_t, a), __builtin_bit_cast(bf16x2_t, b), c, false); }
__device__ __forceinline__ int fresh_lane() { int l = (int)__builtin_amdgcn_mbcnt_hi(~0u, __builtin_amdgcn_mbcnt_lo(~0u, 0u)); asm volatile("" : "+v"(l)); return l; }
__device__ __forceinline__ float xrow_sum(float v) {
    const u32x2 a = __builtin_amdgcn_permlane16_swap(__float_as_uint(v), __float_as_uint(v), false, false); v = __uint_as_float(a.x) + __uint_as_float(a.y);
    const u32x2 b = __builtin_amdgcn_permlane32_swap(__float_as_uint(v), __float_as_uint(v), false, false); return __uint_as_float(b.x) + __uint_as_float(b.y);
}
__device__ __forceinline__ float xrow_max(float v) {
    const u32x2 a = __builtin_amdgcn_permlane16_swap(__float_as_uint(v), __float_as_uint(v), false, false); v = fmaxf(__uint_as_float(a.x), __uint_as_float(a.y));
    const u32x2 b = __builtin_amdgcn_permlane32_swap(__float_as_uint(v), __float_as_uint(v), false, false); return fmaxf(__uint_as_float(b.x), __uint_as_float(b.y));
}
__device__ __forceinline__ float xrow16_other(float v, bool odd_row) {
    const u32x2 a = __builtin_amdgcn_permlane16_swap(__float_as_uint(v), __float_as_uint(v), false, false); return __uint_as_float(odd_row ? a.x : a.y);
}

template <int CTRL> __device__ __forceinline__ float dpp_add(float v) { return v + __int_as_float(__builtin_amdgcn_update_dpp(0, __float_as_int(v), CTRL, 0xF, 0xF, false)); }
template <int CTRL> __device__ __forceinline__ float dpp_mov(float v) { return __int_as_float(__builtin_amdgcn_update_dpp(0, __float_as_int(v), CTRL, 0xF, 0xF, true)); }
__device__ __forceinline__ float allred8(float v) { v = dpp_add<0x141>(v); v = dpp_add<0x1B>(v); v = dpp_add<0xB1>(v); return v; }

template <int CTRL> __device__ __forceinline__ float dpp_max(float v) { return fmaxf(v, __int_as_float(__builtin_amdgcn_update_dpp(0, __float_as_int(v), CTRL, 0xF, 0xF, false))); }
__device__ __forceinline__ float wave_sum(float v) { v = dpp_add<0xB1>(v); v = dpp_add<0x4E>(v); v = dpp_add<0x141>(v); v = dpp_add<0x140>(v); return xrow_sum(v); }
__device__ __forceinline__ float wave_max(float v) { v = dpp_max<0xB1>(v); v = dpp_max<0x4E>(v); v = dpp_max<0x141>(v); v = dpp_max<0x140>(v); return xrow_max(v); }
__device__ __forceinline__ unsigned pack_i8x4_sat(f32x4 x, float inv) {
    const int a = (int)rintf(fminf(fmaxf(x[0] * inv, -127.f), 127.f)), b = (int)rintf(fminf(fmaxf(x[1] * inv, -127.f), 127.f)), c = (int)rintf(fminf(fmaxf(x[2] * inv, -127.f), 127.f)), d = (int)rintf(fminf(fmaxf(x[3] * inv, -127.f), 127.f));
    return ((unsigned)a & 0xffu) | (((unsigned)b & 0xffu) << 8) | (((unsigned)c & 0xffu) << 16) | ((unsigned)d << 24);
}
__device__ __forceinline__ unsigned pack_i8x4(f32x4 x, float inv) {
    const int a = (int)rintf(x[0] * inv), b = (int)rintf(x[1] * inv), c = (int)rintf(x[2] * inv), d = (int)rintf(x[3] * inv);
    return ((unsigned)a & 0xffu) | (((unsigned)b & 0xffu) << 8) | (((unsigned)c & 0xffu) << 16) | ((unsigned)d << 24);
}
template <int CTRL> __device__ __forceinline__ int dpp_movi(int v) { return __builtin_amdgcn_update_dpp(0, v, CTRL, 0xF, 0xF, true); }

namespace pg8 {
#define PG8_LAS __attribute__((address_space(3)))
constexpr int BM = 256, BK = 64, HALF = 128, HTB = HALF * BK * 2, STAGE_BYTES = 8 * HTB, NXCD = 8, WGM = 4;
__host__ __device__ __forceinline__ int lds_byte(int r, int c) { const int st = (r >> 4) * 2 + (c >> 5), rr = r & 15, cc = c & 31, ob = rr * 64 + cc * 2; return st * 1024 + (ob ^ (((ob >> 9) & 1) << 5)); }
__host__ __device__ __forceinline__ void stage_rc(int b, int& R, int& C) { const int st = b / 1024, sb = b % 1024, swz = sb ^ (((sb >> 9) & 1) << 5); R = (st >> 1) * 16 + swz / 64; C = (st & 1) * 32 + (swz % 64) / 2; }
__host__ __device__ __forceinline__ int perm32(int rho) { const int n = rho >> 4, i = rho & 15; return 8 * (i >> 2) + 4 * n + (i & 3); }
struct Unit { int pm, pn; };
struct Gemm { const bf16_t* A; const bf16_t* Bt; int M, N, K; };
struct StaticOrder {
    int nM, nN, nwg, G, c;
    __host__ __device__ void init(int M, int N, int G_, int c_) { nM = M / BM; nN = N / BM; nwg = nM * nN; G = G_; c = c_; }
    __host__ __device__ bool next(int i, Unit& u) const {
        const long L = (long)i * G + c; if (L >= nwg) return false;
        int wgid = (int)L; { const int q = nwg / NXCD, r = nwg % NXCD, xcd = wgid % NXCD, off = wgid / NXCD; wgid = (xcd < r ? xcd * (q + 1) : r * (q + 1) + (xcd - r) * q) + off; }
        const int nig = WGM * nN, gid = wgid / nig, fm = gid * WGM, gsz = (nM - fm) < WGM ? (nM - fm) : WGM;
        u.pm = fm + ((wgid % nig) % gsz); u.pn = (wgid % nig) / gsz; return true;
    }
    __device__ __forceinline__ void a_ready(const Unit&) const {}
    __device__ __forceinline__ void done(const Unit&) const {}
};
__device__ __forceinline__ unsigned cvt_pk_bf16(float lo, float hi) { unsigned r; asm volatile("v_cvt_pk_bf16_f32 %0, %1, %2" : "=v"(r) : "v"(lo), "v"(hi)); return r; }

struct EpiBf16 {
    static constexpr bool PERM = true, AFTER_DRAIN = false;
    bf16_t* O; int ldc;
    __device__ __forceinline__ void operator()(const f32x4 (&acc)[2][2][4][2], const Unit& u, int wr, int wc, int fr, int fq) const {
        const int row0 = u.pm * BM + wr * 64 + fr, col0 = u.pn * BM + wc * 32 + 8 * fq;
#pragma unroll
        for (int ai = 0; ai < 2; ++ai)
#pragma unroll
            for (int m = 0; m < 4; ++m) { bf16_t* rowp = O + (size_t)(row0 + ai * HALF + m * 16) * ldc + col0;
#pragma unroll
                for (int bj = 0; bj < 2; ++bj) { const f32x4 v0 = acc[ai][bj][m][0], v1 = acc[ai][bj][m][1];
                    u32x4 w; w.x = cvt_pk_bf16(v0[0], v0[1]); w.y = cvt_pk_bf16(v0[2], v0[3]); w.z = cvt_pk_bf16(v1[0], v1[1]); w.w = cvt_pk_bf16(v1[2], v1[3]);
                    *(u32x4*)(rowp + bj * HALF) = w; } }
    }
};
struct EpiBf16I8 {
    static constexpr bool PERM = true, AFTER_DRAIN = false;
    bf16_t* O; int ldc; const float* srow; const unsigned* cmax;
    __device__ __forceinline__ void operator()(const f32x4 (&acc)[2][2][4][2], const Unit& u, int wr, int wc, int fr, int fq) const {
        const int row0 = u.pm * BM + wr * 64 + fr, col0 = u.pn * BM + wc * 32 + 8 * fq;
        f32x4 sc[2][2];
#pragma unroll
        for (int bj = 0; bj < 2; ++bj)
#pragma unroll
            for (int n = 0; n < 2; ++n) { const u32x4 b = *(const u32x4*)(cmax + col0 + bj * HALF + 4 * n);
#pragma unroll
                for (int i = 0; i < 4; ++i) sc[bj][n][i] = __uint_as_float(b[i]) * (1.0f / 127.0f); }
        float srv[2][4];
#pragma unroll
        for (int ai = 0; ai < 2; ++ai)
#pragma unroll
            for (int m = 0; m < 4; ++m) srv[ai][m] = srow[row0 + ai * HALF + m * 16];
#pragma unroll
        for (int ai = 0; ai < 2; ++ai)
#pragma unroll
            for (int m = 0; m < 4; ++m) { const int row = row0 + ai * HALF + m * 16; const float sr = srv[ai][m]; bf16_t* rowp = O + (size_t)row * ldc + col0;
#pragma unroll
                for (int bj = 0; bj < 2; ++bj) { const i32x4 a0 = __builtin_bit_cast(i32x4, acc[ai][bj][m][0]), a1 = __builtin_bit_cast(i32x4, acc[ai][bj][m][1]);
                    f32x4 v0, v1;
#pragma unroll
                    for (int i = 0; i < 4; ++i) { v0[i] = (float)a0[i] * sr * sc[bj][0][i]; v1[i] = (float)a1[i] * sr * sc[bj][1][i]; }
                    u32x4 w; w.x = cvt_pk_bf16(v0[0], v0[1]); w.y = cvt_pk_bf16(v0[2], v0[3]); w.z = cvt_pk_bf16(v1[0], v1[1]); w.w = cvt_pk_bf16(v1[2], v1[3]);
                    *(u32x4*)(rowp + bj * HALF) = w; } }
    }
};
struct EpiScoresI8 {
    static constexpr bool PERM = true, AFTER_DRAIN = false;
    bf16_t* O; int M; const float* srow; const unsigned* cmax;
    __device__ __forceinline__ void operator()(const f32x4 (&acc)[2][2][4][2], const Unit& u, int wr, int wc, int fr, int fq) const {
        const int row0 = u.pm * BM + wr * 64 + fr, col0 = u.pn * BM + wc * 32 + 8 * fq;
        f32x4 sc[2][2];
#pragma unroll
        for (int bj = 0; bj < 2; ++bj)
#pragma unroll
            for (int n = 0; n < 2; ++n) { const u32x4 b = *(const u32x4*)(cmax + col0 + bj * HALF + 4 * n);
#pragma unroll
                for (int i = 0; i < 4; ++i) sc[bj][n][i] = __uint_as_float(b[i]) * (1.0f / 127.0f); }
        float srv[2][4];
#pragma unroll
        for (int ai = 0; ai < 2; ++ai)
#pragma unroll
            for (int m = 0; m < 4; ++m) srv[ai][m] = srow[row0 + ai * HALF + m * 16];
#pragma unroll
        for (int ai = 0; ai < 2; ++ai)
#pragma unroll
            for (int m = 0; m < 4; ++m) { const int row = row0 + ai * HALF + m * 16; const float sr = srv[ai][m];
#pragma unroll
                for (int bj = 0; bj < 2; ++bj) { const i32x4 a0 = __builtin_bit_cast(i32x4, acc[ai][bj][m][0]), a1 = __builtin_bit_cast(i32x4, acc[ai][bj][m][1]);
                    f32x4 v0, v1;
#pragma unroll
                    for (int i = 0; i < 4; ++i) { v0[i] = (float)a0[i] * sr * sc[bj][0][i]; v1[i] = (float)a1[i] * sr * sc[bj][1][i]; }
                    u32x4 w; w.x = cvt_pk_bf16(v0[0], v0[1]); w.y = cvt_pk_bf16(v0[2], v0[3]); w.z = cvt_pk_bf16(v1[0], v1[1]); w.w = cvt_pk_bf16(v1[2], v1[3]);
                    *(u32x4*)(O + ((size_t)(u.pn * 32 + bj * 16 + wc * 4 + fq) * M + row) * 8) = w; } }
    }
};
struct EpiProjI8 {
    static constexpr bool PERM = true, AFTER_DRAIN = false;
    bf16_t* O; int ldc; const float* srow; const unsigned* cmax;
    __device__ __forceinline__ void operator()(const f32x4 (&acc)[2][2][4][2], const Unit& u, int wr, int wc, int fr, int fq) const {
        const int row0 = u.pm * BM + wr * 64 + fr;
        const bool prod = u.pn >= 10;
        const int col0 = prod ? 2560 + (u.pn - 10) * 128 + wc * 32 + 8 * fq : u.pn * BM + wc * 32 + 8 * fq;
        const int sc0 = col0, sc1 = prod ? col0 + 1024 : col0 + HALF;
        f32x4 sc[2][2];
#pragma unroll
        for (int n = 0; n < 2; ++n) { const u32x4 b0 = *(const u32x4*)(cmax + sc0 + 4 * n), b1 = *(const u32x4*)(cmax + sc1 + 4 * n);
#pragma unroll
            for (int i = 0; i < 4; ++i) { sc[0][n][i] = __uint_as_float(b0[i]) * (1.0f / 127.0f); sc[1][n][i] = __uint_as_float(b1[i]) * (1.0f / 127.0f); } }
        float srv[2][4];
#pragma unroll
        for (int ai = 0; ai < 2; ++ai)
#pragma unroll
            for (int m = 0; m < 4; ++m) srv[ai][m] = srow[row0 + ai * HALF + m * 16];
#pragma unroll
        for (int ai = 0; ai < 2; ++ai)
#pragma unroll
            for (int m = 0; m < 4; ++m) { const float sr = srv[ai][m]; bf16_t* rowp = O + (size_t)(row0 + ai * HALF + m * 16) * ldc + col0;
                f32x4 v[2][2];
#pragma unroll
                for (int bj = 0; bj < 2; ++bj) { const i32x4 a0 = __builtin_bit_cast(i32x4, acc[ai][bj][m][0]), a1 = __builtin_bit_cast(i32x4, acc[ai][bj][m][1]);
#pragma unroll
                    for (int i = 0; i < 4; ++i) { v[bj][0][i] = (float)a0[i] * sr * sc[bj][0][i]; v[bj][1][i] = (float)a1[i] * sr * sc[bj][1][i]; } }
                if (prod) { const f32x4 p0 = v[0][0] * v[1][0], p1 = v[0][1] * v[1][1];
                    u32x4 w; w.x = cvt_pk_bf16(p0[0], p0[1]); w.y = cvt_pk_bf16(p0[2], p0[3]); w.z = cvt_pk_bf16(p1[0], p1[1]); w.w = cvt_pk_bf16(p1[2], p1[3]);
                    *(u32x4*)rowp = w;
                } else {
#pragma unroll
                    for (int bj = 0; bj < 2; ++bj) { u32x4 w; w.x = cvt_pk_bf16(v[bj][0][0], v[bj][0][1]); w.y = cvt_pk_bf16(v[bj][0][2], v[bj][0][3]); w.z = cvt_pk_bf16(v[bj][1][0], v[bj][1][1]); w.w = cvt_pk_bf16(v[bj][1][2], v[bj][1][3]);
                        *(u32x4*)(rowp + bj * HALF) = w; } }
            }
    }
};
struct EpiResGateI8 {
    static constexpr bool PERM = false, AFTER_DRAIN = false;
    const float* base; float* out; int ldc; const float* gate; int gate_stride; float srow_const; const unsigned* cmax;
    __device__ __forceinline__ void operator()(const f32x4 (&acc)[2][2][4][2], const Unit& u, int wr, int wc, int fr, int fq) const {
        const int row0 = u.pm * BM + wr * 64 + fr, col0 = u.pn * BM + wc * 32 + 4 * fq;
        const float* g = gate + (size_t)((u.pm * BM) >> 12) * gate_stride + col0;
        f32x4 gv[2][2];
#pragma unroll
        for (int bj = 0; bj < 2; ++bj)
#pragma unroll
            for (int n = 0; n < 2; ++n) { const f32x4 gg = *(const f32x4*)(g + bj * HALF + n * 16); const u32x4 b = *(const u32x4*)(cmax + col0 + bj * HALF + n * 16);
#pragma unroll
                for (int i = 0; i < 4; ++i) gv[bj][n][i] = gg[i] * __uint_as_float(b[i]) * (srow_const * (1.0f / 127.0f)); }
#pragma unroll
        for (int g2 = 0; g2 < 4; ++g2) {
            const int ai = g2 >> 1, m0 = (g2 & 1) * 2;
            f32x4 bs[2][2][2];
#pragma unroll
            for (int mm = 0; mm < 2; ++mm)
#pragma unroll
                for (int bj = 0; bj < 2; ++bj)
#pragma unroll
                    for (int n = 0; n < 2; ++n) bs[mm][bj][n] = *(const f32x4*)(base + (size_t)(row0 + ai * HALF + (m0 + mm) * 16) * ldc + col0 + bj * HALF + n * 16);
            asm volatile("" ::: "memory");
#pragma unroll
            for (int mm = 0; mm < 2; ++mm) { const size_t off = (size_t)(row0 + ai * HALF + (m0 + mm) * 16) * ldc + col0;
#pragma unroll
                for (int bj = 0; bj < 2; ++bj)
#pragma unroll
                    for (int n = 0; n < 2; ++n) { const i32x4 a = __builtin_bit_cast(i32x4, acc[ai][bj][m0 + mm][n]);
                        f32x4 o;
#pragma unroll
                        for (int i = 0; i < 4; ++i) o[i] = bs[mm][bj][n][i] + gv[bj][n][i] * (float)a[i];
                        *(f32x4*)(out + off + bj * HALF + n * 16) = o; } }
            asm volatile("" ::: "memory");
        }
    }
};
struct EpiResGateBf16I8 {
    static constexpr bool PERM = true, AFTER_DRAIN = false;
    const float* base; bf16_t* O; int ldc; const float* gate; int gate_stride; float srow_const; const unsigned* cmax;
    __device__ __forceinline__ void operator()(const f32x4 (&acc)[2][2][4][2], const Unit& u, int wr, int wc, int fr, int fq) const {
        const int row0 = u.pm * BM + wr * 64 + fr, col0 = u.pn * BM + wc * 32 + 8 * fq;
        const float* g = gate + (size_t)((u.pm * BM) >> 12) * gate_stride + col0;
        f32x4 gv[2][2];
#pragma unroll
        for (int bj = 0; bj < 2; ++bj)
#pragma unroll
            for (int n = 0; n < 2; ++n) { const f32x4 gg = *(const f32x4*)(g + bj * HALF + 4 * n); const u32x4 b = *(const u32x4*)(cmax + col0 + bj * HALF + 4 * n);
#pragma unroll
                for (int i = 0; i < 4; ++i) gv[bj][n][i] = gg[i] * __uint_as_float(b[i]) * (srow_const * (1.0f / 127.0f)); }
#pragma unroll
        for (int g2 = 0; g2 < 2; ++g2) {
            const int ai = g2, m0 = 0;
            f32x4 bs[4][2][2];
#pragma unroll
            for (int mm = 0; mm < 4; ++mm)
#pragma unroll
                for (int bj = 0; bj < 2; ++bj)
#pragma unroll
                    for (int n = 0; n < 2; ++n) bs[mm][bj][n] = __builtin_nontemporal_load((const f32x4*)(base + (size_t)(row0 + ai * HALF + (m0 + mm) * 16) * ldc + col0 + bj * HALF + 4 * n));
            asm volatile("" ::: "memory");
#pragma unroll
            for (int mm = 0; mm < 4; ++mm) { bf16_t* rowp = O + (size_t)(row0 + ai * HALF + (m0 + mm) * 16) * ldc + col0;
#pragma unroll
                for (int bj = 0; bj < 2; ++bj) { const i32x4 a0 = __builtin_bit_cast(i32x4, acc[ai][bj][m0 + mm][0]), a1 = __builtin_bit_cast(i32x4, acc[ai][bj][m0 + mm][1]);
                    f32x4 v0, v1;
#pragma unroll
                    for (int i = 0; i < 4; ++i) { v0[i] = bs[mm][bj][0][i] + gv[bj][0][i] * (float)a0[i]; v1[i] = bs[mm][bj][1][i] + gv[bj][1][i] * (float)a1[i]; }
                    u32x4 w; w.x = cvt_pk_bf16(v0[0], v0[1]); w.y = cvt_pk_bf16(v0[2], v0[3]); w.z = cvt_pk_bf16(v1[0], v1[1]); w.w = cvt_pk_bf16(v1[2], v1[3]);
                    *(u32x4*)(rowp + bj * HALF) = w; } }
            asm volatile("" ::: "memory");
        }
    }
};
struct EpiResGate {
    static constexpr bool PERM = false, AFTER_DRAIN = false;
    const float* base; float* out; int ldc; const float* gate; int gate_stride;
    __device__ __forceinline__ void operator()(const f32x4 (&acc)[2][2][4][2], const Unit& u, int wr, int wc, int fr, int fq) const {
        const int row0 = u.pm * BM + wr * 64 + fr, col0 = u.pn * BM + wc * 32 + 4 * fq;
        const float* g = gate + (size_t)((u.pm * BM) >> 12) * gate_stride + col0;
        f32x4 gv[2][2];
#pragma unroll
        for (int bj = 0; bj < 2; ++bj)
#pragma unroll
            for (int n = 0; n < 2; ++n) gv[bj][n] = *(const f32x4*)(g + bj * HALF + n * 16);
#pragma unroll
        for (int ai = 0; ai < 2; ++ai)
#pragma unroll
            for (int m = 0; m < 4; ++m) { const size_t off = (size_t)(row0 + ai * HALF + m * 16) * ldc + col0;
#pragma unroll
                for (int bj = 0; bj < 2; ++bj)
#pragma unroll
                    for (int n = 0; n < 2; ++n) { const f32x4 bs = *(const f32x4*)(base + off + bj * HALF + n * 16); *(f32x4*)(out + off + bj * HALF + n * 16) = bs + gv[bj][n] * acc[ai][bj][m][n]; }
                asm volatile("" ::: "memory"); }
    }
};

template <class Epi, class Sched, bool ALIGN_EPI = false, bool SP2 = false, bool I8 = false>
__device__ __forceinline__ void gemm_phase(PG8_LAS unsigned char* lds, const Gemm g, const Sched& S, const Epi& E, const int wid) {
    const int lane = fresh_lane(), tid = wid * 64 + lane, wr = wid >> 2, wc = wid & 3, fr = lane & 15, fq = lane >> 4;
    const int K = g.K, nt = K / BK;
    unsigned voffA[2], voffB[2];
#pragma unroll
    for (int i = 0; i < 2; ++i) { int R, C; stage_rc(tid * 16 + i * 8192, R, C); const int Rb = Epi::PERM ? ((R & ~31) + perm32(R & 31)) : R;
        voffA[i] = (unsigned)(R * K + C) * 2u; voffB[i] = (unsigned)(Rb * K + C) * 2u; }
    const size_t kstep = (size_t)(BK * 2);
    const size_t hstep = (size_t)HALF * K * 2;
    const size_t tstep = 2 * hstep;
    const unsigned ldsw = (unsigned)wid * 1024u;
    const int aoff = lds_byte(wr * 64 + fr, fq * 8), boff = lds_byte(wc * 32 + fr, fq * 8);
#define PG8_SA(b, h) (((b) * 2 + (h)) * HTB)
#define PG8_SB(b, h) ((4 + (b) * 2 + (h)) * HTB)
#define PG8_STAGE(bufoff, gbase, voff) do { _Pragma("unroll") for (int _i = 0; _i < 2; ++_i) \
        __builtin_amdgcn_global_load_lds((const unsigned*)((const char*)(gbase) + (voff)[_i]), (PG8_LAS unsigned*)(lds + (bufoff) + ldsw + _i * 8192), 16, 0, 0); } while (0)
#define PG8_LDA(dst, b, h) do { _Pragma("unroll") for (int m = 0; m < 4; ++m) _Pragma("unroll") for (int k = 0; k < 2; ++k) dst[m][k] = *(const PG8_LAS bf16x8*)(lds + PG8_SA(b, h) + aoff + m * 2048 + k * 1024); } while (0)
#define PG8_LDB(dst, b, h) do { _Pragma("unroll") for (int n = 0; n < 2; ++n) _Pragma("unroll") for (int k = 0; k < 2; ++k) dst[n][k] = *(const PG8_LAS bf16x8*)(lds + PG8_SB(b, h) + boff + n * 2048 + k * 1024); } while (0)
#define PG8_MMA(ai, bj, At, Bt) do { __builtin_amdgcn_s_setprio(1); _Pragma("unroll") for (int m = 0; m < 4; ++m) _Pragma("unroll") for (int n = 0; n < 2; ++n) _Pragma("unroll") for (int k = 0; k < 2; ++k) { \
        if constexpr (I8) acc[ai][bj][m][n] = __builtin_bit_cast(f32x4, __builtin_amdgcn_mfma_i32_16x16x64_i8(__builtin_bit_cast(i32x4, Bt[n][k]), __builtin_bit_cast(i32x4, At[m][k]), __builtin_bit_cast(i32x4, acc[ai][bj][m][n]), 0, 0, 0)); \
        else acc[ai][bj][m][n] = __builtin_amdgcn_mfma_f32_16x16x32_bf16(Bt[n][k], At[m][k], acc[ai][bj][m][n], 0, 0, 0); } __builtin_amdgcn_s_setprio(0); } while (0)
#define PG8_WAIT_V(n) asm volatile("s_waitcnt vmcnt(" #n ")" ::: "memory")
#define PG8_WAIT_L(n) asm volatile("s_waitcnt lgkmcnt(" #n ")" ::: "memory")
#define PG8_BAR __builtin_amdgcn_s_barrier()
#define PG8_SCHED __builtin_amdgcn_sched_barrier(0)
    Unit cur, nxt; int ui = 0;
    if (!S.next(0, cur)) return;
    f32x4 acc[2][2][4][2];
#pragma unroll
    for (int a = 0; a < 2; ++a)
#pragma unroll
        for (int b = 0; b < 2; ++b)
#pragma unroll
            for (int m = 0; m < 4; ++m)
#pragma unroll
                for (int n = 0; n < 2; ++n) acc[a][b][m][n] = (f32x4){0.f, 0.f, 0.f, 0.f};
    bf16x8 At[4][2], B0[2][2], B1[2][2];
    const char* cA = (const char*)g.A + (size_t)cur.pm * tstep; const char* cB = (const char*)g.Bt + (size_t)cur.pn * tstep;
    S.a_ready(cur);
    if constexpr (SP2) {
        PG8_STAGE(PG8_SB(0, 0), cB, voffB); PG8_STAGE(PG8_SB(0, 1), cB + hstep, voffB); PG8_STAGE(PG8_SA(0, 0), cA, voffA); PG8_STAGE(PG8_SA(0, 1), cA + hstep, voffA);
        if (wr == 1) PG8_BAR;
        PG8_WAIT_V(2); PG8_BAR;
        PG8_STAGE(PG8_SB(1, 0), cB + kstep, voffB); PG8_STAGE(PG8_SA(1, 0), cA + kstep, voffA); PG8_STAGE(PG8_SB(1, 1), cB + hstep + kstep, voffB);
        PG8_WAIT_V(6); PG8_BAR;
    } else {
        PG8_STAGE(PG8_SB(0, 0), cB, voffB); PG8_STAGE(PG8_SA(0, 0), cA, voffA); PG8_STAGE(PG8_SB(0, 1), cB + hstep, voffB); PG8_STAGE(PG8_SA(0, 1), cA + hstep, voffA);
        if (wr == 1) PG8_BAR;
        PG8_WAIT_V(4); PG8_BAR;
        PG8_STAGE(PG8_SB(1, 0), cB + kstep, voffB); PG8_STAGE(PG8_SA(1, 0), cA + kstep, voffA); PG8_STAGE(PG8_SB(1, 1), cB + hstep + kstep, voffB);
        PG8_WAIT_V(6); PG8_BAR;
    }
    for (;;) {
        const bool has_next = S.next(ui + 1, nxt);
        const char* nA = has_next ? (const char*)g.A + (size_t)nxt.pm * tstep : cA; const char* nB = has_next ? (const char*)g.Bt + (size_t)nxt.pn * tstep : cB;
        for (int t = 0; t < nt; t += 2) {
            const bool last = (t == nt - 2);
            const char* a1 = cA + (size_t)(t + 1) * kstep;
            const char* a2 = last ? nA : cA + (size_t)(t + 2) * kstep; const char* b2 = last ? nB : cB + (size_t)(t + 2) * kstep;
            const char* a3 = a2 + kstep; const char* b3 = b2 + kstep;
            if (last && has_next) S.a_ready(nxt);
            if constexpr (SP2) {
            PG8_LDB(B0, 0, 0); PG8_LDB(B1, 0, 1); PG8_SCHED; PG8_LDA(At, 0, 0); PG8_STAGE(PG8_SA(1, 1), a1 + hstep, voffA);
            PG8_WAIT_V(8); PG8_WAIT_L(0); PG8_BAR; PG8_MMA(0, 0, At, B0); PG8_MMA(0, 1, At, B1); PG8_BAR; PG8_SCHED;
            PG8_LDA(At, 0, 1); PG8_STAGE(PG8_SB(0, 0), b2, voffB); PG8_STAGE(PG8_SB(0, 1), b2 + hstep, voffB); PG8_STAGE(PG8_SA(0, 0), a2, voffA);
            PG8_WAIT_V(8); PG8_WAIT_L(0); PG8_BAR; PG8_MMA(1, 0, At, B0); PG8_MMA(1, 1, At, B1); PG8_BAR; PG8_SCHED;
            PG8_LDB(B0, 1, 0); PG8_LDB(B1, 1, 1); PG8_SCHED; PG8_LDA(At, 1, 0); PG8_STAGE(PG8_SA(0, 1), a2 + hstep, voffA);
            PG8_WAIT_V(8); PG8_WAIT_L(0); PG8_BAR; PG8_MMA(0, 0, At, B0); PG8_MMA(0, 1, At, B1); PG8_BAR; PG8_SCHED;
            PG8_LDA(At, 1, 1); PG8_STAGE(PG8_SB(1, 0), b3, voffB); PG8_STAGE(PG8_SB(1, 1), b3 + hstep, voffB); PG8_STAGE(PG8_SA(1, 0), a3, voffA);
            PG8_WAIT_V(8); PG8_WAIT_L(0); PG8_BAR; PG8_MMA(1, 0, At, B0); PG8_MMA(1, 1, At, B1); PG8_BAR; PG8_SCHED;
            } else {
            PG8_LDB(B0, 0, 0); PG8_SCHED; PG8_LDA(At, 0, 0); PG8_STAGE(PG8_SA(1, 1), a1 + hstep, voffA);
            PG8_WAIT_L(8); PG8_BAR; PG8_WAIT_L(0); PG8_MMA(0, 0, At, B0); PG8_BAR; PG8_SCHED;
            PG8_LDB(B1, 0, 1); PG8_STAGE(PG8_SB(0, 0), b2, voffB);
            PG8_BAR; PG8_WAIT_L(0); PG8_MMA(0, 1, At, B1); PG8_BAR;
            PG8_LDA(At, 0, 1); PG8_STAGE(PG8_SA(0, 0), a2, voffA);
            PG8_BAR; PG8_WAIT_L(0); PG8_MMA(1, 0, At, B0); PG8_BAR; PG8_SCHED;
            PG8_STAGE(PG8_SB(0, 1), b2 + hstep, voffB);
            PG8_WAIT_V(6); PG8_BAR; PG8_MMA(1, 1, At, B1); PG8_BAR;
            PG8_LDB(B0, 1, 0); PG8_SCHED; PG8_LDA(At, 1, 0); PG8_STAGE(PG8_SA(0, 1), a2 + hstep, voffA);
            PG8_WAIT_L(8); PG8_BAR; PG8_WAIT_L(0); PG8_MMA(0, 0, At, B0); PG8_BAR; PG8_SCHED;
            PG8_LDB(B1, 1, 1); PG8_STAGE(PG8_SB(1, 0), b3, voffB);
            PG8_BAR; PG8_WAIT_L(0); PG8_MMA(0, 1, At, B1); PG8_BAR;
            PG8_LDA(At, 1, 1); PG8_STAGE(PG8_SA(1, 0), a3, voffA);
            PG8_BAR; PG8_WAIT_L(0); PG8_MMA(1, 0, At, B0); PG8_BAR; PG8_SCHED;
            PG8_STAGE(PG8_SB(1, 1), b3 + hstep, voffB);
            PG8_WAIT_V(6); PG8_BAR; PG8_MMA(1, 1, At, B1); PG8_BAR;
            }
        }
        if constexpr (ALIGN_EPI) { if (wr == 0) PG8_BAR; }
        if constexpr (!Epi::AFTER_DRAIN) { E(acc, cur, wr, wc, fr, fq); S.done(cur); }
        if (!has_next) break;
#pragma unroll
        for (int a = 0; a < 2; ++a)
#pragma unroll
            for (int b = 0; b < 2; ++b)
#pragma unroll
                for (int m = 0; m < 4; ++m)
#pragma unroll
                    for (int n = 0; n < 2; ++n) acc[a][b][m][n] = (f32x4){0.f, 0.f, 0.f, 0.f};
        cur = nxt; cA = nA; cB = nB; ++ui;
        if constexpr (ALIGN_EPI) { if (wr == 1) PG8_BAR; }
    }
    PG8_WAIT_V(0);
    if constexpr (!ALIGN_EPI) { if (wr == 0) PG8_BAR; }
    PG8_BAR;
#undef PG8_SA
#undef PG8_SB
#undef PG8_STAGE
#undef PG8_LDA
#undef PG8_LDB
#undef PG8_MMA
#undef PG8_WAIT_V
#undef PG8_WAIT_L
#undef PG8_BAR
#undef PG8_SCHED
}
}

#define XB_TMO      128
#define XB_XCNT(j)  (256  + 64 * (j))
#define XB_XSUB(j)  (1280 + 64 * (j))
#define XB_XGEN(j)  (2304 + 64 * (j))
#define XB_TOP      3328
#define XB_TOPGEN   3392
#define XCD_BAR_WORDS 3456
#define XB_SPIN_CAP (1u << 18)
__device__ __forceinline__ unsigned xb_ld(unsigned* p)              { return __hip_atomic_load(p, __ATOMIC_RELAXED, __HIP_MEMORY_SCOPE_AGENT); }
__device__ __forceinline__ unsigned xb_add(unsigned* p, unsigned v) { return __hip_atomic_fetch_add(p, v, __ATOMIC_RELAXED, __HIP_MEMORY_SCOPE_AGENT); }
__device__ __forceinline__ unsigned xb_xcc_id() { return (unsigned)__builtin_amdgcn_s_getreg((3 << 11) | 20) & 0xFu; }
#define XB_SPIN(cond, bar) do { unsigned _sp = 0; while (cond) { __builtin_amdgcn_s_sleep(1); \
    if ((++_sp & 255u) == 0u) { if (xb_ld(&(bar)[XB_TMO])) break; if (_sp > XB_SPIN_CAP) { atomicAdd(&(bar)[XB_TMO], 1u); break; } } } } while (0)
struct XcdBarrier { unsigned* bar; unsigned x; volatile LAS unsigned* st; int wave; };
__device__ __forceinline__ XcdBarrier xcd_barrier_post(unsigned* bar, volatile LAS unsigned* st, int wave) {
    XcdBarrier b; b.bar = bar; b.x = xb_xcc_id(); b.st = st; b.wave = wave;
    if (wave == 0 && fresh_lane() == 0) (void)xb_add(&bar[XB_XCNT(b.x)], 1u);
    return b;
}
__device__ __forceinline__ void xcd_barrier_complete(unsigned* bar, unsigned x, unsigned& nloc, unsigned& nx) {
    const unsigned G = gridDim.x * gridDim.y * gridDim.z;
    unsigned sum, cnt, mine, sp = 0u;
    for (;;) {
        sum = 0u; cnt = 0u; mine = 0u;
#pragma unroll
        for (unsigned j = 0; j < 16; ++j) { const unsigned c = xb_ld(&bar[XB_XCNT(j)]); sum += c; cnt += (c > 0u) ? 1u : 0u; mine = (j == x) ? c : mine; }
        if (sum == G) break;
        __builtin_amdgcn_s_sleep(1);
        if ((++sp & 255u) == 0u) { if (xb_ld(&bar[XB_TMO])) break; if (sp > XB_SPIN_CAP) { atomicAdd(&bar[XB_TMO], 1u); break; } }
    }
    nloc = mine > 0u ? mine : 1u; nx = cnt > 0u ? cnt : 1u;
}
__device__ __forceinline__ void xcd_barrier(const XcdBarrier& b) {
    asm volatile("s_waitcnt vmcnt(0)" ::: "memory");
    __syncthreads();
    if (b.wave == 0 && fresh_lane() == 0) {
        unsigned* bar = b.bar;
        __builtin_amdgcn_s_waitcnt(0);
        unsigned nloc = b.st[0], nx = b.st[1];
        if (nloc == 0u) { xcd_barrier_complete(bar, b.x, nloc, nx); b.st[0] = nloc; b.st[1] = nx; }
        const unsigned old = xb_add(&bar[XB_XSUB(b.x)], 1u);
        const unsigned gen = old / nloc, target = (gen + 1u) * nx;
        if (old + 1u == (gen + 1u) * nloc) {
            __builtin_amdgcn_fence(__ATOMIC_RELEASE, "agent");
            asm volatile("s_waitcnt vmcnt(0)" ::: "memory");
            const unsigned og = xb_add(&bar[XB_TOP], 1u);
            if (og + 1u != target) XB_SPIN(xb_ld(&bar[XB_TOP]) < target, bar);
        } else {
            XB_SPIN(xb_ld(&bar[XB_TOP]) < target, bar);
        }
        __builtin_amdgcn_fence(__ATOMIC_ACQUIRE, "agent");
        asm volatile("s_waitcnt vmcnt(0)" ::: "memory");
    }
    __syncthreads();
}

__device__ __forceinline__ void p0_ada_item(const float* cvec, const float* w_ada, const float* b_ada, float* mod, LAS unsigned char* lds, int item, int tid, int wave, int lane) {
    LAS float* sc = (LAS float*)(lds + wave * 8192);
    LAS float* red = (LAS float*)(lds + 65536);
    const int k0 = wave * 256;
    { float cv[32];
#pragma unroll
      for (int j = 0; j < 32; ++j) { const int i = lane + 64 * j; cv[j] = cvec[(i & 7) * DM + k0 + (i >> 3)]; }
#pragma unroll
      for (int j = 0; j < 32; ++j) { const int i = lane + 64 * j; const float v = cv[j]; sc[(i >> 3) * 8 + (i & 7)] = v * __builtin_amdgcn_rcpf(1.f + __builtin_amdgcn_exp2f(-v * LOG2E)); } }
    LDS_WAIT();
    const int rg = lane >> 4, cq = lane & 15;
    float acc[8][4];
#pragma unroll
    for (int b = 0; b < 8; ++b)
#pragma unroll
        for (int i = 0; i < 4; ++i) acc[b][i] = 0.f;
    const float* wp = w_ada + (size_t)(k0 + rg) * MODW + item * 64 + 4 * cq;
#pragma unroll 32
    for (int it = 0; it < 64; ++it) {
        const f32x4 w4 = __builtin_nontemporal_load((const f32x4*)(wp + (size_t)it * 4 * MODW));
        const int kk = it * 4 + rg;
        const f32x4 s0 = *(const LAS f32x4*)(sc + kk * 8), s1 = *(const LAS f32x4*)(sc + kk * 8 + 4);
#pragma unroll
        for (int i = 0; i < 4; ++i) {
            acc[0][i] += s0[0] * w4[i]; acc[1][i] += s0[1] * w4[i]; acc[2][i] += s0[2] * w4[i]; acc[3][i] += s0[3] * w4[i];
            acc[4][i] += s1[0] * w4[i]; acc[5][i] += s1[1] * w4[i]; acc[6][i] += s1[2] * w4[i]; acc[7][i] += s1[3] * w4[i];
        }
    }
#pragma unroll
    for (int b = 0; b < 8; ++b)
#pragma unroll
        for (int i = 0; i < 4; ++i) acc[b][i] = xrow_sum(acc[b][i]);
    if (rg == 0) {
#pragma unroll
        for (int b = 0; b < 8; ++b)
#pragma unroll
            for (int i = 0; i < 4; ++i) red[(wave * 8 + b) * 64 + 4 * cq + i] = acc[b][i];
    }
    LDS_WAIT();
    __syncthreads();
    { const int b = tid >> 6, col = tid & 63; float s = b_ada[item * 64 + col];
#pragma unroll
      for (int w = 0; w < 8; ++w) s += red[(w * 8 + b) * 64 + col];
      mod[b * MODW + item * 64 + col] = s; }
    LDS_WAIT();
    __syncthreads();
}
__device__ __forceinline__ void p0_transpose_item(const float* W, int K, int N, bf16_t* WT, LAS float* scr, int item, int lane) {
    const int nblk = N / 32, kb = item / nblk, nb = item % nblk, k0 = 64 * kb, n0 = 32 * nb;
#pragma unroll 8
    for (int i = 0; i < 32; ++i) { const int kk = 2 * i + (lane >> 5); scr[kk * 33 + (lane & 31)] = W[(size_t)(k0 + kk) * N + n0 + (lane & 31)]; }
    LDS_WAIT(); asm volatile("" ::: "memory");
    const int c = lane & 7;
#pragma unroll
    for (int j = 0; j < 4; ++j) { const int n = (lane >> 3) + 8 * j; const LAS float* s = scr + (8 * c) * 33 + n;
        u32x4 o; o.x = cvtpk(s[0 * 33], s[1 * 33]); o.y = cvtpk(s[2 * 33], s[3 * 33]); o.z = cvtpk(s[4 * 33], s[5 * 33]); o.w = cvtpk(s[6 * 33], s[7 * 33]);
        *(u32x4*)(WT + (size_t)(n0 + n) * K + k0 + 8 * c) = o; }
    LDS_WAIT(); asm volatile("" ::: "memory");
}
__device__ __forceinline__ void p0_colmax_item(const float* W, int N, unsigned* cmax, int item, int lane) {
    const int nblk = N / 32, kb = item / nblk, nb = item % nblk, k0 = 64 * kb, n0 = 32 * nb;
    float am = 0.f;
#pragma unroll
    for (int i = 0; i < 32; ++i) am = fmaxf(am, fabsf(W[(size_t)(k0 + 2 * i + (lane >> 5)) * N + n0 + (lane & 31)]));
    am = fmaxf(am, __shfl_xor(am, 32));
    if (lane < 32) atomicMax(cmax + n0 + lane, __float_as_uint(am));
}
template <bool INTERLEAVE>
__device__ __forceinline__ void p1_transpose_i8_item(const float* W, int K, int N, unsigned char* WT, const unsigned* cmax, LAS float* scr, int item, int lane) {
    const int nblk = N / 32, kb = item / nblk, nb = item % nblk, k0 = 64 * kb, nd0 = 32 * nb;
    int n0 = nd0;
    if (INTERLEAVE && nd0 >= 2560) { const int t = (nd0 - 2560) >> 8, j = (nd0 - 2560) & 255; n0 = j < 128 ? 2560 + 128 * t + j : 3584 + 128 * t + (j - 128); }
    float wv[32];
#pragma unroll
    for (int i = 0; i < 32; ++i) wv[i] = __builtin_nontemporal_load(W + (size_t)(k0 + 2 * i + (lane >> 5)) * N + n0 + (lane & 31));
#pragma unroll
    for (int i = 0; i < 32; ++i) { const int kk = 2 * i + (lane >> 5); scr[kk * 33 + (lane & 31)] = wv[i]; }
    LDS_WAIT(); asm volatile("" ::: "memory");
    const int c4 = lane & 3;
#pragma unroll
    for (int j = 0; j < 2; ++j) { const int n = (lane >> 2) + 16 * j; const LAS float* s = scr + (16 * c4) * 33 + n;
        const float am = __uint_as_float(cmax[n0 + n]); const float inv = am > 0.f ? 127.0f / am : 0.f;
        u32x4 o;
#pragma unroll
        for (int w = 0; w < 4; ++w) o[w] = pack_i8x4((f32x4){s[(4 * w) * 33], s[(4 * w + 1) * 33], s[(4 * w + 2) * 33], s[(4 * w + 3) * 33]}, inv);
        *(u32x4*)(WT + (size_t)(nd0 + n) * K + k0 + 16 * c4) = o; }
    LDS_WAIT(); asm volatile("" ::: "memory");
}
__device__ __forceinline__ void p0_w2_item(const float* w_pq, const float* subkeys, bf16_t* W2, unsigned* cmax, int item, int lane) {
    const int blk = item >> 5, kq = (item >> 4) & 1, dch = item & 15, c = lane & 15, quad = lane >> 4;
    bf16x8 kf[4][4];
    { f32x4 sv[4][4][2];
#pragma unroll
      for (int kt = 0; kt < 4; ++kt) { const float* sp = subkeys + ((size_t)blk * 128 + (kq * 4 + kt) * 16 + c) * 128 + 8 * quad;
#pragma unroll
          for (int ks = 0; ks < 4; ++ks) { sv[kt][ks][0] = *(const f32x4*)(sp + ks * 32); sv[kt][ks][1] = *(const f32x4*)(sp + ks * 32 + 4); } }
#pragma unroll
      for (int kt = 0; kt < 4; ++kt)
#pragma unroll
          for (int ks = 0; ks < 4; ++ks) { const f32x4 a = sv[kt][ks][0], b = sv[kt][ks][1];
              u32x4 w; w.x = cvtpk(a[0], a[1]); w.y = cvtpk(a[2], a[3]); w.z = cvtpk(b[0], b[1]); w.w = cvtpk(b[2], b[3]); kf[kt][ks] = __builtin_bit_cast(bf16x8, w); } }
    float am[4] = {0.f, 0.f, 0.f, 0.f};
#pragma nounroll
    for (int dq = 0; dq < 2; ++dq) {
        f32x4 wv[4][4][2];
#pragma unroll
        for (int j = 0; j < 4; ++j) { const float* wp = w_pq + (size_t)(dch * 128 + (dq * 4 + j) * 16 + c) * DM + blk * 128 + 8 * quad;
#pragma unroll
            for (int ks = 0; ks < 4; ++ks) { wv[j][ks][0] = *(const f32x4*)(wp + ks * 32); wv[j][ks][1] = *(const f32x4*)(wp + ks * 32 + 4); } }
#pragma unroll
        for (int j = 0; j < 4; ++j) { const int d0 = dch * 128 + (dq * 4 + j) * 16;
            bf16x8 wb[4];
#pragma unroll
            for (int ks = 0; ks < 4; ++ks) { const f32x4 a = wv[j][ks][0], b = wv[j][ks][1];
                u32x4 w; w.x = cvtpk(a[0], a[1]); w.y = cvtpk(a[2], a[3]); w.z = cvtpk(b[0], b[1]); w.w = cvtpk(b[2], b[3]); wb[ks] = __builtin_bit_cast(bf16x8, w); }
#pragma unroll
            for (int kt = 0; kt < 4; ++kt) {
                f32x4 acc = (f32x4){0.f, 0.f, 0.f, 0.f};
#pragma unroll
                for (int ks = 0; ks < 4; ++ks) acc = __builtin_amdgcn_mfma_f32_16x16x32_bf16(wb[ks], kf[kt][ks], acc, 0, 0, 0);
                am[kt] = fmaxf(fmaxf(am[kt], fmaxf(fabsf(acc[0]), fabsf(acc[1]))), fmaxf(fabsf(acc[2]), fabsf(acc[3])));
                u32x2 o; o.x = cvtpk(acc[0], acc[1]); o.y = cvtpk(acc[2], acc[3]);
                *(u32x2*)(W2 + (size_t)(blk * 128 + (kq * 4 + kt) * 16 + c) * DM + d0 + 4 * quad) = o; } }
    }
#pragma unroll
    for (int kt = 0; kt < 4; ++kt) { const float a = xrow_max(am[kt]); if (quad == 0) atomicMax(cmax + blk * 128 + (kq * 4 + kt) * 16 + c, __float_as_uint(a)); }
}
__device__ __forceinline__ void p1_w2_row(const bf16_t* W2, unsigned char* WT, const unsigned* cmax, int n, int lane) {
    const float am = __uint_as_float(cmax[n]); const float inv = am > 0.f ? 127.0f / am : 0.f;
#pragma unroll
    for (int j = 0; j < 8; ++j) { const u32x2 v = *(const u32x2*)(W2 + (size_t)n * DM + 256 * j + 4 * lane);
        *(unsigned*)(WT + (size_t)n * DM + 256 * j + 4 * lane) = pack_i8x4((f32x4){bf_lo(v.x), bf_hi(v.x), bf_lo(v.y), bf_hi(v.y)}, inv); }
}
__device__ __forceinline__ void p0_cvt_item(const float* src, bf16_t* dst, size_t base, int lane) {
#pragma unroll
    for (int j = 0; j < 4; ++j) { const size_t o = base + (size_t)j * 512 + lane * 8;
        const f32x4 a = *(const f32x4*)(src + o), b = *(const f32x4*)(src + o + 4);
        u32x4 w; w.x = cvtpk(a[0], a[1]); w.y = cvtpk(a[2], a[3]); w.z = cvtpk(b[0], b[1]); w.w = cvtpk(b[2], b[3]);
        *(u32x4*)(dst + o) = w; }
}
__device__ __forceinline__ int vperm4(int grp) { return (grp & 7) * 16 + (grp >> 3) * 4; }
__device__ __forceinline__ size_t tab_off(int row, int col) { return ((size_t)(col >> 7) * PEER_N + row) * 128 + (col & 127); }
__device__ __forceinline__ void p0_fp8_item(const float* src, unsigned char* dst, size_t base, float scale, int lane) {
#pragma unroll
    for (int i = 0; i < 8; ++i) { const size_t o = base + (size_t)i * 256 + lane * 4; const f32x4 a = *(const f32x4*)(src + o);
        int p = 0; p = __builtin_amdgcn_cvt_pk_fp8_f32(a[0] * scale, a[1] * scale, p, false); p = __builtin_amdgcn_cvt_pk_fp8_f32(a[2] * scale, a[3] * scale, p, true);
        *(unsigned*)(dst + ((size_t)(2 * i + (lane >> 5)) * PEER_N + (base >> 11)) * 128 + vperm4(lane & 31)) = (unsigned)p; }
}
__device__ __forceinline__ void p0_i8_row(const float* src, unsigned char* dst, float* scale, int row, int lane) {
    const float* p = src + (size_t)row * DM + lane * 4;
    f32x4 v[8]; float am = 0.f;
#pragma unroll
    for (int i = 0; i < 8; ++i) { v[i] = *(const f32x4*)(p + i * 256); am = fmaxf(fmaxf(am, fmaxf(fabsf(v[i][0]), fabsf(v[i][1]))), fmaxf(fabsf(v[i][2]), fabsf(v[i][3]))); }
    am = wave_max(am);
    const float inv = am > 0.f ? 127.0f / am : 0.f;
#pragma unroll
    for (int i = 0; i < 8; ++i) *(unsigned*)(dst + tab_off(row, i * 256 + lane * 4)) = pack_i8x4(v[i], inv);
    if (lane == 0) scale[row] = am * (1.0f / 127.0f);
}
__device__ __forceinline__ void p0_tables8(const float* peer_u, const float* peer_v, unsigned char* UB, float* SU, unsigned char* VB, int gw, int ngw, int lane) {
#define P0_TAB_SRC(k) (((k) < 8 ? peer_u : peer_v) + (size_t)(gw + ((k) & 7) * ngw) * DM + lane * 4)
    f32x4 ra[8], rb[8], rc[8];
#pragma unroll
    for (int i = 0; i < 8; ++i) ra[i] = *(const f32x4*)(P0_TAB_SRC(0) + i * 256);
#pragma unroll
    for (int i = 0; i < 8; ++i) rb[i] = *(const f32x4*)(P0_TAB_SRC(1) + i * 256);
#pragma unroll
    for (int k = 0; k < 16; ++k) {
        const int row = gw + (k & 7) * ngw;
        f32x4 (&v)[8] = (k % 3 == 0) ? ra : (k % 3 == 1) ? rb : rc;
        f32x4 (&nn)[8] = (k % 3 == 0) ? rc : (k % 3 == 1) ? ra : rb;
        if (k < 14) {
#pragma unroll
            for (int i = 0; i < 8; ++i) nn[i] = *(const f32x4*)(P0_TAB_SRC(k + 2) + i * 256); }
        if (k < 8) {
            float am = 0.f;
#pragma unroll
            for (int i = 0; i < 8; ++i) am = fmaxf(fmaxf(am, fmaxf(fabsf(v[i][0]), fabsf(v[i][1]))), fmaxf(fabsf(v[i][2]), fabsf(v[i][3])));
            am = wave_max(am);
            const float inv = am > 0.f ? 127.0f / am : 0.f;
            unsigned char* q = UB + (size_t)(lane >> 5) * (PEER_N * 128) + (size_t)row * 128 + (lane & 31) * 4;
#pragma unroll
            for (int i = 0; i < 8; ++i) *(unsigned*)(q + (size_t)i * (2 * PEER_N * 128)) = pack_i8x4(v[i], inv);
            if (lane == 0) SU[row] = am * (1.0f / 127.0f);
        } else {
            unsigned char* q = VB + (size_t)(lane >> 5) * (PEER_N * 128) + (size_t)row * 128 + vperm4(lane & 31);
#pragma unroll
            for (int i = 0; i < 8; ++i) { int p = 0; p = __builtin_amdgcn_cvt_pk_fp8_f32(v[i][0] * V_SCALE, v[i][1] * V_SCALE, p, false); p = __builtin_amdgcn_cvt_pk_fp8_f32(v[i][2] * V_SCALE, v[i][3] * V_SCALE, p, true);
                *(unsigned*)(q + (size_t)i * (2 * PEER_N * 128)) = (unsigned)p; }
        }
    }
#undef P0_TAB_SRC
}
struct TabCtx { const float* src; unsigned char* dst; float* SU; int p; };
__device__ __forceinline__ void tab_row_load(const TabCtx& T, int k, f32x4 (&v)[8], int lane) {
    const float* np = T.src + (size_t)(T.p + 1024 * (k < 15 ? k : 15)) * DM + lane * 4;
#pragma unroll
    for (int i = 0; i < 8; ++i) v[i] = __builtin_nontemporal_load((const f32x4*)(np + i * 256));
}
template <bool ISV> __device__ __forceinline__ void tab_row_convert(const TabCtx& T, int k, const f32x4 (&v)[8], int lane) {
    const int row = T.p + 1024 * k;
    unsigned char* q = T.dst + (size_t)(lane >> 5) * (PEER_N * 128) + (size_t)row * 128 + (ISV ? vperm4(lane & 31) : (lane & 31) * 4);
    if (!ISV) {
        float am = 0.f;
#pragma unroll
        for (int i = 0; i < 8; ++i) am = fmaxf(fmaxf(am, fmaxf(fabsf(v[i][0]), fabsf(v[i][1]))), fmaxf(fabsf(v[i][2]), fabsf(v[i][3])));
        am = wave_max(am);
        const float inv = am > 0.f ? 127.0f / am : 0.f;
#pragma unroll
        for (int i = 0; i < 8; ++i) *(unsigned*)(q + (size_t)i * (2 * PEER_N * 128)) = pack_i8x4(v[i], inv);
        if (lane == 0) T.SU[row] = am * (1.0f / 127.0f);
    } else {
#pragma unroll
        for (int i = 0; i < 8; ++i) { int p = 0; p = __builtin_amdgcn_cvt_pk_fp8_f32(v[i][0] * V_SCALE, v[i][1] * V_SCALE, p, false); p = __builtin_amdgcn_cvt_pk_fp8_f32(v[i][2] * V_SCALE, v[i][3] * V_SCALE, p, true);
            *(unsigned*)(q + (size_t)i * (2 * PEER_N * 128)) = (unsigned)p; }
    }
}
__device__ __forceinline__ void p0_rope_item(float* rope, int item, int lane) {
    const int idx = item * 64 + lane, pos = idx >> 3, i = idx & 7;
    const double f = (i == 0) ? 0.15915494309189535 : (i == 1) ? 0.03086376340470123 : (i == 2) ? 0.005985185712713705 : (i == 3) ? 0.001160663641240061
                   : (i == 4) ? 0.00022507907903927653 : (i == 5) ? 4.364795279280289e-05 : (i == 6) ? 8.464330808241401e-06 : 1.6414262627950345e-06;
    const double rev = (double)pos * f; const double fr = rev - (double)(long long)rev;
    rope[idx] = __builtin_amdgcn_cosf((float)fr); rope[32768 + idx] = __builtin_amdgcn_sinf((float)fr);
}

__device__ __forceinline__ void norm_rows(const float* src, const float* gain, const float* mod, int off_shift, int off_scale, unsigned char* dst8, float* scale8, int gw, int ngw, int lane) {
    for (int grp = gw; grp < MTOK / 16; grp += ngw) {
        const int row0 = grp * 16; const float* mb = mod + (size_t)(row0 >> 12) * MODW;
        f32x4 A[8], B[8];
#pragma unroll
        for (int j = 0; j < 8; ++j) { const int c = 256 * j + 4 * lane; const f32x4 g = *(const f32x4*)(gain + c), sc = *(const f32x4*)(mb + off_scale + c); A[j] = g * (sc + 1.0f); B[j] = *(const f32x4*)(mb + off_shift + c); }
        f32x4 ra[8], rb[8], rc[8];
#pragma unroll
        for (int j = 0; j < 8; ++j) ra[j] = __builtin_nontemporal_load((const f32x4*)(src + (size_t)row0 * DM + 4 * lane + 256 * j));
#pragma unroll
        for (int j = 0; j < 8; ++j) rb[j] = __builtin_nontemporal_load((const f32x4*)(src + (size_t)(row0 + 1) * DM + 4 * lane + 256 * j));
#pragma unroll
        for (int r = 0; r < 16; ++r) {
            f32x4 (&cur)[8] = (r % 3 == 0) ? ra : (r % 3 == 1) ? rb : rc;
            f32x4 (&nn)[8] = (r % 3 == 0) ? rc : (r % 3 == 1) ? ra : rb;
            f32x4 v[8]; float ss = 0.f;
#pragma unroll
            for (int j = 0; j < 8; ++j) { v[j] = cur[j]; ss += (v[j][0] * v[j][0] + v[j][1] * v[j][1]) + (v[j][2] * v[j][2] + v[j][3] * v[j][3]); }
            if (r < 14) { const float* xn = src + (size_t)(row0 + r + 2) * DM + 4 * lane;
#pragma unroll
              for (int j = 0; j < 8; ++j) nn[j] = __builtin_nontemporal_load((const f32x4*)(xn + 256 * j)); }
            const float rstd = 1.0f / sqrtf(wave_sum(ss) * (1.0f / DM) + EPS);
            float am = 0.f;
#pragma unroll
            for (int j = 0; j < 8; ++j) { const f32x4 o = v[j] * rstd * A[j] + B[j]; v[j] = o; am = fmaxf(fmaxf(am, fmaxf(fabsf(o[0]), fabsf(o[1]))), fmaxf(fabsf(o[2]), fabsf(o[3]))); }
            am = wave_max(am); const float inv = am > 0.f ? 127.0f / am : 0.f;
            unsigned* q = (unsigned*)(dst8 + (size_t)(row0 + r) * DM + 4 * lane);
#pragma unroll
            for (int j = 0; j < 8; ++j) q[64 * j] = pack_i8x4(v[j], inv);
            if (lane == 0) scale8[row0 + r] = am * (1.0f / 127.0f);
        }
    }
}

__device__ __forceinline__ void norm_rows_bf16(const bf16_t* src, const float* gain, const float* mod, int off_shift, int off_scale, unsigned char* dst8, float* scale8, int gw, int ngw, int lane) {
    for (int grp = gw; grp < MTOK / 16; grp += ngw) {
        const int row0 = grp * 16; const float* mb = mod + (size_t)(row0 >> 12) * MODW;
        f32x4 A[8], B[8];
#pragma unroll
        for (int j = 0; j < 8; ++j) { const int c = 512 * (j >> 1) + 8 * lane + 4 * (j & 1); const f32x4 g = *(const f32x4*)(gain + c), sc = *(const f32x4*)(mb + off_scale + c); A[j] = g * (sc + 1.0f); B[j] = *(const f32x4*)(mb + off_shift + c); }
        u32x4 ra[4], rb[4], rc[4];
#pragma unroll
        for (int j = 0; j < 4; ++j) ra[j] = __builtin_nontemporal_load((const u32x4*)(src + (size_t)row0 * DM + 8 * lane + 512 * j));
#pragma unroll
        for (int j = 0; j < 4; ++j) rb[j] = __builtin_nontemporal_load((const u32x4*)(src + (size_t)(row0 + 1) * DM + 8 * lane + 512 * j));
#pragma unroll
        for (int r = 0; r < 16; ++r) {
            u32x4 (&cur)[4] = (r % 3 == 0) ? ra : (r % 3 == 1) ? rb : rc;
            u32x4 (&nn)[4] = (r % 3 == 0) ? rc : (r % 3 == 1) ? ra : rb;
            f32x4 v[8]; float ss = 0.f;
#pragma unroll
            for (int j = 0; j < 4; ++j) { const u32x4 t = cur[j]; v[2 * j] = (f32x4){bf_lo(t.x), bf_hi(t.x), bf_lo(t.y), bf_hi(t.y)}; v[2 * j + 1] = (f32x4){bf_lo(t.z), bf_hi(t.z), bf_lo(t.w), bf_hi(t.w)}; }
#pragma unroll
            for (int j = 0; j < 8; ++j) ss += (v[j][0] * v[j][0] + v[j][1] * v[j][1]) + (v[j][2] * v[j][2] + v[j][3] * v[j][3]);
            if (r < 14) { const bf16_t* xn = src + (size_t)(row0 + r + 2) * DM + 8 * lane;
#pragma unroll
              for (int j = 0; j < 4; ++j) nn[j] = __builtin_nontemporal_load((const u32x4*)(xn + 512 * j)); }
            const float rstd = __builtin_amdgcn_rsqf(wave_sum(ss) * (1.0f / DM) + EPS);
            float am = 0.f;
#pragma unroll
            for (int j = 0; j < 8; ++j) { const f32x4 o = v[j] * rstd * A[j] + B[j]; v[j] = o; am = fmaxf(fmaxf(am, fmaxf(fabsf(o[0]), fabsf(o[1]))), fmaxf(fabsf(o[2]), fabsf(o[3]))); }
            am = wave_max(am); const float inv = am > 0.f ? 127.0f / am : 0.f;
            unsigned char* q = dst8 + (size_t)(row0 + r) * DM + 8 * lane;
#pragma unroll
            for (int j = 0; j < 4; ++j) { u32x2 o; o.x = pack_i8x4(v[2 * j], inv); o.y = pack_i8x4(v[2 * j + 1], inv); *(u32x2*)(q + 512 * j) = o; }
            if (lane == 0) scale8[row0 + r] = am * (1.0f / 127.0f);
        }
    }
}

constexpr int KS_PITCH = 72;
constexpr int VT_PITCH = 264;
constexpr int LDS_KS = 0, LDS_VT = 256 * KS_PITCH * 2, LDS_RT = LDS_VT + 64 * VT_PITCH * 2;
constexpr int LDS_QS = LDS_RT + 8192, LDS_QS_HI = LDSCTL_OFF + 1024;
__device__ __forceinline__ int qstash_off(int wave) { return wave < 6 ? LDS_QS + wave * 8192 : LDS_QS_HI + (wave - 6) * 8192; }
static_assert(LDS_QS + 6 * 8192 <= LDSCTL_OFF && LDS_QS_HI + 2 * 8192 <= LDS_BYTES, "Q stash placement");
template <bool HOST, bool ISV>
__device__ __forceinline__ void attn_unit(int b, int hk, int n, const bf16_t* PROJ, const float* g_q, const float* g_k, const float* sinks, const float* g_oa, const float* rope, unsigned char* MIXED,
                                          LAS unsigned char* lds, int tid, int wave, int lane, const TabCtx& T, int tabk0, f32x4 (&tcur)[8], f32x4 (&tnx)[8]) {
    LAS bf16_t* Ks = (LAS bf16_t*)(lds + LDS_KS); LAS bf16_t* Vt = (LAS bf16_t*)(lds + LDS_VT); LAS float* RT = (LAS float*)(lds + LDS_RT);
    const size_t rowb = (size_t)b * SEQ;
    const int c = lane & 15, quad = lane >> 4, g = wave >> 1, hf = wave & 1, head = hk * 4 + g;
    const bf16_t* qsrc = PROJ + (rowb + n * 128 + hf * 64 + c) * INC + head * 64 + 8 * quad;
#pragma unroll
    for (int qt = 0; qt < 4; ++qt)
#pragma unroll
        for (int k = 0; k < 2; ++k)
            __builtin_amdgcn_global_load_lds((const unsigned*)(qsrc + (size_t)qt * 16 * INC + k * 32), (LAS unsigned*)(lds + qstash_off(wave) + (qt * 2 + k) * 1024), 16, 0, 2);
    u32x4 kr[2][2]; f32x4 kcs[2][4]; u32x4 vr[4];
    const int part = tid & 3;
#pragma unroll
    for (int it = 0; it < 2; ++it) {
        const int row = (tid + 512 * it) >> 2, pos = (n - 1) * 128 + row, posc = pos >= 0 ? pos : 0;
        const bf16_t* src = PROJ + (rowb + posc) * INC + COL_K + hk * 64 + 16 * part;
        kr[it][0] = *(const u32x4*)src; kr[it][1] = *(const u32x4*)(src + 8);
        const float* rp = rope + posc * 8;
        kcs[it][0] = *(const f32x4*)rp; kcs[it][1] = *(const f32x4*)(rp + 4); kcs[it][2] = *(const f32x4*)(rp + 32768); kcs[it][3] = *(const f32x4*)(rp + 32768 + 4);
    }
#pragma unroll
    for (int it = 0; it < 4; ++it) {
        const int task = tid + 512 * it, row = task & 255, ch = task >> 8, pos = (n - 1) * 128 + row, posc = pos >= 0 ? pos : 0;
        vr[it] = *(const u32x4*)(PROJ + (rowb + posc) * INC + COL_V + hk * 64 + 8 * ch);
    }
    const f32x4 rv = *(const f32x4*)(rope + ((tid & 3) >> 1) * 32768 + (size_t)(n * 128 + (tid >> 2)) * 8 + (tid & 1) * 4);
    f32x4 gk[4], gq[4], goa[4];
#pragma unroll
    for (int i = 0; i < 4; ++i) gk[i] = *(const f32x4*)(g_k + 16 * part + 4 * i);
    gq[0] = *(const f32x4*)(g_q + 8 * quad); gq[1] = *(const f32x4*)(g_q + 8 * quad + 4); gq[2] = *(const f32x4*)(g_q + 32 + 8 * quad); gq[3] = *(const f32x4*)(g_q + 32 + 8 * quad + 4);
#pragma unroll
    for (int dt = 0; dt < 4; ++dt) goa[dt] = *(const f32x4*)(g_oa + head * 64 + dt * 16 + 4 * quad);
    const float sinkv = sinks[head] * LOG2E;
    *(LAS f32x4*)(RT + (tid >> 2) * 16 + (tid & 3) * 4) = rv;
#pragma unroll
    for (int it = 0; it < 2; ++it) {
        const int row = (tid + 512 * it) >> 2; const bool valid = (n - 1) * 128 + row >= 0;
        const u32x4 r0 = kr[it][0], r1 = kr[it][1];
        float x[16];
#pragma unroll
        for (int i = 0; i < 4; ++i) { x[2 * i] = bf_lo(r0[i]); x[2 * i + 1] = bf_hi(r0[i]); x[8 + 2 * i] = bf_lo(r1[i]); x[8 + 2 * i + 1] = bf_hi(r1[i]); }
        float ss = 0.f;
#pragma unroll
        for (int i = 0; i < 16; ++i) ss += x[i] * x[i];
        ss = dpp_add<0xB1>(ss); ss = dpp_add<0x4E>(ss);
        const float rstd = 1.0f / sqrtf(ss * (1.0f / 64.0f) + EPS);
#pragma unroll
        for (int i = 0; i < 16; ++i) x[i] = x[i] * rstd * gk[i >> 2][i & 3];
#pragma unroll
        for (int i = 0; i < 8; ++i) { const float cs = kcs[it][i >> 2][i & 3], sn = kcs[it][2 + (i >> 2)][i & 3]; const float t1 = x[i], t2 = x[8 + i];
            x[i] = part == 0 ? t1 * cs - t2 * sn : t1; x[8 + i] = part == 0 ? t2 * cs + t1 * sn : t2; }
        u32x4 w0, w1;
#pragma unroll
        for (int i = 0; i < 4; ++i) { w0[i] = valid ? cvtpk(x[2 * i], x[2 * i + 1]) : 0u; w1[i] = valid ? cvtpk(x[8 + 2 * i], x[8 + 2 * i + 1]) : 0u; }
        LAS bf16_t* d = Ks + row * KS_PITCH + 16 * part;
        *(LAS u32x4*)d = w0; *(LAS u32x4*)(d + 8) = w1;
    }
#pragma unroll
    for (int it = 0; it < 4; ++it) {
        const int task = tid + 512 * it, row = task & 255, ch = task >> 8; const bool valid = (n - 1) * 128 + row >= 0;
        u32x4 r = vr[it];
        if (!valid) r = (u32x4){0u, 0u, 0u, 0u};
#pragma unroll
        for (int i = 0; i < 4; ++i) { Vt[(8 * ch + 2 * i) * VT_PITCH + row] = (bf16_t)(r[i] & 0xffffu); Vt[(8 * ch + 2 * i + 1) * VT_PITCH + row] = (bf16_t)(r[i] >> 16); }
    }
    VM_WAIT();
    LDS_WAIT();
    __syncthreads();
#pragma unroll
    for (int i = 0; i < 4; ++i) { gq[i] = gq[i] * (0.125f * LOG2E); asm volatile("" : "+v"(gq[i])); asm volatile("" : "+v"(goa[i])); }
    const int lq = 4 * quad - c;
    const LAS unsigned char* qstash = lds + qstash_off(wave) + lane * 16;
    for (int qt = 0; qt < 4; ++qt) {
        const int qi0 = hf * 64 + qt * 16, kt0 = (qi0 >> 4) & ~1, qi = qi0 + c, pos = n * 128 + qi;
        const size_t tq = rowb + pos;
        bf16x8 qf[2];
        {
            const u32x4 r0 = *(const LAS u32x4*)(qstash + qt * 2048), r1 = *(const LAS u32x4*)(qstash + qt * 2048 + 1024);
            float x0[8], x1[8];
#pragma unroll
            for (int i = 0; i < 4; ++i) { x0[2 * i] = bf_lo(r0[i]); x0[2 * i + 1] = bf_hi(r0[i]); x1[2 * i] = bf_lo(r1[i]); x1[2 * i + 1] = bf_hi(r1[i]); }
            float ss = 0.f;
#pragma unroll
            for (int i = 0; i < 8; ++i) ss += x0[i] * x0[i] + x1[i] * x1[i];
            ss = xrow_sum(ss);
            const float rstd = __builtin_amdgcn_rsqf(ss * (1.0f / 64.0f) + EPS);
#pragma unroll
            for (int i = 0; i < 8; ++i) { x0[i] = x0[i] * rstd * gq[i >> 2][i & 3]; x1[i] = x1[i] * rstd * gq[2 + (i >> 2)][i & 3]; }
            const LAS float* rt = RT + qi * 16;
            const f32x4 rc0 = *(const LAS f32x4*)rt, rc1 = *(const LAS f32x4*)(rt + 4), rs0 = *(const LAS f32x4*)(rt + 8), rs1 = *(const LAS f32x4*)(rt + 12);
#pragma unroll
            for (int i = 0; i < 8; ++i) {
                const float other = xrow16_other(x0[i], (quad & 1) != 0);
                const float cs = i < 4 ? rc0[i & 3] : rc1[i & 3], sn = i < 4 ? rs0[i & 3] : rs1[i & 3];
                const float rot = (quad == 0) ? (x0[i] * cs - other * sn) : (x0[i] * cs + other * sn);
                x0[i] = (quad < 2) ? rot : x0[i];
            }
            u32x4 w0, w1;
#pragma unroll
            for (int i = 0; i < 4; ++i) { w0[i] = cvtpk(x0[2 * i], x0[2 * i + 1]); w1[i] = cvtpk(x1[2 * i], x1[2 * i + 1]); }
            qf[0] = __builtin_bit_cast(bf16x8, w0); qf[1] = __builtin_bit_cast(bf16x8, w1);
        }
        f32x4 s[10];
#pragma unroll
        for (int t = 0; t < 10; ++t) {
            s[t] = (f32x4){0.f, 0.f, 0.f, 0.f};
            const LAS bf16_t* kp = Ks + ((kt0 + t) * 16 + c) * KS_PITCH + 8 * quad;
#pragma unroll
            for (int ks = 0; ks < 2; ++ks) { const bf16x8 kf = *(const LAS bf16x8*)(kp + ks * 32); s[t] = __builtin_amdgcn_mfma_f32_16x16x32_bf16(kf, qf[ks], s[t], 0, 0, 0); }
        }
        if (n == 0) {
#pragma unroll
            for (int t = 0; t < 10; ++t)
#pragma unroll
                for (int r = 0; r < 4; ++r) { const int kj = (kt0 + t) * 16 + 4 * quad + r; const bool ok = (kj >= qi + 1) && (kj <= qi + 128) && kj >= 128; s[t][r] = ok ? s[t][r] : -1e30f; }
        } else {
            const int L = kt0 * 16 - qi0 + lq;
#pragma unroll
            for (int t = 0; t < 2; ++t)
#pragma unroll
                for (int r = 0; r < 4; ++r) { s[t][r] = (L >= 1 - (16 * t + r)) ? s[t][r] : -1e30f; s[8 + t][r] = (L <= 128 - (16 * (8 + t) + r)) ? s[8 + t][r] : -1e30f; }
        }
        float m = sinkv;
#pragma unroll
        for (int t = 0; t < 10; ++t)
#pragma unroll
            for (int r = 0; r < 4; ++r) m = __builtin_amdgcn_fmed3f(m, s[t][r], __builtin_inff());
        m = xrow_max(m);
#pragma unroll
        for (int t = 0; t < 10; ++t)
#pragma unroll
            for (int r = 0; r < 4; ++r) s[t][r] = __builtin_amdgcn_exp2f(s[t][r] - m);
        bf16x8 pf[5];
#pragma unroll
        for (int i = 0; i < 5; ++i) { u32x4 w; w.x = cvtpk(s[2 * i][0], s[2 * i][1]); w.y = cvtpk(s[2 * i][2], s[2 * i][3]);
            w.z = cvtpk(s[2 * i + 1][0], s[2 * i + 1][1]); w.w = cvtpk(s[2 * i + 1][2], s[2 * i + 1][3]); pf[i] = __builtin_bit_cast(bf16x8, w); }
        f32x4 osum = (f32x4){0.f, 0.f, 0.f, 0.f};
        { const unsigned ow = (c & 3) == 0 ? 0x3F803F80u : 0u; const bf16x8 onesA = __builtin_bit_cast(bf16x8, (u32x4){ow, ow, ow, ow});
#pragma unroll
          for (int i = 0; i < 5; ++i) osum = __builtin_amdgcn_mfma_f32_16x16x32_bf16(onesA, pf[i], osum, 0, 0, 0); }
        const float inv = __builtin_amdgcn_rcpf(osum[0] + __builtin_amdgcn_exp2f(sinkv - m));
        f32x4 o[4]; float ss = 0.f;
#pragma unroll
        for (int dt = 0; dt < 4; ++dt) {
            o[dt] = (f32x4){0.f, 0.f, 0.f, 0.f};
            const LAS bf16_t* vp = Vt + (dt * 16 + c) * VT_PITCH + kt0 * 16 + 4 * quad;
#pragma unroll
            for (int i = 0; i < 5; ++i) { const u32x2 lo = *(const LAS u32x2*)(vp + i * 32), hi = *(const LAS u32x2*)(vp + i * 32 + 16);
                u32x4 w; w.x = lo.x; w.y = lo.y; w.z = hi.x; w.w = hi.y;
                o[dt] = __builtin_amdgcn_mfma_f32_16x16x32_bf16(__builtin_bit_cast(bf16x8, w), pf[i], o[dt], 0, 0, 0); }
            ss += (o[dt][0] * o[dt][0] + o[dt][1] * o[dt][1]) + (o[dt][2] * o[dt][2] + o[dt][3] * o[dt][3]);
        }
        ss = xrow_sum(ss);
        const float fac = inv * __builtin_amdgcn_rsqf(inv * inv * ss * (1.0f / 64.0f) + EPS) * MIX_SCALE;
        if (HOST) {
            tab_row_convert<ISV>(T, tabk0 + qt, tnx, lane);
            tab_row_load(T, tabk0 + qt + 1, tnx, lane);
        }
        unsigned char* orow = MIXED + tq * DM + head * 64 + 4 * quad;
#pragma unroll
        for (int dt = 0; dt < 4; ++dt) *(unsigned*)(orow + dt * 16) = pack_i8x4_sat(o[dt] * goa[dt], fac);
    }
    __syncthreads();
}
__device__ __forceinline__ void conv_item(int item, const bf16_t* PROJ, const float* conv_w, const float* g_oc, unsigned char* MIXED, int lane) {
    const int t0 = item * 16, ch = 16 * lane;
    float w0[16], w1[16], w2[16], gg[16], up2[16], up1[16];
#pragma unroll
    for (int i = 0; i < 16; ++i) { w0[i] = conv_w[ch + i]; w1[i] = conv_w[1024 + ch + i]; w2[i] = conv_w[2048 + ch + i]; gg[i] = g_oc[ch + i]; up2[i] = 0.f; up1[i] = 0.f; }
    if ((t0 & (SEQ - 1)) != 0) {
#pragma unroll
        for (int h = 0; h < 2; ++h) {
            const bf16_t* pr = PROJ + (size_t)(t0 - 2 + h) * INC + ch;
            const u32x4 c0 = __builtin_nontemporal_load((const u32x4*)(pr + COL_C)), c1 = __builtin_nontemporal_load((const u32x4*)(pr + COL_C + 8));
#pragma unroll
            for (int i = 0; i < 4; ++i) {
                const float u0 = bf_lo(c0[i]), u1 = bf_hi(c0[i]), u2 = bf_lo(c1[i]), u3 = bf_hi(c1[i]);
                if (h == 0) { up2[2 * i] = u0; up2[2 * i + 1] = u1; up2[8 + 2 * i] = u2; up2[8 + 2 * i + 1] = u3; }
                else        { up1[2 * i] = u0; up1[2 * i + 1] = u1; up1[8 + 2 * i] = u2; up1[8 + 2 * i + 1] = u3; }
            }
        }
    }
    u32x4 nb0, nb1, nc0, nc1;
    { const bf16_t* pr = PROJ + (size_t)t0 * INC + ch; nb0 = __builtin_nontemporal_load((const u32x4*)(pr + COL_B)); nb1 = __builtin_nontemporal_load((const u32x4*)(pr + COL_B + 8)); nc0 = __builtin_nontemporal_load((const u32x4*)(pr + COL_C)); nc1 = __builtin_nontemporal_load((const u32x4*)(pr + COL_C + 8)); }
#pragma unroll
    for (int r = 0; r < 16; ++r) {
        const u32x4 b0 = nb0, b1 = nb1, c0 = nc0, c1 = nc1;
        { const bf16_t* pr = PROJ + (size_t)(t0 + (r < 15 ? r + 1 : r)) * INC + ch; nb0 = __builtin_nontemporal_load((const u32x4*)(pr + COL_B)); nb1 = __builtin_nontemporal_load((const u32x4*)(pr + COL_B + 8)); nc0 = __builtin_nontemporal_load((const u32x4*)(pr + COL_C)); nc1 = __builtin_nontemporal_load((const u32x4*)(pr + COL_C + 8)); }
        float u[16], bg[16], y[16];
#pragma unroll
        for (int i = 0; i < 4; ++i) {
            u[2 * i] = bf_lo(c0[i]); u[2 * i + 1] = bf_hi(c0[i]); u[8 + 2 * i] = bf_lo(c1[i]); u[8 + 2 * i + 1] = bf_hi(c1[i]);
            bg[2 * i] = bf_lo(b0[i]); bg[2 * i + 1] = bf_hi(b0[i]); bg[8 + 2 * i] = bf_lo(b1[i]); bg[8 + 2 * i + 1] = bf_hi(b1[i]);
        }
        float ss = 0.f;
#pragma unroll
        for (int i = 0; i < 16; ++i) { y[i] = bg[i] * (w0[i] * up2[i] + w1[i] * up1[i] + w2[i] * u[i]); ss += y[i] * y[i]; up2[i] = up1[i]; up1[i] = u[i]; }
        ss += __shfl_xor(ss, 1); ss += __shfl_xor(ss, 2);
        const float rstd = 1.0f / sqrtf(ss * (1.0f / 64.0f) + EPS);
        u32x4 o0;
#pragma unroll
        for (int i = 0; i < 4; ++i) o0[i] = pack_i8x4_sat((f32x4){y[4 * i] * rstd * gg[4 * i], y[4 * i + 1] * rstd * gg[4 * i + 1], y[4 * i + 2] * rstd * gg[4 * i + 2], y[4 * i + 3] * rstd * gg[4 * i + 3]}, MIX_SCALE);
        *(u32x4*)(MIXED + (size_t)(t0 + r) * DM + 1024 + ch) = o0;
    }
}

__device__ __forceinline__ void ins16(float (&L)[16], float x) {
#pragma unroll
    for (int j = 0; j < 16; ++j) { const float hi = fmaxf(L[j], x); x = fminf(L[j], x); L[j] = hi; }
}
template <int C> __device__ __forceinline__ float pack7(float s, unsigned q32) { unsigned t; asm("v_and_b32 %0, 0xffffff80, %1\n\tv_or3_b32 %0, %0, %2, %3" : "=&v"(t) : "v"(s), "v"(q32), "n"(C)); return __uint_as_float(t); }
template <int C> __device__ __forceinline__ float pack8(float s) { unsigned t; asm("v_and_b32 %0, 0xffffff00, %1\n\tv_or_b32 %0, %2, %0" : "=&v"(t) : "v"(s), "n"(C)); return __uint_as_float(t); }
template <int KEY> __device__ __forceinline__ float pack_lo(unsigned u) { unsigned t; asm("v_lshlrev_b32 %0, 16, %1\n\tv_or_b32 %0, %2, %0" : "=&v"(t) : "v"(u), "n"(KEY)); return __uint_as_float(t); }
template <int KEY> __device__ __forceinline__ float pack_hi(unsigned u) { unsigned t; asm("v_and_b32 %0, 0xffff0000, %1\n\tv_or_b32 %0, %2, %0" : "=&v"(t) : "v"(u), "n"(KEY)); return __uint_as_float(t); }
__device__ __forceinline__ unsigned key_of(unsigned x) { return ((x >> 2) & 7u) * 16u + (x >> 5) * 4u + (x & 3u); }
#define CE_DESC(a, b) do { const float hi_ = fmaxf(a, b), lo_ = fminf(a, b); a = hi_; b = lo_; } while (0)
__device__ __forceinline__ void bitonic_tail16(float (&L)[16]) {
#pragma unroll
    for (int d = 8; d >= 1; d >>= 1)
#pragma unroll
        for (int i = 0; i < 16; ++i) if ((i & d) == 0) CE_DESC(L[i], L[i + d]);
}
__device__ __forceinline__ void sort16_desc(float (&L)[16]) {
#define SN(i, j) CE_DESC(L[i], L[j]);
    SN(0,13) SN(1,12) SN(2,15) SN(3,14) SN(4,8) SN(5,6) SN(7,11) SN(9,10)
    SN(0,5) SN(1,7) SN(2,9) SN(3,4) SN(6,13) SN(8,14) SN(10,15) SN(11,12)
    SN(0,1) SN(2,3) SN(4,5) SN(6,8) SN(7,9) SN(10,11) SN(12,13) SN(14,15)
    SN(0,2) SN(1,3) SN(4,10) SN(5,11) SN(6,7) SN(8,9) SN(12,14) SN(13,15)
    SN(1,2) SN(3,12) SN(4,6) SN(5,7) SN(8,10) SN(9,11) SN(13,14)
    SN(1,4) SN(2,6) SN(5,8) SN(7,10) SN(9,13) SN(11,14)
    SN(2,4) SN(3,6) SN(9,12) SN(11,13)
    SN(3,5) SN(6,8) SN(7,9) SN(10,12)
    SN(3,4) SN(5,6) SN(7,8) SN(9,10) SN(11,12)
    SN(6,7) SN(8,9)
#undef SN
}
__device__ __forceinline__ void top16_of_two(float (&A)[16], const float (&B)[16]) {
#pragma unroll
    for (int j = 0; j < 16; ++j) A[j] = fmaxf(A[j], B[15 - j]);
    bitonic_tail16(A);
}
__device__ __forceinline__ void merge16(float (&L)[16], int mask) {
    float P[16];
#pragma unroll
    for (int j = 0; j < 16; ++j) P[j] = __shfl_xor(L[j], mask);
    top16_of_two(L, P);
}
constexpr int SKT_OFF = 8192 + 512, SKT_PITCH = 272;
__device__ __forceinline__ void peer_chunk(int tokb, const bf16_t* QP, const bf16_t* SK, const unsigned char* H8, const float* SH, const unsigned char* UB, const float* SU, const unsigned char* VB, const float* mod, const bf16_t* X1B, float* out,
                                           LAS unsigned char* lds, int tid, int wave, int lane) {
    LAS unsigned char* wl = lds + wave * 16384;
    int tok0 = tokb + wave * 16;
    LAS bf16_t* eidx = (LAS bf16_t*)wl; LAS bf16_t* gate = (LAS bf16_t*)(wl + 4096); LAS float* accL = (LAS float*)(wl + 8192); LAS unsigned char* ids = wl + 8192;
#pragma nounroll
    for (int rep7a_ = 0; rep7a_ < REP7A; ++rep7a_) {
#pragma nounroll
    for (int i2 = 0; i2 < 2; ++i2) {
        const int p = tid + 512 * i2, tkn = p & 127, h = p >> 7;
        const u32x4* srow = (const u32x4*)QP + (size_t)(h * 32) * MTOK + tokb + tkn;
        float T0[16], T1[16];
#pragma unroll
        for (int hf = 0; hf < 2; ++hf) {
            float L[16], Bv[16];
#define PKC(ch, DST) { const u32x4 a_ = __builtin_nontemporal_load(srow + (size_t)(hf * 16 + 2 * (ch)) * MTOK), b_ = __builtin_nontemporal_load(srow + (size_t)(hf * 16 + 2 * (ch) + 1) * MTOK); \
                DST[0] = pack_lo<(ch) * 16 + 0>(a_.x); DST[1] = pack_hi<(ch) * 16 + 1>(a_.x); DST[2] = pack_lo<(ch) * 16 + 2>(a_.y); DST[3] = pack_hi<(ch) * 16 + 3>(a_.y); \
                DST[4] = pack_lo<(ch) * 16 + 4>(a_.z); DST[5] = pack_hi<(ch) * 16 + 5>(a_.z); DST[6] = pack_lo<(ch) * 16 + 6>(a_.w); DST[7] = pack_hi<(ch) * 16 + 7>(a_.w); \
                DST[8] = pack_lo<(ch) * 16 + 8>(b_.x); DST[9] = pack_hi<(ch) * 16 + 9>(b_.x); DST[10] = pack_lo<(ch) * 16 + 10>(b_.y); DST[11] = pack_hi<(ch) * 16 + 11>(b_.y); \
                DST[12] = pack_lo<(ch) * 16 + 12>(b_.z); DST[13] = pack_hi<(ch) * 16 + 13>(b_.z); DST[14] = pack_lo<(ch) * 16 + 14>(b_.w); DST[15] = pack_hi<(ch) * 16 + 15>(b_.w); }
            PKC(0, L) sort16_desc(L);
            PKC(1, Bv) sort16_desc(Bv); top16_of_two(L, Bv);
            PKC(2, Bv) sort16_desc(Bv); top16_of_two(L, Bv);
            PKC(3, Bv) sort16_desc(Bv); top16_of_two(L, Bv);
            PKC(4, Bv) sort16_desc(Bv); top16_of_two(L, Bv);
            PKC(5, Bv) sort16_desc(Bv); top16_of_two(L, Bv);
            PKC(6, Bv) sort16_desc(Bv); top16_of_two(L, Bv);
            PKC(7, Bv) sort16_desc(Bv); top16_of_two(L, Bv);
#undef PKC
#pragma unroll
            for (int j = 0; j < 16; ++j) { if (hf == 0) T0[j] = L[j]; else T1[j] = L[j]; }
        }
        float R[16], Bc[16], Cc[16];
#define CAND(i, j) pack8<(i) * 16 + (j)>(T0[i] + T1[j])
#pragma unroll
        for (int j = 0; j < 16; ++j) R[j] = __uint_as_float((__float_as_uint(T0[0] + T1[j]) & 0xFFFFFF00u) | (unsigned)j);
        Bc[0] = CAND(1, 0); Bc[1] = CAND(1, 1); Bc[2] = CAND(1, 2); Bc[3] = CAND(1, 3); Bc[4] = CAND(1, 4); Bc[5] = CAND(1, 5); Bc[6] = CAND(1, 6); Bc[7] = CAND(1, 7);
        Bc[8] = CAND(2, 0); Bc[9] = CAND(2, 1); Bc[10] = CAND(2, 2); Bc[11] = CAND(2, 3); Bc[12] = CAND(2, 4); Bc[13] = CAND(3, 0); Bc[14] = CAND(3, 1); Bc[15] = CAND(3, 2);
        Cc[0] = CAND(3, 3); Cc[1] = CAND(4, 0); Cc[2] = CAND(4, 1); Cc[3] = CAND(4, 2); Cc[4] = CAND(5, 0); Cc[5] = CAND(5, 1); Cc[6] = CAND(6, 0); Cc[7] = CAND(6, 1);
        Cc[8] = CAND(7, 0); Cc[9] = CAND(7, 1); Cc[10] = CAND(8, 0); Cc[11] = CAND(9, 0); Cc[12] = CAND(10, 0); Cc[13] = CAND(11, 0); Cc[14] = CAND(12, 0); Cc[15] = CAND(13, 0);
        sort16_desc(Bc); sort16_desc(Cc); top16_of_two(R, Bc); top16_of_two(R, Cc);
        ins16(R, CAND(14, 0)); ins16(R, CAND(15, 0));
#undef CAND
        {
            LAS unsigned char* idb = lds + wave * 16384 + 8192 + lane * 32;
            u32x4 i0, i1;
#pragma unroll
            for (int w = 0; w < 4; ++w) {
                i0[w] = (__float_as_uint(T0[4 * w]) & 0x7Fu) | ((__float_as_uint(T0[4 * w + 1]) & 0x7Fu) << 8) | ((__float_as_uint(T0[4 * w + 2]) & 0x7Fu) << 16) | ((__float_as_uint(T0[4 * w + 3]) & 0x7Fu) << 24);
                i1[w] = (__float_as_uint(T1[4 * w]) & 0x7Fu) | ((__float_as_uint(T1[4 * w + 1]) & 0x7Fu) << 8) | ((__float_as_uint(T1[4 * w + 2]) & 0x7Fu) << 16) | ((__float_as_uint(T1[4 * w + 3]) & 0x7Fu) << 24); }
            *(LAS u32x4*)idb = i0; *(LAS u32x4*)(idb + 16) = i1;
            float e[16], sum = 0.f;
#pragma unroll
            for (int k = 0; k < 16; ++k) { e[k] = __builtin_amdgcn_exp2f((R[k] - R[0]) * LOG2E); sum += e[k]; }
            const float inv = 1.0f / sum;
            LDS_WAIT(); asm volatile("" ::: "memory");
            unsigned ex[16];
#pragma unroll
            for (int k = 0; k < 16; ++k) { const unsigned code = __float_as_uint(R[k]) & 0xFFu; ex[k] = (unsigned)idb[code >> 4] * 128u + (unsigned)idb[16 + (code & 15u)]; }
            LAS unsigned char* tb = lds + (tkn >> 4) * 16384 + ((tkn & 15) * 128 + h * 16) * 2;
            u32x4 ea, eb, ga, gb;
#pragma unroll
            for (int w = 0; w < 4; ++w) { ea[w] = ex[2 * w] | (ex[2 * w + 1] << 16); eb[w] = ex[8 + 2 * w] | (ex[8 + 2 * w + 1] << 16);
                ga[w] = cvtpk(e[2 * w] * inv, e[2 * w + 1] * inv); gb[w] = cvtpk(e[8 + 2 * w] * inv, e[8 + 2 * w + 1] * inv); }
            *(LAS u32x4*)tb = ea; *(LAS u32x4*)(tb + 16) = eb; *(LAS u32x4*)(tb + 4096) = ga; *(LAS u32x4*)(tb + 4096 + 16) = gb;
        }
    }
    LDS_WAIT();
    __syncthreads();
    }
    LDS_WAIT(); asm volatile("" ::: "memory");
    int lane_b = lane; asm volatile("" : "+v"(lane_b));
    const int g = lane_b >> 3, k = lane_b & 7; const unsigned k16 = (unsigned)k * 16u;
    LAS int* accI = (LAS int*)accL;
#pragma nounroll
    for (int rep7u_ = 0; rep7u_ < REP7U; ++rep7u_) {
    LDS_WAIT(); asm volatile("" ::: "memory");
    for (int i = lane_b; i < 2048; i += 64) accI[i] = 0;
    LDS_WAIT(); asm volatile("" ::: "memory");
    asm volatile("" : "+s"(tok0));
    const unsigned char* hbase = H8 + (size_t)(tok0 + g) * DM + k * 16;
    u32x4 hn = __builtin_nontemporal_load((const u32x4*)hbase);
    for (int s = 0; s < 16; ++s) {
        const unsigned char* Us = UB + (size_t)s * (PEER_N * 128);
#pragma unroll
        for (int r = 0; r < 2; ++r) {
            const int tl = r * 8 + g;
            const u32x4 hq = hn;
            { const int sn = r ? s + 1 : s, rn = r ^ 1; if (sn < 16) hn = __builtin_nontemporal_load((const u32x4*)(hbase + (size_t)rn * 8 * DM + sn * 128)); }
            const LAS bf16_t* ei = eidx + tl * 128;
            LAS int* ap = accI + tl * 128 + k;
#pragma nounroll
            for (int ib2 = 0; ib2 < 16; ++ib2) {
                u32x4 uv[8];
#pragma unroll
                for (int q = 0; q < 8; ++q) { const unsigned e = ei[ib2 * 8 + q]; uv[q] = *(const u32x4*)(Us + (size_t)(unsigned)((e << 7) + k16)); }
                {
                    int p[8];
#pragma unroll
                    for (int ii = 0; ii < 8; ++ii) { const u32x4 v = uv[ii];
                        p[ii] = __builtin_amdgcn_sdot4((int)v.x, (int)hq.x, __builtin_amdgcn_sdot4((int)v.y, (int)hq.y, __builtin_amdgcn_sdot4((int)v.z, (int)hq.z, __builtin_amdgcn_sdot4((int)v.w, (int)hq.w, 0, false), false), false), false); }
                    int a4[4], a2[2];
#pragma unroll
                    for (int j = 0; j < 4; ++j) { const int send = (k & 4) ? p[j] : p[j + 4], keep = (k & 4) ? p[j + 4] : p[j]; a4[j] = keep + dpp_movi<0x141>(send); }
#pragma unroll
                    for (int j = 0; j < 2; ++j) { const int send = (k & 2) ? a4[j] : a4[j + 2], keep = (k & 2) ? a4[j + 2] : a4[j]; a2[j] = keep + dpp_movi<0x1B>(send); }
                    const int send = (k & 1) ? a2[0] : a2[1], keep = (k & 1) ? a2[1] : a2[0];
                    const int tot = keep + dpp_movi<0xB1>(send);
                    __hip_atomic_fetch_add(ap + ib2 * 8, tot, __ATOMIC_RELAXED, __HIP_MEMORY_SCOPE_WORKGROUP);
                }
            }
        }
    }
    }
    LDS_WAIT(); asm volatile("" ::: "memory");
    LAS bf16_t* wgt = gate;
    for (int i = lane_b; i < 2048; i += 64) {
        const float a = (float)accI[i] * SU[eidx[i]] * SH[tok0 + (i >> 7)];
        const float ge = 0.5f * a * (1.0f + erff(a * 0.70710678118654752f));
        wgt[i] = (bf16_t)(cvtpk(bf_lo((unsigned)gate[i]) * ge * (1.0f / V_SCALE), 0.f) & 0xffffu);
    }
    LDS_WAIT(); asm volatile("" ::: "memory");
    const float* g2 = mod + (size_t)(tok0 >> 12) * MODW + 5 * DM;
    { const int lv0 = fresh_lane();
#pragma unroll
      for (int j = 0; j < 8; ++j) { const f32x4 gg = *(const f32x4*)(g2 + 256 * j + 4 * lv0); *(LAS f32x4*)(accL + 256 * j + 4 * lv0) = gg; } }
    LDS_WAIT(); asm volatile("" ::: "memory");
    const int lane_v = fresh_lane(); const int gv_ = lane_v >> 3, kv_ = lane_v & 7; const unsigned k16v = (unsigned)kv_ * 16u;
#pragma nounroll
    for (int rep7v_ = 0; rep7v_ < REP7V; ++rep7v_)
    for (int s = 0; s < 16; ++s) {
        const unsigned char* Vs = VB + (size_t)s * (PEER_N * 128);
#pragma nounroll
        for (int r = 0; r < 2; ++r) {
            const int tl = r * 8 + gv_;
            float* orow = out + (size_t)(tok0 + tl) * DM + s * 128 + 4 * kv_;
            const bf16_t* xrow = X1B + (size_t)(tok0 + tl) * DM + s * 128 + 4 * kv_;
            u32x2 xq[4];
#pragma unroll
            for (int q = 0; q < 4; ++q) xq[q] = __builtin_nontemporal_load((const u32x2*)(xrow + 32 * q));
            const LAS bf16_t* ei = eidx + tl * 128; const LAS bf16_t* wi = wgt + tl * 128;
            float y[16];
#pragma unroll
            for (int i = 0; i < 16; ++i) y[i] = 0.f;
#define V_LOAD(buf, B) { _Pragma("unroll") for (int q = 0; q < 8; ++q) { const unsigned e = ei[(B) * 8 + q]; buf[q] = *(const u32x4*)(Vs + (size_t)(unsigned)((e << 7) + k16v)); } asm volatile("" ::: "memory"); }
#define V_COMP(buf, B) { _Pragma("unroll") for (int q = 0; q < 8; ++q) { const float wf = bf_lo((unsigned)wi[(B) * 8 + q]); const u32x4 vv = buf[q]; \
                _Pragma("unroll") for (int w = 0; w < 4; ++w) { const f32x2 f01 = __builtin_amdgcn_cvt_pk_f32_fp8(vv[w], false), f23 = __builtin_amdgcn_cvt_pk_f32_fp8(vv[w], true); \
                    y[4 * w] = fmaf(wf, f01.x, y[4 * w]); y[4 * w + 1] = fmaf(wf, f01.y, y[4 * w + 1]); y[4 * w + 2] = fmaf(wf, f23.x, y[4 * w + 2]); y[4 * w + 3] = fmaf(wf, f23.y, y[4 * w + 3]); } } asm volatile("" ::: "memory"); }
            u32x4 va[8], vb[8];
            V_LOAD(va, 0)
#pragma nounroll
            for (int j = 0; j < 7; ++j) { V_LOAD(vb, 2 * j + 1) V_COMP(va, 2 * j) V_LOAD(va, 2 * j + 2) V_COMP(vb, 2 * j + 1) }
            V_LOAD(vb, 15) V_COMP(va, 14) V_COMP(vb, 15)
#undef V_LOAD
#undef V_COMP
#pragma unroll
            for (int q = 0; q < 4; ++q) { f32x4 o; const f32x4 gv = *(const LAS f32x4*)(accL + s * 128 + 32 * q + 4 * kv_);
                const unsigned xlo = xq[q].x, xhi = xq[q].y;
                const float x1v[4] = {bf_lo(xlo), bf_hi(xlo), bf_lo(xhi), bf_hi(xhi)};
#pragma unroll
                for (int i = 0; i < 4; ++i) o[i] = x1v[i] + gv[i] * y[4 * q + i];
                if (rep7v_ == REP7V - 1) __builtin_nontemporal_store(o, (f32x4*)(orow + 32 * q)); else asm volatile("" :: "v"(o)); }
        }
    }
}

constexpr int N_PHASES = 8;
struct Args { const float* in[18]; float* out; unsigned char* ws; int ph_lo, ph_hi; };
__global__ void __launch_bounds__(NWAVES * 64, 2) hymba_fwd(Args args) {
    extern __shared__ __attribute__((aligned(16))) unsigned char lds_raw[];
    LAS unsigned char* lds = (LAS unsigned char*)lds_raw;
    volatile LAS unsigned* MISC = (volatile LAS unsigned*)(lds + MISC_OFF);
    const int wave = __builtin_amdgcn_readfirstlane((int)threadIdx.x >> 6);
    const int G = gridDim.x, bx = blockIdx.x;
    const int gw = bx * NWAVES + wave, NGW = G * NWAVES;
#define FRESH_IDS() const int lane = fresh_lane(); const int tid = wave * 64 + lane; (void)tid
    unsigned char* ws = args.ws;
    const float* x = args.in[0]; const float* cvec = args.in[1]; const float* w_ada = args.in[2]; const float* b_ada = args.in[3]; const float* g_norm1 = args.in[4];
    const float* w_in = args.in[5]; const float* g_q = args.in[6]; const float* g_k = args.in[7]; const float* sinks = args.in[8]; const float* conv_w = args.in[9];
    const float* g_oa = args.in[10]; const float* g_oc = args.in[11]; const float* w_out = args.in[12]; const float* g_norm2 = args.in[13]; const float* w_pq = args.in[14];
    const float* subkeys = args.in[15]; const float* peer_u = args.in[16]; const float* peer_v = args.in[17];
    float* out = args.out;
    float* mod = (float*)(ws + WS_MOD); float* rope = (float*)(ws + WS_ROPE);
    bf16_t* SK = (bf16_t*)(ws + WS_SK); bf16_t* WIN = (bf16_t*)(ws + WS_WIN); bf16_t* WOUT = (bf16_t*)(ws + WS_WOUT); bf16_t* WPQ = (bf16_t*)(ws + WS_WPQ);
    unsigned char* UB = ws + WS_UB; unsigned char* VB = ws + WS_VB; unsigned char* H8 = ws + WS_H8; float* SU = (float*)(ws + WS_SU); float* SH = (float*)(ws + WS_SH); bf16_t* XN = (bf16_t*)(ws + WS_XN); bf16_t* PROJ = (bf16_t*)(ws + WS_PROJ);
    bf16_t* QP = (bf16_t*)(ws + WS_QP); bf16_t* X1B = (bf16_t*)(ws + WS_X1B); unsigned char* MIXED = ws + WS_MIXED; unsigned char* XN8 = ws + WS_XN; float* SX1 = (float*)(ws + WS_SX1); bf16_t* W2 = (bf16_t*)(ws + WS_XN + 64 * MiB);
    unsigned* ctl = (unsigned*)(ws + WS_CTL);

    { FRESH_IDS(); for (int u = tid; u < (LDS_BYTES - LDSCTL_OFF) / 4; u += NWAVES * 64) ((LAS unsigned*)(lds + LDSCTL_OFF))[u] = 0u; }
    __syncthreads();
    XcdBarrier bar; bar.bar = ctl + CW_BAR; bar.x = 0; bar.st = nullptr; bar.wave = wave;
    if (MK_N_LAUNCHES == 1) bar = xcd_barrier_post(ctl + CW_BAR, MISC + 8, wave);
    const int lo = args.ph_lo, hi = args.ph_hi;
#define IN(k) (lo <= (k) && (k) < hi)
#define SEAM(k) do { if (IN(k) && IN((k) + 1)) xcd_barrier(bar); } while (0)

#pragma nounroll
    for (int rep_ = 0; rep_ < REP0; ++rep_) { if (rep_) xcd_barrier(bar);
    if (IN(0)) { FRESH_IDS();
#pragma nounroll
        for (int ra_ = 0; ra_ < REP0A; ++ra_)
        for (int it = bx; it < MODW / 64; it += G) p0_ada_item(cvec, w_ada, b_ada, mod, lds, it, tid, wave, lane);
        LAS float* scr = (LAS float*)(lds + wave * 16384);
        constexpr int I_IN = (DM / 64) * (INC / 32), I_SQ = (DM / 64) * (DM / 32), I_TAB = PEER_N * DM / 2048, I_W2 = 512, I_ROPE = 512;
        (void)scr;
        { const int nfree = G > MODW / 64 ? (G - MODW / 64) * NWAVES : 0;
          if (nfree > 0) { if (bx >= MODW / 64) for (int r = (bx - MODW / 64) * NWAVES + wave; r < I_W2; r += nfree) p0_w2_item(w_pq, subkeys, W2, ctl + CW_CMX_PQ, r, lane); }
          else for (int r = gw; r < I_W2; r += NGW) p0_w2_item(w_pq, subkeys, W2, ctl + CW_CMX_PQ, r, lane); }
#pragma nounroll
        for (int rc_ = 0; rc_ < REP0C; ++rc_)
        for (int r = gw; r < I_IN + I_SQ; r += NGW) { if (r < I_IN) p0_colmax_item(w_in, INC, ctl + CW_CMX_IN, r, lane); else p0_colmax_item(w_out, DM, ctl + CW_CMX_OUT, r - I_IN, lane); }
        for (int r = gw; r < I_ROPE; r += NGW) p0_rope_item(rope, r, lane);
        if (G == 256) {   }
        else if (NGW * 8 == I_TAB) p0_tables8(peer_u, peer_v, UB, SU, VB, gw, NGW, lane);
        else for (int r = gw; r < 2 * I_TAB; r += NGW) { if (r < I_TAB) p0_i8_row(peer_u, UB, SU, r, lane); else p0_fp8_item(peer_v, VB, (size_t)(r - I_TAB) * 2048, V_SCALE, lane); }
    }
    }
    SEAM(0);
#pragma nounroll
    for (int rep_ = 0; rep_ < REP1; ++rep_) { if (rep_) xcd_barrier(bar);
    if (IN(1)) { FRESH_IDS(); norm_rows(x, g_norm1, mod, 0 * DM, 1 * DM, XN8, SX1, gw, NGW, lane);
        LAS float* scr = (LAS float*)(lds + wave * 16384);
        constexpr int I_IN = (DM / 64) * (INC / 32), I_SQ = (DM / 64) * (DM / 32);
        for (int it = gw; it < I_IN + I_SQ + DM; it += NGW) {
            int r = it;
            if (r < I_IN) { p1_transpose_i8_item<true>(w_in, DM, INC, (unsigned char*)WIN, ctl + CW_CMX_IN, scr, r, lane); continue; } r -= I_IN;
            if (r < I_SQ) { p1_transpose_i8_item<false>(w_out, DM, DM, (unsigned char*)WOUT, ctl + CW_CMX_OUT, scr, r, lane); continue; } r -= I_SQ;
            p1_w2_row(W2, (unsigned char*)WPQ, ctl + CW_CMX_PQ, r, lane);
        }
    }
    }
    SEAM(1);
#if REP2 > 1
    if (IN(2)) {
        pg8::Gemm g{(const bf16_t*)XN8, (const bf16_t*)WIN, MTOK, INC, DM / 2}; pg8::StaticOrder S; S.init(MTOK, INC, G, bx);
        pg8::EpiProjI8 E{PROJ, INC, SX1, ctl + CW_CMX_IN};
        pg8::gemm_phase<pg8::EpiProjI8, pg8::StaticOrder, true, true, true>(lds, g, S, E, wave);
    }
    xcd_barrier(bar);
#endif
    if (IN(2)) {
        pg8::Gemm g{(const bf16_t*)XN8, (const bf16_t*)WIN, MTOK, INC, DM / 2}; pg8::StaticOrder S; S.init(MTOK, INC, G, bx);
        pg8::EpiProjI8 E{PROJ, INC, SX1, ctl + CW_CMX_IN};
        pg8::gemm_phase<pg8::EpiProjI8, pg8::StaticOrder, true, true, true>(lds, g, S, E, wave);
    }
    SEAM(2);
#pragma nounroll
    for (int rep_ = 0; rep_ < REP3; ++rep_) { if (rep_) xcd_barrier(bar);
    if (IN(3)) { FRESH_IDS();
#ifndef REP3A
#define REP3A 1
#endif
#pragma nounroll
        for (int ra_ = 0; ra_ < REP3A; ++ra_)
        { f32x4 tcur[8], tnx[8];
          if (G != 256) {
              const TabCtx T{peer_u, UB, SU, 0};
              for (int u = bx; u < BATCH * 4 * 32; u += G) attn_unit<false, false>(u >> 7, (u >> 5) & 3, u & 31, PROJ, g_q, g_k, sinks, g_oa, rope, MIXED, lds, tid, wave, lane, T, 0, tcur, tnx);
          } else if (wave & 1) {
              const TabCtx T{peer_v, VB, SU, gw >> 1};
              tab_row_load(T, 0, tnx, lane);
              int ui = 0;
              for (int u = bx; u < BATCH * 4 * 32; u += G, ++ui) attn_unit<true, true>(u >> 7, (u >> 5) & 3, u & 31, PROJ, g_q, g_k, sinks, g_oa, rope, MIXED, lds, tid, wave, lane, T, ui * 4, tcur, tnx);
          } else {
              const TabCtx T{peer_u, UB, SU, gw >> 1};
              tab_row_load(T, 0, tnx, lane);
              int ui = 0;
              for (int u = bx; u < BATCH * 4 * 32; u += G, ++ui) attn_unit<true, false>(u >> 7, (u >> 5) & 3, u & 31, PROJ, g_q, g_k, sinks, g_oa, rope, MIXED, lds, tid, wave, lane, T, ui * 4, tcur, tnx);
          } }
        for (int it = gw; it < MTOK / 16; it += NGW) conv_item(it, PROJ, conv_w, g_oc, MIXED, lane);
    }
    }
    SEAM(3);
#if REP4 > 1
    if (IN(4)) {
        pg8::Gemm g{(const bf16_t*)MIXED, (const bf16_t*)WOUT, MTOK, DM, DM / 2}; pg8::StaticOrder S; S.init(MTOK, DM, G, bx);
        pg8::EpiResGateBf16I8 E{x, X1B, DM, mod + 2 * DM, MODW, 1.0f / MIX_SCALE, ctl + CW_CMX_OUT};
        pg8::gemm_phase<pg8::EpiResGateBf16I8, pg8::StaticOrder, true, true, true>(lds, g, S, E, wave);
    }
    xcd_barrier(bar);
#endif
    if (IN(4)) {
        pg8::Gemm g{(const bf16_t*)MIXED, (const bf16_t*)WOUT, MTOK, DM, DM / 2}; pg8::StaticOrder S; S.init(MTOK, DM, G, bx);
        pg8::EpiResGateBf16I8 E{x, X1B, DM, mod + 2 * DM, MODW, 1.0f / MIX_SCALE, ctl + CW_CMX_OUT};
        pg8::gemm_phase<pg8::EpiResGateBf16I8, pg8::StaticOrder, true, true, true>(lds, g, S, E, wave);
    }
    SEAM(4);
#pragma nounroll
    for (int rep_ = 0; rep_ < REP5; ++rep_) { if (rep_) xcd_barrier(bar);
    if (IN(5)) { FRESH_IDS(); norm_rows_bf16(X1B, g_norm2, mod, 3 * DM, 4 * DM, H8, SH, gw, NGW, lane); }
    }
    SEAM(5);
#if REP6 > 1
    if (IN(6)) {
        pg8::Gemm g{(const bf16_t*)H8, (const bf16_t*)WPQ, MTOK, DM, DM / 2}; pg8::StaticOrder S; S.init(MTOK, DM, G, bx);
        pg8::EpiScoresI8 E{QP, MTOK, SH, ctl + CW_CMX_PQ};
        pg8::gemm_phase<pg8::EpiScoresI8, pg8::StaticOrder, true, true, true>(lds, g, S, E, wave);
    }
    xcd_barrier(bar);
#endif
    if (IN(6)) {
        pg8::Gemm g{(const bf16_t*)H8, (const bf16_t*)WPQ, MTOK, DM, DM / 2}; pg8::StaticOrder S; S.init(MTOK, DM, G, bx);
        pg8::EpiScoresI8 E{QP, MTOK, SH, ctl + CW_CMX_PQ};
        pg8::gemm_phase<pg8::EpiScoresI8, pg8::StaticOrder, true, true, true>(lds, g, S, E, wave);
    }
    SEAM(6);
    if (IN(7)) { FRESH_IDS();
        for (int chunk = bx; chunk < MTOK / 128; chunk += G) peer_chunk(chunk * 128, QP, SK, H8, SH, UB, SU, VB, mod, X1B, out, lds, tid, wave, lane);
    }
#undef IN
#undef SEAM
}

extern "C" void kernel_launch(void* const* d_in, const int* in_sizes, int n_in, void* d_out, int out_size, void* d_ws, size_t ws_size, hipStream_t stream) {
    static int grid = 0;
    if (grid == 0) {
        if (n_in != 18 || in_sizes[0] != MTOK * DM || out_size != MTOK * DM || ws_size < WS_END) { fprintf(stderr, "kernel_launch: unexpected shapes (n_in %d, in0 %d, out %d, ws %zu)\n", n_in, n_in > 0 ? in_sizes[0] : -1, out_size, ws_size); grid = -1; return; }
        int dev = 0, cus = 0, per_cu = 0;
        if (hipGetDevice(&dev) != hipSuccess || hipDeviceGetAttribute(&cus, hipDeviceAttributeMultiprocessorCount, dev) != hipSuccess) { grid = -1; return; }
        if (hipFuncSetAttribute((const void*)hymba_fwd, hipFuncAttributeMaxDynamicSharedMemorySize, LDS_BYTES) != hipSuccess) { fprintf(stderr, "kernel_launch: hipFuncSetAttribute failed\n"); grid = -1; return; }
        if (hipOccupancyMaxActiveBlocksPerMultiprocessor(&per_cu, (const void*)hymba_fwd, NWAVES * 64, LDS_BYTES) != hipSuccess || per_cu < 1) { fprintf(stderr, "kernel_launch: occupancy query says %d blocks per CU\n", per_cu); per_cu = 1; }
        (void)hipGetLastError();
        grid = cus;
    }
    if (grid < 0) return;
    (void)hipMemsetAsync((char*)d_ws + WS_CTL, 0, CTL_ZERO_BYTES, stream);
    Args a{};
    for (int i = 0; i < 18; ++i) a.in[i] = (const float*)d_in[i];
    a.out = (float*)d_out; a.ws = (unsigned char*)d_ws;
    if (MK_N_LAUNCHES == 1) {
        a.ph_lo = 0; a.ph_hi = N_PHASES;
        hipLaunchKernelGGL(hymba_fwd, dim3(grid), dim3(NWAVES * 64), LDS_BYTES, stream, a);
    } else {
        for (int p = 0; p < N_PHASES; ++p) { a.ph_lo = p; a.ph_hi = p + 1; hipLaunchKernelGGL(hymba_fwd, dim3(grid), dim3(NWAVES * 64), LDS_BYTES, stream, a); }
    }
}
```
